# Optimizing an MI355X kernel written in HIP

```python
import jax, jax.numpy as jnp
from jax import lax
import numpy as np

D_MODEL = 1024
BATCH = 4
SEQ = 8192
DEPTH = 2

CTX_LEN = 256
GRID_W = 64
CHUNK = GRID_W
D_MIX = D_MODEL
M_W = D_MIX // 2
M_H = 4
M_DH = M_W // M_H
F_W = D_MIX // 4
F_G = 4
C_W = D_MIX // 4
C_G = 4
CONV_K = 31
FFN_HIDDEN = 2816
N_EXPERTS = 8
TOP_K = 2
EPS = 1e-6
N_DENSE = (DEPTH + 1) // 2
N_MOE = DEPTH // 2

O_Q = 0
O_K = O_Q + M_W
O_V = O_K + M_W
O_O = O_V + M_W
O_G = O_O + M_W
O_F = O_G + 4 * M_H
O_CU = O_F + F_W
O_CG = O_CU + C_W
P_IN = O_CG + C_W

kernel_name = "hybrid_mlstm_fourier_conformer_moe_dit"


def rmsnorm(x, g):
    xf = x.astype(jnp.float32)
    y = xf * lax.rsqrt(jnp.mean(xf * xf, axis=-1, keepdims=True) + EPS) * g.astype(jnp.float32)
    return y.astype(x.dtype)


def ada_modulation(cond, w_mod, b_mod):
    return jnp.split(jax.nn.silu(cond) @ w_mod + b_mod, 6, axis=-1)


def modulate(h, shift, scale):
    return h * (1 + scale) + shift


def mlstm_inputs(p, b_gate):
    bsz, n, _ = p.shape
    def heads(a):
        return jnp.transpose(a.reshape(bsz, n, M_H, M_DH), (0, 2, 1, 3)).astype(jnp.float32)
    q = heads(p[..., O_Q:O_K])
    k = heads(p[..., O_K:O_V]) * (M_DH ** -0.5)
    v = heads(p[..., O_V:O_O])
    o = p[..., O_O:O_G]
    g = p[..., O_G:O_F].reshape(bsz, n, 4, M_H) + b_gate.reshape(4, M_H)
    g = jnp.transpose(g, (2, 0, 3, 1)).astype(jnp.float32)
    return q, k, v, o, g


def mlstm_init_state(bsz):
    return (jnp.zeros((bsz, M_H, M_DH, M_DH), jnp.float32),
            jnp.zeros((bsz, M_H, M_DH), jnp.float32),
            jnp.full((bsz, M_H), -1e30, jnp.float32))


def mlstm_chunk_scan(q, k, v, ig, lf, state):
    bsz, nh, n, d = q.shape
    rows = n // CHUNK
    def to_chunks(a):
        return jnp.moveaxis(a.reshape(bsz, nh, rows, CHUNK, *a.shape[3:]), 2, 0)
    tril = jnp.tril(jnp.ones((CHUNK, CHUNK), dtype=bool))

    def step(carry, xs):
        c0, n0, m0 = carry
        qc, kc, vc, igc, lfc = xs
        bcum = jnp.cumsum(lfc, axis=-1)
        dmat = jnp.where(tril, bcum[..., :, None] - bcum[..., None, :] + igc[..., None, :], -jnp.inf)
        m_inter = bcum + m0[..., None]
        m_t = jnp.maximum(m_inter, jnp.max(dmat, axis=-1))
        s = jnp.einsum('bhtd,bhsd->bhts', qc, kc) * jnp.exp(dmat - m_t[..., None])
        inter = jnp.exp(m_inter - m_t)
        num = jnp.einsum('bhts,bhse->bhte', s, vc) + inter[..., None] * jnp.einsum('bhtd,bhde->bhte', qc, c0)
        den = jnp.sum(s, axis=-1) + inter * jnp.einsum('bhtd,bhd->bht', qc, n0)
        h = num / jnp.maximum(jnp.abs(den), jnp.exp(-m_t))[..., None]
        b_last = bcum[..., -1]
        gs = b_last[..., None] - bcum + igc
        m_new = jnp.maximum(b_last + m0, jnp.max(gs, axis=-1))
        wk = jnp.exp(gs - m_new[..., None])
        decay = jnp.exp(b_last + m0 - m_new)
        c_new = decay[..., None, None] * c0 + jnp.einsum('bhs,bhsd,bhse->bhde', wk, kc, vc)
        n_new = decay[..., None] * n0 + jnp.einsum('bhs,bhsd->bhd', wk, kc)
        return (c_new, n_new, m_new), h

    state, hs = lax.scan(step, state, (to_chunks(q), to_chunks(k), to_chunks(v), to_chunks(ig), to_chunks(lf)))
    return jnp.moveaxis(hs, 0, 2).reshape(bsz, nh, n, d), state


def flip_seq(a):
    return jnp.flip(a, axis=2)


def mlstm_output(h_sum, o, norm_g):
    bsz, _, n, _ = h_sum.shape
    h = jnp.swapaxes(h_sum, 1, 2)
    h = h * lax.rsqrt(jnp.mean(h * h, axis=-1, keepdims=True) + EPS) * norm_g.reshape(M_H, M_DH).astype(jnp.float32)
    return (jax.nn.sigmoid(o.astype(jnp.float32)) * h.reshape(bsz, n, M_W)).astype(o.dtype)


def bidir_scan(q, k, v, g, init_f, init_b):
    h_f, s_f = mlstm_chunk_scan(q, k, v, g[0], jax.nn.log_sigmoid(g[1]), init_f)
    h_b, s_b = mlstm_chunk_scan(flip_seq(q), flip_seq(k), flip_seq(v), flip_seq(g[2]),
                                flip_seq(jax.nn.log_sigmoid(g[3])), init_b)
    return h_f + flip_seq(h_b), s_f, s_b


def mlstm_mixer(p_lat, p_ctx, b_gate, norm_g, need_ctx):
    ql, kl, vl, ol, gl = mlstm_inputs(p_lat, b_gate)
    qc, kc, vc, oc, gc = mlstm_inputs(p_ctx, b_gate)
    s0 = mlstm_init_state(p_lat.shape[0])
    h_ctx, s_f, s_b = bidir_scan(qc, kc, vc, gc, s0, s0)
    h_lat, _, _ = bidir_scan(ql, kl, vl, gl, s_f, s_b)
    y_lat = mlstm_output(h_lat, ol, norm_g)
    y_ctx = mlstm_output(h_ctx, oc, norm_g) if need_ctx else None
    return y_lat, y_ctx


def fourier_mix(u):
    bsz, n, _ = u.shape
    z = u.astype(jnp.float32).reshape(bsz, n, F_G, F_W // F_G)
    y = jnp.real(jnp.fft.fftn(z, axes=(1, 3), norm="ortho"))
    return y.reshape(bsz, n, F_W).astype(u.dtype)


def conv_module(u, g, dw, db, ln_g, ln_b):
    bsz, n, _ = u.shape
    a = u * jax.nn.sigmoid(g)
    y = lax.conv_general_dilated(a, dw[:, None, :], window_strides=(1,),
                                 padding=[(CONV_K // 2, CONV_K // 2)],
                                 dimension_numbers=('NWC', 'WIO', 'NWC'),
                                 feature_group_count=C_W) + db
    yf = y.astype(jnp.float32).reshape(bsz, n, C_G, C_W // C_G)
    mu = jnp.mean(yf, axis=-1, keepdims=True)
    var = jnp.mean(jnp.square(yf - mu), axis=-1, keepdims=True)
    yf = ((yf - mu) * lax.rsqrt(var + EPS)).reshape(bsz, n, C_W) * ln_g.astype(jnp.float32) + ln_b.astype(jnp.float32)
    return jax.nn.silu(yf).astype(u.dtype)


def merge_heads(p, y_mlstm, dw, db, ln_g, ln_b, w_out):
    y_f = fourier_mix(p[..., O_F:O_CU])
    y_c = conv_module(p[..., O_CU:O_CG], p[..., O_CG:P_IN], dw, db, ln_g, ln_b)
    return jnp.concatenate([y_mlstm, y_f, y_c], axis=-1) @ w_out


def swiglu(h, w_gate_up, w_down):
    gt, up = jnp.split(h @ w_gate_up, 2, axis=-1)
    return (jax.nn.silu(gt) * up) @ w_down


def moe_swiglu(h, w_router, b_router, w_gate_up, w_down):
    logits = (h @ w_router).astype(jnp.float32) + b_router.astype(jnp.float32)
    top_v, top_i = lax.top_k(logits, TOP_K)
    top_w = jax.nn.softmax(top_v, axis=-1)
    gates = jnp.sum(jax.nn.one_hot(top_i, N_EXPERTS, dtype=jnp.float32) * top_w[..., None], axis=-2).astype(h.dtype)
    y = jnp.zeros_like(h)
    for e in range(N_EXPERTS):
        y = y + gates[..., e:e + 1] * swiglu(h, w_gate_up[e], w_down[e])
    return y


def channel_mixer(h, layer, ffn_w_gate_up, ffn_w_down, moe_w_router, moe_b_router, moe_w_gate_up, moe_w_down):
    idx = layer // 2
    if layer % 2 == 0:
        return swiglu(h, ffn_w_gate_up[idx], ffn_w_down[idx])
    return moe_swiglu(h, moe_w_router[idx], moe_b_router[idx], moe_w_gate_up[idx], moe_w_down[idx])


def setup_inputs(seed: int = 0) -> dict:
    key = jax.random.key(seed)
    ks = jax.random.split(key, 26)
    D = D_MODEL
    def nrm(k, shape, s):
        return jax.random.normal(k, shape, jnp.float32) * s
    f_bias = jnp.linspace(3.0, 6.0, M_H, dtype=jnp.float32)
    b_gate = jnp.concatenate([
        nrm(ks[9], (DEPTH, M_H), 0.1),
        f_bias + nrm(ks[10], (DEPTH, M_H), 0.1),
        nrm(ks[11], (DEPTH, M_H), 0.1),
        f_bias + nrm(ks[12], (DEPTH, M_H), 0.1)], axis=-1)
    return {
        "x": nrm(ks[0], (BATCH, SEQ, D), 1.0),
        "c": nrm(ks[1], (BATCH, D), 1.0),
        "ctx": nrm(ks[2], (BATCH, CTX_LEN, D), 1.0),
        "c_ctx": nrm(ks[3], (D,), 1.0),
        "norm1_g": 1.0 + nrm(ks[4], (DEPTH, D), 0.02),
        "norm2_g": 1.0 + nrm(ks[5], (DEPTH, D), 0.02),
        "w_mod": nrm(ks[6], (DEPTH, D, 6 * D), 0.5 * D ** -0.5),
        "b_mod": nrm(ks[7], (DEPTH, 6 * D), 0.02),
        "w_in": nrm(ks[8], (DEPTH, D, P_IN), D ** -0.5),
        "b_gate": b_gate,
        "mlstm_norm_g": 1.0 + nrm(ks[13], (DEPTH, M_W), 0.02),
        "conv_dw": nrm(ks[14], (DEPTH, CONV_K, C_W), CONV_K ** -0.5),
        "conv_db": nrm(ks[15], (DEPTH, C_W), 0.02),
        "conv_norm_g": 1.0 + nrm(ks[16], (DEPTH, C_W), 0.02),
        "conv_norm_b": nrm(ks[17], (DEPTH, C_W), 0.02),
        "w_out": nrm(ks[18], (DEPTH, D_MIX, D), D_MIX ** -0.5),
        "ffn_w_gate_up": nrm(ks[19], (N_DENSE, D, 2 * FFN_HIDDEN), D ** -0.5),
        "ffn_w_down": nrm(ks[20], (N_DENSE, FFN_HIDDEN, D), FFN_HIDDEN ** -0.5),
        "moe_w_router": nrm(ks[21], (N_MOE, D, N_EXPERTS), D ** -0.5),
        "moe_b_router": nrm(ks[22], (N_MOE, N_EXPERTS), 0.01),
        "moe_w_gate_up": nrm(ks[23], (N_MOE, N_EXPERTS, D, 2 * FFN_HIDDEN), D ** -0.5),
        "moe_w_down": nrm(ks[24], (N_MOE, N_EXPERTS, FFN_HIDDEN, D), FFN_HIDDEN ** -0.5),
        "final_norm_g": 1.0 + nrm(ks[25], (D,), 0.02),
    }


def reference(x, c, ctx, c_ctx, norm1_g, norm2_g, w_mod, b_mod, w_in, b_gate, mlstm_norm_g,
              conv_dw, conv_db, conv_norm_g, conv_norm_b, w_out, ffn_w_gate_up, ffn_w_down,
              moe_w_router, moe_b_router, moe_w_gate_up, moe_w_down, final_norm_g):
    xc = ctx
    for layer in range(DEPTH):
        need_ctx = layer < DEPTH - 1
        sh1, sc1, g1, sh2, sc2, g2 = [m[:, None, :] for m in ada_modulation(c, w_mod[layer], b_mod[layer])]
        csh1, csc1, cg1, csh2, csc2, cg2 = ada_modulation(c_ctx, w_mod[layer], b_mod[layer])

        px = modulate(rmsnorm(x, norm1_g[layer]), sh1, sc1) @ w_in[layer]
        pc = modulate(rmsnorm(xc, norm1_g[layer]), csh1, csc1) @ w_in[layer]
        m_lat, m_ctx = mlstm_mixer(px, pc, b_gate[layer], mlstm_norm_g[layer], need_ctx)
        x = x + g1 * merge_heads(px, m_lat, conv_dw[layer], conv_db[layer], conv_norm_g[layer],
                                 conv_norm_b[layer], w_out[layer])
        if need_ctx:
            xc = xc + cg1 * merge_heads(pc, m_ctx, conv_dw[layer], conv_db[layer], conv_norm_g[layer],
                                        conv_norm_b[layer], w_out[layer])

        hx = modulate(rmsnorm(x, norm2_g[layer]), sh2, sc2)
        x = x + g2 * channel_mixer(hx, layer, ffn_w_gate_up, ffn_w_down, moe_w_router, moe_b_router,
                                   moe_w_gate_up, moe_w_down)
        if need_ctx:
            hc = modulate(rmsnorm(xc, norm2_g[layer]), csh2, csc2)
            xc = xc + cg2 * channel_mixer(hc, layer, ffn_w_gate_up, ffn_w_down, moe_w_router, moe_b_router,
                                          moe_w_gate_up, moe_w_down)
    return rmsnorm(x, final_norm_g)
```

```cpp
#include <hip/hip_runtime.h>
#include <cstdio>
#include <cstdint>
namespace pg8 {
#define PG8_LAS __attribute__((address_space(3)))
typedef unsigned short bf16_t;
typedef short bf16x8 __attribute__((ext_vector_type(8)));
typedef float f32x4 __attribute__((ext_vector_type(4)));
typedef unsigned u32x4 __attribute__((ext_vector_type(4)));
constexpr int BM = 256, BK = 64, HALF = 128, HTB = HALF * BK * 2  , STAGE_BYTES = 8 * HTB, NXCD = 8, WGM = 8;

__host__ __device__ __forceinline__ int lds_byte(int r, int c) { const int st = (r >> 4) * 2 + (c >> 5), rr = r & 15, cc = c & 31, ob = rr * 64 + cc * 2; return st * 1024 + (ob ^ (((ob >> 9) & 1) << 5)); }
__host__ __device__ __forceinline__ void stage_rc(int b, int& R, int& C) { const int st = b / 1024, sb = b % 1024, swz = sb ^ (((sb >> 9) & 1) << 5); R = (st >> 1) * 16 + swz / 64; C = (st & 1) * 32 + (swz % 64) / 2; }
__host__ __device__ __forceinline__ int perm32(int rho) { const int n = rho >> 4, i = rho & 15; return 8 * (i >> 2) + 4 * n + (i & 3); }

struct Unit { int pm, pn; };
struct Gemm { const bf16_t* A; const bf16_t* Bt; int M, N, K; };

struct StaticOrder {
    int nM, nN, nwg, G, c;
    __host__ __device__ void init(int M, int N, int G_, int c_) { nM = M / BM; nN = N / BM; nwg = nM * nN; G = G_; c = c_; }
    __host__ __device__ bool next(int i, Unit& u) const {
        const long L = (long)i * G + c; if (L >= nwg) return false;
        int wgid = (int)L; { const int q = nwg / NXCD, r = nwg % NXCD, xcd = wgid % NXCD, off = wgid / NXCD; wgid = (xcd < r ? xcd * (q + 1) : r * (q + 1) + (xcd - r) * q) + off; }
        const int nig = WGM * nN, gid = wgid / nig, fm = gid * WGM, gsz = (nM - fm) < WGM ? (nM - fm) : WGM;
        u.pm = fm + ((wgid % nig) % gsz); u.pn = (wgid % nig) / gsz; return true;
    }
    __device__ __forceinline__ void a_ready(const Unit&) const {}
    __device__ __forceinline__ void done(const Unit&) const {}
};

__device__ __forceinline__ unsigned cvt_pk_bf16(float lo, float hi) { unsigned r; asm volatile("v_cvt_pk_bf16_f32 %0, %1, %2" : "=v"(r) : "v"(lo), "v"(hi)); return r; }
__device__ __forceinline__ float silu_f(float x) { return x / (1.0f + __expf(-x)); }
struct EpiP {
    static constexpr bool PERM = true, AFTER_DRAIN = false;
    bf16_t* P; float* G;
    __device__ __forceinline__ void operator()(const f32x4 (&acc)[2][2][4][2], const Unit& u, int wr, int wc, int fr, int fq) const {
        const int row0 = u.pm * BM + wr * 64 + fr, col0 = u.pn * BM + wc * 32 + 8 * fq;
#pragma unroll
        for (int ai = 0; ai < 2; ++ai)
#pragma unroll
            for (int m = 0; m < 4; ++m) { bf16_t* rowp = P + (size_t)(row0 + ai * HALF + m * 16) * 3072 + col0;
#pragma unroll
                for (int bj = 0; bj < 2; ++bj) { const f32x4 v0 = acc[ai][bj][m][0], v1 = acc[ai][bj][m][1];
                    u32x4 w; w.x = cvt_pk_bf16(v0[0], v0[1]); w.y = cvt_pk_bf16(v0[2], v0[3]); w.z = cvt_pk_bf16(v1[0], v1[1]); w.w = cvt_pk_bf16(v1[2], v1[3]);
                    *(u32x4*)(rowp + bj * HALF) = w; } }
        if (u.pn == 11 && wc == 0 && fq < 2) {
#pragma unroll
            for (int ai = 0; ai < 2; ++ai)
#pragma unroll
                for (int m = 0; m < 4; ++m) { float* gp = G + (size_t)(row0 + ai * HALF + m * 16) * 16 + 8 * fq;
                    *(f32x4*)gp = acc[ai][0][m][0]; *(f32x4*)(gp + 4) = acc[ai][0][m][1]; }
        }
    }
};
struct EpiRes {
    static constexpr bool PERM = false, AFTER_DRAIN = false;
    const float* base_lat; float* out_lat; const float* base_ctx; float* out_ctx; const float* gate;
    __device__ __forceinline__ void operator()(const f32x4 (&acc)[2][2][4][2], const Unit& u, int wr, int wc, int fr, int fq) const {
        const bool lat = u.pm < 128;
        const float* base = lat ? base_lat + (size_t)u.pm * BM * 1024 : base_ctx + (size_t)(u.pm - 128) * BM * 1024;
        float* out = lat ? out_lat + (size_t)u.pm * BM * 1024 : out_ctx + (size_t)(u.pm - 128) * BM * 1024;
        const float* gv = gate + (size_t)(lat ? (u.pm >> 5) : 4) * 6144;
        const int row0 = wr * 64 + fr, col0 = u.pn * BM + wc * 32 + 4 * fq;
        f32x4 g4[2][2];
#pragma unroll
        for (int bj = 0; bj < 2; ++bj)
#pragma unroll
            for (int n = 0; n < 2; ++n) g4[bj][n] = *(const f32x4*)(gv + col0 + bj * HALF + n * 16);
#pragma unroll
        for (int ai = 0; ai < 2; ++ai)
#pragma unroll
            for (int m = 0; m < 4; ++m) { const size_t off = (size_t)(row0 + ai * HALF + m * 16) * 1024 + col0;
#pragma unroll
                for (int bj = 0; bj < 2; ++bj)
#pragma unroll
                    for (int n = 0; n < 2; ++n) { const f32x4 b = *(const f32x4*)(base + off + bj * HALF + n * 16);
                        *(f32x4*)(out + off + bj * HALF + n * 16) = b + g4[bj][n] * acc[ai][bj][m][n]; }
                asm volatile("" ::: "memory"); }
    }
};
struct EpiSwiglu {
    static constexpr bool PERM = true, AFTER_DRAIN = false;
    bf16_t* H;
    __device__ __forceinline__ void operator()(const f32x4 (&acc)[2][2][4][2], const Unit& u, int wr, int wc, int fr, int fq) const {
        const int row0 = u.pm * BM + wr * 64 + fr, col0 = (u.pn % 22) * HALF + wc * 32 + 8 * fq;
#pragma unroll
        for (int ai = 0; ai < 2; ++ai)
#pragma unroll
            for (int m = 0; m < 4; ++m) { bf16_t* rowp = H + (size_t)(row0 + ai * HALF + m * 16) * 2816 + col0;
                float h[8];
#pragma unroll
                for (int n = 0; n < 2; ++n)
#pragma unroll
                    for (int j = 0; j < 4; ++j) h[4 * n + j] = silu_f(acc[ai][0][m][n][j]) * acc[ai][1][m][n][j];
                u32x4 w; w.x = cvt_pk_bf16(h[0], h[1]); w.y = cvt_pk_bf16(h[2], h[3]); w.z = cvt_pk_bf16(h[4], h[5]); w.w = cvt_pk_bf16(h[6], h[7]);
                *(u32x4*)rowp = w; }
    }
};
struct EpiMoeDown {
    static constexpr bool PERM = true, AFTER_DRAIN = false;
    bf16_t* O; const float* roww;
    __device__ __forceinline__ void operator()(const f32x4 (&acc)[2][2][4][2], const Unit& u, int wr, int wc, int fr, int fq) const {
        const int row0 = u.pm * BM + wr * 64 + fr, col0 = (u.pn & 3) * BM + wc * 32 + 8 * fq;
#pragma unroll
        for (int ai = 0; ai < 2; ++ai)
#pragma unroll
            for (int m = 0; m < 4; ++m) { const int r = row0 + ai * HALF + m * 16; const float s = roww[r]; bf16_t* rowp = O + (size_t)r * 1024 + col0;
#pragma unroll
                for (int bj = 0; bj < 2; ++bj) { const f32x4 v0 = acc[ai][bj][m][0] * s, v1 = acc[ai][bj][m][1] * s;
                    u32x4 w; w.x = cvt_pk_bf16(v0[0], v0[1]); w.y = cvt_pk_bf16(v0[2], v0[3]); w.z = cvt_pk_bf16(v1[0], v1[1]); w.w = cvt_pk_bf16(v1[2], v1[3]);
                    *(u32x4*)(rowp + bj * HALF) = w; } }
    }
};
struct MoeOrder : StaticOrder {
    const int* tile_e; int nNe;
    __device__ void init_moe(int nTiles, int nNe_, const int* te, int G_, int c_) { nM = nTiles; nN = nNe_; nwg = nM * nN; G = G_; c = c_; tile_e = te; nNe = nNe_; }
    __device__ bool next(int i, Unit& u) const { if (!StaticOrder::next(i, u)) return false; u.pn += tile_e[u.pm] * nNe; return true; }
};
template <class Epi, class Sched, bool ALIGN_EPI = false, bool SP2 = false>
__device__ __forceinline__ void gemm_phase(PG8_LAS unsigned char* lds, const Gemm g, const Sched& S, const Epi& E) {
    const int tid = threadIdx.x, wid = __builtin_amdgcn_readfirstlane(tid >> 6), lane = tid & 63, wr = wid >> 2, wc = wid & 3, fr = lane & 15, fq = lane >> 4;
    const int K = g.K, nt = K / BK;
    unsigned voffA[2], voffB[2];
#pragma unroll
    for (int i = 0; i < 2; ++i) { int R, C; stage_rc(tid * 16 + i * 8192, R, C); const int Rb = Epi::PERM ? ((R & ~31) + perm32(R & 31)) : R;
        voffA[i] = (unsigned)(R * K + C) * 2u; voffB[i] = (unsigned)(Rb * K + C) * 2u; }
    const size_t kstep = (size_t)(BK * 2);
    const size_t hstep = (size_t)HALF * K * 2;
    const size_t tstep = 2 * hstep;
    const unsigned ldsw = (unsigned)wid * 1024u;
    const int aoff = lds_byte(wr * 64 + fr, fq * 8), boff = lds_byte(wc * 32 + fr, fq * 8);
#define PG8_SA(b, h) (((b) * 2 + (h)) * HTB)
#define PG8_SB(b, h) ((4 + (b) * 2 + (h)) * HTB)
#define PG8_STAGE(bufoff, gbase, voff) do { _Pragma("unroll") for (int _i = 0; _i < 2; ++_i) \
        __builtin_amdgcn_global_load_lds((const unsigned*)((const char*)(gbase) + (voff)[_i]), (PG8_LAS unsigned*)(lds + (bufoff) + ldsw + _i * 8192), 16, 0, 0); } while (0)
#define PG8_LDA(dst, b, h) do { _Pragma("unroll") for (int m = 0; m < 4; ++m) _Pragma("unroll") for (int k = 0; k < 2; ++k) dst[m][k] = *(const PG8_LAS bf16x8*)(lds + PG8_SA(b, h) + aoff + m * 2048 + k * 1024); } while (0)
#define PG8_LDB(dst, b, h) do { _Pragma("unroll") for (int n = 0; n < 2; ++n) _Pragma("unroll") for (int k = 0; k < 2; ++k) dst[n][k] = *(const PG8_LAS bf16x8*)(lds + PG8_SB(b, h) + boff + n * 2048 + k * 1024); } while (0)
#define PG8_MMA(ai, bj, At, Bt) do { __builtin_amdgcn_s_setprio(1); _Pragma("unroll") for (int m = 0; m < 4; ++m) _Pragma("unroll") for (int n = 0; n < 2; ++n) _Pragma("unroll") for (int k = 0; k < 2; ++k) \
        acc[ai][bj][m][n] = __builtin_amdgcn_mfma_f32_16x16x32_bf16(Bt[n][k], At[m][k], acc[ai][bj][m][n], 0, 0, 0); __builtin_amdgcn_s_setprio(0); } while (0)
#define PG8_WAIT_V(n) asm volatile("s_waitcnt vmcnt(" #n ")" ::: "memory")
#define PG8_WAIT_L(n) asm volatile("s_waitcnt lgkmcnt(" #n ")" ::: "memory")
#define PG8_BAR __builtin_amdgcn_s_barrier()
#define PG8_SCHED __builtin_amdgcn_sched_barrier(0)
    Unit cur, nxt; int ui = 0;
    if (!S.next(0, cur)) return;
    f32x4 acc[2][2][4][2];
#pragma unroll
    for (int a = 0; a < 2; ++a)
#pragma unroll
        for (int b = 0; b < 2; ++b)
#pragma unroll
            for (int m = 0; m < 4; ++m)
#pragma unroll
                for (int n = 0; n < 2; ++n) acc[a][b][m][n] = (f32x4){0.f, 0.f, 0.f, 0.f};
    bf16x8 At[4][2], B0[2][2], B1[2][2];
    const char* cA = (const char*)g.A + (size_t)cur.pm * tstep; const char* cB = (const char*)g.Bt + (size_t)cur.pn * tstep;
    S.a_ready(cur);
    if constexpr (SP2) {
        PG8_STAGE(PG8_SB(0, 0), cB, voffB); PG8_STAGE(PG8_SB(0, 1), cB + hstep, voffB); PG8_STAGE(PG8_SA(0, 0), cA, voffA); PG8_STAGE(PG8_SA(0, 1), cA + hstep, voffA);
        if (wr == 1) PG8_BAR;
        PG8_WAIT_V(2); PG8_BAR;
        PG8_STAGE(PG8_SB(1, 0), cB + kstep, voffB); PG8_STAGE(PG8_SA(1, 0), cA + kstep, voffA); PG8_STAGE(PG8_SB(1, 1), cB + hstep + kstep, voffB);
        PG8_WAIT_V(6); PG8_BAR;
    } else {
        PG8_STAGE(PG8_SB(0, 0), cB, voffB); PG8_STAGE(PG8_SA(0, 0), cA, voffA); PG8_STAGE(PG8_SB(0, 1), cB + hstep, voffB); PG8_STAGE(PG8_SA(0, 1), cA + hstep, voffA);
        if (wr == 1) PG8_BAR;
        PG8_WAIT_V(4); PG8_BAR;
        PG8_STAGE(PG8_SB(1, 0), cB + kstep, voffB); PG8_STAGE(PG8_SA(1, 0), cA + kstep, voffA); PG8_STAGE(PG8_SB(1, 1), cB + hstep + kstep, voffB);
        PG8_WAIT_V(6); PG8_BAR;
    }
    for (;;) {
        const bool has_next = S.next(ui + 1, nxt);
        const char* nA = has_next ? (const char*)g.A + (size_t)nxt.pm * tstep : cA; const char* nB = has_next ? (const char*)g.Bt + (size_t)nxt.pn * tstep : cB;
        for (int t = 0; t < nt; t += 2) {
            const bool last = (t == nt - 2);
            const char* a1 = cA + (size_t)(t + 1) * kstep;
            const char* a2 = last ? nA : cA + (size_t)(t + 2) * kstep; const char* b2 = last ? nB : cB + (size_t)(t + 2) * kstep;
            const char* a3 = a2 + kstep; const char* b3 = b2 + kstep;
            if (last && has_next) S.a_ready(nxt);
            if constexpr (SP2) {
            PG8_LDB(B0, 0, 0); PG8_LDB(B1, 0, 1); PG8_SCHED; PG8_LDA(At, 0, 0); PG8_STAGE(PG8_SA(1, 1), a1 + hstep, voffA);
            PG8_WAIT_V(8); PG8_WAIT_L(0); PG8_BAR; PG8_MMA(0, 0, At, B0); PG8_MMA(0, 1, At, B1); PG8_BAR; PG8_SCHED;
            PG8_LDA(At, 0, 1); PG8_STAGE(PG8_SB(0, 0), b2, voffB); PG8_STAGE(PG8_SB(0, 1), b2 + hstep, voffB); PG8_STAGE(PG8_SA(0, 0), a2, voffA);
            PG8_WAIT_V(8); PG8_WAIT_L(0); PG8_BAR; PG8_MMA(1, 0, At, B0); PG8_MMA(1, 1, At, B1); PG8_BAR; PG8_SCHED;
            PG8_LDB(B0, 1, 0); PG8_LDB(B1, 1, 1); PG8_SCHED; PG8_LDA(At, 1, 0); PG8_STAGE(PG8_SA(0, 1), a2 + hstep, voffA);
            PG8_WAIT_V(8); PG8_WAIT_L(0); PG8_BAR; PG8_MMA(0, 0, At, B0); PG8_MMA(0, 1, At, B1); PG8_BAR; PG8_SCHED;
            PG8_LDA(At, 1, 1); PG8_STAGE(PG8_SB(1, 0), b3, voffB); PG8_STAGE(PG8_SB(1, 1), b3 + hstep, voffB); PG8_STAGE(PG8_SA(1, 0), a3, voffA);
            PG8_WAIT_V(8); PG8_WAIT_L(0); PG8_BAR; PG8_MMA(1, 0, At, B0); PG8_MMA(1, 1, At, B1); PG8_BAR; PG8_SCHED;
            } else {
            PG8_LDB(B0, 0, 0); PG8_SCHED; PG8_LDA(At, 0, 0); PG8_STAGE(PG8_SA(1, 1), a1 + hstep, voffA);
            PG8_WAIT_L(8); PG8_BAR; PG8_WAIT_L(0); PG8_MMA(0, 0, At, B0); PG8_BAR; PG8_SCHED;
            PG8_LDB(B1, 0, 1); PG8_STAGE(PG8_SB(0, 0), b2, voffB);
            PG8_BAR; PG8_WAIT_L(0); PG8_MMA(0, 1, At, B1); PG8_BAR;
            PG8_LDA(At, 0, 1); PG8_STAGE(PG8_SA(0, 0), a2, voffA);
            PG8_BAR; PG8_WAIT_L(0); PG8_MMA(1, 0, At, B0); PG8_BAR; PG8_SCHED;
            PG8_STAGE(PG8_SB(0, 1), b2 + hstep, voffB);
            PG8_WAIT_V(6); PG8_BAR; PG8_MMA(1, 1, At, B1); PG8_BAR;
            PG8_LDB(B0, 1, 0); PG8_SCHED; PG8_LDA(At, 1, 0); PG8_STAGE(PG8_SA(0, 1), a2 + hstep, voffA);
            PG8_WAIT_L(8); PG8_BAR; PG8_WAIT_L(0); PG8_MMA(0, 0, At, B0); PG8_BAR; PG8_SCHED;
            PG8_LDB(B1, 1, 1); PG8_STAGE(PG8_SB(1, 0), b3, voffB);
            PG8_BAR; PG8_WAIT_L(0); PG8_MMA(0, 1, At, B1); PG8_BAR;
            PG8_LDA(At, 1, 1); PG8_STAGE(PG8_SA(1, 0), a3, voffA);
            PG8_BAR; PG8_WAIT_L(0); PG8_MMA(1, 0, At, B0); PG8_BAR; PG8_SCHED;
            PG8_STAGE(PG8_SB(1, 1), b3 + hstep, voffB);
            PG8_WAIT_V(6); PG8_BAR; PG8_MMA(1, 1, At, B1); PG8_BAR;
            }
        }
        if constexpr (ALIGN_EPI) { if (wr == 0) PG8_BAR; }
        if constexpr (!Epi::AFTER_DRAIN) { E(acc, cur, wr, wc, fr, fq); S.done(cur); }
        if (!has_next) break;
#pragma unroll
        for (int a = 0; a < 2; ++a)
#pragma unroll
            for (int b = 0; b < 2; ++b)
#pragma unroll
                for (int m = 0; m < 4; ++m)
#pragma unroll
                    for (int n = 0; n < 2; ++n) acc[a][b][m][n] = (f32x4){0.f, 0.f, 0.f, 0.f};
        cur = nxt; cA = nA; cB = nB; ++ui;
        if constexpr (ALIGN_EPI) { if (wr == 1) PG8_BAR; }
    }
    PG8_WAIT_V(0);
    if constexpr (!ALIGN_EPI) { if (wr == 0) PG8_BAR; }
    PG8_BAR;
    if constexpr (Epi::AFTER_DRAIN) { E.fused(acc, cur, wr, wc, fr, fq, lds, wid, lane); S.done(cur); }
#undef PG8_SA
#undef PG8_SB
#undef PG8_STAGE
#undef PG8_LDA
#undef PG8_LDB
#undef PG8_MMA
#undef PG8_WAIT_V
#undef PG8_WAIT_L
#undef PG8_BAR
#undef PG8_SCHED
}
}
using pg8::silu_f;

constexpr int D = 1024, BATCH = 4, SEQ = 8192, CTXL = 256, NLAT = BATCH * SEQ, NCTX = BATCH * CTXL, MROWS = NLAT + NCTX;
constexpr int PIN_SRC = 2832, PLD = 3072, FFH = 2816, NEXP = 8;
constexpr int PO_Q = 0, PO_K = 512, PO_V = 1024, PO_O = 1536, PO_F = 2048, PO_CU = 2304, PO_CG = 2560;
constexpr float EPS = 1e-6f;
constexpr int NWAVES = 8, NTHR = 512;
constexpr size_t MiB = 1u << 20;
constexpr size_t WS_CTL = 0, CTL_ZERO_BYTES = 1 * MiB;
constexpr size_t WS_MOD = 1 * MiB;
constexpr size_t WS_ROUTE = 1 * MiB + 512 * 1024;
constexpr size_t WS_WIN = 2 * MiB;
constexpr size_t WS_WOUT = 14 * MiB;
constexpr size_t WS_WGU = 18 * MiB;
constexpr size_t WS_WD = 29 * MiB;
constexpr size_t WS_MWGU = 35 * MiB;
constexpr size_t WS_MWD = 123 * MiB;
constexpr size_t WS_G = 167 * MiB;
constexpr size_t WS_XC = 170 * MiB;
constexpr size_t WS_TOK = 174 * MiB;
constexpr size_t WS_R1 = 176 * MiB;
constexpr size_t WS_Y = WS_R1, WS_HF = WS_R1 + 66 * MiB, WS_ASORT = WS_R1, WS_OPAIR = WS_R1;
constexpr size_t WS_R2 = 308 * MiB;
constexpr size_t WS_P = WS_R2, WS_H = WS_R2, WS_A = WS_R2 + 198 * MiB, WS_HB = WS_R2 + 264 * MiB, WS_HSORT = WS_R2;
constexpr size_t WS_END = 671 * MiB;
constexpr int MAXPAIR = 2 * NLAT + NEXP * 256;
static_assert(WS_WIN + (size_t)2 * PLD * D * 2 <= WS_WOUT && WS_WOUT + (size_t)2 * D * D * 2 <= WS_WGU && WS_WGU + (size_t)2 * FFH * D * 2 <= WS_WD && WS_WD + (size_t)D * FFH * 2 <= WS_MWGU, "ws map 1");
static_assert(WS_MWGU + (size_t)NEXP * 2 * FFH * D * 2 <= WS_MWD && WS_MWD + (size_t)NEXP * D * FFH * 2 <= WS_G && WS_G + (size_t)MROWS * 16 * 4 <= WS_XC && WS_XC + (size_t)NCTX * D * 4 <= WS_TOK, "ws map 2");
static_assert(WS_TOK + 3 * 256 * 1024 + (size_t)MAXPAIR * 4 * 2 <= WS_R1 && WS_Y + (size_t)MROWS * D * 2 <= WS_HF && WS_HF + (size_t)MROWS * 512 * 4 <= WS_R2 && WS_ASORT + (size_t)MAXPAIR * D * 2 <= WS_R2, "ws map 3");
static_assert(WS_P + (size_t)MROWS * PLD * 2 <= WS_A && WS_A + (size_t)MROWS * D * 2 <= WS_HB && WS_HB + (size_t)MROWS * 512 * 4 <= WS_END && WS_HSORT + (size_t)MAXPAIR * FFH * 2 <= WS_END && WS_H + (size_t)MROWS * FFH * 2 <= WS_A, "ws map 4");
constexpr int CW_BAR = 4096;
constexpr int RW_HIST = 0;
constexpr int RW_TILE_E = 4096;
constexpr int RW_NTILES = 4096 + 512;
constexpr int LDS_STAGE = 131072, LDSCTL_OFF = LDS_STAGE, LDS_BYTES = 147456;

#define GAS __attribute__((address_space(1)))
#define LAS __attribute__((address_space(3)))
typedef unsigned short bf16;
typedef unsigned v4u __attribute__((ext_vector_type(4)));
typedef unsigned v2u __attribute__((ext_vector_type(2)));
typedef float f32x4 __attribute__((ext_vector_type(4)));
__device__ __forceinline__ unsigned f2bf(float f) { unsigned u = __builtin_bit_cast(unsigned, f); return (u + 0x7fffu + ((u >> 16) & 1u)) >> 16; }
__device__ __forceinline__ unsigned pk2(float lo, float hi) { return f2bf(lo) | (f2bf(hi) << 16); }
__device__ __forceinline__ float bf2f(unsigned short b) { return __builtin_bit_cast(float, (unsigned)b << 16); }
__device__ __forceinline__ float bflo(unsigned w) { return __builtin_bit_cast(float, w << 16); }
__device__ __forceinline__ float bfhi(unsigned w) { return __builtin_bit_cast(float, w & 0xffff0000u); }
__device__ __forceinline__ float wave_sum(float v) {
#pragma unroll
    for (int o = 1; o < 64; o <<= 1) v += __shfl_xor(v, o);
    return v;
}
__device__ __forceinline__ float sigmoid_f(float x) { return 1.0f / (1.0f + __expf(-x)); }
__device__ __forceinline__ float log_sigmoid_f(float x) { return fminf(x, 0.0f) - log1pf(__expf(-fabsf(x))); }

#define XB_TMO      128
#define XB_XCNT(j)  (256  + 64 * (j))
#define XB_XSUB(j)  (1280 + 64 * (j))
#define XB_XGEN(j)  (2304 + 64 * (j))
#define XB_TOP      3328
#define XB_TOPGEN   3392
#define XCD_BAR_WORDS 3456
#define XB_SPIN_CAP (1u << 18)
#define LAS __attribute__((address_space(3)))

__device__ __forceinline__ unsigned xb_ld(unsigned* p)              { return __hip_atomic_load(p, __ATOMIC_RELAXED, __HIP_MEMORY_SCOPE_AGENT); }
__device__ __forceinline__ unsigned xb_add(unsigned* p, unsigned v) { return __hip_atomic_fetch_add(p, v, __ATOMIC_RELAXED, __HIP_MEMORY_SCOPE_AGENT); }
__device__ __forceinline__ unsigned xb_xcc_id() { return (unsigned)__builtin_amdgcn_s_getreg((3 << 11) | 20) & 0xFu; }
#define XB_SPIN(cond, bar) do { unsigned _sp = 0; while (cond) { __builtin_amdgcn_s_sleep(1); \
    if ((++_sp & 255u) == 0u) { if (xb_ld(&(bar)[XB_TMO])) break; if (_sp > XB_SPIN_CAP) { atomicAdd(&(bar)[XB_TMO], 1u); break; } } } } while (0)

struct XcdBarrier {
    unsigned* bar; unsigned x;
    volatile LAS unsigned* st;
};

__device__ __forceinline__ XcdBarrier xcd_barrier_post(unsigned* bar, volatile LAS unsigned* st) {
    XcdBarrier b; b.bar = bar; b.x = xb_xcc_id(); b.st = st;
    if (threadIdx.x == 0) (void)xb_add(&bar[XB_XCNT(b.x)], 1u);
    return b;
}
__device__ __forceinline__ void xcd_barrier_complete(unsigned* bar, unsigned x, unsigned& nloc, unsigned& nx) {
    const unsigned G = gridDim.x * gridDim.y * gridDim.z;
    unsigned sum, cnt, mine, sp = 0u;
    for (;;) {
        sum = 0u; cnt = 0u; mine = 0u;
#pragma unroll
        for (unsigned j = 0; j < 16; ++j) { const unsigned c = xb_ld(&bar[XB_XCNT(j)]); sum += c; cnt += (c > 0u) ? 1u : 0u; mine = (j == x) ? c : mine; }
        if (sum == G) break;
        __builtin_amdgcn_s_sleep(1);
        if ((++sp & 255u) == 0u) { if (xb_ld(&bar[XB_TMO])) break; if (sp > XB_SPIN_CAP) { atomicAdd(&bar[XB_TMO], 1u); break; } }
    }
    nloc = mine > 0u ? mine : 1u; nx = cnt > 0u ? cnt : 1u;
}

__device__ __forceinline__ void xcd_barrier(const XcdBarrier& b) {
    asm volatile("s_waitcnt vmcnt(0)" ::: "memory");
    __syncthreads();
    if (threadIdx.x == 0) {
        unsigned* bar = b.bar;
        __builtin_amdgcn_s_waitcnt(0);
        unsigned nloc = b.st[0], nx = b.st[1];
        if (nloc == 0u) { xcd_barrier_complete(bar, b.x, nloc, nx); b.st[0] = nloc; b.st[1] = nx; }
        const unsigned old = xb_add(&bar[XB_XSUB(b.x)], 1u);
        const unsigned gen = old / nloc;
        if (old + 1u == (gen + 1u) * nloc) {
            __builtin_amdgcn_fence(__ATOMIC_RELEASE, "agent");
            asm volatile("s_waitcnt vmcnt(0)" ::: "memory");
            const unsigned og = xb_add(&bar[XB_TOP], 1u);
            const unsigned tg = og / nx;
            if (og + 1u == (tg + 1u) * nx) xb_add(&bar[XB_TOPGEN], 1u);
            else XB_SPIN(xb_ld(&bar[XB_TOPGEN]) == tg, bar);
            __builtin_amdgcn_fence(__ATOMIC_ACQUIRE, "agent");
            xb_add(&bar[XB_XGEN(b.x)], 1u);
            asm volatile("s_waitcnt vmcnt(0)" ::: "memory");
        } else {
            XB_SPIN(xb_ld(&bar[XB_XGEN(b.x)]) == gen, bar);
            __builtin_amdgcn_fence(__ATOMIC_ACQUIRE, "agent");
            asm volatile("s_waitcnt vmcnt(0)" ::: "memory");
        }
    }
    __syncthreads();
}
#define LDS_WAIT() asm volatile("s_waitcnt lgkmcnt(0)" ::: "memory")

__device__ __forceinline__ void transpose_item(const float* W, int K, int N, bf16* WT, int dst_row0, int src_col0, int nvalid, int kb, LAS float* scr, int lane) {
    const int k0 = 64 * kb, nl = lane & 31;
#pragma unroll 8
    for (int i = 0; i < 32; ++i) { const int kk = 2 * i + (lane >> 5); scr[kk * 33 + nl] = nl < nvalid ? W[(size_t)(k0 + kk) * N + src_col0 + nl] : 0.f; }
    LDS_WAIT();
    const int c = lane & 7;
#pragma unroll
    for (int j = 0; j < 4; ++j) { const int n = (lane >> 3) + 8 * j; const LAS float* s = scr + (8 * c) * 33 + n;
        v4u o; o.x = pk2(s[0 * 33], s[1 * 33]); o.y = pk2(s[2 * 33], s[3 * 33]); o.z = pk2(s[4 * 33], s[5 * 33]); o.w = pk2(s[6 * 33], s[7 * 33]);
        *(v4u*)(WT + (size_t)(dst_row0 + n) * K + k0 + 8 * c) = o; }
    LDS_WAIT();
}
__device__ __forceinline__ void win_map(int nb, int& src, int& nvalid) { const int v0 = 32 * nb; if (v0 < 2048) { src = v0; nvalid = 32; } else if (v0 < 2816) { src = v0 + 16; nvalid = 32; } else if (v0 == 2816) { src = 2048; nvalid = 16; } else { src = 0; nvalid = 0; } }
__device__ __forceinline__ int gu_map(int nb) { const int v0 = 32 * nb; return ((v0 >> 7) & 1) * FFH + (v0 >> 8) * 128 + (v0 & 127); }

__device__ __forceinline__ void prologue_phase(const float* const* in, unsigned char* ws, LAS unsigned char* lds, int wg, int G, int tid) {
    const int lane = tid & 63, wave = tid >> 6, gw = wg * NWAVES + wave, NGW = G * NWAVES;
    LAS float* scr = (LAS float*)(lds + wave * 16384);
    constexpr int I_WIN = 16 * 96, I_WOUT = 16 * 32, I_GU = 16 * 176, I_DN = 44 * 32;
    constexpr int NITEMS = 2 * I_WIN + 2 * I_WOUT + 9 * I_GU + 9 * I_DN;
    for (int it = gw; it < NITEMS; it += NGW) {
        int r = it;
        if (r < 2 * I_WIN) { const int L = r / I_WIN; r -= L * I_WIN; const int kb = r / 96, nb = r % 96; int src, nv; win_map(nb, src, nv);
            transpose_item(in[8] + (size_t)L * D * PIN_SRC, D, PIN_SRC, (bf16*)(ws + WS_WIN) + (size_t)L * PLD * D, 32 * nb, src, nv, kb, scr, lane); continue; }
        r -= 2 * I_WIN;
        if (r < 2 * I_WOUT) { const int L = r / I_WOUT; r -= L * I_WOUT; const int kb = r / 32, nb = r % 32;
            transpose_item(in[15] + (size_t)L * D * D, D, D, (bf16*)(ws + WS_WOUT) + (size_t)L * D * D, 32 * nb, 32 * nb, 32, kb, scr, lane); continue; }
        r -= 2 * I_WOUT;
        if (r < 9 * I_GU) { const int e = r / I_GU; r -= e * I_GU; const int kb = r / 176, nb = r % 176;
            const float* W = e == 0 ? in[16] : in[20] + (size_t)(e - 1) * D * 2 * FFH; bf16* WT = e == 0 ? (bf16*)(ws + WS_WGU) : (bf16*)(ws + WS_MWGU) + (size_t)(e - 1) * 2 * FFH * D;
            transpose_item(W, D, 2 * FFH, WT, 32 * nb, gu_map(nb), 32, kb, scr, lane); continue; }
        r -= 9 * I_GU;
        { const int e = r / I_DN; r -= e * I_DN; const int kb = r / 32, nb = r % 32;
            const float* W = e == 0 ? in[17] : in[21] + (size_t)(e - 1) * FFH * D; bf16* WT = e == 0 ? (bf16*)(ws + WS_WD) : (bf16*)(ws + WS_MWD) + (size_t)(e - 1) * D * FFH;
            transpose_item(W, FFH, D, WT, 32 * nb, 32 * nb, 32, kb, scr, lane); }
    }
    __syncthreads();
    LAS float* cond_s = (LAS float*)lds;
    LAS float* part = (LAS float*)(lds + 32768);
    for (int i = tid; i < 5 * D; i += NTHR) { const int r = i >> 10, k = i & 1023; const float v = r < 4 ? in[1][r * D + k] : in[3][k]; cond_s[i] = silu_f(v); }
    __syncthreads();
    float* MOD = (float*)(ws + WS_MOD);
    for (int t = wg; t < 192; t += G) {
        const int L = t / 96, nb = t % 96; const float* W = in[6] + (size_t)L * D * 6144 + nb * 64 + lane;
        float a0 = 0.f, a1 = 0.f, a2 = 0.f, a3 = 0.f, a4 = 0.f;
#pragma unroll 8
        for (int kk = 0; kk < 128; ++kk) { const int k = wave * 128 + kk; const float w = W[(size_t)k * 6144];
            a0 += cond_s[k] * w; a1 += cond_s[D + k] * w; a2 += cond_s[2 * D + k] * w; a3 += cond_s[3 * D + k] * w; a4 += cond_s[4 * D + k] * w; }
        part[(wave * 5 + 0) * 64 + lane] = a0; part[(wave * 5 + 1) * 64 + lane] = a1; part[(wave * 5 + 2) * 64 + lane] = a2; part[(wave * 5 + 3) * 64 + lane] = a3; part[(wave * 5 + 4) * 64 + lane] = a4;
        __syncthreads();
        if (tid < 320) { const int r = tid >> 6, l = tid & 63; float s = in[7][L * 6144 + nb * 64 + l];
#pragma unroll
            for (int w = 0; w < 8; ++w) s += part[(w * 5 + r) * 64 + l];
            MOD[(size_t)(L * 5 + r) * 6144 + nb * 64 + l] = s; }
        __syncthreads();
    }
}

template <bool ROUTER>
__device__ __forceinline__ void norm_phase(const float* xlat, const float* xctx, bool do_ctx, const float* ng, const float* modL, int chunk_shift, bf16* A,
                                           const float* w_router, const float* b_router, int* tok_e, float* tok_w, int* hist, LAS unsigned char* lds, int wg, int G, int tid) {
    const int lane = tid & 63, wave = tid >> 6;
    LAS float* wr_s = (LAS float*)lds;
    LAS int* lh = (LAS int*)(lds + 32768);
    if (ROUTER) { for (int i = tid; i < D * NEXP; i += NTHR) wr_s[i] = w_router[i]; }
    for (int blk = wg; blk < 256; blk += G) {
        if (ROUTER) { if (tid < 8) lh[tid] = 0; __syncthreads(); }
        for (int pass = 0; pass < (do_ctx ? 2 : 1); ++pass) {
            const int b = pass == 0 ? (blk >> 6) : 4;
            const float* sh = modL + (size_t)b * 6144 + chunk_shift * D; const float* sc = sh + D;
            f32x4 mul[4], add[4];
#pragma unroll
            for (int j = 0; j < 4; ++j) { const int c = 4 * lane + 256 * j; const f32x4 g = *(const f32x4*)(ng + c), s = *(const f32x4*)(sc + c); mul[j] = g * (s + 1.0f); add[j] = *(const f32x4*)(sh + c); }
            const int nrow = pass == 0 ? 16 : (wave < 4 ? 1 : 0);
            for (int i = 0; i < nrow; ++i) {
                const int lrow = pass == 0 ? blk * 128 + wave * 16 + i : blk * 4 + wave;
                const float* xr = (pass == 0 ? xlat : xctx) + (size_t)lrow * D; const int arow = pass == 0 ? lrow : NLAT + lrow;
                f32x4 v[4]; float ss = 0.f;
#pragma unroll
                for (int j = 0; j < 4; ++j) { v[j] = *(const f32x4*)(xr + 4 * lane + 256 * j); ss += (v[j].x * v[j].x + v[j].y * v[j].y) + (v[j].z * v[j].z + v[j].w * v[j].w); }
                const float rstd = 1.0f / sqrtf(wave_sum(ss) * (1.0f / D) + EPS);
                unsigned long long* o8 = (unsigned long long*)(A + (size_t)arow * D) + lane;
#pragma unroll
                for (int j = 0; j < 4; ++j) { v[j] = v[j] * rstd * mul[j] + add[j]; o8[64 * j] = (unsigned long long)pk2(v[j].x, v[j].y) | ((unsigned long long)pk2(v[j].z, v[j].w) << 32); }
                if (ROUTER && pass == 0) {
                    float lg[8];
#pragma unroll
                    for (int e = 0; e < 8; ++e) lg[e] = 0.f;
#pragma unroll
                    for (int j = 0; j < 4; ++j)
#pragma unroll
                        for (int q = 0; q < 4; ++q) { const int c = 4 * lane + 256 * j + q; const f32x4 w0 = *(const LAS f32x4*)(wr_s + c * 8), w1 = *(const LAS f32x4*)(wr_s + c * 8 + 4); const float y = v[j][q];
                            lg[0] += y * w0.x; lg[1] += y * w0.y; lg[2] += y * w0.z; lg[3] += y * w0.w; lg[4] += y * w1.x; lg[5] += y * w1.y; lg[6] += y * w1.z; lg[7] += y * w1.w; }
#pragma unroll
                    for (int e = 0; e < 8; ++e) lg[e] = wave_sum(lg[e]) + b_router[e];
                    if (lane == 0) {
                        int e1 = 0; float v1 = lg[0];
#pragma unroll
                        for (int e = 1; e < 8; ++e) if (lg[e] > v1) { v1 = lg[e]; e1 = e; }
                        int e2 = -1; float v2 = -3.0e38f;
#pragma unroll
                        for (int e = 0; e < 8; ++e) if (e != e1 && lg[e] > v2) { v2 = lg[e]; e2 = e; }
                        const float w2 = 1.0f / (1.0f + __expf(v1 - v2)), w1 = 1.0f - w2;
                        tok_e[lrow * 2] = e1; tok_e[lrow * 2 + 1] = e2; tok_w[lrow * 2] = w1; tok_w[lrow * 2 + 1] = w2;
                        __hip_atomic_fetch_add(&lh[e1], 1, __ATOMIC_RELAXED, __HIP_MEMORY_SCOPE_WORKGROUP); __hip_atomic_fetch_add(&lh[e2], 1, __ATOMIC_RELAXED, __HIP_MEMORY_SCOPE_WORKGROUP);
                    }
                }
            }
        }
        if (ROUTER) { __syncthreads(); if (tid < 8) hist[blk * 8 + tid] = lh[tid]; __syncthreads(); }
    }
}

__device__ __forceinline__ void route_phase(unsigned char* ws, LAS unsigned char* lds, int wg, int G, int tid) {
    const int lane = tid & 63, wave = tid >> 6;
    int* rw = (int*)(ws + WS_ROUTE); const int* hist = rw + RW_HIST;
    const int* tok_e = (const int*)(ws + WS_TOK); const float* tok_w = (const float*)(ws + WS_TOK + 256 * 1024); int* pair_pos = (int*)(ws + WS_TOK + 512 * 1024); float* row_w = (float*)(ws + WS_TOK + 768 * 1024);
    const bf16* A = (const bf16*)(ws + WS_A); bf16* AS = (bf16*)(ws + WS_ASORT);
    LAS int* hs = (LAS int*)lds;
    LAS int* tot = hs + 2048;
    LAS int* te = hs + 2048 + 32;
    LAS int* ps = te + 256;
    for (int blk = wg; blk < 256; blk += G) {
        __syncthreads();
        for (int i = tid; i < 2048; i += NTHR) hs[i] = hist[i];
        if (tid < 256) te[tid] = tok_e[blk * 256 + tid];
        __syncthreads();
        if (tid < 8) { int t = 0, mb = 0; for (int b = 0; b < 256; ++b) { const int h = hs[b * 8 + tid]; t += h; mb += (b < blk) ? h : 0; } tot[tid] = t; tot[16 + tid] = mb; }
        __syncthreads();
        if (tid == 0) { int s = 0; for (int e = 0; e < 8; ++e) { tot[8 + e] = s; s += (tot[e] + 255) & ~255; } tot[24] = s >> 8; }
        __syncthreads();
        if (tid < 256) { const int e = te[tid]; int rank = 0; for (int q = 0; q < tid; ++q) rank += (te[q] == e) ? 1 : 0;
            const int pos = tot[8 + e] + tot[16 + e] + rank; ps[tid] = pos; pair_pos[blk * 256 + tid] = pos; row_w[pos] = tok_w[blk * 256 + tid]; }
        __syncthreads();
        for (int q = wave * 32; q < wave * 32 + 32; ++q) { const int token = blk * 128 + (q >> 1), pos = ps[q];
            const v4u* s = (const v4u*)(A + (size_t)token * D); v4u* d = (v4u*)(AS + (size_t)pos * D); const v4u a = s[lane], b = s[lane + 64]; d[lane] = a; d[lane + 64] = b; }
        if (blk == 0) {
            if (tid < 264) { int e = 0; for (int e2 = 1; e2 < 8; ++e2) if (tid * 256 >= tot[8 + e2]) e = e2; rw[RW_TILE_E + tid] = e; }
            if (tid == 0) rw[RW_NTILES] = tot[24];
        }
        if (blk < 8) { const int e = blk, r0 = tot[8 + e] + tot[e], r1 = tot[8 + e] + ((tot[e] + 255) & ~255);
            for (int r = r0 + wave; r < r1; r += NWAVES) { v4u* d = (v4u*)(AS + (size_t)r * D); const v4u z = {0u, 0u, 0u, 0u}; d[lane] = z; d[lane + 64] = z; if (lane == 0) row_w[r] = 0.f; } }
    }
}

__device__ __forceinline__ void mout_phase(const float* HF, const float* HB, const bf16* P, const float* ng, bf16* Y, int nrows, int wg, int G, int tid) {
    const int lane = tid & 63, wave = tid >> 6;
    const f32x4 g0 = *(const f32x4*)(ng + 8 * lane), g1 = *(const f32x4*)(ng + 8 * lane + 4);
    for (int row = wg * NWAVES + wave; row < nrows; row += G * NWAVES) {
        const f32x4 a0 = *(const f32x4*)(HF + (size_t)row * 512 + 8 * lane), a1 = *(const f32x4*)(HF + (size_t)row * 512 + 8 * lane + 4);
        const f32x4 b0 = *(const f32x4*)(HB + (size_t)row * 512 + 8 * lane), b1 = *(const f32x4*)(HB + (size_t)row * 512 + 8 * lane + 4);
        const v4u o = *(const v4u*)(P + (size_t)row * PLD + PO_O + 8 * lane);
        const f32x4 s0 = a0 + b0, s1 = a1 + b1;
        float ss = (s0.x * s0.x + s0.y * s0.y) + (s0.z * s0.z + s0.w * s0.w) + (s1.x * s1.x + s1.y * s1.y) + (s1.z * s1.z + s1.w * s1.w);
        ss += __shfl_xor(ss, 1); ss += __shfl_xor(ss, 2); ss += __shfl_xor(ss, 4); ss += __shfl_xor(ss, 8);
        const float rstd = 1.0f / sqrtf(ss * (1.0f / 128.0f) + EPS);
        v4u w;
        w.x = pk2(sigmoid_f(bflo(o.x)) * s0.x * rstd * g0.x, sigmoid_f(bfhi(o.x)) * s0.y * rstd * g0.y);
        w.y = pk2(sigmoid_f(bflo(o.y)) * s0.z * rstd * g0.z, sigmoid_f(bfhi(o.y)) * s0.w * rstd * g0.w);
        w.z = pk2(sigmoid_f(bflo(o.z)) * s1.x * rstd * g1.x, sigmoid_f(bfhi(o.z)) * s1.y * rstd * g1.y);
        w.w = pk2(sigmoid_f(bflo(o.w)) * s1.z * rstd * g1.z, sigmoid_f(bfhi(o.w)) * s1.w * rstd * g1.w);
        *(v4u*)(Y + (size_t)row * D + 8 * lane) = w;
    }
}

__device__ __forceinline__ void final_phase(float* X, const bf16* O, const int* pair_pos, const float* modL, const float* fg, int wg, int G, int tid) {
    const int lane = tid & 63, wave = tid >> 6;
    for (int row = wg * NWAVES + wave; row < NLAT; row += G * NWAVES) {
        const int b = row >> 13; const float* g2 = modL + (size_t)b * 6144 + 5 * D;
        const int p1 = pair_pos[row * 2], p2 = pair_pos[row * 2 + 1];
        float* xr = X + (size_t)row * D; const v2u* o1 = (const v2u*)(O + (size_t)p1 * D) + lane; const v2u* o2 = (const v2u*)(O + (size_t)p2 * D) + lane;
        f32x4 v[4]; float ss = 0.f;
#pragma unroll
        for (int j = 0; j < 4; ++j) { const f32x4 x = *(const f32x4*)(xr + 4 * lane + 256 * j), g = *(const f32x4*)(g2 + 4 * lane + 256 * j); const v2u a = o1[64 * j], c = o2[64 * j];
            f32x4 m; m.x = bflo(a.x) + bflo(c.x); m.y = bfhi(a.x) + bfhi(c.x); m.z = bflo(a.y) + bflo(c.y); m.w = bfhi(a.y) + bfhi(c.y);
            v[j] = x + g * m; ss += (v[j].x * v[j].x + v[j].y * v[j].y) + (v[j].z * v[j].z + v[j].w * v[j].w); }
        const float rstd = 1.0f / sqrtf(wave_sum(ss) * (1.0f / D) + EPS);
#pragma unroll
        for (int j = 0; j < 4; ++j) { const f32x4 g = *(const f32x4*)(fg + 4 * lane + 256 * j); *(f32x4*)(xr + 4 * lane + 256 * j) = v[j] * rstd * g; }
    }
}

__device__ __forceinline__ void mlstm_naive_task(const bf16* P, const float* Gt, const float* bgate, float* HF, float* HB, LAS unsigned char* lds, int task, int tid) {
    const int bb = task >> 6, h = (task >> 4) & 3, dir = (task >> 3) & 1, sl = task & 7;
    const int e = tid & 15, dg = tid >> 4, d0 = dg * 4, wave = tid >> 6, lane = tid & 63;
    float C0 = 0.f, C1 = 0.f, C2 = 0.f, C3 = 0.f, n0 = 0.f, n1 = 0.f, n2 = 0.f, n3 = 0.f, m = -1e30f;
    const float bi = bgate[dir * 8 + h], bfg = bgate[dir * 8 + 4 + h];
    float* HS = dir ? HB : HF;
    LAS float* red = (LAS float*)lds;
    constexpr int NSTEP = CTXL + SEQ;
    constexpr float KSC = 0.08838834764831845f;
    __syncthreads();
#define MLSTM_ROW(s) ((s) < CTXL ? NLAT + bb * CTXL + (dir ? CTXL - 1 - (s) : (s)) : bb * SEQ + (dir ? SEQ - 1 - ((s) - CTXL) : ((s) - CTXL)))
    int rown = MLSTM_ROW(0);
    v2u qn = *(const v2u*)(P + (size_t)rown * PLD + PO_Q + h * 128 + d0), kn = *(const v2u*)(P + (size_t)rown * PLD + PO_K + h * 128 + d0);
    unsigned short vn = P[(size_t)rown * PLD + PO_V + h * 128 + sl * 16 + e]; float gin = Gt[(size_t)rown * 16 + dir * 8 + h], gfn = Gt[(size_t)rown * 16 + dir * 8 + 4 + h];
    for (int s = 0; s < NSTEP; ++s) {
        const int row = rown; const v2u q2 = qn, k2 = kn; const float v = bf2f(vn), ipre = gin + bi, fpre = gfn + bfg;
        if (s + 1 < NSTEP) { rown = MLSTM_ROW(s + 1);
            qn = *(const v2u*)(P + (size_t)rown * PLD + PO_Q + h * 128 + d0); kn = *(const v2u*)(P + (size_t)rown * PLD + PO_K + h * 128 + d0);
            vn = P[(size_t)rown * PLD + PO_V + h * 128 + sl * 16 + e]; gin = Gt[(size_t)rown * 16 + dir * 8 + h]; gfn = Gt[(size_t)rown * 16 + dir * 8 + 4 + h]; }
        const float q0 = bflo(q2.x), q1 = bfhi(q2.x), q2f = bflo(q2.y), q3 = bfhi(q2.y);
        const float k0 = bflo(k2.x) * KSC, k1 = bfhi(k2.x) * KSC, k2f = bflo(k2.y) * KSC, k3 = bfhi(k2.y) * KSC;
        const float lf = log_sigmoid_f(fpre), mn = fmaxf(lf + m, ipre), fw = __expf(lf + m - mn), iw = __expf(ipre - mn); m = mn;
        const float kv = iw * v;
        C0 = fw * C0 + k0 * kv; C1 = fw * C1 + k1 * kv; C2 = fw * C2 + k2f * kv; C3 = fw * C3 + k3 * kv;
        n0 = fw * n0 + iw * k0; n1 = fw * n1 + iw * k1; n2 = fw * n2 + iw * k2f; n3 = fw * n3 + iw * k3;
        float pn = (q0 * C0 + q1 * C1) + (q2f * C2 + q3 * C3), pd = (q0 * n0 + q1 * n1) + (q2f * n2 + q3 * n3);
        pn += __shfl_xor(pn, 16); pn += __shfl_xor(pn, 32); pd += __shfl_xor(pd, 16); pd += __shfl_xor(pd, 32);
        const int par = s & 1;
        if (lane < 16) red[(par * 8 + wave) * 17 + lane] = pn;
        if (lane == 0) red[(par * 8 + wave) * 17 + 16] = pd;
        __syncthreads();
        if (tid < 16) { float num = 0.f, den = 0.f;
#pragma unroll
            for (int w = 0; w < 8; ++w) { num += red[(par * 8 + w) * 17 + tid]; den += red[(par * 8 + w) * 17 + 16]; }
            HS[(size_t)row * 512 + h * 128 + sl * 16 + tid] = num / fmaxf(fabsf(den), __expf(-m)); }
    }
#undef MLSTM_ROW
    __syncthreads();
}
typedef float f32x2 __attribute__((ext_vector_type(2)));
__device__ __forceinline__ void fourier_naive_task(const bf16* P, bf16* Y, LAS unsigned char* lds, int task, bool ctx, int tid) {
    const int lane = tid & 63, wave = tid >> 6;
    LAS f32x2* tab = (LAS f32x2*)lds;
    LAS unsigned short* zb = (LAS unsigned short*)(lds + 65536);
    LAS float* ure_s = (LAS float*)(lds + 98304);
    LAS float* uim_s = ure_s + 4096;
    const int N = ctx ? CTXL : SEQ, nkb = N / 64, tstride = 8192 / N;
    const int b = task / (4 * nkb), g = (task / nkb) & 3, kb = task % nkb;
    const int rowbase = ctx ? NLAT + b * CTXL : b * SEQ;
    float ure[8], uim[8]; int idx[8], stp[8];
#pragma unroll
    for (int j = 0; j < 8; ++j) { ure[j] = 0.f; uim[j] = 0.f; idx[j] = 0; stp[j] = ((kb * 64 + wave * 8 + j) * tstride) & 8191; }
    for (int nb0 = 0; nb0 < N; nb0 += 256) {
        __syncthreads();
#pragma unroll
        for (int i = 0; i < 4; ++i) { const int p = tid + NTHR * i, r = p >> 3, ch = p & 7;
            *(LAS v4u*)(zb + r * 64 + ch * 8) = *(const v4u*)(P + (size_t)(rowbase + nb0 + r) * PLD + PO_F + g * 64 + ch * 8); }
        __syncthreads();
#pragma unroll 2
        for (int nn = 0; nn < 256; ++nn) { const float z = bf2f(zb[nn * 64 + lane]);
#pragma unroll
            for (int j = 0; j < 8; ++j) { const f32x2 t = tab[idx[j]]; ure[j] += z * t.x; uim[j] -= z * t.y; idx[j] = (idx[j] + stp[j]) & 8191; } }
    }
    __syncthreads();
#pragma unroll
    for (int j = 0; j < 8; ++j) { ure_s[(wave * 8 + j) * 64 + lane] = ure[j]; uim_s[(wave * 8 + j) * 64 + lane] = uim[j]; }
    __syncthreads();
    const float scale = 1.0f / sqrtf((float)N * 64.0f);
#pragma unroll 1
    for (int j = 0; j < 8; ++j) { const int kl = wave * 8 + j; float acc = 0.f;
#pragma unroll 4
        for (int c = 0; c < 64; ++c) { const f32x2 t = tab[((c * lane) & 63) * 128]; acc += ure_s[kl * 64 + c] * t.x + uim_s[kl * 64 + c] * t.y; }
        Y[(size_t)(rowbase + kb * 64 + kl) * D + 512 + g * 64 + lane] = (bf16)f2bf(acc * scale); }
}
__device__ __forceinline__ void conv_task(const bf16* P, bf16* Y, const float* dw, const float* db, const float* lg, const float* lb, LAS unsigned char* lds, int task, bool ctx, int tid) {
    const int lane = tid & 63, wave = tid >> 6;
    const int N = ctx ? CTXL : SEQ, ntile = N / 32, b = task / ntile, t0 = (task % ntile) * 32, rowbase = ctx ? NLAT + b * CTXL : b * SEQ;
    LAS float* a = (LAS float*)lds;
    LAS float* o = a + 62 * 256;
    __syncthreads();
    for (int i = tid; i < 62 * 256; i += NTHR) { const int r = i >> 8, ch = i & 255, t = t0 - 15 + r; float v = 0.f;
        if (t >= 0 && t < N) { const bf16* pr = P + (size_t)(rowbase + t) * PLD; v = bf2f(pr[PO_CU + ch]) * sigmoid_f(bf2f(pr[PO_CG + ch])); }
        a[i] = v; }
    __syncthreads();
    { const int ch = tid & 255, th = tid >> 8; float w[31];
#pragma unroll
        for (int j = 0; j < 31; ++j) w[j] = dw[j * 256 + ch];
        const float bias = db[ch];
        for (int tt = 0; tt < 16; ++tt) { const int t = th * 16 + tt; float s = bias;
#pragma unroll
            for (int j = 0; j < 31; ++j) s += a[(t + j) * 256 + ch] * w[j];
            o[t * 256 + ch] = s; } }
    __syncthreads();
    for (int i = 0; i < 16; ++i) { const int p = wave * 16 + i, t = p >> 2, g = p & 3; const float v = o[t * 256 + g * 64 + lane];
        const float mu = wave_sum(v) * (1.0f / 64.0f), d = v - mu, var = wave_sum(d * d) * (1.0f / 64.0f);
        const float yn = d * (1.0f / sqrtf(var + EPS)) * lg[g * 64 + lane] + lb[g * 64 + lane];
        Y[(size_t)(rowbase + t0 + t) * D + 768 + g * 64 + lane] = (bf16)f2bf(silu_f(yn)); }
}
__device__ __forceinline__ void mix_naive_phase(const float* const* in, unsigned char* ws, int L, bool do_ctx, LAS unsigned char* lds, int wg, int G, int tid) {
    const bf16* P = (const bf16*)(ws + WS_P); bf16* Y = (bf16*)(ws + WS_Y);
#ifndef MIXSEL
#define MIXSEL 7
#endif
    if (MIXSEL & 1) for (int t = wg; t < 256; t += G) mlstm_naive_task(P, (const float*)(ws + WS_G), in[9] + L * 16, (float*)(ws + WS_HF), (float*)(ws + WS_HB), lds, t, tid);
    __syncthreads();
    { LAS f32x2* tab = (LAS f32x2*)lds; for (int i = tid; i < 8192; i += NTHR) { float s, c; sincospif((float)i * (1.0f / 4096.0f), &s, &c); tab[i] = (f32x2){c, s}; } }
    __syncthreads();
    if (MIXSEL & 2) for (int t = wg; t < 16 * 128; t += G) fourier_naive_task(P, Y, lds, t, false, tid);
    if ((MIXSEL & 2) && do_ctx) for (int t = wg; t < 16 * 4; t += G) fourier_naive_task(P, Y, lds, t, true, tid);
    if (MIXSEL & 4) for (int t = wg; t < 4 * 256; t += G) conv_task(P, Y, in[11] + L * 31 * 256, in[12] + L * 256, in[13] + L * 256, in[14] + L * 256, lds, t, false, tid);
    if ((MIXSEL & 4) && do_ctx) for (int t = wg; t < 4 * 8; t += G) conv_task(P, Y, in[11] + L * 31 * 256, in[12] + L * 256, in[13] + L * 256, in[14] + L * 256, lds, t, true, tid);
}

constexpr int NPH = 19;
#ifndef MK_SINGLE
#define MK_SINGLE 1
#endif
struct Params { const float* in[23]; float* out; unsigned char* ws; int ph_lo, ph_hi; };
static_assert(sizeof(Params) == 23 * 8 + 8 + 8 + 8, "Params has no padding");

__global__ void __launch_bounds__(NTHR, 2) fwd_kernel(Params p) {
    extern __shared__ __attribute__((aligned(16))) unsigned char lds_raw[];
    LAS unsigned char* lds = (LAS unsigned char*)lds_raw;
    const int tid = threadIdx.x, wg = blockIdx.x, G = gridDim.x;
    unsigned char* ws = p.ws;
    const float* const* in = p.in;
    for (int u = tid; u < (LDS_BYTES - LDSCTL_OFF) / 4; u += NTHR) ((LAS unsigned*)(lds + LDSCTL_OFF))[u] = 0u;
    __syncthreads();
    XcdBarrier bar; bar.bar = (unsigned*)(ws + WS_CTL) + CW_BAR; bar.x = 0; bar.st = (volatile LAS unsigned*)(lds + LDSCTL_OFF + 64);
    if (MK_SINGLE) bar = xcd_barrier_post((unsigned*)(ws + WS_CTL) + CW_BAR, (volatile LAS unsigned*)(lds + LDSCTL_OFF + 64));
    const int lo = p.ph_lo, hi = p.ph_hi;
#ifndef PH_MASK
#define PH_MASK 0xFFFFFFFFu
#endif
#define IN(k) (((PH_MASK >> (k)) & 1u) && lo <= (k) && (k) < hi)
#define SEAM(k) do { if (MK_SINGLE && IN((k) + 1)) xcd_barrier(bar); } while (0)
    const float* MOD = (const float*)(ws + WS_MOD);
    bf16* A = (bf16*)(ws + WS_A); bf16* Pb = (bf16*)(ws + WS_P); bf16* Yb = (bf16*)(ws + WS_Y); bf16* Hb = (bf16*)(ws + WS_H);
    float* Gt = (float*)(ws + WS_G); float* XC = (float*)(ws + WS_XC); float* HF = (float*)(ws + WS_HF); float* HB = (float*)(ws + WS_HB);
    int* rw = (int*)(ws + WS_ROUTE);
    int* tok_e = (int*)(ws + WS_TOK); float* tok_w = (float*)(ws + WS_TOK + 256 * 1024); int* pair_pos = (int*)(ws + WS_TOK + 512 * 1024); float* row_w = (float*)(ws + WS_TOK + 768 * 1024);

    if (IN(0)) { prologue_phase(in, ws, lds, wg, G, tid); SEAM(0); }
    if (IN(1)) { norm_phase<false>(in[0], in[2], true, in[4], MOD, 0, A, nullptr, nullptr, nullptr, nullptr, nullptr, lds, wg, G, tid); SEAM(1); }
    if (IN(2)) { pg8::Gemm g{A, (const bf16*)(ws + WS_WIN), MROWS, PLD, D}; pg8::StaticOrder S; S.init(MROWS, PLD, G, wg); pg8::EpiP E{Pb, Gt};
        pg8::gemm_phase<pg8::EpiP, pg8::StaticOrder, true, true>(lds, g, S, E); SEAM(2); }
    if (IN(3)) { mix_naive_phase(in, ws, 0, true, lds, wg, G, tid); SEAM(3); }
    if (IN(4)) { mout_phase(HF, HB, Pb, in[10], Yb, MROWS, wg, G, tid); SEAM(4); }
    if (IN(5)) { pg8::Gemm g{Yb, (const bf16*)(ws + WS_WOUT), MROWS, D, D}; pg8::StaticOrder S; S.init(MROWS, D, G, wg); pg8::EpiRes E{in[0], p.out, in[2], XC, MOD + 2 * D};
        pg8::gemm_phase<pg8::EpiRes, pg8::StaticOrder, true, true>(lds, g, S, E); SEAM(5); }
    if (IN(6)) { norm_phase<false>(p.out, XC, true, in[5], MOD, 3, A, nullptr, nullptr, nullptr, nullptr, nullptr, lds, wg, G, tid); SEAM(6); }
    if (IN(7)) { pg8::Gemm g{A, (const bf16*)(ws + WS_WGU), MROWS, 2 * FFH, D}; pg8::StaticOrder S; S.init(MROWS, 2 * FFH, G, wg); pg8::EpiSwiglu E{Hb};
        pg8::gemm_phase<pg8::EpiSwiglu, pg8::StaticOrder, true, true>(lds, g, S, E); SEAM(7); }
    if (IN(8)) { pg8::Gemm g{Hb, (const bf16*)(ws + WS_WD), MROWS, D, FFH}; pg8::StaticOrder S; S.init(MROWS, D, G, wg); pg8::EpiRes E{p.out, p.out, XC, XC, MOD + 5 * D};
        pg8::gemm_phase<pg8::EpiRes, pg8::StaticOrder, true, true>(lds, g, S, E); SEAM(8); }
    const float* MOD1 = MOD + 5 * 6144;
    if (IN(9)) { norm_phase<false>(p.out, XC, true, in[4] + D, MOD1, 0, A, nullptr, nullptr, nullptr, nullptr, nullptr, lds, wg, G, tid); SEAM(9); }
    if (IN(10)) { pg8::Gemm g{A, (const bf16*)(ws + WS_WIN) + (size_t)PLD * D, MROWS, PLD, D}; pg8::StaticOrder S; S.init(MROWS, PLD, G, wg); pg8::EpiP E{Pb, Gt};
        pg8::gemm_phase<pg8::EpiP, pg8::StaticOrder, true, true>(lds, g, S, E); SEAM(10); }
    if (IN(11)) { mix_naive_phase(in, ws, 1, false, lds, wg, G, tid); SEAM(11); }
    if (IN(12)) { mout_phase(HF, HB, Pb, in[10] + 512, Yb, NLAT, wg, G, tid); SEAM(12); }
    if (IN(13)) { pg8::Gemm g{Yb, (const bf16*)(ws + WS_WOUT) + (size_t)D * D, NLAT, D, D}; pg8::StaticOrder S; S.init(NLAT, D, G, wg); pg8::EpiRes E{p.out, p.out, XC, XC, MOD1 + 2 * D};
        pg8::gemm_phase<pg8::EpiRes, pg8::StaticOrder, true, true>(lds, g, S, E); SEAM(13); }
    if (IN(14)) { norm_phase<true>(p.out, XC, false, in[5] + D, MOD1, 3, A, in[18], in[19], tok_e, tok_w, rw + RW_HIST, lds, wg, G, tid); SEAM(14); }
    if (IN(15)) { route_phase(ws, lds, wg, G, tid); SEAM(15); }
    if (IN(16)) { const int nT = rw[RW_NTILES]; pg8::Gemm g{(const bf16*)(ws + WS_ASORT), (const bf16*)(ws + WS_MWGU), nT * 256, NEXP * 2 * FFH, D};
        pg8::MoeOrder S; S.init_moe(nT, 22, rw + RW_TILE_E, G, wg); pg8::EpiSwiglu E{(bf16*)(ws + WS_HSORT)};
        pg8::gemm_phase<pg8::EpiSwiglu, pg8::MoeOrder, true, true>(lds, g, S, E); SEAM(16); }
    if (IN(17)) { const int nT = rw[RW_NTILES]; pg8::Gemm g{(const bf16*)(ws + WS_HSORT), (const bf16*)(ws + WS_MWD), nT * 256, NEXP * D, FFH};
        pg8::MoeOrder S; S.init_moe(nT, 4, rw + RW_TILE_E, G, wg); pg8::EpiMoeDown E{(bf16*)(ws + WS_OPAIR), row_w};
        pg8::gemm_phase<pg8::EpiMoeDown, pg8::MoeOrder, true, true>(lds, g, S, E); SEAM(17); }
    if (IN(18)) { final_phase(p.out, (const bf16*)(ws + WS_OPAIR), pair_pos, MOD1, in[22], wg, G, tid); }
#undef IN
#undef SEAM
}

extern "C" void kernel_launch(void* const* d_in, const int* in_sizes, int n_in, void* d_out, int out_size, void* d_ws, size_t ws_size, hipStream_t stream) {
    static int grid = 0;
    if (grid == 0) {
        if (n_in != 23 || in_sizes[0] != NLAT * D || out_size != NLAT * D || ws_size < WS_END) { fprintf(stderr, "kernel_launch: unexpected problem shape (n_in %d, out %d, ws %zu); nothing launched\n", n_in, out_size, ws_size); grid = -1; return; }
        int dev = 0, cus = 0;
        if (hipGetDevice(&dev) != hipSuccess || hipDeviceGetAttribute(&cus, hipDeviceAttributeMultiprocessorCount, dev) != hipSuccess) { grid = -1; return; }
        if (hipFuncSetAttribute((const void*)fwd_kernel, hipFuncAttributeMaxDynamicSharedMemorySize, LDS_BYTES) != hipSuccess) { fprintf(stderr, "kernel_launch: hipFuncSetAttribute failed\n"); grid = -1; return; }
        int per_cu = 0;
        if (hipOccupancyMaxActiveBlocksPerMultiprocessor(&per_cu, (const void*)fwd_kernel, NTHR, LDS_BYTES) != hipSuccess || per_cu < 1) { fprintf(stderr, "kernel_launch: occupancy query says %d blocks per CU\n", per_cu); }
        (void)hipGetLastError();
        grid = cus;
    }
    if (grid < 0) return;
    if (hipMemsetAsync((char*)d_ws + WS_CTL, 0, CTL_ZERO_BYTES, stream) != hipSuccess) return;
    Params p{};
    for (int i = 0; i < 23; ++i) p.in[i] = (const float*)d_in[i];
    p.out = (float*)d_out; p.ws = (unsigned char*)d_ws;
#if MK_SINGLE
    p.ph_lo = 0; p.ph_hi = NPH;
    hipLaunchKernelGGL(fwd_kernel, dim3(grid), dim3(NTHR), LDS_BYTES, stream, p);
#else
    for (int k = 0; k < NPH; ++k) { p.ph_lo = k; p.ph_hi = k + 1; hipLaunchKernelGGL(fwd_kernel, dim3(grid), dim3(NTHR), LDS_BYTES, stream, p); }
#endif
}
```

```cpp
#include <hip/hip_runtime.h>
#include <cstdio>
#include <cstdint>
namespace pg8 {
#define PG8_LAS __attribute__((address_space(3)))
typedef unsigned short bf16_t;
typedef short bf16x8 __attribute__((ext_vector_type(8)));
typedef float f32x4 __attribute__((ext_vector_type(4)));
typedef unsigned u32x4 __attribute__((ext_vector_type(4)));
constexpr int BM = 256, BK = 64, HALF = 128, HTB = HALF * BK * 2  , STAGE_BYTES = 8 * HTB, NXCD = 8, WGM = 8;

__host__ __device__ __forceinline__ int lds_byte(int r, int c) { const int st = (r >> 4) * 2 + (c >> 5), rr = r & 15, cc = c & 31, ob = rr * 64 + cc * 2; return st * 1024 + (ob ^ (((ob >> 9) & 1) << 5)); }
__host__ __device__ __forceinline__ void stage_rc(int b, int& R, int& C) { const int st = b / 1024, sb = b % 1024, swz = sb ^ (((sb >> 9) & 1) << 5); R = (st >> 1) * 16 + swz / 64; C = (st & 1) * 32 + (swz % 64) / 2; }
__host__ __device__ __forceinline__ int perm32(int rho) { const int n = rho >> 4, i = rho & 15; return 8 * (i >> 2) + 4 * n + (i & 3); }

struct Unit { int pm, pn; };
struct Gemm { const bf16_t* A; const bf16_t* Bt; int M, N, K; };

struct StaticOrder {
    int nM, nN, nwg, G, c;
    __host__ __device__ void init(int M, int N, int G_, int c_) { nM = M / BM; nN = N / BM; nwg = nM * nN; G = G_; c = c_; }
    __host__ __device__ bool next(int i, Unit& u) const {
        const long L = (long)i * G + c; if (L >= nwg) return false;
        int wgid = (int)L; { const int q = nwg / NXCD, r = nwg % NXCD, xcd = wgid % NXCD, off = wgid / NXCD; wgid = (xcd < r ? xcd * (q + 1) : r * (q + 1) + (xcd - r) * q) + off; }
        const int nig = WGM * nN, gid = wgid / nig, fm = gid * WGM, gsz = (nM - fm) < WGM ? (nM - fm) : WGM;
        u.pm = fm + ((wgid % nig) % gsz); u.pn = (wgid % nig) / gsz; return true;
    }
    __device__ __forceinline__ void a_ready(const Unit&) const {}
    __device__ __forceinline__ void done(const Unit&) const {}
};

__device__ __forceinline__ unsigned cvt_pk_bf16(float lo, float hi) { unsigned r; asm volatile("v_cvt_pk_bf16_f32 %0, %1, %2" : "=v"(r) : "v"(lo), "v"(hi)); return r; }
__device__ __forceinline__ float silu_f(float x) { return x / (1.0f + __expf(-x)); }
struct EpiP {
    static constexpr bool PERM = true, AFTER_DRAIN = false;
    bf16_t* P; float* G;
    __device__ __forceinline__ void operator()(const f32x4 (&acc)[2][2][4][2], const Unit& u, int wr, int wc, int fr, int fq) const {
        const int row0 = u.pm * BM + wr * 64 + fr, col0 = u.pn * BM + wc * 32 + 8 * fq;
#pragma unroll
        for (int ai = 0; ai < 2; ++ai)
#pragma unroll
            for (int m = 0; m < 4; ++m) { bf16_t* rowp = P + (size_t)(row0 + ai * HALF + m * 16) * 3072 + col0;
#pragma unroll
                for (int bj = 0; bj < 2; ++bj) { const f32x4 v0 = acc[ai][bj][m][0], v1 = acc[ai][bj][m][1];
                    u32x4 w; w.x = cvt_pk_bf16(v0[0], v0[1]); w.y = cvt_pk_bf16(v0[2], v0[3]); w.z = cvt_pk_bf16(v1[0], v1[1]); w.w = cvt_pk_bf16(v1[2], v1[3]);
                    *(u32x4*)(rowp + bj * HALF) = w; } }
        if (u.pn == 11 && wc == 0 && fq < 2) {
#pragma unroll
            for (int ai = 0; ai < 2; ++ai)
#pragma unroll
                for (int m = 0; m < 4; ++m) { float* gp = G + (size_t)(row0 + ai * HALF + m * 16) * 16 + 8 * fq;
                    *(f32x4*)gp = acc[ai][0][m][0]; *(f32x4*)(gp + 4) = acc[ai][0][m][1]; }
        }
    }
};
struct EpiRes {
    static constexpr bool PERM = false, AFTER_DRAIN = false;
    const float* base_lat; float* out_lat; const float* base_ctx; float* out_ctx; const float* gate;
    __device__ __forceinline__ void operator()(const f32x4 (&acc)[2][2][4][2], const Unit& u, int wr, int wc, int fr, int fq) const {
        const bool lat = u.pm < 128;
        const float* base = lat ? base_lat + (size_t)u.pm * BM * 1024 : base_ctx + (size_t)(u.pm - 128) * BM * 1024;
        float* out = lat ? out_lat + (size_t)u.pm * BM * 1024 : out_ctx + (size_t)(u.pm - 128) * BM * 1024;
        const float* gv = gate + (size_t)(lat ? (u.pm >> 5) : 4) * 6144;
        const int row0 = wr * 64 + fr, col0 = u.pn * BM + wc * 32 + 4 * fq;
        f32x4 g4[2][2];
#pragma unroll
        for (int bj = 0; bj < 2; ++bj)
#pragma unroll
            for (int n = 0; n < 2; ++n) g4[bj][n] = *(const f32x4*)(gv + col0 + bj * HALF + n * 16);
#pragma unroll
        for (int ai = 0; ai < 2; ++ai)
#pragma unroll
            for (int m = 0; m < 4; ++m) { const size_t off = (size_t)(row0 + ai * HALF + m * 16) * 1024 + col0;
#pragma unroll
                for (int bj = 0; bj < 2; ++bj)
#pragma unroll
                    for (int n = 0; n < 2; ++n) { const f32x4 b = *(const f32x4*)(base + off + bj * HALF + n * 16);
                        *(f32x4*)(out + off + bj * HALF + n * 16) = b + g4[bj][n] * acc[ai][bj][m][n]; }
                asm volatile("" ::: "memory"); }
    }
};
struct EpiSwiglu {
    static constexpr bool PERM = true, AFTER_DRAIN = false;
    bf16_t* H;
    __device__ __forceinline__ void operator()(const f32x4 (&acc)[2][2][4][2], const Unit& u, int wr, int wc, int fr, int fq) const {
        const int row0 = u.pm * BM + wr * 64 + fr, col0 = (u.pn % 22) * HALF + wc * 32 + 8 * fq;
#pragma unroll
        for (int ai = 0; ai < 2; ++ai)
#pragma unroll
            for (int m = 0; m < 4; ++m) { bf16_t* rowp = H + (size_t)(row0 + ai * HALF + m * 16) * 2816 + col0;
                float h[8];
#pragma unroll
                for (int n = 0; n < 2; ++n)
#pragma unroll
                    for (int j = 0; j < 4; ++j) h[4 * n + j] = silu_f(acc[ai][0][m][n][j]) * acc[ai][1][m][n][j];
                u32x4 w; w.x = cvt_pk_bf16(h[0], h[1]); w.y = cvt_pk_bf16(h[2], h[3]); w.z = cvt_pk_bf16(h[4], h[5]); w.w = cvt_pk_bf16(h[6], h[7]);
                *(u32x4*)rowp = w; }
    }
};
struct EpiMoeDown {
    static constexpr bool PERM = true, AFTER_DRAIN = false;
    bf16_t* O; const float* roww;
    __device__ __forceinline__ void operator()(const f32x4 (&acc)[2][2][4][2], const Unit& u, int wr, int wc, int fr, int fq) const {
        const int row0 = u.pm * BM + wr * 64 + fr, col0 = (u.pn & 3) * BM + wc * 32 + 8 * fq;
#pragma unroll
        for (int ai = 0; ai < 2; ++ai)
#pragma unroll
            for (int m = 0; m < 4; ++m) { const int r = row0 + ai * HALF + m * 16; const float s = roww[r]; bf16_t* rowp = O + (size_t)r * 1024 + col0;
#pragma unroll
                for (int bj = 0; bj < 2; ++bj) { const f32x4 v0 = acc[ai][bj][m][0] * s, v1 = acc[ai][bj][m][1] * s;
                    u32x4 w; w.x = cvt_pk_bf16(v0[0], v0[1]); w.y = cvt_pk_bf16(v0[2], v0[3]); w.z = cvt_pk_bf16(v1[0], v1[1]); w.w = cvt_pk_bf16(v1[2], v1[3]);
                    *(u32x4*)(rowp + bj * HALF) = w; } }
    }
};
struct MoeOrder : StaticOrder {
    const int* tile_e; int nNe;
    __device__ void init_moe(int nTiles, int nNe_, const int* te, int G_, int c_) { nM = nTiles; nN = nNe_; nwg = nM * nN; G = G_; c = c_; tile_e = te; nNe = nNe_; }
    __device__ bool next(int i, Unit& u) const { if (!StaticOrder::next(i, u)) return false; u.pn += tile_e[u.pm] * nNe; return true; }
};
template <class Epi, class Sched, bool ALIGN_EPI = false, bool SP2 = false>
__device__ __forceinline__ void gemm_phase(PG8_LAS unsigned char* lds, const Gemm g, const Sched& S, const Epi& E) {
    const int tid = threadIdx.x, wid = __builtin_amdgcn_readfirstlane(tid >> 6), lane = tid & 63, wr = wid >> 2, wc = wid & 3, fr = lane & 15, fq = lane >> 4;
    const int K = g.K, nt = K / BK;
    unsigned voffA[2], voffB[2];
#pragma unroll
    for (int i = 0; i < 2; ++i) { int R, C; stage_rc(tid * 16 + i * 8192, R, C); const int Rb = Epi::PERM ? ((R & ~31) + perm32(R & 31)) : R;
        voffA[i] = (unsigned)(R * K + C) * 2u; voffB[i] = (unsigned)(Rb * K + C) * 2u; }
    const size_t kstep = (size_t)(BK * 2);
    const size_t hstep = (size_t)HALF * K * 2;
    const size_t tstep = 2 * hstep;
    const unsigned ldsw = (unsigned)wid * 1024u;
    const int aoff = lds_byte(wr * 64 + fr, fq * 8), boff = lds_byte(wc * 32 + fr, fq * 8);
#define PG8_SA(b, h) (((b) * 2 + (h)) * HTB)
#define PG8_SB(b, h) ((4 + (b) * 2 + (h)) * HTB)
#define PG8_STAGE(bufoff, gbase, voff) do { _Pragma("unroll") for (int _i = 0; _i < 2; ++_i) \
        __builtin_amdgcn_global_load_lds((const unsigned*)((const char*)(gbase) + (voff)[_i]), (PG8_LAS unsigned*)(lds + (bufoff) + ldsw + _i * 8192), 16, 0, 0); } while (0)
#define PG8_LDA(dst, b, h) do { _Pragma("unroll") for (int m = 0; m < 4; ++m) _Pragma("unroll") for (int k = 0; k < 2; ++k) dst[m][k] = *(const PG8_LAS bf16x8*)(lds + PG8_SA(b, h) + aoff + m * 2048 + k * 1024); } while (0)
#define PG8_LDB(dst, b, h) do { _Pragma("unroll") for (int n = 0; n < 2; ++n) _Pragma("unroll") for (int k = 0; k < 2; ++k) dst[n][k] = *(const PG8_LAS bf16x8*)(lds + PG8_SB(b, h) + boff + n * 2048 + k * 1024); } while (0)
#define PG8_MMA(ai, bj, At, Bt) do { __builtin_amdgcn_s_setprio(1); _Pragma("unroll") for (int m = 0; m < 4; ++m) _Pragma("unroll") for (int n = 0; n < 2; ++n) _Pragma("unroll") for (int k = 0; k < 2; ++k) \
        acc[ai][bj][m][n] = __builtin_amdgcn_mfma_f32_16x16x32_bf16(Bt[n][k], At[m][k], acc[ai][bj][m][n], 0, 0, 0); __builtin_amdgcn_s_setprio(0); } while (0)
#define PG8_WAIT_V(n) asm volatile("s_waitcnt vmcnt(" #n ")" ::: "memory")
#define PG8_WAIT_L(n) asm volatile("s_waitcnt lgkmcnt(" #n ")" ::: "memory")
#define PG8_BAR __builtin_amdgcn_s_barrier()
#define PG8_SCHED __builtin_amdgcn_sched_barrier(0)
    Unit cur, nxt; int ui = 0;
    if (!S.next(0, cur)) return;
    f32x4 acc[2][2][4][2];
#pragma unroll
    for (int a = 0; a < 2; ++a)
#pragma unroll
        for (int b = 0; b < 2; ++b)
#pragma unroll
            for (int m = 0; m < 4; ++m)
#pragma unroll
                for (int n = 0; n < 2; ++n) acc[a][b][m][n] = (f32x4){0.f, 0.f, 0.f, 0.f};
    bf16x8 At[4][2], B0[2][2], B1[2][2];
    const char* cA = (const char*)g.A + (size_t)cur.pm * tstep; const char* cB = (const char*)g.Bt + (size_t)cur.pn * tstep;
    S.a_ready(cur);
    if constexpr (SP2) {
        PG8_STAGE(PG8_SB(0, 0), cB, voffB); PG8_STAGE(PG8_SB(0, 1), cB + hstep, voffB); PG8_STAGE(PG8_SA(0, 0), cA, voffA); PG8_STAGE(PG8_SA(0, 1), cA + hstep, voffA);
        if (wr == 1) PG8_BAR;
        PG8_WAIT_V(2); PG8_BAR;
        PG8_STAGE(PG8_SB(1, 0), cB + kstep, voffB); PG8_STAGE(PG8_SA(1, 0), cA + kstep, voffA); PG8_STAGE(PG8_SB(1, 1), cB + hstep + kstep, voffB);
        PG8_WAIT_V(6); PG8_BAR;
    } else {
        PG8_STAGE(PG8_SB(0, 0), cB, voffB); PG8_STAGE(PG8_SA(0, 0), cA, voffA); PG8_STAGE(PG8_SB(0, 1), cB + hstep, voffB); PG8_STAGE(PG8_SA(0, 1), cA + hstep, voffA);
        if (wr == 1) PG8_BAR;
        PG8_WAIT_V(4); PG8_BAR;
        PG8_STAGE(PG8_SB(1, 0), cB + kstep, voffB); PG8_STAGE(PG8_SA(1, 0), cA + kstep, voffA); PG8_STAGE(PG8_SB(1, 1), cB + hstep + kstep, voffB);
        PG8_WAIT_V(6); PG8_BAR;
    }
    for (;;) {
        const bool has_next = S.next(ui + 1, nxt);
        const char* nA = has_next ? (const char*)g.A + (size_t)nxt.pm * tstep : cA; const char* nB = has_next ? (const char*)g.Bt + (size_t)nxt.pn * tstep : cB;
        for (int t = 0; t < nt; t += 2) {
            const bool last = (t == nt - 2);
            const char* a1 = cA + (size_t)(t + 1) * kstep;
            const char* a2 = last ? nA : cA + (size_t)(t + 2) * kstep; const char* b2 = last ? nB : cB + (size_t)(t + 2) * kstep;
            const char* a3 = a2 + kstep; const char* b3 = b2 + kstep;
            if (last && has_next) S.a_ready(nxt);
            if constexpr (SP2) {
            PG8_LDB(B0, 0, 0); PG8_LDB(B1, 0, 1); PG8_SCHED; PG8_LDA(At, 0, 0); PG8_STAGE(PG8_SA(1, 1), a1 + hstep, voffA);
            PG8_WAIT_V(8); PG8_WAIT_L(0); PG8_BAR; PG8_MMA(0, 0, At, B0); PG8_MMA(0, 1, At, B1); PG8_BAR; PG8_SCHED;
            PG8_LDA(At, 0, 1); PG8_STAGE(PG8_SB(0, 0), b2, voffB); PG8_STAGE(PG8_SB(0, 1), b2 + hstep, voffB); PG8_STAGE(PG8_SA(0, 0), a2, voffA);
            PG8_WAIT_V(8); PG8_WAIT_L(0); PG8_BAR; PG8_MMA(1, 0, At, B0); PG8_MMA(1, 1, At, B1); PG8_BAR; PG8_SCHED;
            PG8_LDB(B0, 1, 0); PG8_LDB(B1, 1, 1); PG8_SCHED; PG8_LDA(At, 1, 0); PG8_STAGE(PG8_SA(0, 1), a2 + hstep, voffA);
            PG8_WAIT_V(8); PG8_WAIT_L(0); PG8_BAR; PG8_MMA(0, 0, At, B0); PG8_MMA(0, 1, At, B1); PG8_BAR; PG8_SCHED;
            PG8_LDA(At, 1, 1); PG8_STAGE(PG8_SB(1, 0), b3, voffB); PG8_STAGE(PG8_SB(1, 1), b3 + hstep, voffB); PG8_STAGE(PG8_SA(1, 0), a3, voffA);
            PG8_WAIT_V(8); PG8_WAIT_L(0); PG8_BAR; PG8_MMA(1, 0, At, B0); PG8_MMA(1, 1, At, B1); PG8_BAR; PG8_SCHED;
            } else {
            PG8_LDB(B0, 0, 0); PG8_SCHED; PG8_LDA(At, 0, 0); PG8_STAGE(PG8_SA(1, 1), a1 + hstep, voffA);
            PG8_WAIT_L(8); PG8_BAR; PG8_WAIT_L(0); PG8_MMA(0, 0, At, B0); PG8_BAR; PG8_SCHED;
            PG8_LDB(B1, 0, 1); PG8_STAGE(PG8_SB(0, 0), b2, voffB);
            PG8_BAR; PG8_WAIT_L(0); PG8_MMA(0, 1, At, B1); PG8_BAR;
            PG8_LDA(At, 0, 1); PG8_STAGE(PG8_SA(0, 0), a2, voffA);
            PG8_BAR; PG8_WAIT_L(0); PG8_MMA(1, 0, At, B0); PG8_BAR; PG8_SCHED;
            PG8_STAGE(PG8_SB(0, 1), b2 + hstep, voffB);
            PG8_WAIT_V(6); PG8_BAR; PG8_MMA(1, 1, At, B1); PG8_BAR;
            PG8_LDB(B0, 1, 0); PG8_SCHED; PG8_LDA(At, 1, 0); PG8_STAGE(PG8_SA(0, 1), a2 + hstep, voffA);
            PG8_WAIT_L(8); PG8_BAR; PG8_WAIT_L(0); PG8_MMA(0, 0, At, B0); PG8_BAR; PG8_SCHED;
            PG8_LDB(B1, 1, 1); PG8_STAGE(PG8_SB(1, 0), b3, voffB);
            PG8_BAR; PG8_WAIT_L(0); PG8_MMA(0, 1, At, B1); PG8_BAR;
            PG8_LDA(At, 1, 1); PG8_STAGE(PG8_SA(1, 0), a3, voffA);
            PG8_BAR; PG8_WAIT_L(0); PG8_MMA(1, 0, At, B0); PG8_BAR; PG8_SCHED;
            PG8_STAGE(PG8_SB(1, 1), b3 + hstep, voffB);
            PG8_WAIT_V(6); PG8_BAR; PG8_MMA(1, 1, At, B1); PG8_BAR;
            }
        }
        if constexpr (ALIGN_EPI) { if (wr == 0) PG8_BAR; }
        if constexpr (!Epi::AFTER_DRAIN) { E(acc, cur, wr, wc, fr, fq); S.done(cur); }
        if (!has_next) break;
#pragma unroll
        for (int a = 0; a < 2; ++a)
#pragma unroll
            for (int b = 0; b < 2; ++b)
#pragma unroll
                for (int m = 0; m < 4; ++m)
#pragma unroll
                    for (int n = 0; n < 2; ++n) acc[a][b][m][n] = (f32x4){0.f, 0.f, 0.f, 0.f};
        cur = nxt; cA = nA; cB = nB; ++ui;
        if constexpr (ALIGN_EPI) { if (wr == 1) PG8_BAR; }
    }
    PG8_WAIT_V(0);
    if constexpr (!ALIGN_EPI) { if (wr == 0) PG8_BAR; }
    PG8_BAR;
    if constexpr (Epi::AFTER_DRAIN) { E.fused(acc, cur, wr, wc, fr, fq, lds, wid, lane); S.done(cur); }
#undef PG8_SA
#undef PG8_SB
#undef PG8_STAGE
#undef PG8_LDA
#undef PG8_LDB
#undef PG8_MMA
#undef PG8_WAIT_V
#undef PG8_WAIT_L
#undef PG8_BAR
#undef PG8_SCHED
}
}
using pg8::silu_f;

constexpr int D = 1024, BATCH = 4, SEQ = 8192, CTXL = 256, NLAT = BATCH * SEQ, NCTX = BATCH * CTXL, MROWS = NLAT + NCTX;
constexpr int PIN_SRC = 2832, PLD = 3072, FFH = 2816, NEXP = 8;
constexpr int PO_Q = 0, PO_K = 512, PO_V = 1024, PO_O = 1536, PO_F = 2048, PO_CU = 2304, PO_CG = 2560;
constexpr float EPS = 1e-6f;
constexpr int NWAVES = 8, NTHR = 512;
constexpr size_t MiB = 1u << 20;
constexpr size_t WS_CTL = 0, CTL_ZERO_BYTES = 1 * MiB;
constexpr size_t WS_MOD = 1 * MiB;
constexpr size_t WS_ROUTE = 1 * MiB + 512 * 1024;
constexpr size_t WS_WIN = 2 * MiB;
constexpr size_t WS_WOUT = 14 * MiB;
constexpr size_t WS_WGU = 18 * MiB;
constexpr size_t WS_WD = 29 * MiB;
constexpr size_t WS_MWGU = 35 * MiB;
constexpr size_t WS_MWD = 123 * MiB;
constexpr size_t WS_G = 167 * MiB;
constexpr size_t WS_XC = 170 * MiB;
constexpr size_t WS_TOK = 174 * MiB;
constexpr size_t WS_R1 = 176 * MiB;
constexpr size_t WS_Y = WS_R1, WS_HF = WS_R1 + 66 * MiB, WS_ASORT = WS_R1, WS_OPAIR = WS_R1;
constexpr size_t WS_R2 = 308 * MiB;
constexpr size_t WS_P = WS_R2, WS_H = WS_R2, WS_A = WS_R2 + 198 * MiB, WS_HB = WS_R2 + 264 * MiB, WS_HSORT = WS_R2;
constexpr size_t WS_END = 671 * MiB;
constexpr int MAXPAIR = 2 * NLAT + NEXP * 256;
static_assert(WS_WIN + (size_t)2 * PLD * D * 2 <= WS_WOUT && WS_WOUT + (size_t)2 * D * D * 2 <= WS_WGU && WS_WGU + (size_t)2 * FFH * D * 2 <= WS_WD && WS_WD + (size_t)D * FFH * 2 <= WS_MWGU, "ws map 1");
static_assert(WS_MWGU + (size_t)NEXP * 2 * FFH * D * 2 <= WS_MWD && WS_MWD + (size_t)NEXP * D * FFH * 2 <= WS_G && WS_G + (size_t)MROWS * 16 * 4 <= WS_XC && WS_XC + (size_t)NCTX * D * 4 <= WS_TOK, "ws map 2");
static_assert(WS_TOK + 3 * 256 * 1024 + (size_t)MAXPAIR * 4 * 2 <= WS_R1 && WS_Y + (size_t)MROWS * D * 2 <= WS_HF && WS_HF + (size_t)MROWS * 512 * 4 <= WS_R2 && WS_ASORT + (size_t)MAXPAIR * D * 2 <= WS_R2, "ws map 3");
static_assert(WS_P + (size_t)MROWS * PLD * 2 <= WS_A && WS_A + (size_t)MROWS * D * 2 <= WS_HB && WS_HB + (size_t)MROWS * 512 * 4 <= WS_END && WS_HSORT + (size_t)MAXPAIR * FFH * 2 <= WS_END && WS_H + (size_t)MROWS * FFH * 2 <= WS_A, "ws map 4");
constexpr int CW_BAR = 4096;
constexpr int RW_HIST = 0;
constexpr int RW_TILE_E = 4096;
constexpr int RW_NTILES = 4096 + 512;
constexpr int LDS_STAGE = 131072, LDSCTL_OFF = LDS_STAGE, LDS_BYTES = 147456;

#define GAS __attribute__((address_space(1)))
#define LAS __attribute__((address_space(3)))
typedef unsigned short bf16;
typedef unsigned v4u __attribute__((ext_vector_type(4)));
typedef unsigned v2u __attribute__((ext_vector_type(2)));
typedef float f32x4 __attribute__((ext_vector_type(4)));
__device__ __forceinline__ unsigned f2bf(float f) { unsigned u = __builtin_bit_cast(unsigned, f); return (u + 0x7fffu + ((u >> 16) & 1u)) >> 16; }
__device__ __forceinline__ unsigned pk2(float lo, float hi) { return f2bf(lo) | (f2bf(hi) << 16); }
__device__ __forceinline__ float bf2f(unsigned short b) { return __builtin_bit_cast(float, (unsigned)b << 16); }
__device__ __forceinline__ float bflo(unsigned w) { return __builtin_bit_cast(float, w << 16); }
__device__ __forceinline__ float bfhi(unsigned w) { return __builtin_bit_cast(float, w & 0xffff0000u); }
__device__ __forceinline__ float wave_sum(float v) {
#pragma unroll
    for (int o = 1; o < 64; o <<= 1) v += __shfl_xor(v, o);
    return v;
}
__device__ __forceinline__ float sigmoid_f(float x) { return 1.0f / (1.0f + __expf(-x)); }
__device__ __forceinline__ float log_sigmoid_f(float x) { return fminf(x, 0.0f) - log1pf(__expf(-fabsf(x))); }

#define XB_TMO      128
#define XB_XCNT(j)  (256  + 64 * (j))
#define XB_XSUB(j)  (1280 + 64 * (j))
#define XB_XGEN(j)  (2304 + 64 * (j))
#define XB_TOP      3328
#define XB_TOPGEN   3392
#define XCD_BAR_WORDS 3456
#define XB_SPIN_CAP (1u << 18)
#define LAS __attribute__((address_space(3)))

__device__ __forceinline__ unsigned xb_ld(unsigned* p)              { return __hip_atomic_load(p, __ATOMIC_RELAXED, __HIP_MEMORY_SCOPE_AGENT); }
__device__ __forceinline__ unsigned xb_add(unsigned* p, unsigned v) { return __hip_atomic_fetch_add(p, v, __ATOMIC_RELAXED, __HIP_MEMORY_SCOPE_AGENT); }
__device__ __forceinline__ unsigned xb_xcc_id() { return (unsigned)__builtin_amdgcn_s_getreg((3 << 11) | 20) & 0xFu; }
#define XB_SPIN(cond, bar) do { unsigned _sp = 0; while (cond) { __builtin_amdgcn_s_sleep(1); \
    if ((++_sp & 255u) == 0u) { if (xb_ld(&(bar)[XB_TMO])) break; if (_sp > XB_SPIN_CAP) { atomicAdd(&(bar)[XB_TMO], 1u); break; } } } } while (0)

struct XcdBarrier {
    unsigned* bar; unsigned x;
    volatile LAS unsigned* st;
};

__device__ __forceinline__ XcdBarrier xcd_barrier_post(unsigned* bar, volatile LAS unsigned* st) {
    XcdBarrier b; b.bar = bar; b.x = xb_xcc_id(); b.st = st;
    if (threadIdx.x == 0) (void)xb_add(&bar[XB_XCNT(b.x)], 1u);
    return b;
}
__device__ __forceinline__ void xcd_barrier_complete(unsigned* bar, unsigned x, unsigned& nloc, unsigned& nx) {
    const unsigned G = gridDim.x * gridDim.y * gridDim.z;
    unsigned sum, cnt, mine, sp = 0u;
    for (;;) {
        sum = 0u; cnt = 0u; mine = 0u;
#pragma unroll
        for (unsigned j = 0; j < 16; ++j) { const unsigned c = xb_ld(&bar[XB_XCNT(j)]); sum += c; cnt += (c > 0u) ? 1u : 0u; mine = (j == x) ? c : mine; }
        if (sum == G) break;
        __builtin_amdgcn_s_sleep(1);
        if ((++sp & 255u) == 0u) { if (xb_ld(&bar[XB_TMO])) break; if (sp > XB_SPIN_CAP) { atomicAdd(&bar[XB_TMO], 1u); break; } }
    }
    nloc = mine > 0u ? mine : 1u; nx = cnt > 0u ? cnt : 1u;
}

__device__ __forceinline__ void xcd_barrier(const XcdBarrier& b) {
    asm volatile("s_waitcnt vmcnt(0)" ::: "memory");
    __syncthreads();
    if (threadIdx.x == 0) {
        unsigned* bar = b.bar;
        __builtin_amdgcn_s_waitcnt(0);
        unsigned nloc = b.st[0], nx = b.st[1];
        if (nloc == 0u) { xcd_barrier_complete(bar, b.x, nloc, nx); b.st[0] = nloc; b.st[1] = nx; }
        const unsigned old = xb_add(&bar[XB_XSUB(b.x)], 1u);
        const unsigned gen = old / nloc;
        if (old + 1u == (gen + 1u) * nloc) {
            __builtin_amdgcn_fence(__ATOMIC_RELEASE, "agent");
            asm volatile("s_waitcnt vmcnt(0)" ::: "memory");
            const unsigned og = xb_add(&bar[XB_TOP], 1u);
            const unsigned tg = og / nx;
            if (og + 1u == (tg + 1u) * nx) xb_add(&bar[XB_TOPGEN], 1u);
            else XB_SPIN(xb_ld(&bar[XB_TOPGEN]) == tg, bar);
            __builtin_amdgcn_fence(__ATOMIC_ACQUIRE, "agent");
            xb_add(&bar[XB_XGEN(b.x)], 1u);
            asm volatile("s_waitcnt vmcnt(0)" ::: "memory");
        } else {
            XB_SPIN(xb_ld(&bar[XB_XGEN(b.x)]) == gen, bar);
            __builtin_amdgcn_fence(__ATOMIC_ACQUIRE, "agent");
            asm volatile("s_waitcnt vmcnt(0)" ::: "memory");
        }
    }
    __syncthreads();
}
#define LDS_WAIT() asm volatile("s_waitcnt lgkmcnt(0)" ::: "memory")

__device__ __forceinline__ void transpose_item(const float* W, int K, int N, bf16* WT, int dst_row0, int src_col0, int nvalid, int kb, LAS float* scr, int lane) {
    const int k0 = 64 * kb, nl = lane & 31;
#pragma unroll 8
    for (int i = 0; i < 32; ++i) { const int kk = 2 * i + (lane >> 5); scr[kk * 33 + nl] = nl < nvalid ? W[(size_t)(k0 + kk) * N + src_col0 + nl] : 0.f; }
    LDS_WAIT();
    const int c = lane & 7;
#pragma unroll
    for (int j = 0; j < 4; ++j) { const int n = (lane >> 3) + 8 * j; const LAS float* s = scr + (8 * c) * 33 + n;
        v4u o; o.x = pk2(s[0 * 33], s[1 * 33]); o.y = pk2(s[2 * 33], s[3 * 33]); o.z = pk2(s[4 * 33], s[5 * 33]); o.w = pk2(s[6 * 33], s[7 * 33]);
        *(v4u*)(WT + (size_t)(dst_row0 + n) * K + k0 + 8 * c) = o; }
    LDS_WAIT();
}
__device__ __forceinline__ void win_map(int nb, int& src, int& nvalid) { const int v0 = 32 * nb; if (v0 < 2048) { src = v0; nvalid = 32; } else if (v0 < 2816) { src = v0 + 16; nvalid = 32; } else if (v0 == 2816) { src = 2048; nvalid = 16; } else { src = 0; nvalid = 0; } }
__device__ __forceinline__ int gu_map(int nb) { const int v0 = 32 * nb; return ((v0 >> 7) & 1) * FFH + (v0 >> 8) * 128 + (v0 & 127); }

__device__ __forceinline__ void prologue_phase(const float* const* in, unsigned char* ws, LAS unsigned char* lds, int wg, int G, int tid) {
    const int lane = tid & 63, wave = tid >> 6, gw = wg * NWAVES + wave, NGW = G * NWAVES;
    LAS float* scr = (LAS float*)(lds + wave * 16384);
    constexpr int I_WIN = 16 * 96, I_WOUT = 16 * 32, I_GU = 16 * 176, I_DN = 44 * 32;
    constexpr int NITEMS = 2 * I_WIN + 2 * I_WOUT + 9 * I_GU + 9 * I_DN;
    for (int it = gw; it < NITEMS; it += NGW) {
        int r = it;
        if (r < 2 * I_WIN) { const int L = r / I_WIN; r -= L * I_WIN; const int kb = r / 96, nb = r % 96; int src, nv; win_map(nb, src, nv);
            transpose_item(in[8] + (size_t)L * D * PIN_SRC, D, PIN_SRC, (bf16*)(ws + WS_WIN) + (size_t)L * PLD * D, 32 * nb, src, nv, kb, scr, lane); continue; }
        r -= 2 * I_WIN;
        if (r < 2 * I_WOUT) { const int L = r / I_WOUT; r -= L * I_WOUT; const int kb = r / 32, nb = r % 32;
            transpose_item(in[15] + (size_t)L * D * D, D, D, (bf16*)(ws + WS_WOUT) + (size_t)L * D * D, 32 * nb, 32 * nb, 32, kb, scr, lane); continue; }
        r -= 2 * I_WOUT;
        if (r < 9 * I_GU) { const int e = r / I_GU; r -= e * I_GU; const int kb = r / 176, nb = r % 176;
            const float* W = e == 0 ? in[16] : in[20] + (size_t)(e - 1) * D * 2 * FFH; bf16* WT = e == 0 ? (bf16*)(ws + WS_WGU) : (bf16*)(ws + WS_MWGU) + (size_t)(e - 1) * 2 * FFH * D;
            transpose_item(W, D, 2 * FFH, WT, 32 * nb, gu_map(nb), 32, kb, scr, lane); continue; }
        r -= 9 * I_GU;
        { const int e = r / I_DN; r -= e * I_DN; const int kb = r / 32, nb = r % 32;
            const float* W = e == 0 ? in[17] : in[21] + (size_t)(e - 1) * FFH * D; bf16* WT = e == 0 ? (bf16*)(ws + WS_WD) : (bf16*)(ws + WS_MWD) + (size_t)(e - 1) * D * FFH;
            transpose_item(W, FFH, D, WT, 32 * nb, 32 * nb, 32, kb, scr, lane); }
    }
    __syncthreads();
    LAS float* cond_s = (LAS float*)lds;
    LAS float* part = (LAS float*)(lds + 32768);
    for (int i = tid; i < 5 * D; i += NTHR) { const int r = i >> 10, k = i & 1023; const float v = r < 4 ? in[1][r * D + k] : in[3][k]; cond_s[i] = silu_f(v); }
    __syncthreads();
    float* MOD = (float*)(ws + WS_MOD);
    for (int t = wg; t < 192; t += G) {
        const int L = t / 96, nb = t % 96; const float* W = in[6] + (size_t)L * D * 6144 + nb * 64 + lane;
        float a0 = 0.f, a1 = 0.f, a2 = 0.f, a3 = 0.f, a4 = 0.f;
#pragma unroll 8
        for (int kk = 0; kk < 128; ++kk) { const int k = wave * 128 + kk; const float w = W[(size_t)k * 6144];
            a0 += cond_s[k] * w; a1 += cond_s[D + k] * w; a2 += cond_s[2 * D + k] * w; a3 += cond_s[3 * D + k] * w; a4 += cond_s[4 * D + k] * w; }
        part[(wave * 5 + 0) * 64 + lane] = a0; part[(wave * 5 + 1) * 64 + lane] = a1; part[(wave * 5 + 2) * 64 + lane] = a2; part[(wave * 5 + 3) * 64 + lane] = a3; part[(wave * 5 + 4) * 64 + lane] = a4;
        __syncthreads();
        if (tid < 320) { const int r = tid >> 6, l = tid & 63; float s = in[7][L * 6144 + nb * 64 + l];
#pragma unroll
            for (int w = 0; w < 8; ++w) s += part[(w * 5 + r) * 64 + l];
            MOD[(size_t)(L * 5 + r) * 6144 + nb * 64 + l] = s; }
        __syncthreads();
    }
}

template <bool ROUTER>
__device__ __forceinline__ void norm_phase(const float* xlat, const float* xctx, bool do_ctx, const float* ng, const float* modL, int chunk_shift, bf16* A,
                                           const float* w_router, const float* b_router, int* tok_e, float* tok_w, int* hist, LAS unsigned char* lds, int wg, int G, int tid) {
    const int lane = tid & 63, wave = tid >> 6;
    LAS float* wr_s = (LAS float*)lds;
    LAS int* lh = (LAS int*)(lds + 32768);
    if (ROUTER) { for (int i = tid; i < D * NEXP; i += NTHR) wr_s[i] = w_router[i]; }
    for (int blk = wg; blk < 256; blk += G) {
        if (ROUTER) { if (tid < 8) lh[tid] = 0; __syncthreads(); }
        for (int pass = 0; pass < (do_ctx ? 2 : 1); ++pass) {
            const int b = pass == 0 ? (blk >> 6) : 4;
            const float* sh = modL + (size_t)b * 6144 + chunk_shift * D; const float* sc = sh + D;
            f32x4 mul[4], add[4];
#pragma unroll
            for (int j = 0; j < 4; ++j) { const int c = 4 * lane + 256 * j; const f32x4 g = *(const f32x4*)(ng + c), s = *(const f32x4*)(sc + c); mul[j] = g * (s + 1.0f); add[j] = *(const f32x4*)(sh + c); }
            const int nrow = pass == 0 ? 16 : (wave < 4 ? 1 : 0);
            for (int i = 0; i < nrow; ++i) {
                const int lrow = pass == 0 ? blk * 128 + wave * 16 + i : blk * 4 + wave;
                const float* xr = (pass == 0 ? xlat : xctx) + (size_t)lrow * D; const int arow = pass == 0 ? lrow : NLAT + lrow;
                f32x4 v[4]; float ss = 0.f;
#pragma unroll
                for (int j = 0; j < 4; ++j) { v[j] = *(const f32x4*)(xr + 4 * lane + 256 * j); ss += (v[j].x * v[j].x + v[j].y * v[j].y) + (v[j].z * v[j].z + v[j].w * v[j].w); }
                const float rstd = 1.0f / sqrtf(wave_sum(ss) * (1.0f / D) + EPS);
                unsigned long long* o8 = (unsigned long long*)(A + (size_t)arow * D) + lane;
#pragma unroll
                for (int j = 0; j < 4; ++j) { v[j] = v[j] * rstd * mul[j] + add[j]; o8[64 * j] = (unsigned long long)pk2(v[j].x, v[j].y) | ((unsigned long long)pk2(v[j].z, v[j].w) << 32); }
                if (ROUTER && pass == 0) {
                    float lg[8];
#pragma unroll
                    for (int e = 0; e < 8; ++e) lg[e] = 0.f;
#pragma unroll
                    for (int j = 0; j < 4; ++j)
#pragma unroll
                        for (int q = 0; q < 4; ++q) { const int c = 4 * lane + 256 * j + q; const f32x4 w0 = *(const LAS f32x4*)(wr_s + c * 8), w1 = *(const LAS f32x4*)(wr_s + c * 8 + 4); const float y = v[j][q];
                            lg[0] += y * w0.x; lg[1] += y * w0.y; lg[2] += y * w0.z; lg[3] += y * w0.w; lg[4] += y * w1.x; lg[5] += y * w1.y; lg[6] += y * w1.z; lg[7] += y * w1.w; }
#pragma unroll
                    for (int e = 0; e < 8; ++e) lg[e] = wave_sum(lg[e]) + b_router[e];
                    if (lane == 0) {
                        int e1 = 0; float v1 = lg[0];
#pragma unroll
                        for (int e = 1; e < 8; ++e) if (lg[e] > v1) { v1 = lg[e]; e1 = e; }
                        int e2 = -1; float v2 = -3.0e38f;
#pragma unroll
                        for (int e = 0; e < 8; ++e) if (e != e1 && lg[e] > v2) { v2 = lg[e]; e2 = e; }
                        const float w2 = 1.0f / (1.0f + __expf(v1 - v2)), w1 = 1.0f - w2;
                        tok_e[lrow * 2] = e1; tok_e[lrow * 2 + 1] = e2; tok_w[lrow * 2] = w1; tok_w[lrow * 2 + 1] = w2;
                        __hip_atomic_fetch_add(&lh[e1], 1, __ATOMIC_RELAXED, __HIP_MEMORY_SCOPE_WORKGROUP); __hip_atomic_fetch_add(&lh[e2], 1, __ATOMIC_RELAXED, __HIP_MEMORY_SCOPE_WORKGROUP);
                    }
                }
            }
        }
        if (ROUTER) { __syncthreads(); if (tid < 8) hist[blk * 8 + tid] = lh[tid]; __syncthreads(); }
    }
}

__device__ __forceinline__ void route_phase(unsigned char* ws, LAS unsigned char* lds, int wg, int G, int tid) {
    const int lane = tid & 63, wave = tid >> 6;
    int* rw = (int*)(ws + WS_ROUTE); const int* hist = rw + RW_HIST;
    const int* tok_e = (const int*)(ws + WS_TOK); const float* tok_w = (const float*)(ws + WS_TOK + 256 * 1024); int* pair_pos = (int*)(ws + WS_TOK + 512 * 1024); float* row_w = (float*)(ws + WS_TOK + 768 * 1024);
    const bf16* A = (const bf16*)(ws + WS_A); bf16* AS = (bf16*)(ws + WS_ASORT);
    LAS int* hs = (LAS int*)lds;
    LAS int* tot = hs + 2048;
    LAS int* te = hs + 2048 + 32;
    LAS int* ps = te + 256;
    for (int blk = wg; blk < 256; blk += G) {
        __syncthreads();
        for (int i = tid; i < 2048; i += NTHR) hs[i] = hist[i];
        if (tid < 256) te[tid] = tok_e[blk * 256 + tid];
        __syncthreads();
        if (tid < 8) { int t = 0, mb = 0; for (int b = 0; b < 256; ++b) { const int h = hs[b * 8 + tid]; t += h; mb += (b < blk) ? h : 0; } tot[tid] = t; tot[16 + tid] = mb; }
        __syncthreads();
        if (tid == 0) { int s = 0; for (int e = 0; e < 8; ++e) { tot[8 + e] = s; s += (tot[e] + 255) & ~255; } tot[24] = s >> 8; }
        __syncthreads();
        if (tid < 256) { const int e = te[tid]; int rank = 0; for (int q = 0; q < tid; ++q) rank += (te[q] == e) ? 1 : 0;
            const int pos = tot[8 + e] + tot[16 + e] + rank; ps[tid] = pos; pair_pos[blk * 256 + tid] = pos; row_w[pos] = tok_w[blk * 256 + tid]; }
        __syncthreads();
        for (int q = wave * 32; q < wave * 32 + 32; ++q) { const int token = blk * 128 + (q >> 1), pos = ps[q];
            const v4u* s = (const v4u*)(A + (size_t)token * D); v4u* d = (v4u*)(AS + (size_t)pos * D); const v4u a = s[lane], b = s[lane + 64]; d[lane] = a; d[lane + 64] = b; }
        if (blk == 0) {
            if (tid < 264) { int e = 0; for (int e2 = 1; e2 < 8; ++e2) if (tid * 256 >= tot[8 + e2]) e = e2; rw[RW_TILE_E + tid] = e; }
            if (tid == 0) rw[RW_NTILES] = tot[24];
        }
        if (blk < 8) { const int e = blk, r0 = tot[8 + e] + tot[e], r1 = tot[8 + e] + ((tot[e] + 255) & ~255);
            for (int r = r0 + wave; r < r1; r += NWAVES) { v4u* d = (v4u*)(AS + (size_t)r * D); const v4u z = {0u, 0u, 0u, 0u}; d[lane] = z; d[lane + 64] = z; if (lane == 0) row_w[r] = 0.f; } }
    }
}

__device__ __forceinline__ void mout_phase(const float* HF, const float* HB, const bf16* P, const float* ng, bf16* Y, int nrows, int wg, int G, int tid) {
    const int lane = tid & 63, wave = tid >> 6;
    const f32x4 g0 = *(const f32x4*)(ng + 8 * lane), g1 = *(const f32x4*)(ng + 8 * lane + 4);
    for (int row = wg * NWAVES + wave; row < nrows; row += G * NWAVES) {
        const f32x4 a0 = *(const f32x4*)(HF + (size_t)row * 512 + 8 * lane), a1 = *(const f32x4*)(HF + (size_t)row * 512 + 8 * lane + 4);
        const f32x4 b0 = *(const f32x4*)(HB + (size_t)row * 512 + 8 * lane), b1 = *(const f32x4*)(HB + (size_t)row * 512 + 8 * lane + 4);
        const v4u o = *(const v4u*)(P + (size_t)row * PLD + PO_O + 8 * lane);
        const f32x4 s0 = a0 + b0, s1 = a1 + b1;
        float ss = (s0.x * s0.x + s0.y * s0.y) + (s0.z * s0.z + s0.w * s0.w) + (s1.x * s1.x + s1.y * s1.y) + (s1.z * s1.z + s1.w * s1.w);
        ss += __shfl_xor(ss, 1); ss += __shfl_xor(ss, 2); ss += __shfl_xor(ss, 4); ss += __shfl_xor(ss, 8);
        const float rstd = 1.0f / sqrtf(ss * (1.0f / 128.0f) + EPS);
        v4u w;
        w.x = pk2(sigmoid_f(bflo(o.x)) * s0.x * rstd * g0.x, sigmoid_f(bfhi(o.x)) * s0.y * rstd * g0.y);
        w.y = pk2(sigmoid_f(bflo(o.y)) * s0.z * rstd * g0.z, sigmoid_f(bfhi(o.y)) * s0.w * rstd * g0.w);
        w.z = pk2(sigmoid_f(bflo(o.z)) * s1.x * rstd * g1.x, sigmoid_f(bfhi(o.z)) * s1.y * rstd * g1.y);
        w.w = pk2(sigmoid_f(bflo(o.w)) * s1.z * rstd * g1.z, sigmoid_f(bfhi(o.w)) * s1.w * rstd * g1.w);
        *(v4u*)(Y + (size_t)row * D + 8 * lane) = w;
    }
}

__device__ __forceinline__ void final_phase(float* X, const bf16* O, const int* pair_pos, const float* modL, const float* fg, int wg, int G, int tid) {
    const int lane = tid & 63, wave = tid >> 6;
    for (int row = wg * NWAVES + wave; row < NLAT; row += G * NWAVES) {
        const int b = row >> 13; const float* g2 = modL + (size_t)b * 6144 + 5 * D;
        const int p1 = pair_pos[row * 2], p2 = pair_pos[row * 2 + 1];
        float* xr = X + (size_t)row * D; const v2u* o1 = (const v2u*)(O + (size_t)p1 * D) + lane; const v2u* o2 = (const v2u*)(O + (size_t)p2 * D) + lane;
        f32x4 v[4]; float ss = 0.f;
#pragma unroll
        for (int j = 0; j < 4; ++j) { const f32x4 x = *(const f32x4*)(xr + 4 * lane + 256 * j), g = *(const f32x4*)(g2 + 4 * lane + 256 * j); const v2u a = o1[64 * j], c = o2[64 * j];
            f32x4 m; m.x = bflo(a.x) + bflo(c.x); m.y = bfhi(a.x) + bfhi(c.x); m.z = bflo(a.y) + bflo(c.y); m.w = bfhi(a.y) + bfhi(c.y);
            v[j] = x + g * m; ss += (v[j].x * v[j].x + v[j].y * v[j].y) + (v[j].z * v[j].z + v[j].w * v[j].w); }
        const float rstd = 1.0f / sqrtf(wave_sum(ss) * (1.0f / D) + EPS);
#pragma unroll
        for (int j = 0; j < 4; ++j) { const f32x4 g = *(const f32x4*)(fg + 4 * lane + 256 * j); *(f32x4*)(xr + 4 * lane + 256 * j) = v[j] * rstd * g; }
    }
}

__device__ __forceinline__ void mlstm_naive_task(const bf16* P, const float* Gt, const float* bgate, float* HF, float* HB, LAS unsigned char* lds, int task, int tid) {
    const int bb = task >> 6, h = (task >> 4) & 3, dir = (task >> 3) & 1, sl = task & 7;
    const int e = tid & 15, dg = tid >> 4, d0 = dg * 4, wave = tid >> 6, lane = tid & 63;
    float C0 = 0.f, C1 = 0.f, C2 = 0.f, C3 = 0.f, n0 = 0.f, n1 = 0.f, n2 = 0.f, n3 = 0.f, m = -1e30f;
    const float bi = bgate[dir * 8 + h], bfg = bgate[dir * 8 + 4 + h];
    float* HS = dir ? HB : HF;
    LAS float* red = (LAS float*)lds;
    constexpr int NSTEP = CTXL + SEQ;
    constexpr float KSC = 0.08838834764831845f;
    __syncthreads();
#define MLSTM_ROW(s) ((s) < CTXL ? NLAT + bb * CTXL + (dir ? CTXL - 1 - (s) : (s)) : bb * SEQ + (dir ? SEQ - 1 - ((s) - CTXL) : ((s) - CTXL)))
    int rown = MLSTM_ROW(0);
    v2u qn = *(const v2u*)(P + (size_t)rown * PLD + PO_Q + h * 128 + d0), kn = *(const v2u*)(P + (size_t)rown * PLD + PO_K + h * 128 + d0);
    unsigned short vn = P[(size_t)rown * PLD + PO_V + h * 128 + sl * 16 + e]; float gin = Gt[(size_t)rown * 16 + dir * 8 + h], gfn = Gt[(size_t)rown * 16 + dir * 8 + 4 + h];
    for (int s = 0; s < NSTEP; ++s) {
        const int row = rown; const v2u q2 = qn, k2 = kn; const float v = bf2f(vn), ipre = gin + bi, fpre = gfn + bfg;
        if (s + 1 < NSTEP) { rown = MLSTM_ROW(s + 1);
            qn = *(const v2u*)(P + (size_t)rown * PLD + PO_Q + h * 128 + d0); kn = *(const v2u*)(P + (size_t)rown * PLD + PO_K + h * 128 + d0);
            vn = P[(size_t)rown * PLD + PO_V + h * 128 + sl * 16 + e]; gin = Gt[(size_t)rown * 16 + dir * 8 + h]; gfn = Gt[(size_t)rown * 16 + dir * 8 + 4 + h]; }
        const float q0 = bflo(q2.x), q1 = bfhi(q2.x), q2f = bflo(q2.y), q3 = bfhi(q2.y);
        const float k0 = bflo(k2.x) * KSC, k1 = bfhi(k2.x) * KSC, k2f = bflo(k2.y) * KSC, k3 = bfhi(k2.y) * KSC;
        const float lf = log_sigmoid_f(fpre), mn = fmaxf(lf + m, ipre), fw = __expf(lf + m - mn), iw = __expf(ipre - mn); m = mn;
        const float kv = iw * v;
        C0 = fw * C0 + k0 * kv; C1 = fw * C1 + k1 * kv; C2 = fw * C2 + k2f * kv; C3 = fw * C3 + k3 * kv;
        n0 = fw * n0 + iw * k0; n1 = fw * n1 + iw * k1; n2 = fw * n2 + iw * k2f; n3 = fw * n3 + iw * k3;
        float pn = (q0 * C0 + q1 * C1) + (q2f * C2 + q3 * C3), pd = (q0 * n0 + q1 * n1) + (q2f * n2 + q3 * n3);
        pn += __shfl_xor(pn, 16); pn += __shfl_xor(pn, 32); pd += __shfl_xor(pd, 16); pd += __shfl_xor(pd, 32);
        const int par = s & 1;
        if (lane < 16) red[(par * 8 + wave) * 17 + lane] = pn;
        if (lane == 0) red[(par * 8 + wave) * 17 + 16] = pd;
        __syncthreads();
        if (tid < 16) { float num = 0.f, den = 0.f;
#pragma unroll
            for (int w = 0; w < 8; ++w) { num += red[(par * 8 + w) * 17 + tid]; den += red[(par * 8 + w) * 17 + 16]; }
            HS[(size_t)row * 512 + h * 128 + sl * 16 + tid] = num / fmaxf(fabsf(den), __expf(-m)); }
    }
#undef MLSTM_ROW
    __syncthreads();
}
typedef float f32x2 __attribute__((ext_vector_type(2)));
__device__ __forceinline__ void fourier_naive_task(const bf16* P, bf16* Y, LAS unsigned char* lds, int task, bool ctx, int tid) {
    const int lane = tid & 63, wave = tid >> 6;
    LAS f32x2* tab = (LAS f32x2*)lds;
    LAS unsigned short* zb = (LAS unsigned short*)(lds + 65536);
    LAS float* ure_s = (LAS float*)(lds + 98304);
    LAS float* uim_s = ure_s + 4096;
    const int N = ctx ? CTXL : SEQ, nkb = N / 64, tstride = 8192 / N;
    const int b = task / (4 * nkb), g = (task / nkb) & 3, kb = task % nkb;
    const int rowbase = ctx ? NLAT + b * CTXL : b * SEQ;
    float ure[8], uim[8]; int idx[8], stp[8];
#pragma unroll
    for (int j = 0; j < 8; ++j) { ure[j] = 0.f; uim[j] = 0.f; idx[j] = 0; stp[j] = ((kb * 64 + wave * 8 + j) * tstride) & 8191; }
    for (int nb0 = 0; nb0 < N; nb0 += 256) {
        __syncthreads();
#pragma unroll
        for (int i = 0; i < 4; ++i) { const int p = tid + NTHR * i, r = p >> 3, ch = p & 7;
            *(LAS v4u*)(zb + r * 64 + ch * 8) = *(const v4u*)(P + (size_t)(rowbase + nb0 + r) * PLD + PO_F + g * 64 + ch * 8); }
        __syncthreads();
#pragma unroll 2
        for (int nn = 0; nn < 256; ++nn) { const float z = bf2f(zb[nn * 64 + lane]);
#pragma unroll
            for (int j = 0; j < 8; ++j) { const f32x2 t = tab[idx[j]]; ure[j] += z * t.x; uim[j] -= z * t.y; idx[j] = (idx[j] + stp[j]) & 8191; } }
    }
    __syncthreads();
#pragma unroll
    for (int j = 0; j < 8; ++j) { ure_s[(wave * 8 + j) * 64 + lane] = ure[j]; uim_s[(wave * 8 + j) * 64 + lane] = uim[j]; }
    __syncthreads();
    const float scale = 1.0f / sqrtf((float)N * 64.0f);
#pragma unroll 1
    for (int j = 0; j < 8; ++j) { const int kl = wave * 8 + j; float acc = 0.f;
#pragma unroll 4
        for (int c = 0; c < 64; ++c) { const f32x2 t = tab[((c * lane) & 63) * 128]; acc += ure_s[kl * 64 + c] * t.x + uim_s[kl * 64 + c] * t.y; }
        Y[(size_t)(rowbase + kb * 64 + kl) * D + 512 + g * 64 + lane] = (bf16)f2bf(acc * scale); }
}
__device__ __forceinline__ void conv_task(const bf16* P, bf16* Y, const float* dw, const float* db, const float* lg, const float* lb, LAS unsigned char* lds, int task, bool ctx, int tid) {
    const int lane = tid & 63, wave = tid >> 6;
    const int N = ctx ? CTXL : SEQ, ntile = N / 32, b = task / ntile, t0 = (task % ntile) * 32, rowbase = ctx ? NLAT + b * CTXL : b * SEQ;
    LAS float* a = (LAS float*)lds;
    LAS float* o = a + 62 * 256;
    __syncthreads();
    for (int i = tid; i < 62 * 256; i += NTHR) { const int r = i >> 8, ch = i & 255, t = t0 - 15 + r; float v = 0.f;
        if (t >= 0 && t < N) { const bf16* pr = P + (size_t)(rowbase + t) * PLD; v = bf2f(pr[PO_CU + ch]) * sigmoid_f(bf2f(pr[PO_CG + ch])); }
        a[i] = v; }
    __syncthreads();
    { const int ch = tid & 255, th = tid >> 8; float w[31];
#pragma unroll
        for (int j = 0; j < 31; ++j) w[j] = dw[j * 256 + ch];
        const float bias = db[ch];
        for (int tt = 0; tt < 16; ++tt) { const int t = th * 16 + tt; float s = bias;
#pragma unroll
            for (int j = 0; j < 31; ++j) s += a[(t + j) * 256 + ch] * w[j];
            o[t * 256 + ch] = s; } }
    __syncthreads();
    for (int i = 0; i < 16; ++i) { const int p = wave * 16 + i, t = p >> 2, g = p & 3; const float v = o[t * 256 + g * 64 + lane];
        const float mu = wave_sum(v) * (1.0f / 64.0f), d = v - mu, var = wave_sum(d * d) * (1.0f / 64.0f);
        const float yn = d * (1.0f / sqrtf(var + EPS)) * lg[g * 64 + lane] + lb[g * 64 + lane];
        Y[(size_t)(rowbase + t0 + t) * D + 768 + g * 64 + lane] = (bf16)f2bf(silu_f(yn)); }
}
__device__ __forceinline__ void mix_naive_phase(const float* const* in, unsigned char* ws, int L, bool do_ctx, LAS unsigned char* lds, int wg, int G, int tid) {
    const bf16* P = (const bf16*)(ws + WS_P); bf16* Y = (bf16*)(ws + WS_Y);
#ifndef MIXSEL
#define MIXSEL 7
#endif
    if (MIXSEL & 1) for (int t = wg; t < 256; t += G) mlstm_naive_task(P, (const float*)(ws + WS_G), in[9] + L * 16, (float*)(ws + WS_HF), (float*)(ws + WS_HB), lds, t, tid);
    __syncthreads();
    { LAS f32x2* tab = (LAS f32x2*)lds; for (int i = tid; i < 8192; i += NTHR) { float s, c; sincospif((float)i * (1.0f / 4096.0f), &s, &c); tab[i] = (f32x2){c, s}; } }
    __syncthreads();
    if (MIXSEL & 2) for (int t = wg; t < 16 * 128; t += G) fourier_naive_task(P, Y, lds, t, false, tid);
    if ((MIXSEL & 2) && do_ctx) for (int t = wg; t < 16 * 4; t += G) fourier_naive_task(P, Y, lds, t, true, tid);
    if (MIXSEL & 4) for (int t = wg; t < 4 * 256; t += G) conv_task(P, Y, in[11] + L * 31 * 256, in[12] + L * 256, in[13] + L * 256, in[14] + L * 256, lds, t, false, tid);
    if ((MIXSEL & 4) && do_ctx) for (int t = wg; t < 4 * 8; t += G) conv_task(P, Y, in[11] + L * 31 * 256, in[12] + L * 256, in[13] + L * 256, in[14] + L * 256, lds, t, true, tid);
}

typedef short bf16x8v __attribute__((ext_vector_type(8)));
constexpr size_t WS_NS = WS_R2 + 330 * MiB;
constexpr size_t WS_SC = WS_R2 + 333 * MiB;
static_assert(WS_HB + (size_t)16 * 132 * 16384 * 2 <= WS_NS && WS_NS + (size_t)2 * 16 * 132 * 128 * 4 <= WS_SC && WS_SC + (size_t)2 * 16 * 132 * 16 <= WS_END && WS_HF + (size_t)16 * 132 * 16384 * 2 <= WS_R2, "mlstm state map");
constexpr int NCHK = 132;
constexpr float KSC = 0.08838834764831845f;
__device__ __forceinline__ int chunk_rowbase(int b, int c) { return c < 128 ? b * SEQ + 64 * c : NLAT + b * CTXL + 64 * (c - 128); }
__device__ __forceinline__ float scan_add(float x, int lane, bool rev) {
#pragma unroll
    for (int o = 1; o < 64; o <<= 1) { const float y = rev ? __shfl_down(x, o) : __shfl_up(x, o); const bool ok = rev ? (lane + o < 64) : (lane >= o); x = ok ? x + y : x; }
    return x;
}
__device__ __forceinline__ float scan_max(float x, int lane, bool rev) {
#pragma unroll
    for (int o = 1; o < 64; o <<= 1) { const float y = rev ? __shfl_down(x, o) : __shfl_up(x, o); const bool ok = rev ? (lane + o < 64) : (lane >= o); x = ok ? fmaxf(x, y) : x; }
    return x;
}
__device__ __forceinline__ float wave_max(float v) {
#pragma unroll
    for (int o = 1; o < 64; o <<= 1) v = fmaxf(v, __shfl_xor(v, o));
    return v;
}
#define MFMA16(a, b, c) __builtin_amdgcn_mfma_f32_16x16x32_bf16((a), (b), (c), 0, 0, 0)

__device__ __forceinline__ void mlstm_m1_task(const bf16* P, const float* Gt, const float* bg, unsigned char* ws, LAS unsigned char* lds, int task, int tid) {
    const int lane = tid & 63, wave = tid >> 6, r = lane & 15, g = lane >> 4;
    const int bh = task / NCHK, c = task % NCHK, b = bh >> 2, h = bh & 3, rowbase = chunk_rowbase(b, c);
    LAS unsigned short* KT0 = (LAS unsigned short*)lds;
    LAS unsigned short* VT = (LAS unsigned short*)(lds + 36864);
    LAS float* gw = (LAS float*)(lds + 55296);
    float* SC = (float*)(ws + WS_SC); float* NS = (float*)(ws + WS_NS);
    __syncthreads();
    if (wave < 2) { const int dir = wave; const float* gr = Gt + (size_t)(rowbase + lane) * 16 + dir * 8 + h;
        const float a = gr[0] + bg[dir * 8 + h], lf = log_sigmoid_f(gr[4] + bg[dir * 8 + 4 + h]);
        const float cum = scan_add(lf, lane, dir != 0), gg = a - cum, gmax = wave_max(gg);
        gw[dir * 64 + lane] = __expf(gg - gmax) * KSC;
        const float tot = __shfl(cum, dir ? 0 : 63);
        if (lane == 0) { float* sc = SC + ((size_t)(dir * 16 + bh) * NCHK + c) * 4; sc[0] = tot; sc[1] = tot + gmax; } }
    __syncthreads();
#pragma unroll
    for (int i2 = 0; i2 < 2; ++i2) { const int p = tid + NTHR * i2, s = p >> 4, dg = p & 15;
        const v4u kq = *(const v4u*)(P + (size_t)(rowbase + s) * PLD + PO_K + h * 128 + dg * 8), vq = *(const v4u*)(P + (size_t)(rowbase + s) * PLD + PO_V + h * 128 + dg * 8);
        const float wf = gw[s], wb = gw[64 + s];
        const unsigned kk[4] = {kq.x, kq.y, kq.z, kq.w}, vv[4] = {vq.x, vq.y, vq.z, vq.w};
#pragma unroll
        for (int j = 0; j < 4; ++j) { const float k0 = bflo(kk[j]), k1 = bfhi(kk[j]); const int d = dg * 8 + 2 * j;
            KT0[d * 72 + s] = (unsigned short)f2bf(k0 * wf); KT0[(d + 1) * 72 + s] = (unsigned short)f2bf(k1 * wf);
            KT0[9216 + d * 72 + s] = (unsigned short)f2bf(k0 * wb); KT0[9216 + (d + 1) * 72 + s] = (unsigned short)f2bf(k1 * wb);
            VT[d * 72 + s] = (unsigned short)(vv[j] & 0xffffu); VT[(d + 1) * 72 + s] = (unsigned short)(vv[j] >> 16); } }
    __syncthreads();
    { const int dir = wave >> 2, dt0 = (wave & 3) * 2; LAS unsigned short* KT = KT0 + dir * 9216;
        bf16* CS = (bf16*)(ws + (dir ? WS_HB : WS_HF)) + ((size_t)bh * NCHK + c) * 16384;
        bf16x8v af[2][2];
#pragma unroll
        for (int m = 0; m < 2; ++m)
#pragma unroll
            for (int kk = 0; kk < 2; ++kk) af[m][kk] = *(const LAS bf16x8v*)(KT + ((dt0 + m) * 16 + r) * 72 + kk * 32 + 8 * g);
#pragma unroll
        for (int et = 0; et < 8; ++et) {
            const bf16x8v b0 = *(const LAS bf16x8v*)(VT + (et * 16 + r) * 72 + 8 * g), b1 = *(const LAS bf16x8v*)(VT + (et * 16 + r) * 72 + 32 + 8 * g);
#pragma unroll
            for (int m = 0; m < 2; ++m) { f32x4 acc = {0.f, 0.f, 0.f, 0.f}; acc = MFMA16(af[m][0], b0, acc); acc = MFMA16(af[m][1], b1, acc);
                v2u o; o.x = pk2(acc[0], acc[1]); o.y = pk2(acc[2], acc[3]);
                *(v2u*)(CS + (size_t)(et * 16 + r) * 128 + (dt0 + m) * 16 + 4 * g) = o; } }
    }
    if (tid < 256) { const int dir = tid >> 7, dd = tid & 127; const LAS unsigned short* kr = KT0 + dir * 9216 + dd * 72; float s = 0.f;
#pragma unroll
        for (int q = 0; q < 8; ++q) { const v4u w = *(const LAS v4u*)(kr + 8 * q); s += (bflo(w.x) + bfhi(w.x)) + (bflo(w.y) + bfhi(w.y)) + (bflo(w.z) + bfhi(w.z)) + (bflo(w.w) + bfhi(w.w)); }
        NS[((size_t)(dir * 16 + bh) * NCHK + c) * 128 + dd] = s; }
}

__device__ __forceinline__ void mlstm_m2_phase(unsigned char* ws, int wg, int G, int tid) {
    for (int u = wg; u < 256; u += G) {
        const int seq = u >> 3, part = u & 7, dir = seq >> 4, bh = seq & 15;
        bf16* base = (bf16*)(ws + (dir ? WS_HB : WS_HF)) + (size_t)bh * NCHK * 16384 + part * 2048 + tid * 4;
        float* SC = (float*)(ws + WS_SC) + (size_t)(dir * 16 + bh) * NCHK * 4;
        float* NSb = (float*)(ws + WS_NS) + (size_t)(dir * 16 + bh) * NCHK * 128 + tid * 4;
        const bool do_n = (part == 0 && tid < 32), do_m = (part == 0 && tid == 0);
        float s0 = 0.f, s1 = 0.f, s2 = 0.f, s3 = 0.f, m = -1e30f; f32x4 ns = {0.f, 0.f, 0.f, 0.f};
        for (int j0 = 0; j0 < NCHK; j0 += 4) {
            v2u dl[4]; float tot[4], ml[4]; int cc[4]; f32x4 dn[4];
#pragma unroll
            for (int q = 0; q < 4; ++q) { const int j = j0 + q; cc[q] = dir ? (NCHK - 1 - j) : ((j + 128) % NCHK);
                dl[q] = *(const v2u*)(base + (size_t)cc[q] * 16384); tot[q] = SC[cc[q] * 4]; ml[q] = SC[cc[q] * 4 + 1];
                if (do_n) dn[q] = *(const f32x4*)(NSb + (size_t)cc[q] * 128); }
#pragma unroll
            for (int q = 0; q < 4; ++q) {
                v2u o; o.x = pk2(s0, s1); o.y = pk2(s2, s3); *(v2u*)(base + (size_t)cc[q] * 16384) = o;
                if (do_n) *(f32x4*)(NSb + (size_t)cc[q] * 128) = ns;
                if (do_m) SC[cc[q] * 4 + 2] = m;
                const float me = fmaxf(tot[q] + m, ml[q]), al = __expf(tot[q] + m - me), be = __expf(ml[q] - me); m = me;
                s0 = al * s0 + be * bflo(dl[q].x); s1 = al * s1 + be * bfhi(dl[q].x); s2 = al * s2 + be * bflo(dl[q].y); s3 = al * s3 + be * bfhi(dl[q].y);
                if (do_n) ns = ns * al + dn[q] * be;
            }
        }
    }
}

__device__ __forceinline__ void mlstm_m3_task(const bf16* P, const float* Gt, const float* bg, const float* ngl, unsigned char* ws, bf16* Y, LAS unsigned char* lds, int task, int tid) {
    const int lane = tid & 63, wave = tid >> 6, r = lane & 15, g = lane >> 4;
    const int bh = task / NCHK, c = task % NCHK, b = bh >> 2, h = bh & 3, rowbase = chunk_rowbase(b, c);
    LAS unsigned short* Qs = (LAS unsigned short*)lds;
    LAS unsigned short* Ks = (LAS unsigned short*)(lds + 17408);
    LAS unsigned short* VT = (LAS unsigned short*)(lds + 34816);
    LAS unsigned short* CT = (LAS unsigned short*)(lds + 53248);
    LAS float* nsl = (LAS float*)(lds + 122880);
    LAS float* tok = (LAS float*)(lds + 123904);
    LAS float* dens = (LAS float*)(lds + 125952);
    LAS float* ssq = (LAS float*)(lds + 126976);
    const float* SC = (const float*)(ws + WS_SC); const float* NS = (const float*)(ws + WS_NS);
    __syncthreads();
    if (wave < 2) { const int dir = wave; const float* gr = Gt + (size_t)(rowbase + lane) * 16 + dir * 8 + h;
        const float a = gr[0] + bg[dir * 8 + h], lf = log_sigmoid_f(gr[4] + bg[dir * 8 + 4 + h]);
        const float cum = scan_add(lf, lane, dir != 0), gg = a - cum, pm = scan_max(gg, lane, dir != 0);
        const float mst = SC[((size_t)(dir * 16 + bh) * NCHK + c) * 4 + 2];
        tok[dir * 256 + lane] = -fmaxf(mst, pm); tok[dir * 256 + 64 + lane] = gg; tok[dir * 256 + 128 + lane] = cum; tok[dir * 256 + 192 + lane] = mst; }
    else if (wave < 4) { const int dir = wave - 2; const float* src = NS + ((size_t)(dir * 16 + bh) * NCHK + c) * 128; nsl[dir * 128 + lane] = src[lane]; nsl[dir * 128 + 64 + lane] = src[64 + lane]; }
#pragma unroll
    for (int i2 = 0; i2 < 2; ++i2) { const int p = tid + NTHR * i2, s = p >> 4, dg = p & 15; const bf16* pr = P + (size_t)(rowbase + s) * PLD + h * 128 + dg * 8;
        const v4u qq = *(const v4u*)(pr + PO_Q), kq = *(const v4u*)(pr + PO_K), vq = *(const v4u*)(pr + PO_V);
        *(LAS v4u*)(Qs + s * 136 + dg * 8) = qq; *(LAS v4u*)(Ks + s * 136 + dg * 8) = kq;
        const unsigned vv[4] = {vq.x, vq.y, vq.z, vq.w};
#pragma unroll
        for (int j = 0; j < 4; ++j) { const int d = dg * 8 + 2 * j; VT[d * 72 + s] = (unsigned short)(vv[j] & 0xffffu); VT[(d + 1) * 72 + s] = (unsigned short)(vv[j] >> 16); } }
#pragma unroll
    for (int i2 = 0; i2 < 8; ++i2) { const int p = tid + NTHR * i2, dir = p >> 11, e = (p >> 4) & 127, dg = p & 15;
        const bf16* CS = (const bf16*)(ws + (dir ? WS_HB : WS_HF)) + ((size_t)bh * NCHK + c) * 16384;
        *(LAS v4u*)(CT + dir * 17408 + e * 136 + dg * 8) = *(const v4u*)(CS + e * 128 + dg * 8); }
    __syncthreads();
    const int rt = wave & 3, ch = wave >> 2;
    bf16x8v qf[4];
#pragma unroll
    for (int kk = 0; kk < 4; ++kk) qf[kk] = *(const LAS bf16x8v*)(Qs + (16 * rt + r) * 136 + 32 * kk + 8 * g);
    f32x4 sT[4];
#pragma unroll
    for (int st = 0; st < 4; ++st) { f32x4 acc = {0.f, 0.f, 0.f, 0.f};
#pragma unroll
        for (int kk = 0; kk < 4; ++kk) { const bf16x8v a = *(const LAS bf16x8v*)(Ks + (16 * st + r) * 136 + 32 * kk + 8 * g); acc = MFMA16(a, qf[kk], acc); }
        sT[st] = acc; }
    const int t = 16 * rt + r;
    const float uf = tok[t], ub = tok[256 + t];
    float dsf = 0.f, dsb = 0.f; f32x4 Sf[4], Sb[4];
#pragma unroll
    for (int st = 0; st < 4; ++st)
#pragma unroll
        for (int i = 0; i < 4; ++i) { const int s = 16 * st + 4 * g + i; const float sv = sT[st][i] * KSC;
            const float wf = (s <= t) ? __expf(uf + tok[64 + s]) : 0.f, wb = (s >= t) ? __expf(ub + tok[256 + 64 + s]) : 0.f;
            Sf[st][i] = sv * wf; Sb[st][i] = sv * wb; dsf += Sf[st][i]; dsb += Sb[st][i]; }
    float qnf = 0.f, qnb = 0.f;
#pragma unroll
    for (int kk = 0; kk < 4; ++kk)
#pragma unroll
        for (int i = 0; i < 8; ++i) { const float qv = bf2f((unsigned short)qf[kk][i]); const int d = 32 * kk + 8 * g + i; qnf += qv * nsl[d]; qnb += qv * nsl[128 + d]; }
    dsf += __shfl_xor(dsf, 16); dsf += __shfl_xor(dsf, 32); dsb += __shfl_xor(dsb, 16); dsb += __shfl_xor(dsb, 32);
    qnf += __shfl_xor(qnf, 16); qnf += __shfl_xor(qnf, 32); qnb += __shfl_xor(qnb, 16); qnb += __shfl_xor(qnb, 32);
    if (g == 0) { dens[(wave * 2 + 0) * 16 + r] = dsf + __expf(uf + tok[192 + t]) * qnf; dens[(wave * 2 + 1) * 16 + r] = dsb + __expf(ub + tok[256 + 192 + t]) * qnb; }
    bf16x8v paf[2], pab[2];
#pragma unroll
    for (int k2 = 0; k2 < 2; ++k2) {
        v4u w; w.x = pk2(Sf[2 * k2][0], Sf[2 * k2][1]); w.y = pk2(Sf[2 * k2][2], Sf[2 * k2][3]); w.z = pk2(Sf[2 * k2 + 1][0], Sf[2 * k2 + 1][1]); w.w = pk2(Sf[2 * k2 + 1][2], Sf[2 * k2 + 1][3]); paf[k2] = __builtin_bit_cast(bf16x8v, w);
        v4u x; x.x = pk2(Sb[2 * k2][0], Sb[2 * k2][1]); x.y = pk2(Sb[2 * k2][2], Sb[2 * k2][3]); x.z = pk2(Sb[2 * k2 + 1][0], Sb[2 * k2 + 1][1]); x.w = pk2(Sb[2 * k2 + 1][2], Sb[2 * k2 + 1][3]); pab[k2] = __builtin_bit_cast(bf16x8v, x); }
    LDS_WAIT();
    float intf[4], intb[4], rdf[4], rdb[4];
#pragma unroll
    for (int i = 0; i < 4; ++i) { const int tr = 16 * rt + 4 * g + i, tl = 4 * g + i;
        const float u0 = tok[tr], u1 = tok[256 + tr];
        intf[i] = __expf(u0 + tok[192 + tr]); intb[i] = __expf(u1 + tok[256 + 192 + tr]);
        rdf[i] = 1.0f / fmaxf(fabsf(dens[(wave * 2 + 0) * 16 + tl]), __expf(u0 - tok[128 + tr])); rdb[i] = 1.0f / fmaxf(fabsf(dens[(wave * 2 + 1) * 16 + tl]), __expf(u1 - tok[256 + 128 + tr])); }
    f32x4 hs[4]; float sq[4] = {0.f, 0.f, 0.f, 0.f};
#pragma unroll
    for (int ct = 0; ct < 4; ++ct) { const int e0 = 64 * ch + 16 * ct;
        f32x4 aPf = {0.f, 0.f, 0.f, 0.f}, aPb = aPf, aCf = aPf, aCb = aPf;
#pragma unroll
        for (int k2 = 0; k2 < 2; ++k2) { const v2u lo = *(const LAS v2u*)(VT + (e0 + r) * 72 + 32 * k2 + 4 * g), hi = *(const LAS v2u*)(VT + (e0 + r) * 72 + 32 * k2 + 16 + 4 * g);
            v4u bw; bw.x = lo.x; bw.y = lo.y; bw.z = hi.x; bw.w = hi.y; const bf16x8v bfr = __builtin_bit_cast(bf16x8v, bw);
            aPf = MFMA16(paf[k2], bfr, aPf); aPb = MFMA16(pab[k2], bfr, aPb); }
#pragma unroll
        for (int kk = 0; kk < 4; ++kk) { const bf16x8v cf = *(const LAS bf16x8v*)(CT + (e0 + r) * 136 + 32 * kk + 8 * g), cb = *(const LAS bf16x8v*)(CT + 17408 + (e0 + r) * 136 + 32 * kk + 8 * g);
            aCf = MFMA16(qf[kk], cf, aCf); aCb = MFMA16(qf[kk], cb, aCb); }
#pragma unroll
        for (int i = 0; i < 4; ++i) { const float hv = (aPf[i] + intf[i] * aCf[i]) * rdf[i] + (aPb[i] + intb[i] * aCb[i]) * rdb[i]; hs[ct][i] = hv; sq[i] += hv * hv; } }
#pragma unroll
    for (int i = 0; i < 4; ++i) { float v = sq[i]; v += __shfl_xor(v, 1); v += __shfl_xor(v, 2); v += __shfl_xor(v, 4); v += __shfl_xor(v, 8); sq[i] = v; }
    if (r == 0) {
#pragma unroll
        for (int i = 0; i < 4; ++i) ssq[wave * 16 + 4 * g + i] = sq[i]; }
    __syncthreads();
#pragma unroll
    for (int i = 0; i < 4; ++i) { const int tl = 4 * g + i, row = rowbase + 16 * rt + tl;
        const float rstd = 1.0f / sqrtf((ssq[wave * 16 + tl] + ssq[(wave ^ 4) * 16 + tl]) * (1.0f / 128.0f) + EPS);
#pragma unroll
        for (int ct = 0; ct < 4; ++ct) { const int e = 64 * ch + 16 * ct + r; const float o = bf2f(P[(size_t)row * PLD + PO_O + h * 128 + e]);
            Y[(size_t)row * D + h * 128 + e] = (bf16)f2bf(hs[ct][i] * rstd * ngl[h * 128 + e] * sigmoid_f(o)); } }
}


constexpr size_t WS_FA = WS_A;
__device__ __forceinline__ bf16x8v pack8(const float (&v)[8]) { v4u w; w.x = pk2(v[0], v[1]); w.y = pk2(v[2], v[3]); w.z = pk2(v[4], v[5]); w.w = pk2(v[6], v[7]); return __builtin_bit_cast(bf16x8v, w); }
__device__ __forceinline__ void fourier_a_phase(const bf16* P, bf16* FA, LAS unsigned char* lds, int wg, int G, int tid) {
    const int lane = tid & 63, wave = tid >> 6, r = lane & 15, g = lane >> 4;
    LAS unsigned short* ZT = (LAS unsigned short*)lds;
    bf16x8v cfr[4], nsfr[4];
    { const int k1 = 16 * wave + r;
#pragma unroll
        for (int kk = 0; kk < 4; ++kk) { float cv[8], sv[8];
#pragma unroll
            for (int i = 0; i < 8; ++i) { const int n1 = 32 * kk + 8 * g + i; float s, c; sincospif((float)((k1 * n1) & 127) * (1.0f / 64.0f), &s, &c); cv[i] = c; sv[i] = -s; }
            cfr[kk] = pack8(cv); nsfr[kk] = pack8(sv); } }
    for (int task = wg; task < 16 * 64; task += G) {
        const int bg = task >> 6, n2 = task & 63, b = bg >> 2, g4 = bg & 3;
        __syncthreads();
#pragma unroll
        for (int i2 = 0; i2 < 2; ++i2) { const int p = tid + NTHR * i2, n1 = p & 127, cg = p >> 7;
            const v4u z = *(const v4u*)(P + (size_t)(b * SEQ + 64 * n1 + n2) * PLD + PO_F + 64 * g4 + 8 * cg); const unsigned zz[4] = {z.x, z.y, z.z, z.w};
#pragma unroll
            for (int j = 0; j < 4; ++j) { ZT[(8 * cg + 2 * j) * 136 + n1] = (unsigned short)(zz[j] & 0xffffu); ZT[(8 * cg + 2 * j + 1) * 136 + n1] = (unsigned short)(zz[j] >> 16); } }
        __syncthreads();
        const int k1 = 16 * wave + r; float tc, ts; sincospif((float)(n2 * k1) * (1.0f / 4096.0f), &ts, &tc);
        bf16* dst = FA + ((size_t)(bg * 128 + k1) * 2) * 4096 + n2 * 64;
#pragma unroll
        for (int ct = 0; ct < 4; ++ct) { f32x4 aR = {0.f, 0.f, 0.f, 0.f}, aI = aR;
#pragma unroll
            for (int kk = 0; kk < 4; ++kk) { const bf16x8v a = *(const LAS bf16x8v*)(ZT + (16 * ct + r) * 136 + 32 * kk + 8 * g); aR = MFMA16(a, cfr[kk], aR); aI = MFMA16(a, nsfr[kk], aI); }
            v2u oR, oI; oR.x = pk2(aR[0] * tc + aI[0] * ts, aR[1] * tc + aI[1] * ts); oR.y = pk2(aR[2] * tc + aI[2] * ts, aR[3] * tc + aI[3] * ts);
            oI.x = pk2(aI[0] * tc - aR[0] * ts, aI[1] * tc - aR[1] * ts); oI.y = pk2(aI[2] * tc - aR[2] * ts, aI[3] * tc - aR[3] * ts);
            *(v2u*)(dst + 16 * ct + 4 * g) = oR; *(v2u*)(dst + 4096 + 16 * ct + 4 * g) = oI; }
    }
}
__device__ __forceinline__ void fourier_b_phase(const bf16* FA, bf16* Y, LAS unsigned char* lds, int wg, int G, int tid) {
    const int lane = tid & 63, wave = tid >> 6, r = lane & 15, g = lane >> 4, kt = wave & 3, kh = wave >> 2;
    LAS unsigned short* Ms = (LAS unsigned short*)lds;
    bf16x8v Cf[2], Sf[2], NSf[2], C2[2][2], S2[2][2];
    { const int kc = 16 * kt + r;
#pragma unroll
        for (int kk = 0; kk < 2; ++kk) { float cv[8], sv[8], nv[8];
#pragma unroll
            for (int i = 0; i < 8; ++i) { const int c = 32 * kk + 8 * g + i; float s, co; sincospif((float)((kc * c) & 63) * (1.0f / 32.0f), &s, &co); cv[i] = co; sv[i] = s; nv[i] = -s; }
            Cf[kk] = pack8(cv); Sf[kk] = pack8(sv); NSf[kk] = pack8(nv); }
#pragma unroll
        for (int m = 0; m < 2; ++m) { const int k2 = 16 * (2 * kh + m) + r;
#pragma unroll
            for (int kk = 0; kk < 2; ++kk) { float cv[8], sv[8];
#pragma unroll
                for (int i = 0; i < 8; ++i) { const int n2 = 32 * kk + 16 * (i >> 2) + 4 * g + (i & 3); float s, co; sincospif((float)((k2 * n2) & 63) * (1.0f / 32.0f), &s, &co); cv[i] = co; sv[i] = s; }
                C2[m][kk] = pack8(cv); S2[m][kk] = pack8(sv); } } }
    const float scale = 1.0f / sqrtf(8192.0f * 64.0f);
    for (int task = wg; task < 16 * 128; task += G) {
        const int bg = task >> 7, k1 = task & 127, b = bg >> 2, g4 = bg & 3;
        const bf16* src = FA + (size_t)(bg * 128 + k1) * 8192;
        __syncthreads();
#pragma unroll
        for (int i2 = 0; i2 < 2; ++i2) { const int p = tid + NTHR * i2, plane = p >> 9, n2 = (p >> 3) & 63, cg = p & 7;
            *(LAS v4u*)(Ms + plane * 4608 + n2 * 72 + 8 * cg) = *(const v4u*)(src + plane * 4096 + n2 * 64 + 8 * cg); }
        __syncthreads();
        f32x4 tre[4], tim[4];
#pragma unroll
        for (int nt = 0; nt < 4; ++nt) { f32x4 a = {0.f, 0.f, 0.f, 0.f}, bq = a;
#pragma unroll
            for (int kk = 0; kk < 2; ++kk) { const bf16x8v are = *(const LAS bf16x8v*)(Ms + (16 * nt + r) * 72 + 32 * kk + 8 * g), aim = *(const LAS bf16x8v*)(Ms + 4608 + (16 * nt + r) * 72 + 32 * kk + 8 * g);
                a = MFMA16(are, Cf[kk], a); a = MFMA16(aim, Sf[kk], a); bq = MFMA16(aim, Cf[kk], bq); bq = MFMA16(are, NSf[kk], bq); }
            tre[nt] = a; tim[nt] = bq; }
        bf16x8v bre[2], bim[2];
#pragma unroll
        for (int kk = 0; kk < 2; ++kk) { const float v0[8] = {tre[2 * kk][0], tre[2 * kk][1], tre[2 * kk][2], tre[2 * kk][3], tre[2 * kk + 1][0], tre[2 * kk + 1][1], tre[2 * kk + 1][2], tre[2 * kk + 1][3]};
            const float v1[8] = {tim[2 * kk][0], tim[2 * kk][1], tim[2 * kk][2], tim[2 * kk][3], tim[2 * kk + 1][0], tim[2 * kk + 1][1], tim[2 * kk + 1][2], tim[2 * kk + 1][3]};
            bre[kk] = pack8(v0); bim[kk] = pack8(v1); }
#pragma unroll
        for (int m = 0; m < 2; ++m) { f32x4 y = {0.f, 0.f, 0.f, 0.f};
#pragma unroll
            for (int kk = 0; kk < 2; ++kk) { y = MFMA16(C2[m][kk], bre[kk], y); y = MFMA16(S2[m][kk], bim[kk], y); }
#pragma unroll
            for (int i = 0; i < 4; ++i) { const int k2 = 16 * (2 * kh + m) + 4 * g + i;
                Y[(size_t)(b * SEQ + k1 + 128 * k2) * D + 512 + 64 * g4 + 16 * kt + r] = (bf16)f2bf(y[i] * scale); } }
    }
}

__device__ __forceinline__ void mix_a_phase(const float* const* in, unsigned char* ws, int L, bool do_ctx, LAS unsigned char* lds, int wg, int G, int tid) {
    const bf16* P = (const bf16*)(ws + WS_P); bf16* Y = (bf16*)(ws + WS_Y);
    for (int t = wg; t < 16 * NCHK; t += G) mlstm_m1_task(P, (const float*)(ws + WS_G), in[9] + L * 16, ws, lds, t, tid);
    fourier_a_phase(P, (bf16*)(ws + WS_FA), lds, wg, G, tid);
    if (do_ctx) {
        __syncthreads();
        { LAS f32x2* tab = (LAS f32x2*)lds; for (int i = tid; i < 8192; i += NTHR) { float s, c; sincospif((float)i * (1.0f / 4096.0f), &s, &c); tab[i] = (f32x2){c, s}; } }
        __syncthreads();
        for (int t = wg; t < 16 * 4; t += G) fourier_naive_task(P, Y, lds, t, true, tid);
    }
    for (int t = wg; t < 4 * 256; t += G) conv_task(P, Y, in[11] + L * 31 * 256, in[12] + L * 256, in[13] + L * 256, in[14] + L * 256, lds, t, false, tid);
    if (do_ctx) for (int t = wg; t < 4 * 8; t += G) conv_task(P, Y, in[11] + L * 31 * 256, in[12] + L * 256, in[13] + L * 256, in[14] + L * 256, lds, t, true, tid);
}

constexpr int NPH = 21;
#ifndef MK_SINGLE
#define MK_SINGLE 1
#endif
struct Params { const float* in[23]; float* out; unsigned char* ws; int ph_lo, ph_hi; };
static_assert(sizeof(Params) == 23 * 8 + 8 + 8 + 8, "Params has no padding");

__global__ void __launch_bounds__(NTHR, 2) fwd_kernel(Params p) {
    extern __shared__ __attribute__((aligned(16))) unsigned char lds_raw[];
    LAS unsigned char* lds = (LAS unsigned char*)lds_raw;
    const int tid = threadIdx.x, wg = blockIdx.x, G = gridDim.x;
    unsigned char* ws = p.ws;
    const float* const* in = p.in;
    for (int u = tid; u < (LDS_BYTES - LDSCTL_OFF) / 4; u += NTHR) ((LAS unsigned*)(lds + LDSCTL_OFF))[u] = 0u;
    __syncthreads();
    XcdBarrier bar; bar.bar = (unsigned*)(ws + WS_CTL) + CW_BAR; bar.x = 0; bar.st = (volatile LAS unsigned*)(lds + LDSCTL_OFF + 64);
    if (MK_SINGLE) bar = xcd_barrier_post((unsigned*)(ws + WS_CTL) + CW_BAR, (volatile LAS unsigned*)(lds + LDSCTL_OFF + 64));
    const int lo = p.ph_lo, hi = p.ph_hi;
#ifndef PH_MASK
#define PH_MASK 0xFFFFFFFFu
#endif
#define IN(k) (((PH_MASK >> (k)) & 1u) && lo <= (k) && (k) < hi)
#define SEAM(k) do { if (MK_SINGLE && IN((k) + 1)) xcd_barrier(bar); } while (0)
    const float* MOD = (const float*)(ws + WS_MOD);
    bf16* A = (bf16*)(ws + WS_A); bf16* Pb = (bf16*)(ws + WS_P); bf16* Yb = (bf16*)(ws + WS_Y); bf16* Hb = (bf16*)(ws + WS_H);
    float* Gt = (float*)(ws + WS_G); float* XC = (float*)(ws + WS_XC); float* HF = (float*)(ws + WS_HF); float* HB = (float*)(ws + WS_HB);
    int* rw = (int*)(ws + WS_ROUTE);
    int* tok_e = (int*)(ws + WS_TOK); float* tok_w = (float*)(ws + WS_TOK + 256 * 1024); int* pair_pos = (int*)(ws + WS_TOK + 512 * 1024); float* row_w = (float*)(ws + WS_TOK + 768 * 1024);

    if (IN(0)) { prologue_phase(in, ws, lds, wg, G, tid); SEAM(0); }
    if (IN(1)) { norm_phase<false>(in[0], in[2], true, in[4], MOD, 0, A, nullptr, nullptr, nullptr, nullptr, nullptr, lds, wg, G, tid); SEAM(1); }
    if (IN(2)) { pg8::Gemm g{A, (const bf16*)(ws + WS_WIN), MROWS, PLD, D}; pg8::StaticOrder S; S.init(MROWS, PLD, G, wg); pg8::EpiP E{Pb, Gt};
        pg8::gemm_phase<pg8::EpiP, pg8::StaticOrder, true, true>(lds, g, S, E); SEAM(2); }
    if (IN(3)) { mix_a_phase(in, ws, 0, true, lds, wg, G, tid); SEAM(3); }
    if (IN(4)) { mlstm_m2_phase(ws, wg, G, tid); fourier_b_phase((const bf16*)(ws + WS_FA), Yb, lds, wg, G, tid); SEAM(4); }
    if (IN(5)) { for (int t = wg; t < 16 * NCHK; t += G) mlstm_m3_task(Pb, Gt, in[9], in[10], ws, Yb, lds, t, tid); SEAM(5); }
    if (IN(6)) { pg8::Gemm g{Yb, (const bf16*)(ws + WS_WOUT), MROWS, D, D}; pg8::StaticOrder S; S.init(MROWS, D, G, wg); pg8::EpiRes E{in[0], p.out, in[2], XC, MOD + 2 * D};
        pg8::gemm_phase<pg8::EpiRes, pg8::StaticOrder, true, true>(lds, g, S, E); SEAM(6); }
    if (IN(7)) { norm_phase<false>(p.out, XC, true, in[5], MOD, 3, A, nullptr, nullptr, nullptr, nullptr, nullptr, lds, wg, G, tid); SEAM(7); }
    if (IN(8)) { pg8::Gemm g{A, (const bf16*)(ws + WS_WGU), MROWS, 2 * FFH, D}; pg8::StaticOrder S; S.init(MROWS, 2 * FFH, G, wg); pg8::EpiSwiglu E{Hb};
        pg8::gemm_phase<pg8::EpiSwiglu, pg8::StaticOrder, true, true>(lds, g, S, E); SEAM(8); }
    if (IN(9)) { pg8::Gemm g{Hb, (const bf16*)(ws + WS_WD), MROWS, D, FFH}; pg8::StaticOrder S; S.init(MROWS, D, G, wg); pg8::EpiRes E{p.out, p.out, XC, XC, MOD + 5 * D};
        pg8::gemm_phase<pg8::EpiRes, pg8::StaticOrder, true, true>(lds, g, S, E); SEAM(9); }
    const float* MOD1 = MOD + 5 * 6144;
    if (IN(10)) { norm_phase<false>(p.out, XC, true, in[4] + D, MOD1, 0, A, nullptr, nullptr, nullptr, nullptr, nullptr, lds, wg, G, tid); SEAM(10); }
    if (IN(11)) { pg8::Gemm g{A, (const bf16*)(ws + WS_WIN) + (size_t)PLD * D, MROWS, PLD, D}; pg8::StaticOrder S; S.init(MROWS, PLD, G, wg); pg8::EpiP E{Pb, Gt};
        pg8::gemm_phase<pg8::EpiP, pg8::StaticOrder, true, true>(lds, g, S, E); SEAM(11); }
    if (IN(12)) { mix_a_phase(in, ws, 1, false, lds, wg, G, tid); SEAM(12); }
    if (IN(13)) { mlstm_m2_phase(ws, wg, G, tid); fourier_b_phase((const bf16*)(ws + WS_FA), Yb, lds, wg, G, tid); SEAM(13); }
    if (IN(14)) { for (int t = wg; t < 16 * 128; t += G) mlstm_m3_task(Pb, Gt, in[9] + 16, in[10] + 512, ws, Yb, lds, (t >> 7) * NCHK + (t & 127), tid); SEAM(14); }
    if (IN(15)) { pg8::Gemm g{Yb, (const bf16*)(ws + WS_WOUT) + (size_t)D * D, NLAT, D, D}; pg8::StaticOrder S; S.init(NLAT, D, G, wg); pg8::EpiRes E{p.out, p.out, XC, XC, MOD1 + 2 * D};
        pg8::gemm_phase<pg8::EpiRes, pg8::StaticOrder, true, true>(lds, g, S, E); SEAM(15); }
    if (IN(16)) { norm_phase<true>(p.out, XC, false, in[5] + D, MOD1, 3, A, in[18], in[19], tok_e, tok_w, rw + RW_HIST, lds, wg, G, tid); SEAM(16); }
    if (IN(17)) { route_phase(ws, lds, wg, G, tid); SEAM(17); }
    if (IN(18)) { const int nT = rw[RW_NTILES]; pg8::Gemm g{(const bf16*)(ws + WS_ASORT), (const bf16*)(ws + WS_MWGU), nT * 256, NEXP * 2 * FFH, D};
        pg8::MoeOrder S; S.init_moe(nT, 22, rw + RW_TILE_E, G, wg); pg8::EpiSwiglu E{(bf16*)(ws + WS_HSORT)};
        pg8::gemm_phase<pg8::EpiSwiglu, pg8::MoeOrder, true, true>(lds, g, S, E); SEAM(18); }
    if (IN(19)) { const int nT = rw[RW_NTILES]; pg8::Gemm g{(const bf16*)(ws + WS_HSORT), (const bf16*)(ws + WS_MWD), nT * 256, NEXP * D, FFH};
        pg8::MoeOrder S; S.init_moe(nT, 4, rw + RW_TILE_E, G, wg); pg8::EpiMoeDown E{(bf16*)(ws + WS_OPAIR), row_w};
        pg8::gemm_phase<pg8::EpiMoeDown, pg8::MoeOrder, true, true>(lds, g, S, E); SEAM(19); }
    if (IN(20)) { final_phase(p.out, (const bf16*)(ws + WS_OPAIR), pair_pos, MOD1, in[22], wg, G, tid); }
#undef IN
#undef SEAM
}

extern "C" void kernel_launch(void* const* d_in, const int* in_sizes, int n_in, void* d_out, int out_size, void* d_ws, size_t ws_size, hipStream_t stream) {
    static int grid = 0;
    if (grid == 0) {
        if (n_in != 23 || in_sizes[0] != NLAT * D || out_size != NLAT * D || ws_size < WS_END) { fprintf(stderr, "kernel_launch: unexpected problem shape (n_in %d, out %d, ws %zu); nothing launched\n", n_in, out_size, ws_size); grid = -1; return; }
        int dev = 0, cus = 0;
        if (hipGetDevice(&dev) != hipSuccess || hipDeviceGetAttribute(&cus, hipDeviceAttributeMultiprocessorCount, dev) != hipSuccess) { grid = -1; return; }
        if (hipFuncSetAttribute((const void*)fwd_kernel, hipFuncAttributeMaxDynamicSharedMemorySize, LDS_BYTES) != hipSuccess) { fprintf(stderr, "kernel_launch: hipFuncSetAttribute failed\n"); grid = -1; return; }
        int per_cu = 0;
        if (hipOccupancyMaxActiveBlocksPerMultiprocessor(&per_cu, (const void*)fwd_kernel, NTHR, LDS_BYTES) != hipSuccess || per_cu < 1) { fprintf(stderr, "kernel_launch: occupancy query says %d blocks per CU\n", per_cu); }
        (void)hipGetLastError();
        grid = cus;
    }
    if (grid < 0) return;
    if (hipMemsetAsync((char*)d_ws + WS_CTL, 0, CTL_ZERO_BYTES, stream) != hipSuccess) return;
    Params p{};
    for (int i = 0; i < 23; ++i) p.in[i] = (const float*)d_in[i];
    p.out = (float*)d_out; p.ws = (unsigned char*)d_ws;
#if MK_SINGLE
    p.ph_lo = 0; p.ph_hi = NPH;
    hipLaunchKernelGGL(fwd_kernel, dim3(grid), dim3(NTHR), LDS_BYTES, stream, p);
#else
    for (int k = 0; k < NPH; ++k) { p.ph_lo = k; p.ph_hi = k + 1; hipLaunchKernelGGL(fwd_kernel, dim3(grid), dim3(NTHR), LDS_BYTES, stream, p); }
#endif
}
```

```cpp
#include <hip/hip_runtime.h>
#include <cstdio>
#include <cstdint>
namespace pg8 {
#define PG8_LAS __attribute__((address_space(3)))
typedef unsigned short bf16_t;
typedef short bf16x8 __attribute__((ext_vector_type(8)));
typedef float f32x4 __attribute__((ext_vector_type(4)));
typedef unsigned u32x4 __attribute__((ext_vector_type(4)));
constexpr int BM = 256, BK = 64, HALF = 128, HTB = HALF * BK * 2  , STAGE_BYTES = 8 * HTB, NXCD = 8, WGM = 8;

__host__ __device__ __forceinline__ int lds_byte(int r, int c) { const int st = (r >> 4) * 2 + (c >> 5), rr = r & 15, cc = c & 31, ob = rr * 64 + cc * 2; return st * 1024 + (ob ^ (((ob >> 9) & 1) << 5)); }
__host__ __device__ __forceinline__ void stage_rc(int b, int& R, int& C) { const int st = b / 1024, sb = b % 1024, swz = sb ^ (((sb >> 9) & 1) << 5); R = (st >> 1) * 16 + swz / 64; C = (st & 1) * 32 + (swz % 64) / 2; }
__host__ __device__ __forceinline__ int perm32(int rho) { const int n = rho >> 4, i = rho & 15; return 8 * (i >> 2) + 4 * n + (i & 3); }

struct Unit { int pm, pn; };
struct Gemm { const bf16_t* A; const bf16_t* Bt; int M, N, K; };

struct StaticOrder {
    int nM, nN, nwg, G, c;
    __host__ __device__ void init(int M, int N, int G_, int c_) { nM = M / BM; nN = N / BM; nwg = nM * nN; G = G_; c = c_; }
    __host__ __device__ bool next(int i, Unit& u) const {
        const long L = (long)i * G + c; if (L >= nwg) return false;
        int wgid = (int)L; { const int q = nwg / NXCD, r = nwg % NXCD, xcd = wgid % NXCD, off = wgid / NXCD; wgid = (xcd < r ? xcd * (q + 1) : r * (q + 1) + (xcd - r) * q) + off; }
        const int nig = WGM * nN, gid = wgid / nig, fm = gid * WGM, gsz = (nM - fm) < WGM ? (nM - fm) : WGM;
        u.pm = fm + ((wgid % nig) % gsz); u.pn = (wgid % nig) / gsz; return true;
    }
    __device__ __forceinline__ void a_ready(const Unit&) const {}
    __device__ __forceinline__ void done(const Unit&) const {}
};

__device__ __forceinline__ unsigned cvt_pk_bf16(float lo, float hi) { unsigned r; asm volatile("v_cvt_pk_bf16_f32 %0, %1, %2" : "=v"(r) : "v"(lo), "v"(hi)); return r; }
__device__ __forceinline__ float silu_f(float x) { return x / (1.0f + __expf(-x)); }
struct EpiP {
    static constexpr bool PERM = true, AFTER_DRAIN = false;
    bf16_t* P; float* G;
    __device__ __forceinline__ void operator()(const f32x4 (&acc)[2][2][4][2], const Unit& u, int wr, int wc, int fr, int fq) const {
        const int row0 = u.pm * BM + wr * 64 + fr, col0 = u.pn * BM + wc * 32 + 8 * fq;
#pragma unroll
        for (int ai = 0; ai < 2; ++ai)
#pragma unroll
            for (int m = 0; m < 4; ++m) { bf16_t* rowp = P + (size_t)(row0 + ai * HALF + m * 16) * 3072 + col0;
#pragma unroll
                for (int bj = 0; bj < 2; ++bj) { const f32x4 v0 = acc[ai][bj][m][0], v1 = acc[ai][bj][m][1];
                    u32x4 w; w.x = cvt_pk_bf16(v0[0], v0[1]); w.y = cvt_pk_bf16(v0[2], v0[3]); w.z = cvt_pk_bf16(v1[0], v1[1]); w.w = cvt_pk_bf16(v1[2], v1[3]);
                    *(u32x4*)(rowp + bj * HALF) = w; } }
        if (u.pn == 11 && wc == 0 && fq < 2) {
#pragma unroll
            for (int ai = 0; ai < 2; ++ai)
#pragma unroll
                for (int m = 0; m < 4; ++m) { float* gp = G + (size_t)(row0 + ai * HALF + m * 16) * 16 + 8 * fq;
                    *(f32x4*)gp = acc[ai][0][m][0]; *(f32x4*)(gp + 4) = acc[ai][0][m][1]; }
        }
    }
};
struct EpiRes {
    static constexpr bool PERM = false, AFTER_DRAIN = false;
    const float* base_lat; float* out_lat; const float* base_ctx; float* out_ctx; const float* gate;
    __device__ __forceinline__ void operator()(const f32x4 (&acc)[2][2][4][2], const Unit& u, int wr, int wc, int fr, int fq) const {
        const bool lat = u.pm < 128;
        const float* base = lat ? base_lat + (size_t)u.pm * BM * 1024 : base_ctx + (size_t)(u.pm - 128) * BM * 1024;
        float* out = lat ? out_lat + (size_t)u.pm * BM * 1024 : out_ctx + (size_t)(u.pm - 128) * BM * 1024;
        const float* gv = gate + (size_t)(lat ? (u.pm >> 5) : 4) * 6144;
        const int row0 = wr * 64 + fr, col0 = u.pn * BM + wc * 32 + 4 * fq;
        f32x4 g4[2][2];
#pragma unroll
        for (int bj = 0; bj < 2; ++bj)
#pragma unroll
            for (int n = 0; n < 2; ++n) g4[bj][n] = *(const f32x4*)(gv + col0 + bj * HALF + n * 16);
#pragma unroll
        for (int ai = 0; ai < 2; ++ai)
#pragma unroll
            for (int m = 0; m < 4; ++m) { const size_t off = (size_t)(row0 + ai * HALF + m * 16) * 1024 + col0;
#pragma unroll
                for (int bj = 0; bj < 2; ++bj)
#pragma unroll
                    for (int n = 0; n < 2; ++n) { const f32x4 b = *(const f32x4*)(base + off + bj * HALF + n * 16);
                        *(f32x4*)(out + off + bj * HALF + n * 16) = b + g4[bj][n] * acc[ai][bj][m][n]; }
                asm volatile("" ::: "memory"); }
    }
};
struct EpiSwiglu {
    static constexpr bool PERM = true, AFTER_DRAIN = false;
    bf16_t* H;
    __device__ __forceinline__ void operator()(const f32x4 (&acc)[2][2][4][2], const Unit& u, int wr, int wc, int fr, int fq) const {
        const int row0 = u.pm * BM + wr * 64 + fr, col0 = (u.pn % 22) * HALF + wc * 32 + 8 * fq;
#pragma unroll
        for (int ai = 0; ai < 2; ++ai)
#pragma unroll
            for (int m = 0; m < 4; ++m) { bf16_t* rowp = H + (size_t)(row0 + ai * HALF + m * 16) * 2816 + col0;
                float h[8];
#pragma unroll
                for (int n = 0; n < 2; ++n)
#pragma unroll
                    for (int j = 0; j < 4; ++j) h[4 * n + j] = silu_f(acc[ai][0][m][n][j]) * acc[ai][1][m][n][j];
                u32x4 w; w.x = cvt_pk_bf16(h[0], h[1]); w.y = cvt_pk_bf16(h[2], h[3]); w.z = cvt_pk_bf16(h[4], h[5]); w.w = cvt_pk_bf16(h[6], h[7]);
                *(u32x4*)rowp = w; }
    }
};
struct EpiMoeDown {
    static constexpr bool PERM = true, AFTER_DRAIN = false;
    bf16_t* O; const float* roww;
    __device__ __forceinline__ void operator()(const f32x4 (&acc)[2][2][4][2], const Unit& u, int wr, int wc, int fr, int fq) const {
        const int row0 = u.pm * BM + wr * 64 + fr, col0 = (u.pn & 3) * BM + wc * 32 + 8 * fq;
#pragma unroll
        for (int ai = 0; ai < 2; ++ai)
#pragma unroll
            for (int m = 0; m < 4; ++m) { const int r = row0 + ai * HALF + m * 16; const float s = roww[r]; bf16_t* rowp = O + (size_t)r * 1024 + col0;
#pragma unroll
                for (int bj = 0; bj < 2; ++bj) { const f32x4 v0 = acc[ai][bj][m][0] * s, v1 = acc[ai][bj][m][1] * s;
                    u32x4 w; w.x = cvt_pk_bf16(v0[0], v0[1]); w.y = cvt_pk_bf16(v0[2], v0[3]); w.z = cvt_pk_bf16(v1[0], v1[1]); w.w = cvt_pk_bf16(v1[2], v1[3]);
                    *(u32x4*)(rowp + bj * HALF) = w; } }
    }
};
struct MoeOrder : StaticOrder {
    const int* tile_e; int nNe;
    __device__ void init_moe(int nTiles, int nNe_, const int* te, int G_, int c_) { nM = nTiles; nN = nNe_; nwg = nM * nN; G = G_; c = c_; tile_e = te; nNe = nNe_; }
    __device__ bool next(int i, Unit& u) const { if (!StaticOrder::next(i, u)) return false; u.pn += tile_e[u.pm] * nNe; return true; }
};
template <class Epi, class Sched, bool ALIGN_EPI = false, bool SP2 = false>
__device__ __forceinline__ void gemm_phase(PG8_LAS unsigned char* lds, const Gemm g, const Sched& S, const Epi& E) {
    const int tid = threadIdx.x, wid = __builtin_amdgcn_readfirstlane(tid >> 6), lane = tid & 63, wr = wid >> 2, wc = wid & 3, fr = lane & 15, fq = lane >> 4;
    const int K = g.K, nt = K / BK;
    unsigned voffA[2], voffB[2];
#pragma unroll
    for (int i = 0; i < 2; ++i) { int R, C; stage_rc(tid * 16 + i * 8192, R, C); const int Rb = Epi::PERM ? ((R & ~31) + perm32(R & 31)) : R;
        voffA[i] = (unsigned)(R * K + C) * 2u; voffB[i] = (unsigned)(Rb * K + C) * 2u; }
    const size_t kstep = (size_t)(BK * 2);
    const size_t hstep = (size_t)HALF * K * 2;
    const size_t tstep = 2 * hstep;
    const unsigned ldsw = (unsigned)wid * 1024u;
    const int aoff = lds_byte(wr * 64 + fr, fq * 8), boff = lds_byte(wc * 32 + fr, fq * 8);
#define PG8_SA(b, h) (((b) * 2 + (h)) * HTB)
#define PG8_SB(b, h) ((4 + (b) * 2 + (h)) * HTB)
#define PG8_STAGE(bufoff, gbase, voff) do { _Pragma("unroll") for (int _i = 0; _i < 2; ++_i) \
        __builtin_amdgcn_global_load_lds((const unsigned*)((const char*)(gbase) + (voff)[_i]), (PG8_LAS unsigned*)(lds + (bufoff) + ldsw + _i * 8192), 16, 0, 0); } while (0)
#define PG8_LDA(dst, b, h) do { _Pragma("unroll") for (int m = 0; m < 4; ++m) _Pragma("unroll") for (int k = 0; k < 2; ++k) dst[m][k] = *(const PG8_LAS bf16x8*)(lds + PG8_SA(b, h) + aoff + m * 2048 + k * 1024); } while (0)
#define PG8_LDB(dst, b, h) do { _Pragma("unroll") for (int n = 0; n < 2; ++n) _Pragma("unroll") for (int k = 0; k < 2; ++k) dst[n][k] = *(const PG8_LAS bf16x8*)(lds + PG8_SB(b, h) + boff + n * 2048 + k * 1024); } while (0)
#define PG8_MMA(ai, bj, At, Bt) do { __builtin_amdgcn_s_setprio(1); _Pragma("unroll") for (int m = 0; m < 4; ++m) _Pragma("unroll") for (int n = 0; n < 2; ++n) _Pragma("unroll") for (int k = 0; k < 2; ++k) \
        acc[ai][bj][m][n] = __builtin_amdgcn_mfma_f32_16x16x32_bf16(Bt[n][k], At[m][k], acc[ai][bj][m][n], 0, 0, 0); __builtin_amdgcn_s_setprio(0); } while (0)
#define PG8_WAIT_V(n) asm volatile("s_waitcnt vmcnt(" #n ")" ::: "memory")
#define PG8_WAIT_L(n) asm volatile("s_waitcnt lgkmcnt(" #n ")" ::: "memory")
#define PG8_BAR __builtin_amdgcn_s_barrier()
#define PG8_SCHED __builtin_amdgcn_sched_barrier(0)
    Unit cur, nxt; int ui = 0;
    if (!S.next(0, cur)) return;
    f32x4 acc[2][2][4][2];
#pragma unroll
    for (int a = 0; a < 2; ++a)
#pragma unroll
        for (int b = 0; b < 2; ++b)
#pragma unroll
            for (int m = 0; m < 4; ++m)
#pragma unroll
                for (int n = 0; n < 2; ++n) acc[a][b][m][n] = (f32x4){0.f, 0.f, 0.f, 0.f};
    bf16x8 At[4][2], B0[2][2], B1[2][2];
    const char* cA = (const char*)g.A + (size_t)cur.pm * tstep; const char* cB = (const char*)g.Bt + (size_t)cur.pn * tstep;
    S.a_ready(cur);
    if constexpr (SP2) {
        PG8_STAGE(PG8_SB(0, 0), cB, voffB); PG8_STAGE(PG8_SB(0, 1), cB + hstep, voffB); PG8_STAGE(PG8_SA(0, 0), cA, voffA); PG8_STAGE(PG8_SA(0, 1), cA + hstep, voffA);
        if (wr == 1) PG8_BAR;
        PG8_WAIT_V(2); PG8_BAR;
        PG8_STAGE(PG8_SB(1, 0), cB + kstep, voffB); PG8_STAGE(PG8_SA(1, 0), cA + kstep, voffA); PG8_STAGE(PG8_SB(1, 1), cB + hstep + kstep, voffB);
        PG8_WAIT_V(6); PG8_BAR;
    } else {
        PG8_STAGE(PG8_SB(0, 0), cB, voffB); PG8_STAGE(PG8_SA(0, 0), cA, voffA); PG8_STAGE(PG8_SB(0, 1), cB + hstep, voffB); PG8_STAGE(PG8_SA(0, 1), cA + hstep, voffA);
        if (wr == 1) PG8_BAR;
        PG8_WAIT_V(4); PG8_BAR;
        PG8_STAGE(PG8_SB(1, 0), cB + kstep, voffB); PG8_STAGE(PG8_SA(1, 0), cA + kstep, voffA); PG8_STAGE(PG8_SB(1, 1), cB + hstep + kstep, voffB);
        PG8_WAIT_V(6); PG8_BAR;
    }
    for (;;) {
        const bool has_next = S.next(ui + 1, nxt);
        const char* nA = has_next ? (const char*)g.A + (size_t)nxt.pm * tstep : cA; const char* nB = has_next ? (const char*)g.Bt + (size_t)nxt.pn * tstep : cB;
        for (int t = 0; t < nt; t += 2) {
            const bool last = (t == nt - 2);
            const char* a1 = cA + (size_t)(t + 1) * kstep;
            const char* a2 = last ? nA : cA + (size_t)(t + 2) * kstep; const char* b2 = last ? nB : cB + (size_t)(t + 2) * kstep;
            const char* a3 = a2 + kstep; const char* b3 = b2 + kstep;
            if (last && has_next) S.a_ready(nxt);
            if constexpr (SP2) {
            PG8_LDB(B0, 0, 0); PG8_LDB(B1, 0, 1); PG8_SCHED; PG8_LDA(At, 0, 0); PG8_STAGE(PG8_SA(1, 1), a1 + hstep, voffA);
            PG8_WAIT_V(8); PG8_WAIT_L(0); PG8_BAR; PG8_MMA(0, 0, At, B0); PG8_MMA(0, 1, At, B1); PG8_BAR; PG8_SCHED;
            PG8_LDA(At, 0, 1); PG8_STAGE(PG8_SB(0, 0), b2, voffB); PG8_STAGE(PG8_SB(0, 1), b2 + hstep, voffB); PG8_STAGE(PG8_SA(0, 0), a2, voffA);
            PG8_WAIT_V(8); PG8_WAIT_L(0); PG8_BAR; PG8_MMA(1, 0, At, B0); PG8_MMA(1, 1, At, B1); PG8_BAR; PG8_SCHED;
            PG8_LDB(B0, 1, 0); PG8_LDB(B1, 1, 1); PG8_SCHED; PG8_LDA(At, 1, 0); PG8_STAGE(PG8_SA(0, 1), a2 + hstep, voffA);
            PG8_WAIT_V(8); PG8_WAIT_L(0); PG8_BAR; PG8_MMA(0, 0, At, B0); PG8_MMA(0, 1, At, B1); PG8_BAR; PG8_SCHED;
            PG8_LDA(At, 1, 1); PG8_STAGE(PG8_SB(1, 0), b3, voffB); PG8_STAGE(PG8_SB(1, 1), b3 + hstep, voffB); PG8_STAGE(PG8_SA(1, 0), a3, voffA);
            PG8_WAIT_V(8); PG8_WAIT_L(0); PG8_BAR; PG8_MMA(1, 0, At, B0); PG8_MMA(1, 1, At, B1); PG8_BAR; PG8_SCHED;
            } else {
            PG8_LDB(B0, 0, 0); PG8_SCHED; PG8_LDA(At, 0, 0); PG8_STAGE(PG8_SA(1, 1), a1 + hstep, voffA);
            PG8_WAIT_L(8); PG8_BAR; PG8_WAIT_L(0); PG8_MMA(0, 0, At, B0); PG8_BAR; PG8_SCHED;
            PG8_LDB(B1, 0, 1); PG8_STAGE(PG8_SB(0, 0), b2, voffB);
            PG8_BAR; PG8_WAIT_L(0); PG8_MMA(0, 1, At, B1); PG8_BAR;
            PG8_LDA(At, 0, 1); PG8_STAGE(PG8_SA(0, 0), a2, voffA);
            PG8_BAR; PG8_WAIT_L(0); PG8_MMA(1, 0, At, B0); PG8_BAR; PG8_SCHED;
            PG8_STAGE(PG8_SB(0, 1), b2 + hstep, voffB);
            PG8_WAIT_V(6); PG8_BAR; PG8_MMA(1, 1, At, B1); PG8_BAR;
            PG8_LDB(B0, 1, 0); PG8_SCHED; PG8_LDA(At, 1, 0); PG8_STAGE(PG8_SA(0, 1), a2 + hstep, voffA);
            PG8_WAIT_L(8); PG8_BAR; PG8_WAIT_L(0); PG8_MMA(0, 0, At, B0); PG8_BAR; PG8_SCHED;
            PG8_LDB(B1, 1, 1); PG8_STAGE(PG8_SB(1, 0), b3, voffB);
            PG8_BAR; PG8_WAIT_L(0); PG8_MMA(0, 1, At, B1); PG8_BAR;
            PG8_LDA(At, 1, 1); PG8_STAGE(PG8_SA(1, 0), a3, voffA);
            PG8_BAR; PG8_WAIT_L(0); PG8_MMA(1, 0, At, B0); PG8_BAR; PG8_SCHED;
            PG8_STAGE(PG8_SB(1, 1), b3 + hstep, voffB);
            PG8_WAIT_V(6); PG8_BAR; PG8_MMA(1, 1, At, B1); PG8_BAR;
            }
        }
        if constexpr (ALIGN_EPI) { if (wr == 0) PG8_BAR; }
        if constexpr (!Epi::AFTER_DRAIN) { E(acc, cur, wr, wc, fr, fq); S.done(cur); }
        if (!has_next) break;
#pragma unroll
        for (int a = 0; a < 2; ++a)
#pragma unroll
            for (int b = 0; b < 2; ++b)
#pragma unroll
                for (int m = 0; m < 4; ++m)
#pragma unroll
                    for (int n = 0; n < 2; ++n) acc[a][b][m][n] = (f32x4){0.f, 0.f, 0.f, 0.f};
        cur = nxt; cA = nA; cB = nB; ++ui;
        if constexpr (ALIGN_EPI) { if (wr == 1) PG8_BAR; }
    }
    PG8_WAIT_V(0);
    if constexpr (!ALIGN_EPI) { if (wr == 0) PG8_BAR; }
    PG8_BAR;
    if constexpr (Epi::AFTER_DRAIN) { E.fused(acc, cur, wr, wc, fr, fq, lds, wid, lane); S.done(cur); }
#undef PG8_SA
#undef PG8_SB
#undef PG8_STAGE
#undef PG8_LDA
#undef PG8_LDB
#undef PG8_MMA
#undef PG8_WAIT_V
#undef PG8_WAIT_L
#undef PG8_BAR
#undef PG8_SCHED
}
}
using pg8::silu_f;

constexpr int D = 1024, BATCH = 4, SEQ = 8192, CTXL = 256, NLAT = BATCH * SEQ, NCTX = BATCH * CTXL, MROWS = NLAT + NCTX;
constexpr int PIN_SRC = 2832, PLD = 3072, FFH = 2816, NEXP = 8;
constexpr int PO_Q = 0, PO_K = 512, PO_V = 1024, PO_O = 1536, PO_F = 2048, PO_CU = 2304, PO_CG = 2560;
constexpr float EPS = 1e-6f;
constexpr int NWAVES = 8, NTHR = 512;
constexpr size_t MiB = 1u << 20;
constexpr size_t WS_CTL = 0, CTL_ZERO_BYTES = 1 * MiB;
constexpr size_t WS_MOD = 1 * MiB;
constexpr size_t WS_ROUTE = 1 * MiB + 512 * 1024;
constexpr size_t WS_WIN = 2 * MiB;
constexpr size_t WS_WOUT = 14 * MiB;
constexpr size_t WS_WGU = 18 * MiB;
constexpr size_t WS_WD = 29 * MiB;
constexpr size_t WS_MWGU = 35 * MiB;
constexpr size_t WS_MWD = 123 * MiB;
constexpr size_t WS_G = 167 * MiB;
constexpr size_t WS_XC = 170 * MiB;
constexpr size_t WS_TOK = 174 * MiB;
constexpr size_t WS_R1 = 176 * MiB;
constexpr size_t WS_Y = WS_R1, WS_HF = WS_R1 + 66 * MiB, WS_ASORT = WS_R1, WS_OPAIR = WS_R1;
constexpr size_t WS_R2 = 308 * MiB;
constexpr size_t WS_P = WS_R2, WS_H = WS_R2, WS_A = WS_R2 + 198 * MiB, WS_HB = WS_R2 + 264 * MiB, WS_HSORT = WS_R2;
constexpr size_t WS_END = 671 * MiB;
constexpr int MAXPAIR = 2 * NLAT + NEXP * 256;
static_assert(WS_WIN + (size_t)2 * PLD * D * 2 <= WS_WOUT && WS_WOUT + (size_t)2 * D * D * 2 <= WS_WGU && WS_WGU + (size_t)2 * FFH * D * 2 <= WS_WD && WS_WD + (size_t)D * FFH * 2 <= WS_MWGU, "ws map 1");
static_assert(WS_MWGU + (size_t)NEXP * 2 * FFH * D * 2 <= WS_MWD && WS_MWD + (size_t)NEXP * D * FFH * 2 <= WS_G && WS_G + (size_t)MROWS * 16 * 4 <= WS_XC && WS_XC + (size_t)NCTX * D * 4 <= WS_TOK, "ws map 2");
static_assert(WS_TOK + 3 * 256 * 1024 + (size_t)MAXPAIR * 4 * 2 <= WS_R1 && WS_Y + (size_t)MROWS * D * 2 <= WS_HF && WS_HF + (size_t)MROWS * 512 * 4 <= WS_R2 && WS_ASORT + (size_t)MAXPAIR * D * 2 <= WS_R2, "ws map 3");
static_assert(WS_P + (size_t)MROWS * PLD * 2 <= WS_A && WS_A + (size_t)MROWS * D * 2 <= WS_HB && WS_HB + (size_t)MROWS * 512 * 4 <= WS_END && WS_HSORT + (size_t)MAXPAIR * FFH * 2 <= WS_END && WS_H + (size_t)MROWS * FFH * 2 <= WS_A, "ws map 4");
constexpr int CW_BAR = 4096;
constexpr int RW_HIST = 0;
constexpr int RW_TILE_E = 4096;
constexpr int RW_NTILES = 4096 + 512;
constexpr int LDS_STAGE = 131072, LDSCTL_OFF = LDS_STAGE, LDS_BYTES = 147456;

#define GAS __attribute__((address_space(1)))
#define LAS __attribute__((address_space(3)))
typedef unsigned short bf16;
typedef unsigned v4u __attribute__((ext_vector_type(4)));
typedef unsigned v2u __attribute__((ext_vector_type(2)));
typedef float f32x4 __attribute__((ext_vector_type(4)));
__device__ __forceinline__ unsigned f2bf(float f) { unsigned u = __builtin_bit_cast(unsigned, f); return (u + 0x7fffu + ((u >> 16) & 1u)) >> 16; }
__device__ __forceinline__ unsigned pk2(float lo, float hi) { return f2bf(lo) | (f2bf(hi) << 16); }
__device__ __forceinline__ float bf2f(unsigned short b) { return __builtin_bit_cast(float, (unsigned)b << 16); }
__device__ __forceinline__ float bflo(unsigned w) { return __builtin_bit_cast(float, w << 16); }
__device__ __forceinline__ float bfhi(unsigned w) { return __builtin_bit_cast(float, w & 0xffff0000u); }
__device__ __forceinline__ float wave_sum(float v) {
#pragma unroll
    for (int o = 1; o < 64; o <<= 1) v += __shfl_xor(v, o);
    return v;
}
__device__ __forceinline__ float sigmoid_f(float x) { return 1.0f / (1.0f + __expf(-x)); }
__device__ __forceinline__ float log_sigmoid_f(float x) { return fminf(x, 0.0f) - log1pf(__expf(-fabsf(x))); }

#define XB_TMO      128
#define XB_XCNT(j)  (256  + 64 * (j))
#define XB_XSUB(j)  (1280 + 64 * (j))
#define XB_XGEN(j)  (2304 + 64 * (j))
#define XB_TOP      3328
#define XB_TOPGEN   3392
#define XCD_BAR_WORDS 3456
#define XB_SPIN_CAP (1u << 18)
#define LAS __attribute__((address_space(3)))

__device__ __forceinline__ unsigned xb_ld(unsigned* p)              { return __hip_atomic_load(p, __ATOMIC_RELAXED, __HIP_MEMORY_SCOPE_AGENT); }
__device__ __forceinline__ unsigned xb_add(unsigned* p, unsigned v) { return __hip_atomic_fetch_add(p, v, __ATOMIC_RELAXED, __HIP_MEMORY_SCOPE_AGENT); }
__device__ __forceinline__ unsigned xb_xcc_id() { return (unsigned)__builtin_amdgcn_s_getreg((3 << 11) | 20) & 0xFu; }
#define XB_SPIN(cond, bar) do { unsigned _sp = 0; while (cond) { __builtin_amdgcn_s_sleep(1); \
    if ((++_sp & 255u) == 0u) { if (xb_ld(&(bar)[XB_TMO])) break; if (_sp > XB_SPIN_CAP) { atomicAdd(&(bar)[XB_TMO], 1u); break; } } } } while (0)

struct XcdBarrier {
    unsigned* bar; unsigned x;
    volatile LAS unsigned* st;
};

__device__ __forceinline__ XcdBarrier xcd_barrier_post(unsigned* bar, volatile LAS unsigned* st) {
    XcdBarrier b; b.bar = bar; b.x = xb_xcc_id(); b.st = st;
    if (threadIdx.x == 0) (void)xb_add(&bar[XB_XCNT(b.x)], 1u);
    return b;
}
__device__ __forceinline__ void xcd_barrier_complete(unsigned* bar, unsigned x, unsigned& nloc, unsigned& nx) {
    const unsigned G = gridDim.x * gridDim.y * gridDim.z;
    unsigned sum, cnt, mine, sp = 0u;
    for (;;) {
        sum = 0u; cnt = 0u; mine = 0u;
#pragma unroll
        for (unsigned j = 0; j < 16; ++j) { const unsigned c = xb_ld(&bar[XB_XCNT(j)]); sum += c; cnt += (c > 0u) ? 1u : 0u; mine = (j == x) ? c : mine; }
        if (sum == G) break;
        __builtin_amdgcn_s_sleep(1);
        if ((++sp & 255u) == 0u) { if (xb_ld(&bar[XB_TMO])) break; if (sp > XB_SPIN_CAP) { atomicAdd(&bar[XB_TMO], 1u); break; } }
    }
    nloc = mine > 0u ? mine : 1u; nx = cnt > 0u ? cnt : 1u;
}

__device__ __forceinline__ void xcd_barrier(const XcdBarrier& b) {
    asm volatile("s_waitcnt vmcnt(0)" ::: "memory");
    __syncthreads();
    if (threadIdx.x == 0) {
        unsigned* bar = b.bar;
        __builtin_amdgcn_s_waitcnt(0);
        unsigned nloc = b.st[0], nx = b.st[1];
        if (nloc == 0u) { xcd_barrier_complete(bar, b.x, nloc, nx); b.st[0] = nloc; b.st[1] = nx; }
        const unsigned old = xb_add(&bar[XB_XSUB(b.x)], 1u);
        const unsigned gen = old / nloc;
        if (old + 1u == (gen + 1u) * nloc) {
            __builtin_amdgcn_fence(__ATOMIC_RELEASE, "agent");
            asm volatile("s_waitcnt vmcnt(0)" ::: "memory");
            const unsigned og = xb_add(&bar[XB_TOP], 1u);
            const unsigned tg = og / nx;
            if (og + 1u == (tg + 1u) * nx) xb_add(&bar[XB_TOPGEN], 1u);
            else XB_SPIN(xb_ld(&bar[XB_TOPGEN]) == tg, bar);
            __builtin_amdgcn_fence(__ATOMIC_ACQUIRE, "agent");
            xb_add(&bar[XB_XGEN(b.x)], 1u);
            asm volatile("s_waitcnt vmcnt(0)" ::: "memory");
        } else {
            XB_SPIN(xb_ld(&bar[XB_XGEN(b.x)]) == gen, bar);
            __builtin_amdgcn_fence(__ATOMIC_ACQUIRE, "agent");
            asm volatile("s_waitcnt vmcnt(0)" ::: "memory");
        }
    }
    __syncthreads();
}
#define LDS_WAIT() asm volatile("s_waitcnt lgkmcnt(0)" ::: "memory")

__device__ __forceinline__ void transpose_item(const float* W, int K, int N, bf16* WT, int dst_row0, int src_col0, int nvalid, int kb, LAS float* scr, int lane) {
    const int k0 = 64 * kb, nl = lane & 31;
#pragma unroll 8
    for (int i = 0; i < 32; ++i) { const int kk = 2 * i + (lane >> 5); scr[kk * 33 + nl] = nl < nvalid ? W[(size_t)(k0 + kk) * N + src_col0 + nl] : 0.f; }
    LDS_WAIT();
    const int c = lane & 7;
#pragma unroll
    for (int j = 0; j < 4; ++j) { const int n = (lane >> 3) + 8 * j; const LAS float* s = scr + (8 * c) * 33 + n;
        v4u o; o.x = pk2(s[0 * 33], s[1 * 33]); o.y = pk2(s[2 * 33], s[3 * 33]); o.z = pk2(s[4 * 33], s[5 * 33]); o.w = pk2(s[6 * 33], s[7 * 33]);
        *(v4u*)(WT + (size_t)(dst_row0 + n) * K + k0 + 8 * c) = o; }
    LDS_WAIT();
}
__device__ __forceinline__ void win_map(int nb, int& src, int& nvalid) { const int v0 = 32 * nb; if (v0 < 2048) { src = v0; nvalid = 32; } else if (v0 < 2816) { src = v0 + 16; nvalid = 32; } else if (v0 == 2816) { src = 2048; nvalid = 16; } else { src = 0; nvalid = 0; } }
__device__ __forceinline__ int gu_map(int nb) { const int v0 = 32 * nb; return ((v0 >> 7) & 1) * FFH + (v0 >> 8) * 128 + (v0 & 127); }

__device__ __forceinline__ void prologue_phase(const float* const* in, unsigned char* ws, LAS unsigned char* lds, int wg, int G, int tid) {
    const int lane = tid & 63, wave = tid >> 6, gw = wg * NWAVES + wave, NGW = G * NWAVES;
    LAS float* scr = (LAS float*)(lds + wave * 16384);
    constexpr int I_WIN = 16 * 96, I_WOUT = 16 * 32, I_GU = 16 * 176, I_DN = 44 * 32;
    constexpr int NITEMS = 2 * I_WIN + 2 * I_WOUT + 9 * I_GU + 9 * I_DN;
    for (int it = gw; it < NITEMS; it += NGW) {
        int r = it;
        if (r < 2 * I_WIN) { const int L = r / I_WIN; r -= L * I_WIN; const int kb = r / 96, nb = r % 96; int src, nv; win_map(nb, src, nv);
            transpose_item(in[8] + (size_t)L * D * PIN_SRC, D, PIN_SRC, (bf16*)(ws + WS_WIN) + (size_t)L * PLD * D, 32 * nb, src, nv, kb, scr, lane); continue; }
        r -= 2 * I_WIN;
        if (r < 2 * I_WOUT) { const int L = r / I_WOUT; r -= L * I_WOUT; const int kb = r / 32, nb = r % 32;
            transpose_item(in[15] + (size_t)L * D * D, D, D, (bf16*)(ws + WS_WOUT) + (size_t)L * D * D, 32 * nb, 32 * nb, 32, kb, scr, lane); continue; }
        r -= 2 * I_WOUT;
        if (r < 9 * I_GU) { const int e = r / I_GU; r -= e * I_GU; const int kb = r / 176, nb = r % 176;
            const float* W = e == 0 ? in[16] : in[20] + (size_t)(e - 1) * D * 2 * FFH; bf16* WT = e == 0 ? (bf16*)(ws + WS_WGU) : (bf16*)(ws + WS_MWGU) + (size_t)(e - 1) * 2 * FFH * D;
            transpose_item(W, D, 2 * FFH, WT, 32 * nb, gu_map(nb), 32, kb, scr, lane); continue; }
        r -= 9 * I_GU;
        { const int e = r / I_DN; r -= e * I_DN; const int kb = r / 32, nb = r % 32;
            const float* W = e == 0 ? in[17] : in[21] + (size_t)(e - 1) * FFH * D; bf16* WT = e == 0 ? (bf16*)(ws + WS_WD) : (bf16*)(ws + WS_MWD) + (size_t)(e - 1) * D * FFH;
            transpose_item(W, FFH, D, WT, 32 * nb, 32 * nb, 32, kb, scr, lane); }
    }
    __syncthreads();
    LAS float* cond_s = (LAS float*)lds;
    LAS float* part = (LAS float*)(lds + 32768);
    for (int i = tid; i < 5 * D; i += NTHR) { const int r = i >> 10, k = i & 1023; const float v = r < 4 ? in[1][r * D + k] : in[3][k]; cond_s[i] = silu_f(v); }
    __syncthreads();
    float* MOD = (float*)(ws + WS_MOD);
    for (int t = wg; t < 192; t += G) {
        const int L = t / 96, nb = t % 96; const float* W = in[6] + (size_t)L * D * 6144 + nb * 64 + lane;
        float a0 = 0.f, a1 = 0.f, a2 = 0.f, a3 = 0.f, a4 = 0.f;
#pragma unroll 8
        for (int kk = 0; kk < 128; ++kk) { const int k = wave * 128 + kk; const float w = W[(size_t)k * 6144];
            a0 += cond_s[k] * w; a1 += cond_s[D + k] * w; a2 += cond_s[2 * D + k] * w; a3 += cond_s[3 * D + k] * w; a4 += cond_s[4 * D + k] * w; }
        part[(wave * 5 + 0) * 64 + lane] = a0; part[(wave * 5 + 1) * 64 + lane] = a1; part[(wave * 5 + 2) * 64 + lane] = a2; part[(wave * 5 + 3) * 64 + lane] = a3; part[(wave * 5 + 4) * 64 + lane] = a4;
        __syncthreads();
        if (tid < 320) { const int r = tid >> 6, l = tid & 63; float s = in[7][L * 6144 + nb * 64 + l];
#pragma unroll
            for (int w = 0; w < 8; ++w) s += part[(w * 5 + r) * 64 + l];
            MOD[(size_t)(L * 5 + r) * 6144 + nb * 64 + l] = s; }
        __syncthreads();
    }
}

template <bool ROUTER>
__device__ __forceinline__ void norm_phase(const float* xlat, const float* xctx, bool do_ctx, const float* ng, const float* modL, int chunk_shift, bf16* A,
                                           const float* w_router, const float* b_router, int* tok_e, float* tok_w, int* hist, LAS unsigned char* lds, int wg, int G, int tid) {
    const int lane = tid & 63, wave = tid >> 6;
    LAS float* wr_s = (LAS float*)lds;
    LAS int* lh = (LAS int*)(lds + 32768);
    if (ROUTER) { for (int i = tid; i < D * NEXP; i += NTHR) wr_s[i] = w_router[i]; }
    for (int blk = wg; blk < 256; blk += G) {
        if (ROUTER) { if (tid < 8) lh[tid] = 0; __syncthreads(); }
        for (int pass = 0; pass < (do_ctx ? 2 : 1); ++pass) {
            const int b = pass == 0 ? (blk >> 6) : 4;
            const float* sh = modL + (size_t)b * 6144 + chunk_shift * D; const float* sc = sh + D;
            f32x4 mul[4], add[4];
#pragma unroll
            for (int j = 0; j < 4; ++j) { const int c = 4 * lane + 256 * j; const f32x4 g = *(const f32x4*)(ng + c), s = *(const f32x4*)(sc + c); mul[j] = g * (s + 1.0f); add[j] = *(const f32x4*)(sh + c); }
            const int nrow = pass == 0 ? 16 : (wave < 4 ? 1 : 0);
            for (int i = 0; i < nrow; ++i) {
                const int lrow = pass == 0 ? blk * 128 + wave * 16 + i : blk * 4 + wave;
                const float* xr = (pass == 0 ? xlat : xctx) + (size_t)lrow * D; const int arow = pass == 0 ? lrow : NLAT + lrow;
                f32x4 v[4]; float ss = 0.f;
#pragma unroll
                for (int j = 0; j < 4; ++j) { v[j] = *(const f32x4*)(xr + 4 * lane + 256 * j); ss += (v[j].x * v[j].x + v[j].y * v[j].y) + (v[j].z * v[j].z + v[j].w * v[j].w); }
                const float rstd = 1.0f / sqrtf(wave_sum(ss) * (1.0f / D) + EPS);
                unsigned long long* o8 = (unsigned long long*)(A + (size_t)arow * D) + lane;
#pragma unroll
                for (int j = 0; j < 4; ++j) { v[j] = v[j] * rstd * mul[j] + add[j]; o8[64 * j] = (unsigned long long)pk2(v[j].x, v[j].y) | ((unsigned long long)pk2(v[j].z, v[j].w) << 32); }
                if (ROUTER && pass == 0) {
                    float lg[8];
#pragma unroll
                    for (int e = 0; e < 8; ++e) lg[e] = 0.f;
#pragma unroll
                    for (int j = 0; j < 4; ++j)
#pragma unroll
                        for (int q = 0; q < 4; ++q) { const int c = 4 * lane + 256 * j + q; const f32x4 w0 = *(const LAS f32x4*)(wr_s + c * 8), w1 = *(const LAS f32x4*)(wr_s + c * 8 + 4); const float y = v[j][q];
                            lg[0] += y * w0.x; lg[1] += y * w0.y; lg[2] += y * w0.z; lg[3] += y * w0.w; lg[4] += y * w1.x; lg[5] += y * w1.y; lg[6] += y * w1.z; lg[7] += y * w1.w; }
#pragma unroll
                    for (int e = 0; e < 8; ++e) lg[e] = wave_sum(lg[e]) + b_router[e];
                    if (lane == 0) {
                        int e1 = 0; float v1 = lg[0];
#pragma unroll
                        for (int e = 1; e < 8; ++e) if (lg[e] > v1) { v1 = lg[e]; e1 = e; }
                        int e2 = -1; float v2 = -3.0e38f;
#pragma unroll
                        for (int e = 0; e < 8; ++e) if (e != e1 && lg[e] > v2) { v2 = lg[e]; e2 = e; }
                        const float w2 = 1.0f / (1.0f + __expf(v1 - v2)), w1 = 1.0f - w2;
                        tok_e[lrow * 2] = e1; tok_e[lrow * 2 + 1] = e2; tok_w[lrow * 2] = w1; tok_w[lrow * 2 + 1] = w2;
                        __hip_atomic_fetch_add(&lh[e1], 1, __ATOMIC_RELAXED, __HIP_MEMORY_SCOPE_WORKGROUP); __hip_atomic_fetch_add(&lh[e2], 1, __ATOMIC_RELAXED, __HIP_MEMORY_SCOPE_WORKGROUP);
                    }
                }
            }
        }
        if (ROUTER) { __syncthreads(); if (tid < 8) hist[blk * 8 + tid] = lh[tid]; __syncthreads(); }
    }
}

__device__ __forceinline__ void route_phase(unsigned char* ws, LAS unsigned char* lds, int wg, int G, int tid) {
    const int lane = tid & 63, wave = tid >> 6;
    int* rw = (int*)(ws + WS_ROUTE); const int* hist = rw + RW_HIST;
    const int* tok_e = (const int*)(ws + WS_TOK); const float* tok_w = (const float*)(ws + WS_TOK + 256 * 1024); int* pair_pos = (int*)(ws + WS_TOK + 512 * 1024); float* row_w = (float*)(ws + WS_TOK + 768 * 1024);
    const bf16* A = (const bf16*)(ws + WS_A); bf16* AS = (bf16*)(ws + WS_ASORT);
    LAS int* hs = (LAS int*)lds;
    LAS int* tot = hs + 2048;
    LAS int* te = hs + 2048 + 32;
    LAS int* ps = te + 256;
    for (int blk = wg; blk < 256; blk += G) {
        __syncthreads();
        for (int i = tid; i < 2048; i += NTHR) hs[i] = hist[i];
        if (tid < 256) te[tid] = tok_e[blk * 256 + tid];
        __syncthreads();
        if (tid < 8) { int t = 0, mb = 0; for (int b = 0; b < 256; ++b) { const int h = hs[b * 8 + tid]; t += h; mb += (b < blk) ? h : 0; } tot[tid] = t; tot[16 + tid] = mb; }
        __syncthreads();
        if (tid == 0) { int s = 0; for (int e = 0; e < 8; ++e) { tot[8 + e] = s; s += (tot[e] + 255) & ~255; } tot[24] = s >> 8; }
        __syncthreads();
        if (tid < 256) { const int e = te[tid]; int rank = 0; for (int q = 0; q < tid; ++q) rank += (te[q] == e) ? 1 : 0;
            const int pos = tot[8 + e] + tot[16 + e] + rank; ps[tid] = pos; pair_pos[blk * 256 + tid] = pos; row_w[pos] = tok_w[blk * 256 + tid]; }
        __syncthreads();
        for (int q = wave * 32; q < wave * 32 + 32; ++q) { const int token = blk * 128 + (q >> 1), pos = ps[q];
            const v4u* s = (const v4u*)(A + (size_t)token * D); v4u* d = (v4u*)(AS + (size_t)pos * D); const v4u a = s[lane], b = s[lane + 64]; d[lane] = a; d[lane + 64] = b; }
        if (blk == 0) {
            if (tid < 264) { int e = 0; for (int e2 = 1; e2 < 8; ++e2) if (tid * 256 >= tot[8 + e2]) e = e2; rw[RW_TILE_E + tid] = e; }
            if (tid == 0) rw[RW_NTILES] = tot[24];
        }
        if (blk < 8) { const int e = blk, r0 = tot[8 + e] + tot[e], r1 = tot[8 + e] + ((tot[e] + 255) & ~255);
            for (int r = r0 + wave; r < r1; r += NWAVES) { v4u* d = (v4u*)(AS + (size_t)r * D); const v4u z = {0u, 0u, 0u, 0u}; d[lane] = z; d[lane + 64] = z; if (lane == 0) row_w[r] = 0.f; } }
    }
}

__device__ __forceinline__ void mout_phase(const float* HF, const float* HB, const bf16* P, const float* ng, bf16* Y, int nrows, int wg, int G, int tid) {
    const int lane = tid & 63, wave = tid >> 6;
    const f32x4 g0 = *(const f32x4*)(ng + 8 * lane), g1 = *(const f32x4*)(ng + 8 * lane + 4);
    for (int row = wg * NWAVES + wave; row < nrows; row += G * NWAVES) {
        const f32x4 a0 = *(const f32x4*)(HF + (size_t)row * 512 + 8 * lane), a1 = *(const f32x4*)(HF + (size_t)row * 512 + 8 * lane + 4);
        const f32x4 b0 = *(const f32x4*)(HB + (size_t)row * 512 + 8 * lane), b1 = *(const f32x4*)(HB + (size_t)row * 512 + 8 * lane + 4);
        const v4u o = *(const v4u*)(P + (size_t)row * PLD + PO_O + 8 * lane);
        const f32x4 s0 = a0 + b0, s1 = a1 + b1;
        float ss = (s0.x * s0.x + s0.y * s0.y) + (s0.z * s0.z + s0.w * s0.w) + (s1.x * s1.x + s1.y * s1.y) + (s1.z * s1.z + s1.w * s1.w);
        ss += __shfl_xor(ss, 1); ss += __shfl_xor(ss, 2); ss += __shfl_xor(ss, 4); ss += __shfl_xor(ss, 8);
        const float rstd = 1.0f / sqrtf(ss * (1.0f / 128.0f) + EPS);
        v4u w;
        w.x = pk2(sigmoid_f(bflo(o.x)) * s0.x * rstd * g0.x, sigmoid_f(bfhi(o.x)) * s0.y * rstd * g0.y);
        w.y = pk2(sigmoid_f(bflo(o.y)) * s0.z * rstd * g0.z, sigmoid_f(bfhi(o.y)) * s0.w * rstd * g0.w);
        w.z = pk2(sigmoid_f(bflo(o.z)) * s1.x * rstd * g1.x, sigmoid_f(bfhi(o.z)) * s1.y * rstd * g1.y);
        w.w = pk2(sigmoid_f(bflo(o.w)) * s1.z * rstd * g1.z, sigmoid_f(bfhi(o.w)) * s1.w * rstd * g1.w);
        *(v4u*)(Y + (size_t)row * D + 8 * lane) = w;
    }
}

__device__ __forceinline__ void final_phase(float* X, const bf16* O, const int* pair_pos, const float* modL, const float* fg, int wg, int G, int tid) {
    const int lane = tid & 63, wave = tid >> 6;
    for (int row = wg * NWAVES + wave; row < NLAT; row += G * NWAVES) {
        const int b = row >> 13; const float* g2 = modL + (size_t)b * 6144 + 5 * D;
        const int p1 = pair_pos[row * 2], p2 = pair_pos[row * 2 + 1];
        float* xr = X + (size_t)row * D; const v2u* o1 = (const v2u*)(O + (size_t)p1 * D) + lane; const v2u* o2 = (const v2u*)(O + (size_t)p2 * D) + lane;
        f32x4 v[4]; float ss = 0.f;
#pragma unroll
        for (int j = 0; j < 4; ++j) { const f32x4 x = *(const f32x4*)(xr + 4 * lane + 256 * j), g = *(const f32x4*)(g2 + 4 * lane + 256 * j); const v2u a = o1[64 * j], c = o2[64 * j];
            f32x4 m; m.x = bflo(a.x) + bflo(c.x); m.y = bfhi(a.x) + bfhi(c.x); m.z = bflo(a.y) + bflo(c.y); m.w = bfhi(a.y) + bfhi(c.y);
            v[j] = x + g * m; ss += (v[j].x * v[j].x + v[j].y * v[j].y) + (v[j].z * v[j].z + v[j].w * v[j].w); }
        const float rstd = 1.0f / sqrtf(wave_sum(ss) * (1.0f / D) + EPS);
#pragma unroll
        for (int j = 0; j < 4; ++j) { const f32x4 g = *(const f32x4*)(fg + 4 * lane + 256 * j); *(f32x4*)(xr + 4 * lane + 256 * j) = v[j] * rstd * g; }
    }
}

__device__ __forceinline__ void mlstm_naive_task(const bf16* P, const float* Gt, const float* bgate, float* HF, float* HB, LAS unsigned char* lds, int task, int tid) {
    const int bb = task >> 6, h = (task >> 4) & 3, dir = (task >> 3) & 1, sl = task & 7;
    const int e = tid & 15, dg = tid >> 4, d0 = dg * 4, wave = tid >> 6, lane = tid & 63;
    float C0 = 0.f, C1 = 0.f, C2 = 0.f, C3 = 0.f, n0 = 0.f, n1 = 0.f, n2 = 0.f, n3 = 0.f, m = -1e30f;
    const float bi = bgate[dir * 8 + h], bfg = bgate[dir * 8 + 4 + h];
    float* HS = dir ? HB : HF;
    LAS float* red = (LAS float*)lds;
    constexpr int NSTEP = CTXL + SEQ;
    constexpr float KSC = 0.08838834764831845f;
    __syncthreads();
#define MLSTM_ROW(s) ((s) < CTXL ? NLAT + bb * CTXL + (dir ? CTXL - 1 - (s) : (s)) : bb * SEQ + (dir ? SEQ - 1 - ((s) - CTXL) : ((s) - CTXL)))
    int rown = MLSTM_ROW(0);
    v2u qn = *(const v2u*)(P + (size_t)rown * PLD + PO_Q + h * 128 + d0), kn = *(const v2u*)(P + (size_t)rown * PLD + PO_K + h * 128 + d0);
    unsigned short vn = P[(size_t)rown * PLD + PO_V + h * 128 + sl * 16 + e]; float gin = Gt[(size_t)rown * 16 + dir * 8 + h], gfn = Gt[(size_t)rown * 16 + dir * 8 + 4 + h];
    for (int s = 0; s < NSTEP; ++s) {
        const int row = rown; const v2u q2 = qn, k2 = kn; const float v = bf2f(vn), ipre = gin + bi, fpre = gfn + bfg;
        if (s + 1 < NSTEP) { rown = MLSTM_ROW(s + 1);
            qn = *(const v2u*)(P + (size_t)rown * PLD + PO_Q + h * 128 + d0); kn = *(const v2u*)(P + (size_t)rown * PLD + PO_K + h * 128 + d0);
            vn = P[(size_t)rown * PLD + PO_V + h * 128 + sl * 16 + e]; gin = Gt[(size_t)rown * 16 + dir * 8 + h]; gfn = Gt[(size_t)rown * 16 + dir * 8 + 4 + h]; }
        const float q0 = bflo(q2.x), q1 = bfhi(q2.x), q2f = bflo(q2.y), q3 = bfhi(q2.y);
        const float k0 = bflo(k2.x) * KSC, k1 = bfhi(k2.x) * KSC, k2f = bflo(k2.y) * KSC, k3 = bfhi(k2.y) * KSC;
        const float lf = log_sigmoid_f(fpre), mn = fmaxf(lf + m, ipre), fw = __expf(lf + m - mn), iw = __expf(ipre - mn); m = mn;
        const float kv = iw * v;
        C0 = fw * C0 + k0 * kv; C1 = fw * C1 + k1 * kv; C2 = fw * C2 + k2f * kv; C3 = fw * C3 + k3 * kv;
        n0 = fw * n0 + iw * k0; n1 = fw * n1 + iw * k1; n2 = fw * n2 + iw * k2f; n3 = fw * n3 + iw * k3;
        float pn = (q0 * C0 + q1 * C1) + (q2f * C2 + q3 * C3), pd = (q0 * n0 + q1 * n1) + (q2f * n2 + q3 * n3);
        pn += __shfl_xor(pn, 16); pn += __shfl_xor(pn, 32); pd += __shfl_xor(pd, 16); pd += __shfl_xor(pd, 32);
        const int par = s & 1;
        if (lane < 16) red[(par * 8 + wave) * 17 + lane] = pn;
        if (lane == 0) red[(par * 8 + wave) * 17 + 16] = pd;
        __syncthreads();
        if (tid < 16) { float num = 0.f, den = 0.f;
#pragma unroll
            for (int w = 0; w < 8; ++w) { num += red[(par * 8 + w) * 17 + tid]; den += red[(par * 8 + w) * 17 + 16]; }
            HS[(size_t)row * 512 + h * 128 + sl * 16 + tid] = num / fmaxf(fabsf(den), __expf(-m)); }
    }
#undef MLSTM_ROW
    __syncthreads();
}
typedef float f32x2 __attribute__((ext_vector_type(2)));
__device__ __forceinline__ void fourier_naive_task(const bf16* P, bf16* Y, LAS unsigned char* lds, int task, bool ctx, int tid) {
    const int lane = tid & 63, wave = tid >> 6;
    LAS f32x2* tab = (LAS f32x2*)lds;
    LAS unsigned short* zb = (LAS unsigned short*)(lds + 65536);
    LAS float* ure_s = (LAS float*)(lds + 98304);
    LAS float* uim_s = ure_s + 4096;
    const int N = ctx ? CTXL : SEQ, nkb = N / 64, tstride = 8192 / N;
    const int b = task / (4 * nkb), g = (task / nkb) & 3, kb = task % nkb;
    const int rowbase = ctx ? NLAT + b * CTXL : b * SEQ;
    float ure[8], uim[8]; int idx[8], stp[8];
#pragma unroll
    for (int j = 0; j < 8; ++j) { ure[j] = 0.f; uim[j] = 0.f; idx[j] = 0; stp[j] = ((kb * 64 + wave * 8 + j) * tstride) & 8191; }
    for (int nb0 = 0; nb0 < N; nb0 += 256) {
        __syncthreads();
#pragma unroll
        for (int i = 0; i < 4; ++i) { const int p = tid + NTHR * i, r = p >> 3, ch = p & 7;
            *(LAS v4u*)(zb + r * 64 + ch * 8) = *(const v4u*)(P + (size_t)(rowbase + nb0 + r) * PLD + PO_F + g * 64 + ch * 8); }
        __syncthreads();
#pragma unroll 2
        for (int nn = 0; nn < 256; ++nn) { const float z = bf2f(zb[nn * 64 + lane]);
#pragma unroll
            for (int j = 0; j < 8; ++j) { const f32x2 t = tab[idx[j]]; ure[j] += z * t.x; uim[j] -= z * t.y; idx[j] = (idx[j] + stp[j]) & 8191; } }
    }
    __syncthreads();
#pragma unroll
    for (int j = 0; j < 8; ++j) { ure_s[(wave * 8 + j) * 64 + lane] = ure[j]; uim_s[(wave * 8 + j) * 64 + lane] = uim[j]; }
    __syncthreads();
    const float scale = 1.0f / sqrtf((float)N * 64.0f);
#pragma unroll 1
    for (int j = 0; j < 8; ++j) { const int kl = wave * 8 + j; float acc = 0.f;
#pragma unroll 4
        for (int c = 0; c < 64; ++c) { const f32x2 t = tab[((c * lane) & 63) * 128]; acc += ure_s[kl * 64 + c] * t.x + uim_s[kl * 64 + c] * t.y; }
        Y[(size_t)(rowbase + kb * 64 + kl) * D + 512 + g * 64 + lane] = (bf16)f2bf(acc * scale); }
}
__device__ __forceinline__ void conv_task(const bf16* P, bf16* Y, const float* dw, const float* db, const float* lg, const float* lb, LAS unsigned char* lds, int task, bool ctx, int tid) {
    const int lane = tid & 63, wave = tid >> 6;
    const int N = ctx ? CTXL : SEQ, ntile = N / 32, b = task / ntile, t0 = (task % ntile) * 32, rowbase = ctx ? NLAT + b * CTXL : b * SEQ;
    LAS float* a = (LAS float*)lds;
    LAS float* o = a + 62 * 256;
    __syncthreads();
    for (int i = tid; i < 62 * 256; i += NTHR) { const int r = i >> 8, ch = i & 255, t = t0 - 15 + r; float v = 0.f;
        if (t >= 0 && t < N) { const bf16* pr = P + (size_t)(rowbase + t) * PLD; v = bf2f(pr[PO_CU + ch]) * sigmoid_f(bf2f(pr[PO_CG + ch])); }
        a[i] = v; }
    __syncthreads();
    { const int ch = tid & 255, th = tid >> 8; float w[31];
#pragma unroll
        for (int j = 0; j < 31; ++j) w[j] = dw[j * 256 + ch];
        const float bias = db[ch];
        for (int tt = 0; tt < 16; ++tt) { const int t = th * 16 + tt; float s = bias;
#pragma unroll
            for (int j = 0; j < 31; ++j) s += a[(t + j) * 256 + ch] * w[j];
            o[t * 256 + ch] = s; } }
    __syncthreads();
    for (int i = 0; i < 16; ++i) { const int p = wave * 16 + i, t = p >> 2, g = p & 3; const float v = o[t * 256 + g * 64 + lane];
        const float mu = wave_sum(v) * (1.0f / 64.0f), d = v - mu, var = wave_sum(d * d) * (1.0f / 64.0f);
        const float yn = d * (1.0f / sqrtf(var + EPS)) * lg[g * 64 + lane] + lb[g * 64 + lane];
        Y[(size_t)(rowbase + t0 + t) * D + 768 + g * 64 + lane] = (bf16)f2bf(silu_f(yn)); }
}
__device__ __forceinline__ void mix_naive_phase(const float* const* in, unsigned char* ws, int L, bool do_ctx, LAS unsigned char* lds, int wg, int G, int tid) {
    const bf16* P = (const bf16*)(ws + WS_P); bf16* Y = (bf16*)(ws + WS_Y);
#ifndef MIXSEL
#define MIXSEL 7
#endif
    if (MIXSEL & 1) for (int t = wg; t < 256; t += G) mlstm_naive_task(P, (const float*)(ws + WS_G), in[9] + L * 16, (float*)(ws + WS_HF), (float*)(ws + WS_HB), lds, t, tid);
    __syncthreads();
    { LAS f32x2* tab = (LAS f32x2*)lds; for (int i = tid; i < 8192; i += NTHR) { float s, c; sincospif((float)i * (1.0f / 4096.0f), &s, &c); tab[i] = (f32x2){c, s}; } }
    __syncthreads();
    if (MIXSEL & 2) for (int t = wg; t < 16 * 128; t += G) fourier_naive_task(P, Y, lds, t, false, tid);
    if ((MIXSEL & 2) && do_ctx) for (int t = wg; t < 16 * 4; t += G) fourier_naive_task(P, Y, lds, t, true, tid);
    if (MIXSEL & 4) for (int t = wg; t < 4 * 256; t += G) conv_task(P, Y, in[11] + L * 31 * 256, in[12] + L * 256, in[13] + L * 256, in[14] + L * 256, lds, t, false, tid);
    if ((MIXSEL & 4) && do_ctx) for (int t = wg; t < 4 * 8; t += G) conv_task(P, Y, in[11] + L * 31 * 256, in[12] + L * 256, in[13] + L * 256, in[14] + L * 256, lds, t, true, tid);
}

typedef short bf16x8v __attribute__((ext_vector_type(8)));
constexpr size_t WS_NS = WS_R2 + 330 * MiB;
constexpr size_t WS_SC = WS_R2 + 333 * MiB;
static_assert(WS_HB + (size_t)16 * 132 * 16384 * 2 <= WS_NS && WS_NS + (size_t)2 * 16 * 132 * 128 * 4 <= WS_SC && WS_SC + (size_t)2 * 16 * 132 * 16 <= WS_END && WS_HF + (size_t)16 * 132 * 16384 * 2 <= WS_R2, "mlstm state map");
constexpr int NCHK = 132;
constexpr float KSC = 0.08838834764831845f;
__device__ __forceinline__ int chunk_rowbase(int b, int c) { return c < 128 ? b * SEQ + 64 * c : NLAT + b * CTXL + 64 * (c - 128); }
__device__ __forceinline__ float scan_add(float x, int lane, bool rev) {
#pragma unroll
    for (int o = 1; o < 64; o <<= 1) { const float y = rev ? __shfl_down(x, o) : __shfl_up(x, o); const bool ok = rev ? (lane + o < 64) : (lane >= o); x = ok ? x + y : x; }
    return x;
}
__device__ __forceinline__ float scan_max(float x, int lane, bool rev) {
#pragma unroll
    for (int o = 1; o < 64; o <<= 1) { const float y = rev ? __shfl_down(x, o) : __shfl_up(x, o); const bool ok = rev ? (lane + o < 64) : (lane >= o); x = ok ? fmaxf(x, y) : x; }
    return x;
}
__device__ __forceinline__ float wave_max(float v) {
#pragma unroll
    for (int o = 1; o < 64; o <<= 1) v = fmaxf(v, __shfl_xor(v, o));
    return v;
}
#define MFMA16(a, b, c) __builtin_amdgcn_mfma_f32_16x16x32_bf16((a), (b), (c), 0, 0, 0)

__device__ __forceinline__ void mlstm_m1_task(const bf16* P, const float* Gt, const float* bg, unsigned char* ws, LAS unsigned char* lds, int task, int tid) {
    const int lane = tid & 63, wave = tid >> 6, r = lane & 15, g = lane >> 4;
    const int bh = task / NCHK, c = task % NCHK, b = bh >> 2, h = bh & 3, rowbase = chunk_rowbase(b, c);
    LAS unsigned short* KT0 = (LAS unsigned short*)lds;
    LAS unsigned short* VT = (LAS unsigned short*)(lds + 36864);
    LAS float* gw = (LAS float*)(lds + 55296);
    float* SC = (float*)(ws + WS_SC); float* NS = (float*)(ws + WS_NS);
    __syncthreads();
    if (wave < 2) { const int dir = wave; const float* gr = Gt + (size_t)(rowbase + lane) * 16 + dir * 8 + h;
        const float a = gr[0] + bg[dir * 8 + h], lf = log_sigmoid_f(gr[4] + bg[dir * 8 + 4 + h]);
        const float cum = scan_add(lf, lane, dir != 0), gg = a - cum, gmax = wave_max(gg);
        gw[dir * 64 + lane] = __expf(gg - gmax) * KSC;
        const float tot = __shfl(cum, dir ? 0 : 63);
        if (lane == 0) { float* sc = SC + ((size_t)(dir * 16 + bh) * NCHK + c) * 4; sc[0] = tot; sc[1] = tot + gmax; } }
    __syncthreads();
#pragma unroll
    for (int i2 = 0; i2 < 2; ++i2) { const int p = tid + NTHR * i2, s = p >> 4, dg = p & 15;
        const v4u kq = *(const v4u*)(P + (size_t)(rowbase + s) * PLD + PO_K + h * 128 + dg * 8), vq = *(const v4u*)(P + (size_t)(rowbase + s) * PLD + PO_V + h * 128 + dg * 8);
        const float wf = gw[s], wb = gw[64 + s];
        const unsigned kk[4] = {kq.x, kq.y, kq.z, kq.w}, vv[4] = {vq.x, vq.y, vq.z, vq.w};
#pragma unroll
        for (int j = 0; j < 4; ++j) { const float k0 = bflo(kk[j]), k1 = bfhi(kk[j]); const int d = dg * 8 + 2 * j;
            KT0[d * 72 + s] = (unsigned short)f2bf(k0 * wf); KT0[(d + 1) * 72 + s] = (unsigned short)f2bf(k1 * wf);
            KT0[9216 + d * 72 + s] = (unsigned short)f2bf(k0 * wb); KT0[9216 + (d + 1) * 72 + s] = (unsigned short)f2bf(k1 * wb);
            VT[d * 72 + s] = (unsigned short)(vv[j] & 0xffffu); VT[(d + 1) * 72 + s] = (unsigned short)(vv[j] >> 16); } }
    __syncthreads();
    { const int dir = wave >> 2, dt0 = (wave & 3) * 2; LAS unsigned short* KT = KT0 + dir * 9216;
        bf16* CS = (bf16*)(ws + (dir ? WS_HB : WS_HF)) + ((size_t)bh * NCHK + c) * 16384;
        bf16x8v af[2][2];
#pragma unroll
        for (int m = 0; m < 2; ++m)
#pragma unroll
            for (int kk = 0; kk < 2; ++kk) af[m][kk] = *(const LAS bf16x8v*)(KT + ((dt0 + m) * 16 + r) * 72 + kk * 32 + 8 * g);
#pragma unroll
        for (int et = 0; et < 8; ++et) {
            const bf16x8v b0 = *(const LAS bf16x8v*)(VT + (et * 16 + r) * 72 + 8 * g), b1 = *(const LAS bf16x8v*)(VT + (et * 16 + r) * 72 + 32 + 8 * g);
#pragma unroll
            for (int m = 0; m < 2; ++m) { f32x4 acc = {0.f, 0.f, 0.f, 0.f}; acc = MFMA16(af[m][0], b0, acc); acc = MFMA16(af[m][1], b1, acc);
                v2u o; o.x = pk2(acc[0], acc[1]); o.y = pk2(acc[2], acc[3]);
                *(v2u*)(CS + (size_t)(et * 16 + r) * 128 + (dt0 + m) * 16 + 4 * g) = o; } }
    }
    if (tid < 256) { const int dir = tid >> 7, dd = tid & 127; const LAS unsigned short* kr = KT0 + dir * 9216 + dd * 72; float s = 0.f;
#pragma unroll
        for (int q = 0; q < 8; ++q) { const v4u w = *(const LAS v4u*)(kr + 8 * q); s += (bflo(w.x) + bfhi(w.x)) + (bflo(w.y) + bfhi(w.y)) + (bflo(w.z) + bfhi(w.z)) + (bflo(w.w) + bfhi(w.w)); }
        NS[((size_t)(dir * 16 + bh) * NCHK + c) * 128 + dd] = s; }
}

__device__ __forceinline__ void mlstm_m2_phase(unsigned char* ws, int wg, int G, int tid) {
    for (int u = wg; u < 256; u += G) {
        const int seq = u >> 3, part = u & 7, dir = seq >> 4, bh = seq & 15;
        bf16* base = (bf16*)(ws + (dir ? WS_HB : WS_HF)) + (size_t)bh * NCHK * 16384 + part * 2048 + tid * 4;
        float* SC = (float*)(ws + WS_SC) + (size_t)(dir * 16 + bh) * NCHK * 4;
        float* NSb = (float*)(ws + WS_NS) + (size_t)(dir * 16 + bh) * NCHK * 128 + tid * 4;
        const bool do_n = (part == 0 && tid < 32), do_m = (part == 0 && tid == 0);
        float s0 = 0.f, s1 = 0.f, s2 = 0.f, s3 = 0.f, m = -1e30f; f32x4 ns = {0.f, 0.f, 0.f, 0.f};
        for (int j0 = 0; j0 < NCHK; j0 += 4) {
            v2u dl[4]; float tot[4], ml[4]; int cc[4]; f32x4 dn[4];
#pragma unroll
            for (int q = 0; q < 4; ++q) { const int j = j0 + q; cc[q] = dir ? (NCHK - 1 - j) : ((j + 128) % NCHK);
                dl[q] = *(const v2u*)(base + (size_t)cc[q] * 16384); tot[q] = SC[cc[q] * 4]; ml[q] = SC[cc[q] * 4 + 1];
                if (do_n) dn[q] = *(const f32x4*)(NSb + (size_t)cc[q] * 128); }
#pragma unroll
            for (int q = 0; q < 4; ++q) {
                v2u o; o.x = pk2(s0, s1); o.y = pk2(s2, s3); *(v2u*)(base + (size_t)cc[q] * 16384) = o;
                if (do_n) *(f32x4*)(NSb + (size_t)cc[q] * 128) = ns;
                if (do_m) SC[cc[q] * 4 + 2] = m;
                const float me = fmaxf(tot[q] + m, ml[q]), al = __expf(tot[q] + m - me), be = __expf(ml[q] - me); m = me;
                s0 = al * s0 + be * bflo(dl[q].x); s1 = al * s1 + be * bfhi(dl[q].x); s2 = al * s2 + be * bflo(dl[q].y); s3 = al * s3 + be * bfhi(dl[q].y);
                if (do_n) ns = ns * al + dn[q] * be;
            }
        }
    }
}

__device__ __forceinline__ void mlstm_m3_task(const bf16* P, const float* Gt, const float* bg, const float* ngl, unsigned char* ws, bf16* Y, LAS unsigned char* lds, int task, int tid) {
    const int lane = tid & 63, wave = tid >> 6, r = lane & 15, g = lane >> 4;
    const int bh = task / NCHK, c = task % NCHK, b = bh >> 2, h = bh & 3, rowbase = chunk_rowbase(b, c);
    LAS unsigned short* Qs = (LAS unsigned short*)lds;
    LAS unsigned short* Ks = (LAS unsigned short*)(lds + 17408);
    LAS unsigned short* VT = (LAS unsigned short*)(lds + 34816);
    LAS unsigned short* CT = (LAS unsigned short*)(lds + 53248);
    LAS float* nsl = (LAS float*)(lds + 122880);
    LAS float* tok = (LAS float*)(lds + 123904);
    LAS float* dens = (LAS float*)(lds + 125952);
    LAS float* ssq = (LAS float*)(lds + 126976);
    const float* SC = (const float*)(ws + WS_SC); const float* NS = (const float*)(ws + WS_NS);
    __syncthreads();
    if (wave < 2) { const int dir = wave; const float* gr = Gt + (size_t)(rowbase + lane) * 16 + dir * 8 + h;
        const float a = gr[0] + bg[dir * 8 + h], lf = log_sigmoid_f(gr[4] + bg[dir * 8 + 4 + h]);
        const float cum = scan_add(lf, lane, dir != 0), gg = a - cum, pm = scan_max(gg, lane, dir != 0);
        const float mst = SC[((size_t)(dir * 16 + bh) * NCHK + c) * 4 + 2];
        tok[dir * 256 + lane] = -fmaxf(mst, pm); tok[dir * 256 + 64 + lane] = gg; tok[dir * 256 + 128 + lane] = cum; tok[dir * 256 + 192 + lane] = mst; }
    else if (wave < 4) { const int dir = wave - 2; const float* src = NS + ((size_t)(dir * 16 + bh) * NCHK + c) * 128; nsl[dir * 128 + lane] = src[lane]; nsl[dir * 128 + 64 + lane] = src[64 + lane]; }
#pragma unroll
    for (int i2 = 0; i2 < 2; ++i2) { const int p = tid + NTHR * i2, s = p >> 4, dg = p & 15; const bf16* pr = P + (size_t)(rowbase + s) * PLD + h * 128 + dg * 8;
        const v4u qq = *(const v4u*)(pr + PO_Q), kq = *(const v4u*)(pr + PO_K), vq = *(const v4u*)(pr + PO_V);
        *(LAS v4u*)(Qs + s * 136 + dg * 8) = qq; *(LAS v4u*)(Ks + s * 136 + dg * 8) = kq;
        const unsigned vv[4] = {vq.x, vq.y, vq.z, vq.w};
#pragma unroll
        for (int j = 0; j < 4; ++j) { const int d = dg * 8 + 2 * j; VT[d * 72 + s] = (unsigned short)(vv[j] & 0xffffu); VT[(d + 1) * 72 + s] = (unsigned short)(vv[j] >> 16); } }
#pragma unroll
    for (int i2 = 0; i2 < 8; ++i2) { const int p = tid + NTHR * i2, dir = p >> 11, e = (p >> 4) & 127, dg = p & 15;
        const bf16* CS = (const bf16*)(ws + (dir ? WS_HB : WS_HF)) + ((size_t)bh * NCHK + c) * 16384;
        *(LAS v4u*)(CT + dir * 17408 + e * 136 + dg * 8) = *(const v4u*)(CS + e * 128 + dg * 8); }
    __syncthreads();
    const int rt = wave & 3, ch = wave >> 2;
    bf16x8v qf[4];
#pragma unroll
    for (int kk = 0; kk < 4; ++kk) qf[kk] = *(const LAS bf16x8v*)(Qs + (16 * rt + r) * 136 + 32 * kk + 8 * g);
    f32x4 sT[4];
#pragma unroll
    for (int st = 0; st < 4; ++st) { f32x4 acc = {0.f, 0.f, 0.f, 0.f};
#pragma unroll
        for (int kk = 0; kk < 4; ++kk) { const bf16x8v a = *(const LAS bf16x8v*)(Ks + (16 * st + r) * 136 + 32 * kk + 8 * g); acc = MFMA16(a, qf[kk], acc); }
        sT[st] = acc; }
    const int t = 16 * rt + r;
    const float uf = tok[t], ub = tok[256 + t];
    float dsf = 0.f, dsb = 0.f; f32x4 Sf[4], Sb[4];
#pragma unroll
    for (int st = 0; st < 4; ++st)
#pragma unroll
        for (int i = 0; i < 4; ++i) { const int s = 16 * st + 4 * g + i; const float sv = sT[st][i] * KSC;
            const float wf = (s <= t) ? __expf(uf + tok[64 + s]) : 0.f, wb = (s >= t) ? __expf(ub + tok[256 + 64 + s]) : 0.f;
            Sf[st][i] = sv * wf; Sb[st][i] = sv * wb; dsf += Sf[st][i]; dsb += Sb[st][i]; }
    float qnf = 0.f, qnb = 0.f;
#pragma unroll
    for (int kk = 0; kk < 4; ++kk)
#pragma unroll
        for (int i = 0; i < 8; ++i) { const float qv = bf2f((unsigned short)qf[kk][i]); const int d = 32 * kk + 8 * g + i; qnf += qv * nsl[d]; qnb += qv * nsl[128 + d]; }
    dsf += __shfl_xor(dsf, 16); dsf += __shfl_xor(dsf, 32); dsb += __shfl_xor(dsb, 16); dsb += __shfl_xor(dsb, 32);
    qnf += __shfl_xor(qnf, 16); qnf += __shfl_xor(qnf, 32); qnb += __shfl_xor(qnb, 16); qnb += __shfl_xor(qnb, 32);
    if (g == 0) { dens[(wave * 2 + 0) * 16 + r] = dsf + __expf(uf + tok[192 + t]) * qnf; dens[(wave * 2 + 1) * 16 + r] = dsb + __expf(ub + tok[256 + 192 + t]) * qnb; }
    bf16x8v paf[2], pab[2];
#pragma unroll
    for (int k2 = 0; k2 < 2; ++k2) {
        v4u w; w.x = pk2(Sf[2 * k2][0], Sf[2 * k2][1]); w.y = pk2(Sf[2 * k2][2], Sf[2 * k2][3]); w.z = pk2(Sf[2 * k2 + 1][0], Sf[2 * k2 + 1][1]); w.w = pk2(Sf[2 * k2 + 1][2], Sf[2 * k2 + 1][3]); paf[k2] = __builtin_bit_cast(bf16x8v, w);
        v4u x; x.x = pk2(Sb[2 * k2][0], Sb[2 * k2][1]); x.y = pk2(Sb[2 * k2][2], Sb[2 * k2][3]); x.z = pk2(Sb[2 * k2 + 1][0], Sb[2 * k2 + 1][1]); x.w = pk2(Sb[2 * k2 + 1][2], Sb[2 * k2 + 1][3]); pab[k2] = __builtin_bit_cast(bf16x8v, x); }
    LDS_WAIT();
    float intf[4], intb[4], rdf[4], rdb[4];
#pragma unroll
    for (int i = 0; i < 4; ++i) { const int tr = 16 * rt + 4 * g + i, tl = 4 * g + i;
        const float u0 = tok[tr], u1 = tok[256 + tr];
        intf[i] = __expf(u0 + tok[192 + tr]); intb[i] = __expf(u1 + tok[256 + 192 + tr]);
        rdf[i] = 1.0f / fmaxf(fabsf(dens[(wave * 2 + 0) * 16 + tl]), __expf(u0 - tok[128 + tr])); rdb[i] = 1.0f / fmaxf(fabsf(dens[(wave * 2 + 1) * 16 + tl]), __expf(u1 - tok[256 + 128 + tr])); }
    f32x4 hs[4]; float sq[4] = {0.f, 0.f, 0.f, 0.f};
#pragma unroll
    for (int ct = 0; ct < 4; ++ct) { const int e0 = 64 * ch + 16 * ct;
        f32x4 aPf = {0.f, 0.f, 0.f, 0.f}, aPb = aPf, aCf = aPf, aCb = aPf;
#pragma unroll
        for (int k2 = 0; k2 < 2; ++k2) { const v2u lo = *(const LAS v2u*)(VT + (e0 + r) * 72 + 32 * k2 + 4 * g), hi = *(const LAS v2u*)(VT + (e0 + r) * 72 + 32 * k2 + 16 + 4 * g);
            v4u bw; bw.x = lo.x; bw.y = lo.y; bw.z = hi.x; bw.w = hi.y; const bf16x8v bfr = __builtin_bit_cast(bf16x8v, bw);
            aPf = MFMA16(paf[k2], bfr, aPf); aPb = MFMA16(pab[k2], bfr, aPb); }
#pragma unroll
        for (int kk = 0; kk < 4; ++kk) { const bf16x8v cf = *(const LAS bf16x8v*)(CT + (e0 + r) * 136 + 32 * kk + 8 * g), cb = *(const LAS bf16x8v*)(CT + 17408 + (e0 + r) * 136 + 32 * kk + 8 * g);
            aCf = MFMA16(qf[kk], cf, aCf); aCb = MFMA16(qf[kk], cb, aCb); }
#pragma unroll
        for (int i = 0; i < 4; ++i) { const float hv = (aPf[i] + intf[i] * aCf[i]) * rdf[i] + (aPb[i] + intb[i] * aCb[i]) * rdb[i]; hs[ct][i] = hv; sq[i] += hv * hv; } }
#pragma unroll
    for (int i = 0; i < 4; ++i) { float v = sq[i]; v += __shfl_xor(v, 1); v += __shfl_xor(v, 2); v += __shfl_xor(v, 4); v += __shfl_xor(v, 8); sq[i] = v; }
    if (r == 0) {
#pragma unroll
        for (int i = 0; i < 4; ++i) ssq[wave * 16 + 4 * g + i] = sq[i]; }
    __syncthreads();
#pragma unroll
    for (int i = 0; i < 4; ++i) { const int tl = 4 * g + i, row = rowbase + 16 * rt + tl;
        const float rstd = 1.0f / sqrtf((ssq[wave * 16 + tl] + ssq[(wave ^ 4) * 16 + tl]) * (1.0f / 128.0f) + EPS);
#pragma unroll
        for (int ct = 0; ct < 4; ++ct) { const int e = 64 * ch + 16 * ct + r; const float o = bf2f(P[(size_t)row * PLD + PO_O + h * 128 + e]);
            Y[(size_t)row * D + h * 128 + e] = (bf16)f2bf(hs[ct][i] * rstd * ngl[h * 128 + e] * sigmoid_f(o)); } }
}


__device__ __forceinline__ void conv_fast_task(const bf16* P, bf16* Y, const float* dw, const float* db, const float* lg, const float* lb, LAS unsigned char* lds, int task, bool ctx, int tid) {
    const int lane = tid & 63, wave = tid >> 6;
    const int N = ctx ? CTXL : SEQ, ntile = N / 64, b = task / ntile, t0 = (task % ntile) * 64, rowbase = ctx ? NLAT + b * CTXL : b * SEQ;
    LAS float* a = (LAS float*)lds;
    __syncthreads();
    for (int p = tid; p < 94 * 32; p += NTHR) { const int rr = p >> 5, cg = p & 31, t = t0 - 15 + rr; f32x4 o0 = {0.f, 0.f, 0.f, 0.f}, o1 = o0;
        if (t >= 0 && t < N) { const bf16* pr = P + (size_t)(rowbase + t) * PLD; const v4u u = *(const v4u*)(pr + PO_CU + 8 * cg), gq = *(const v4u*)(pr + PO_CG + 8 * cg);
            o0.x = bflo(u.x) * sigmoid_f(bflo(gq.x)); o0.y = bfhi(u.x) * sigmoid_f(bfhi(gq.x)); o0.z = bflo(u.y) * sigmoid_f(bflo(gq.y)); o0.w = bfhi(u.y) * sigmoid_f(bfhi(gq.y));
            o1.x = bflo(u.z) * sigmoid_f(bflo(gq.z)); o1.y = bfhi(u.z) * sigmoid_f(bfhi(gq.z)); o1.z = bflo(u.w) * sigmoid_f(bflo(gq.w)); o1.w = bfhi(u.w) * sigmoid_f(bfhi(gq.w)); }
        *(LAS f32x4*)(a + rr * 256 + 8 * cg) = o0; *(LAS f32x4*)(a + rr * 256 + 8 * cg + 4) = o1; }
    __syncthreads();
    const int grp = wave & 3, th = wave >> 2, ch = grp * 64 + lane;
    float w[31];
#pragma unroll
    for (int j = 0; j < 31; ++j) w[j] = dw[j * 256 + ch];
    const float bias = db[ch], gam = lg[ch], bet = lb[ch];
    float acc[32];
#pragma unroll
    for (int t = 0; t < 32; ++t) acc[t] = bias;
#pragma unroll
    for (int j = 0; j < 62; ++j) { const float v = a[(th * 32 + j) * 256 + ch];
#pragma unroll
        for (int t = 0; t < 32; ++t) if (j - t >= 0 && j - t <= 30) acc[t] += v * w[j - t]; }
#pragma unroll
    for (int t = 0; t < 32; ++t) { const float mu = wave_sum(acc[t]) * (1.0f / 64.0f), d = acc[t] - mu, var = wave_sum(d * d) * (1.0f / 64.0f);
        const float yn = d * (1.0f / sqrtf(var + EPS)) * gam + bet;
        Y[(size_t)(rowbase + t0 + th * 32 + t) * D + 768 + ch] = (bf16)f2bf(silu_f(yn)); }
}

constexpr size_t WS_FA = WS_A;
__device__ __forceinline__ bf16x8v pack8(const float (&v)[8]) { v4u w; w.x = pk2(v[0], v[1]); w.y = pk2(v[2], v[3]); w.z = pk2(v[4], v[5]); w.w = pk2(v[6], v[7]); return __builtin_bit_cast(bf16x8v, w); }
__device__ __forceinline__ void fourier_a_phase(const bf16* P, bf16* FA, LAS unsigned char* lds, int wg, int G, int tid) {
    const int lane = tid & 63, wave = tid >> 6, r = lane & 15, g = lane >> 4;
    LAS unsigned short* ZT = (LAS unsigned short*)lds;
    bf16x8v cfr[4], nsfr[4];
    { const int k1 = 16 * wave + r;
#pragma unroll
        for (int kk = 0; kk < 4; ++kk) { float cv[8], sv[8];
#pragma unroll
            for (int i = 0; i < 8; ++i) { const int n1 = 32 * kk + 8 * g + i; float s, c; sincospif((float)((k1 * n1) & 127) * (1.0f / 64.0f), &s, &c); cv[i] = c; sv[i] = -s; }
            cfr[kk] = pack8(cv); nsfr[kk] = pack8(sv); } }
    for (int task = wg; task < 16 * 64; task += G) {
        const int bg = task >> 6, n2 = task & 63, b = bg >> 2, g4 = bg & 3;
        __syncthreads();
#pragma unroll
        for (int i2 = 0; i2 < 2; ++i2) { const int p = tid + NTHR * i2, n1 = p & 127, cg = p >> 7;
            const v4u z = *(const v4u*)(P + (size_t)(b * SEQ + 64 * n1 + n2) * PLD + PO_F + 64 * g4 + 8 * cg); const unsigned zz[4] = {z.x, z.y, z.z, z.w};
#pragma unroll
            for (int j = 0; j < 4; ++j) { ZT[(8 * cg + 2 * j) * 136 + n1] = (unsigned short)(zz[j] & 0xffffu); ZT[(8 * cg + 2 * j + 1) * 136 + n1] = (unsigned short)(zz[j] >> 16); } }
        __syncthreads();
        const int k1 = 16 * wave + r; float tc, ts; sincospif((float)(n2 * k1) * (1.0f / 4096.0f), &ts, &tc);
        bf16* dst = FA + ((size_t)(bg * 128 + k1) * 2) * 4096 + n2 * 64;
#pragma unroll
        for (int ct = 0; ct < 4; ++ct) { f32x4 aR = {0.f, 0.f, 0.f, 0.f}, aI = aR;
#pragma unroll
            for (int kk = 0; kk < 4; ++kk) { const bf16x8v a = *(const LAS bf16x8v*)(ZT + (16 * ct + r) * 136 + 32 * kk + 8 * g); aR = MFMA16(a, cfr[kk], aR); aI = MFMA16(a, nsfr[kk], aI); }
            v2u oR, oI; oR.x = pk2(aR[0] * tc + aI[0] * ts, aR[1] * tc + aI[1] * ts); oR.y = pk2(aR[2] * tc + aI[2] * ts, aR[3] * tc + aI[3] * ts);
            oI.x = pk2(aI[0] * tc - aR[0] * ts, aI[1] * tc - aR[1] * ts); oI.y = pk2(aI[2] * tc - aR[2] * ts, aI[3] * tc - aR[3] * ts);
            *(v2u*)(dst + 16 * ct + 4 * g) = oR; *(v2u*)(dst + 4096 + 16 * ct + 4 * g) = oI; }
    }
}
__device__ __forceinline__ void fourier_b_phase(const bf16* FA, bf16* Y, LAS unsigned char* lds, int wg, int G, int tid) {
    const int lane = tid & 63, wave = tid >> 6, r = lane & 15, g = lane >> 4, kt = wave & 3, kh = wave >> 2;
    LAS unsigned short* Ms = (LAS unsigned short*)lds;
    bf16x8v Cf[2], Sf[2], NSf[2], C2[2][2], S2[2][2];
    { const int kc = 16 * kt + r;
#pragma unroll
        for (int kk = 0; kk < 2; ++kk) { float cv[8], sv[8], nv[8];
#pragma unroll
            for (int i = 0; i < 8; ++i) { const int c = 32 * kk + 8 * g + i; float s, co; sincospif((float)((kc * c) & 63) * (1.0f / 32.0f), &s, &co); cv[i] = co; sv[i] = s; nv[i] = -s; }
            Cf[kk] = pack8(cv); Sf[kk] = pack8(sv); NSf[kk] = pack8(nv); }
#pragma unroll
        for (int m = 0; m < 2; ++m) { const int k2 = 16 * (2 * kh + m) + r;
#pragma unroll
            for (int kk = 0; kk < 2; ++kk) { float cv[8], sv[8];
#pragma unroll
                for (int i = 0; i < 8; ++i) { const int n2 = 32 * kk + 16 * (i >> 2) + 4 * g + (i & 3); float s, co; sincospif((float)((k2 * n2) & 63) * (1.0f / 32.0f), &s, &co); cv[i] = co; sv[i] = s; }
                C2[m][kk] = pack8(cv); S2[m][kk] = pack8(sv); } } }
    const float scale = 1.0f / sqrtf(8192.0f * 64.0f);
    for (int task = wg; task < 16 * 128; task += G) {
        const int bg = task >> 7, k1 = task & 127, b = bg >> 2, g4 = bg & 3;
        const bf16* src = FA + (size_t)(bg * 128 + k1) * 8192;
        __syncthreads();
#pragma unroll
        for (int i2 = 0; i2 < 2; ++i2) { const int p = tid + NTHR * i2, plane = p >> 9, n2 = (p >> 3) & 63, cg = p & 7;
            *(LAS v4u*)(Ms + plane * 4608 + n2 * 72 + 8 * cg) = *(const v4u*)(src + plane * 4096 + n2 * 64 + 8 * cg); }
        __syncthreads();
        f32x4 tre[4], tim[4];
#pragma unroll
        for (int nt = 0; nt < 4; ++nt) { f32x4 a = {0.f, 0.f, 0.f, 0.f}, bq = a;
#pragma unroll
            for (int kk = 0; kk < 2; ++kk) { const bf16x8v are = *(const LAS bf16x8v*)(Ms + (16 * nt + r) * 72 + 32 * kk + 8 * g), aim = *(const LAS bf16x8v*)(Ms + 4608 + (16 * nt + r) * 72 + 32 * kk + 8 * g);
                a = MFMA16(are, Cf[kk], a); a = MFMA16(aim, Sf[kk], a); bq = MFMA16(aim, Cf[kk], bq); bq = MFMA16(are, NSf[kk], bq); }
            tre[nt] = a; tim[nt] = bq; }
        bf16x8v bre[2], bim[2];
#pragma unroll
        for (int kk = 0; kk < 2; ++kk) { const float v0[8] = {tre[2 * kk][0], tre[2 * kk][1], tre[2 * kk][2], tre[2 * kk][3], tre[2 * kk + 1][0], tre[2 * kk + 1][1], tre[2 * kk + 1][2], tre[2 * kk + 1][3]};
            const float v1[8] = {tim[2 * kk][0], tim[2 * kk][1], tim[2 * kk][2], tim[2 * kk][3], tim[2 * kk + 1][0], tim[2 * kk + 1][1], tim[2 * kk + 1][2], tim[2 * kk + 1][3]};
            bre[kk] = pack8(v0); bim[kk] = pack8(v1); }
#pragma unroll
        for (int m = 0; m < 2; ++m) { f32x4 y = {0.f, 0.f, 0.f, 0.f};
#pragma unroll
            for (int kk = 0; kk < 2; ++kk) { y = MFMA16(C2[m][kk], bre[kk], y); y = MFMA16(S2[m][kk], bim[kk], y); }
#pragma unroll
            for (int i = 0; i < 4; ++i) { const int k2 = 16 * (2 * kh + m) + 4 * g + i;
                Y[(size_t)(b * SEQ + k1 + 128 * k2) * D + 512 + 64 * g4 + 16 * kt + r] = (bf16)f2bf(y[i] * scale); } }
    }
}

__device__ __forceinline__ void mix_a_phase(const float* const* in, unsigned char* ws, int L, bool do_ctx, LAS unsigned char* lds, int wg, int G, int tid) {
    const bf16* P = (const bf16*)(ws + WS_P); bf16* Y = (bf16*)(ws + WS_Y);
    for (int t = wg; t < 16 * NCHK; t += G) mlstm_m1_task(P, (const float*)(ws + WS_G), in[9] + L * 16, ws, lds, t, tid);
    fourier_a_phase(P, (bf16*)(ws + WS_FA), lds, wg, G, tid);
    if (do_ctx) {
        __syncthreads();
        { LAS f32x2* tab = (LAS f32x2*)lds; for (int i = tid; i < 8192; i += NTHR) { float s, c; sincospif((float)i * (1.0f / 4096.0f), &s, &c); tab[i] = (f32x2){c, s}; } }
        __syncthreads();
        for (int t = wg; t < 16 * 4; t += G) fourier_naive_task(P, Y, lds, t, true, tid);
    }
    for (int t = wg; t < 4 * 128; t += G) conv_fast_task(P, Y, in[11] + L * 31 * 256, in[12] + L * 256, in[13] + L * 256, in[14] + L * 256, lds, t, false, tid);
    if (do_ctx) for (int t = wg; t < 4 * 4; t += G) conv_fast_task(P, Y, in[11] + L * 31 * 256, in[12] + L * 256, in[13] + L * 256, in[14] + L * 256, lds, t, true, tid);
}

constexpr int NPH = 21;
#ifndef MK_SINGLE
#define MK_SINGLE 1
#endif
struct Params { const float* in[23]; float* out; unsigned char* ws; int ph_lo, ph_hi; };
static_assert(sizeof(Params) == 23 * 8 + 8 + 8 + 8, "Params has no padding");

__global__ void __launch_bounds__(NTHR, 2) fwd_kernel(Params p) {
    extern __shared__ __attribute__((aligned(16))) unsigned char lds_raw[];
    LAS unsigned char* lds = (LAS unsigned char*)lds_raw;
    const int tid = threadIdx.x, wg = blockIdx.x, G = gridDim.x;
    unsigned char* ws = p.ws;
    const float* const* in = p.in;
    for (int u = tid; u < (LDS_BYTES - LDSCTL_OFF) / 4; u += NTHR) ((LAS unsigned*)(lds + LDSCTL_OFF))[u] = 0u;
    __syncthreads();
    XcdBarrier bar; bar.bar = (unsigned*)(ws + WS_CTL) + CW_BAR; bar.x = 0; bar.st = (volatile LAS unsigned*)(lds + LDSCTL_OFF + 64);
    if (MK_SINGLE) bar = xcd_barrier_post((unsigned*)(ws + WS_CTL) + CW_BAR, (volatile LAS unsigned*)(lds + LDSCTL_OFF + 64));
    const int lo = p.ph_lo, hi = p.ph_hi;
#ifndef PH_MASK
#define PH_MASK 0xFFFFFFFFu
#endif
#define IN(k) (((PH_MASK >> (k)) & 1u) && lo <= (k) && (k) < hi)
#ifndef DUP_MASK
#define DUP_MASK 0u
#endif
#define REP(k) _Pragma("unroll") for (int rep_ = 0; rep_ < ((((DUP_MASK) >> (k)) & 1u) ? 2 : 1); ++rep_)
#define SEAM(k) do { if (MK_SINGLE && IN((k) + 1)) xcd_barrier(bar); } while (0)
    const float* MOD = (const float*)(ws + WS_MOD);
    bf16* A = (bf16*)(ws + WS_A); bf16* Pb = (bf16*)(ws + WS_P); bf16* Yb = (bf16*)(ws + WS_Y); bf16* Hb = (bf16*)(ws + WS_H);
    float* Gt = (float*)(ws + WS_G); float* XC = (float*)(ws + WS_XC); float* HF = (float*)(ws + WS_HF); float* HB = (float*)(ws + WS_HB);
    int* rw = (int*)(ws + WS_ROUTE);
    int* tok_e = (int*)(ws + WS_TOK); float* tok_w = (float*)(ws + WS_TOK + 256 * 1024); int* pair_pos = (int*)(ws + WS_TOK + 512 * 1024); float* row_w = (float*)(ws + WS_TOK + 768 * 1024);

    if (IN(0)) { REP(0) { if (rep_) __syncthreads(); prologue_phase(in, ws, lds, wg, G, tid); } SEAM(0); }
    if (IN(1)) { REP(1) { if (rep_) __syncthreads(); norm_phase<false>(in[0], in[2], true, in[4], MOD, 0, A, nullptr, nullptr, nullptr, nullptr, nullptr, lds, wg, G, tid); } SEAM(1); }
    if (IN(2)) { REP(2) { if (rep_) __syncthreads(); pg8::Gemm g{A, (const bf16*)(ws + WS_WIN), MROWS, PLD, D}; pg8::StaticOrder S; S.init(MROWS, PLD, G, wg); pg8::EpiP E{Pb, Gt};
        pg8::gemm_phase<pg8::EpiP, pg8::StaticOrder, true, true>(lds, g, S, E); } SEAM(2); }
    if (IN(3)) { REP(3) { if (rep_) __syncthreads(); mix_a_phase(in, ws, 0, true, lds, wg, G, tid); } SEAM(3); }
    if (IN(4)) { REP(4) { if (rep_) __syncthreads(); mlstm_m2_phase(ws, wg, G, tid); REP(21) { if (rep_) __syncthreads(); fourier_b_phase((const bf16*)(ws + WS_FA), Yb, lds, wg, G, tid); } } SEAM(4); }
    if (IN(5)) { REP(5) { if (rep_) __syncthreads(); for (int t = wg; t < 16 * NCHK; t += G) mlstm_m3_task(Pb, Gt, in[9], in[10], ws, Yb, lds, t, tid); } SEAM(5); }
    if (IN(6)) { REP(6) { if (rep_) __syncthreads(); pg8::Gemm g{Yb, (const bf16*)(ws + WS_WOUT), MROWS, D, D}; pg8::StaticOrder S; S.init(MROWS, D, G, wg); pg8::EpiRes E{in[0], p.out, in[2], XC, MOD + 2 * D};
        pg8::gemm_phase<pg8::EpiRes, pg8::StaticOrder, true, true>(lds, g, S, E); } SEAM(6); }
    if (IN(7)) { REP(7) { if (rep_) __syncthreads(); norm_phase<false>(p.out, XC, true, in[5], MOD, 3, A, nullptr, nullptr, nullptr, nullptr, nullptr, lds, wg, G, tid); } SEAM(7); }
    if (IN(8)) { REP(8) { if (rep_) __syncthreads(); pg8::Gemm g{A, (const bf16*)(ws + WS_WGU), MROWS, 2 * FFH, D}; pg8::StaticOrder S; S.init(MROWS, 2 * FFH, G, wg); pg8::EpiSwiglu E{Hb};
        pg8::gemm_phase<pg8::EpiSwiglu, pg8::StaticOrder, true, true>(lds, g, S, E); } SEAM(8); }
    if (IN(9)) { REP(9) { if (rep_) __syncthreads(); pg8::Gemm g{Hb, (const bf16*)(ws + WS_WD), MROWS, D, FFH}; pg8::StaticOrder S; S.init(MROWS, D, G, wg); pg8::EpiRes E{p.out, p.out, XC, XC, MOD + 5 * D};
        pg8::gemm_phase<pg8::EpiRes, pg8::StaticOrder, true, true>(lds, g, S, E); } SEAM(9); }
    const float* MOD1 = MOD + 5 * 6144;
    if (IN(10)) { REP(10) { if (rep_) __syncthreads(); norm_phase<false>(p.out, XC, true, in[4] + D, MOD1, 0, A, nullptr, nullptr, nullptr, nullptr, nullptr, lds, wg, G, tid); } SEAM(10); }
    if (IN(11)) { REP(11) { if (rep_) __syncthreads(); pg8::Gemm g{A, (const bf16*)(ws + WS_WIN) + (size_t)PLD * D, MROWS, PLD, D}; pg8::StaticOrder S; S.init(MROWS, PLD, G, wg); pg8::EpiP E{Pb, Gt};
        pg8::gemm_phase<pg8::EpiP, pg8::StaticOrder, true, true>(lds, g, S, E); } SEAM(11); }
    if (IN(12)) { REP(12) { if (rep_) __syncthreads(); mix_a_phase(in, ws, 1, false, lds, wg, G, tid); } SEAM(12); }
    if (IN(13)) { REP(13) { if (rep_) __syncthreads(); mlstm_m2_phase(ws, wg, G, tid); REP(21) { if (rep_) __syncthreads(); fourier_b_phase((const bf16*)(ws + WS_FA), Yb, lds, wg, G, tid); } } SEAM(13); }
    if (IN(14)) { REP(14) { if (rep_) __syncthreads(); for (int t = wg; t < 16 * 128; t += G) mlstm_m3_task(Pb, Gt, in[9] + 16, in[10] + 512, ws, Yb, lds, (t >> 7) * NCHK + (t & 127), tid); } SEAM(14); }
    if (IN(15)) { REP(15) { if (rep_) __syncthreads(); pg8::Gemm g{Yb, (const bf16*)(ws + WS_WOUT) + (size_t)D * D, NLAT, D, D}; pg8::StaticOrder S; S.init(NLAT, D, G, wg); pg8::EpiRes E{p.out, p.out, XC, XC, MOD1 + 2 * D};
        pg8::gemm_phase<pg8::EpiRes, pg8::StaticOrder, true, true>(lds, g, S, E); } SEAM(15); }
    if (IN(16)) { REP(16) { if (rep_) __syncthreads(); norm_phase<true>(p.out, XC, false, in[5] + D, MOD1, 3, A, in[18], in[19], tok_e, tok_w, rw + RW_HIST, lds, wg, G, tid); } SEAM(16); }
    if (IN(17)) { REP(17) { if (rep_) __syncthreads(); route_phase(ws, lds, wg, G, tid); } SEAM(17); }
    if (IN(18)) { REP(18) { if (rep_) __syncthreads(); const int nT = rw[RW_NTILES]; pg8::Gemm g{(const bf16*)(ws + WS_ASORT), (const bf16*)(ws + WS_MWGU), nT * 256, NEXP * 2 * FFH, D};
        pg8::MoeOrder S; S.init_moe(nT, 22, rw + RW_TILE_E, G, wg); pg8::EpiSwiglu E{(bf16*)(ws + WS_HSORT)};
        pg8::gemm_phase<pg8::EpiSwiglu, pg8::MoeOrder, true, true>(lds, g, S, E); } SEAM(18); }
    if (IN(19)) { REP(19) { if (rep_) __syncthreads(); const int nT = rw[RW_NTILES]; pg8::Gemm g{(const bf16*)(ws + WS_HSORT), (const bf16*)(ws + WS_MWD), nT * 256, NEXP * D, FFH};
        pg8::MoeOrder S; S.init_moe(nT, 4, rw + RW_TILE_E, G, wg); pg8::EpiMoeDown E{(bf16*)(ws + WS_OPAIR), row_w};
        pg8::gemm_phase<pg8::EpiMoeDown, pg8::MoeOrder, true, true>(lds, g, S, E); } SEAM(19); }
    if (IN(20)) { final_phase(p.out, (const bf16*)(ws + WS_OPAIR), pair_pos, MOD1, in[22], wg, G, tid); }
#undef IN
#undef SEAM
}

extern "C" void kernel_launch(void* const* d_in, const int* in_sizes, int n_in, void* d_out, int out_size, void* d_ws, size_t ws_size, hipStream_t stream) {
    static int grid = 0;
    if (grid == 0) {
        if (n_in != 23 || in_sizes[0] != NLAT * D || out_size != NLAT * D || ws_size < WS_END) { fprintf(stderr, "kernel_launch: unexpected problem shape (n_in %d, out %d, ws %zu); nothing launched\n", n_in, out_size, ws_size); grid = -1; return; }
        int dev = 0, cus = 0;
        if (hipGetDevice(&dev) != hipSuccess || hipDeviceGetAttribute(&cus, hipDeviceAttributeMultiprocessorCount, dev) != hipSuccess) { grid = -1; return; }
        if (hipFuncSetAttribute((const void*)fwd_kernel, hipFuncAttributeMaxDynamicSharedMemorySize, LDS_BYTES) != hipSuccess) { fprintf(stderr, "kernel_launch: hipFuncSetAttribute failed\n"); grid = -1; return; }
        int per_cu = 0;
        if (hipOccupancyMaxActiveBlocksPerMultiprocessor(&per_cu, (const void*)fwd_kernel, NTHR, LDS_BYTES) != hipSuccess || per_cu < 1) { fprintf(stderr, "kernel_launch: occupancy query says %d blocks per CU\n", per_cu); }
        (void)hipGetLastError();
        grid = cus;
    }
    if (grid < 0) return;
    if (hipMemsetAsync((char*)d_ws + WS_CTL, 0, CTL_ZERO_BYTES, stream) != hipSuccess) return;
    Params p{};
    for (int i = 0; i < 23; ++i) p.in[i] = (const float*)d_in[i];
    p.out = (float*)d_out; p.ws = (unsigned char*)d_ws;
#if MK_SINGLE
    p.ph_lo = 0; p.ph_hi = NPH;
    hipLaunchKernelGGL(fwd_kernel, dim3(grid), dim3(NTHR), LDS_BYTES, stream, p);
#else
    for (int k = 0; k < NPH; ++k) { p.ph_lo = k; p.ph_hi = k + 1; hipLaunchKernelGGL(fwd_kernel, dim3(grid), dim3(NTHR), LDS_BYTES, stream, p); }
#endif
}
```

```cpp
#include <hip/hip_runtime.h>
#include <cstdio>
#include <cstdint>
namespace pg8 {
#define PG8_LAS __attribute__((address_space(3)))
typedef unsigned short bf16_t;
typedef short bf16x8 __attribute__((ext_vector_type(8)));
typedef float f32x4 __attribute__((ext_vector_type(4)));
typedef unsigned u32x4 __attribute__((ext_vector_type(4)));
constexpr int BM = 256, BK = 64, HALF = 128, HTB = HALF * BK * 2  , STAGE_BYTES = 8 * HTB, NXCD = 8, WGM = 8;

__host__ __device__ __forceinline__ int lds_byte(int r, int c) { const int st = (r >> 4) * 2 + (c >> 5), rr = r & 15, cc = c & 31, ob = rr * 64 + cc * 2; return st * 1024 + (ob ^ (((ob >> 9) & 1) << 5)); }
__host__ __device__ __forceinline__ void stage_rc(int b, int& R, int& C) { const int st = b / 1024, sb = b % 1024, swz = sb ^ (((sb >> 9) & 1) << 5); R = (st >> 1) * 16 + swz / 64; C = (st & 1) * 32 + (swz % 64) / 2; }
__host__ __device__ __forceinline__ int perm32(int rho) { const int n = rho >> 4, i = rho & 15; return 8 * (i >> 2) + 4 * n + (i & 3); }

struct Unit { int pm, pn; };
struct Gemm { const bf16_t* A; const bf16_t* Bt; int M, N, K; };

struct StaticOrder {
    int nM, nN, nwg, G, c;
    __host__ __device__ void init(int M, int N, int G_, int c_) { nM = M / BM; nN = N / BM; nwg = nM * nN; G = G_; c = c_; }
    __host__ __device__ bool next(int i, Unit& u) const {
        const long L = (long)i * G + c; if (L >= nwg) return false;
        int wgid = (int)L; { const int q = nwg / NXCD, r = nwg % NXCD, xcd = wgid % NXCD, off = wgid / NXCD; wgid = (xcd < r ? xcd * (q + 1) : r * (q + 1) + (xcd - r) * q) + off; }
        const int nig = WGM * nN, gid = wgid / nig, fm = gid * WGM, gsz = (nM - fm) < WGM ? (nM - fm) : WGM;
        u.pm = fm + ((wgid % nig) % gsz); u.pn = (wgid % nig) / gsz; return true;
    }
    __device__ __forceinline__ void a_ready(const Unit&) const {}
    __device__ __forceinline__ void done(const Unit&) const {}
};

__device__ __forceinline__ unsigned cvt_pk_bf16(float lo, float hi) { unsigned r; asm volatile("v_cvt_pk_bf16_f32 %0, %1, %2" : "=v"(r) : "v"(lo), "v"(hi)); return r; }
__device__ __forceinline__ float silu_f(float x) { return x / (1.0f + __expf(-x)); }
struct EpiP {
    static constexpr bool PERM = true, AFTER_DRAIN = false;
    bf16_t* P; float* G;
    __device__ __forceinline__ void operator()(const f32x4 (&acc)[2][2][4][2], const Unit& u, int wr, int wc, int fr, int fq) const {
        const int row0 = u.pm * BM + wr * 64 + fr, col0 = u.pn * BM + wc * 32 + 8 * fq;
#pragma unroll
        for (int ai = 0; ai < 2; ++ai)
#pragma unroll
            for (int m = 0; m < 4; ++m) { bf16_t* rowp = P + (size_t)(row0 + ai * HALF + m * 16) * 3072 + col0;
#pragma unroll
                for (int bj = 0; bj < 2; ++bj) { const f32x4 v0 = acc[ai][bj][m][0], v1 = acc[ai][bj][m][1];
                    u32x4 w; w.x = cvt_pk_bf16(v0[0], v0[1]); w.y = cvt_pk_bf16(v0[2], v0[3]); w.z = cvt_pk_bf16(v1[0], v1[1]); w.w = cvt_pk_bf16(v1[2], v1[3]);
                    *(u32x4*)(rowp + bj * HALF) = w; } }
        if (u.pn == 11 && wc == 0 && fq < 2) {
#pragma unroll
            for (int ai = 0; ai < 2; ++ai)
#pragma unroll
                for (int m = 0; m < 4; ++m) { float* gp = G + (size_t)(row0 + ai * HALF + m * 16) * 16 + 8 * fq;
                    *(f32x4*)gp = acc[ai][0][m][0]; *(f32x4*)(gp + 4) = acc[ai][0][m][1]; }
        }
    }
};
struct EpiRes {
    static constexpr bool PERM = false, AFTER_DRAIN = false;
    const float* base_lat; float* out_lat; const float* base_ctx; float* out_ctx; const float* gate;
    __device__ __forceinline__ void operator()(const f32x4 (&acc)[2][2][4][2], const Unit& u, int wr, int wc, int fr, int fq) const {
        const bool lat = u.pm < 128;
        const float* base = lat ? base_lat + (size_t)u.pm * BM * 1024 : base_ctx + (size_t)(u.pm - 128) * BM * 1024;
        float* out = lat ? out_lat + (size_t)u.pm * BM * 1024 : out_ctx + (size_t)(u.pm - 128) * BM * 1024;
        const float* gv = gate + (size_t)(lat ? (u.pm >> 5) : 4) * 6144;
        const int row0 = wr * 64 + fr, col0 = u.pn * BM + wc * 32 + 4 * fq;
        f32x4 g4[2][2];
#pragma unroll
        for (int bj = 0; bj < 2; ++bj)
#pragma unroll
            for (int n = 0; n < 2; ++n) g4[bj][n] = *(const f32x4*)(gv + col0 + bj * HALF + n * 16);
#pragma unroll
        for (int ai = 0; ai < 2; ++ai)
#pragma unroll
            for (int m = 0; m < 4; ++m) { const size_t off = (size_t)(row0 + ai * HALF + m * 16) * 1024 + col0;
#pragma unroll
                for (int bj = 0; bj < 2; ++bj)
#pragma unroll
                    for (int n = 0; n < 2; ++n) { const f32x4 b = *(const f32x4*)(base + off + bj * HALF + n * 16);
                        *(f32x4*)(out + off + bj * HALF + n * 16) = b + g4[bj][n] * acc[ai][bj][m][n]; }
                asm volatile("" ::: "memory"); }
    }
};
struct EpiSwiglu {
    static constexpr bool PERM = true, AFTER_DRAIN = false;
    bf16_t* H;
    __device__ __forceinline__ void operator()(const f32x4 (&acc)[2][2][4][2], const Unit& u, int wr, int wc, int fr, int fq) const {
        const int row0 = u.pm * BM + wr * 64 + fr, col0 = (u.pn % 22) * HALF + wc * 32 + 8 * fq;
#pragma unroll
        for (int ai = 0; ai < 2; ++ai)
#pragma unroll
            for (int m = 0; m < 4; ++m) { bf16_t* rowp = H + (size_t)(row0 + ai * HALF + m * 16) * 2816 + col0;
                float h[8];
#pragma unroll
                for (int n = 0; n < 2; ++n)
#pragma unroll
                    for (int j = 0; j < 4; ++j) h[4 * n + j] = silu_f(acc[ai][0][m][n][j]) * acc[ai][1][m][n][j];
                u32x4 w; w.x = cvt_pk_bf16(h[0], h[1]); w.y = cvt_pk_bf16(h[2], h[3]); w.z = cvt_pk_bf16(h[4], h[5]); w.w = cvt_pk_bf16(h[6], h[7]);
                *(u32x4*)rowp = w; }
    }
};
struct EpiMoeDown {
    static constexpr bool PERM = true, AFTER_DRAIN = false;
    bf16_t* O; const float* roww;
    __device__ __forceinline__ void operator()(const f32x4 (&acc)[2][2][4][2], const Unit& u, int wr, int wc, int fr, int fq) const {
        const int row0 = u.pm * BM + wr * 64 + fr, col0 = (u.pn & 3) * BM + wc * 32 + 8 * fq;
#pragma unroll
        for (int ai = 0; ai < 2; ++ai)
#pragma unroll
            for (int m = 0; m < 4; ++m) { const int r = row0 + ai * HALF + m * 16; const float s = roww[r]; bf16_t* rowp = O + (size_t)r * 1024 + col0;
#pragma unroll
                for (int bj = 0; bj < 2; ++bj) { const f32x4 v0 = acc[ai][bj][m][0] * s, v1 = acc[ai][bj][m][1] * s;
                    u32x4 w; w.x = cvt_pk_bf16(v0[0], v0[1]); w.y = cvt_pk_bf16(v0[2], v0[3]); w.z = cvt_pk_bf16(v1[0], v1[1]); w.w = cvt_pk_bf16(v1[2], v1[3]);
                    *(u32x4*)(rowp + bj * HALF) = w; } }
    }
};
struct MoeOrder : StaticOrder {
    const int* tile_e; int nNe;
    __device__ void init_moe(int nTiles, int nNe_, const int* te, int G_, int c_) { nM = nTiles; nN = nNe_; nwg = nM * nN; G = G_; c = c_; tile_e = te; nNe = nNe_; }
    __device__ bool next(int i, Unit& u) const { if (!StaticOrder::next(i, u)) return false; u.pn += tile_e[u.pm] * nNe; return true; }
};
template <class Epi, class Sched, bool ALIGN_EPI = false, bool SP2 = false>
__device__ __forceinline__ void gemm_phase(PG8_LAS unsigned char* lds, const Gemm g, const Sched& S, const Epi& E) {
    const int tid = threadIdx.x, wid = __builtin_amdgcn_readfirstlane(tid >> 6), lane = tid & 63, wr = wid >> 2, wc = wid & 3, fr = lane & 15, fq = lane >> 4;
    const int K = g.K, nt = K / BK;
    unsigned voffA[2], voffB[2];
#pragma unroll
    for (int i = 0; i < 2; ++i) { int R, C; stage_rc(tid * 16 + i * 8192, R, C); const int Rb = Epi::PERM ? ((R & ~31) + perm32(R & 31)) : R;
        voffA[i] = (unsigned)(R * K + C) * 2u; voffB[i] = (unsigned)(Rb * K + C) * 2u; }
    const size_t kstep = (size_t)(BK * 2);
    const size_t hstep = (size_t)HALF * K * 2;
    const size_t tstep = 2 * hstep;
    const unsigned ldsw = (unsigned)wid * 1024u;
    const int aoff = lds_byte(wr * 64 + fr, fq * 8), boff = lds_byte(wc * 32 + fr, fq * 8);
#define PG8_SA(b, h) (((b) * 2 + (h)) * HTB)
#define PG8_SB(b, h) ((4 + (b) * 2 + (h)) * HTB)
#define PG8_STAGE(bufoff, gbase, voff) do { _Pragma("unroll") for (int _i = 0; _i < 2; ++_i) \
        __builtin_amdgcn_global_load_lds((const unsigned*)((const char*)(gbase) + (voff)[_i]), (PG8_LAS unsigned*)(lds + (bufoff) + ldsw + _i * 8192), 16, 0, 0); } while (0)
#define PG8_LDA(dst, b, h) do { _Pragma("unroll") for (int m = 0; m < 4; ++m) _Pragma("unroll") for (int k = 0; k < 2; ++k) dst[m][k] = *(const PG8_LAS bf16x8*)(lds + PG8_SA(b, h) + aoff + m * 2048 + k * 1024); } while (0)
#define PG8_LDB(dst, b, h) do { _Pragma("unroll") for (int n = 0; n < 2; ++n) _Pragma("unroll") for (int k = 0; k < 2; ++k) dst[n][k] = *(const PG8_LAS bf16x8*)(lds + PG8_SB(b, h) + boff + n * 2048 + k * 1024); } while (0)
#define PG8_MMA(ai, bj, At, Bt) do { __builtin_amdgcn_s_setprio(1); _Pragma("unroll") for (int m = 0; m < 4; ++m) _Pragma("unroll") for (int n = 0; n < 2; ++n) _Pragma("unroll") for (int k = 0; k < 2; ++k) \
        acc[ai][bj][m][n] = __builtin_amdgcn_mfma_f32_16x16x32_bf16(Bt[n][k], At[m][k], acc[ai][bj][m][n], 0, 0, 0); __builtin_amdgcn_s_setprio(0); } while (0)
#define PG8_WAIT_V(n) asm volatile("s_waitcnt vmcnt(" #n ")" ::: "memory")
#define PG8_WAIT_L(n) asm volatile("s_waitcnt lgkmcnt(" #n ")" ::: "memory")
#define PG8_BAR __builtin_amdgcn_s_barrier()
#define PG8_SCHED __builtin_amdgcn_sched_barrier(0)
    Unit cur, nxt; int ui = 0;
    if (!S.next(0, cur)) return;
    f32x4 acc[2][2][4][2];
#pragma unroll
    for (int a = 0; a < 2; ++a)
#pragma unroll
        for (int b = 0; b < 2; ++b)
#pragma unroll
            for (int m = 0; m < 4; ++m)
#pragma unroll
                for (int n = 0; n < 2; ++n) acc[a][b][m][n] = (f32x4){0.f, 0.f, 0.f, 0.f};
    bf16x8 At[4][2], B0[2][2], B1[2][2];
    const char* cA = (const char*)g.A + (size_t)cur.pm * tstep; const char* cB = (const char*)g.Bt + (size_t)cur.pn * tstep;
    S.a_ready(cur);
    if constexpr (SP2) {
        PG8_STAGE(PG8_SB(0, 0), cB, voffB); PG8_STAGE(PG8_SB(0, 1), cB + hstep, voffB); PG8_STAGE(PG8_SA(0, 0), cA, voffA); PG8_STAGE(PG8_SA(0, 1), cA + hstep, voffA);
        if (wr == 1) PG8_BAR;
        PG8_WAIT_V(2); PG8_BAR;
        PG8_STAGE(PG8_SB(1, 0), cB + kstep, voffB); PG8_STAGE(PG8_SA(1, 0), cA + kstep, voffA); PG8_STAGE(PG8_SB(1, 1), cB + hstep + kstep, voffB);
        PG8_WAIT_V(6); PG8_BAR;
    } else {
        PG8_STAGE(PG8_SB(0, 0), cB, voffB); PG8_STAGE(PG8_SA(0, 0), cA, voffA); PG8_STAGE(PG8_SB(0, 1), cB + hstep, voffB); PG8_STAGE(PG8_SA(0, 1), cA + hstep, voffA);
        if (wr == 1) PG8_BAR;
        PG8_WAIT_V(4); PG8_BAR;
        PG8_STAGE(PG8_SB(1, 0), cB + kstep, voffB); PG8_STAGE(PG8_SA(1, 0), cA + kstep, voffA); PG8_STAGE(PG8_SB(1, 1), cB + hstep + kstep, voffB);
        PG8_WAIT_V(6); PG8_BAR;
    }
    for (;;) {
        const bool has_next = S.next(ui + 1, nxt);
        const char* nA = has_next ? (const char*)g.A + (size_t)nxt.pm * tstep : cA; const char* nB = has_next ? (const char*)g.Bt + (size_t)nxt.pn * tstep : cB;
        for (int t = 0; t < nt; t += 2) {
            const bool last = (t == nt - 2);
            const char* a1 = cA + (size_t)(t + 1) * kstep;
            const char* a2 = last ? nA : cA + (size_t)(t + 2) * kstep; const char* b2 = last ? nB : cB + (size_t)(t + 2) * kstep;
            const char* a3 = a2 + kstep; const char* b3 = b2 + kstep;
            if (last && has_next) S.a_ready(nxt);
            if constexpr (SP2) {
            PG8_LDB(B0, 0, 0); PG8_LDB(B1, 0, 1); PG8_SCHED; PG8_LDA(At, 0, 0); PG8_STAGE(PG8_SA(1, 1), a1 + hstep, voffA);
            PG8_WAIT_V(8); PG8_WAIT_L(0); PG8_BAR; PG8_MMA(0, 0, At, B0); PG8_MMA(0, 1, At, B1); PG8_BAR; PG8_SCHED;
            PG8_LDA(At, 0, 1); PG8_STAGE(PG8_SB(0, 0), b2, voffB); PG8_STAGE(PG8_SB(0, 1), b2 + hstep, voffB); PG8_STAGE(PG8_SA(0, 0), a2, voffA);
            PG8_WAIT_V(8); PG8_WAIT_L(0); PG8_BAR; PG8_MMA(1, 0, At, B0); PG8_MMA(1, 1, At, B1); PG8_BAR; PG8_SCHED;
            PG8_LDB(B0, 1, 0); PG8_LDB(B1, 1, 1); PG8_SCHED; PG8_LDA(At, 1, 0); PG8_STAGE(PG8_SA(0, 1), a2 + hstep, voffA);
            PG8_WAIT_V(8); PG8_WAIT_L(0); PG8_BAR; PG8_MMA(0, 0, At, B0); PG8_MMA(0, 1, At, B1); PG8_BAR; PG8_SCHED;
            PG8_LDA(At, 1, 1); PG8_STAGE(PG8_SB(1, 0), b3, voffB); PG8_STAGE(PG8_SB(1, 1), b3 + hstep, voffB); PG8_STAGE(PG8_SA(1, 0), a3, voffA);
            PG8_WAIT_V(8); PG8_WAIT_L(0); PG8_BAR; PG8_MMA(1, 0, At, B0); PG8_MMA(1, 1, At, B1); PG8_BAR; PG8_SCHED;
            } else {
            PG8_LDB(B0, 0, 0); PG8_SCHED; PG8_LDA(At, 0, 0); PG8_STAGE(PG8_SA(1, 1), a1 + hstep, voffA);
            PG8_WAIT_L(8); PG8_BAR; PG8_WAIT_L(0); PG8_MMA(0, 0, At, B0); PG8_BAR; PG8_SCHED;
            PG8_LDB(B1, 0, 1); PG8_STAGE(PG8_SB(0, 0), b2, voffB);
            PG8_BAR; PG8_WAIT_L(0); PG8_MMA(0, 1, At, B1); PG8_BAR;
            PG8_LDA(At, 0, 1); PG8_STAGE(PG8_SA(0, 0), a2, voffA);
            PG8_BAR; PG8_WAIT_L(0); PG8_MMA(1, 0, At, B0); PG8_BAR; PG8_SCHED;
            PG8_STAGE(PG8_SB(0, 1), b2 + hstep, voffB);
            PG8_WAIT_V(6); PG8_BAR; PG8_MMA(1, 1, At, B1); PG8_BAR;
            PG8_LDB(B0, 1, 0); PG8_SCHED; PG8_LDA(At, 1, 0); PG8_STAGE(PG8_SA(0, 1), a2 + hstep, voffA);
            PG8_WAIT_L(8); PG8_BAR; PG8_WAIT_L(0); PG8_MMA(0, 0, At, B0); PG8_BAR; PG8_SCHED;
            PG8_LDB(B1, 1, 1); PG8_STAGE(PG8_SB(1, 0), b3, voffB);
            PG8_BAR; PG8_WAIT_L(0); PG8_MMA(0, 1, At, B1); PG8_BAR;
            PG8_LDA(At, 1, 1); PG8_STAGE(PG8_SA(1, 0), a3, voffA);
            PG8_BAR; PG8_WAIT_L(0); PG8_MMA(1, 0, At, B0); PG8_BAR; PG8_SCHED;
            PG8_STAGE(PG8_SB(1, 1), b3 + hstep, voffB);
            PG8_WAIT_V(6); PG8_BAR; PG8_MMA(1, 1, At, B1); PG8_BAR;
            }
        }
        if constexpr (ALIGN_EPI) { if (wr == 0) PG8_BAR; }
        if constexpr (!Epi::AFTER_DRAIN) { E(acc, cur, wr, wc, fr, fq); S.done(cur); }
        if (!has_next) break;
#pragma unroll
        for (int a = 0; a < 2; ++a)
#pragma unroll
            for (int b = 0; b < 2; ++b)
#pragma unroll
                for (int m = 0; m < 4; ++m)
#pragma unroll
                    for (int n = 0; n < 2; ++n) acc[a][b][m][n] = (f32x4){0.f, 0.f, 0.f, 0.f};
        cur = nxt; cA = nA; cB = nB; ++ui;
        if constexpr (ALIGN_EPI) { if (wr == 1) PG8_BAR; }
    }
    PG8_WAIT_V(0);
    if constexpr (!ALIGN_EPI) { if (wr == 0) PG8_BAR; }
    PG8_BAR;
    if constexpr (Epi::AFTER_DRAIN) { E.fused(acc, cur, wr, wc, fr, fq, lds, wid, lane); S.done(cur); }
#undef PG8_SA
#undef PG8_SB
#undef PG8_STAGE
#undef PG8_LDA
#undef PG8_LDB
#undef PG8_MMA
#undef PG8_WAIT_V
#undef PG8_WAIT_L
#undef PG8_BAR
#undef PG8_SCHED
}
}
using pg8::silu_f;

constexpr int D = 1024, BATCH = 4, SEQ = 8192, CTXL = 256, NLAT = BATCH * SEQ, NCTX = BATCH * CTXL, MROWS = NLAT + NCTX;
constexpr int PIN_SRC = 2832, PLD = 3072, FFH = 2816, NEXP = 8;
constexpr int PO_Q = 0, PO_K = 512, PO_V = 1024, PO_O = 1536, PO_F = 2048, PO_CU = 2304, PO_CG = 2560;
constexpr float EPS = 1e-6f;
constexpr int NWAVES = 8, NTHR = 512;
constexpr size_t MiB = 1u << 20;
constexpr size_t WS_CTL = 0, CTL_ZERO_BYTES = 1 * MiB;
constexpr size_t WS_MOD = 1 * MiB;
constexpr size_t WS_ROUTE = 1 * MiB + 512 * 1024;
constexpr size_t WS_WIN = 2 * MiB;
constexpr size_t WS_WOUT = 14 * MiB;
constexpr size_t WS_WGU = 18 * MiB;
constexpr size_t WS_WD = 29 * MiB;
constexpr size_t WS_MWGU = 35 * MiB;
constexpr size_t WS_MWD = 123 * MiB;
constexpr size_t WS_G = 167 * MiB;
constexpr size_t WS_XC = 170 * MiB;
constexpr size_t WS_TOK = 174 * MiB;
constexpr size_t WS_R1 = 176 * MiB;
constexpr size_t WS_Y = WS_R1, WS_HF = WS_R1 + 66 * MiB, WS_ASORT = WS_R1, WS_OPAIR = WS_R1;
constexpr size_t WS_R2 = 308 * MiB;
constexpr size_t WS_P = WS_R2, WS_H = WS_R2, WS_A = WS_R2 + 198 * MiB, WS_HB = WS_R2 + 264 * MiB, WS_HSORT = WS_R2;
constexpr size_t WS_END = 671 * MiB;
constexpr int MAXPAIR = 2 * NLAT + NEXP * 256;
static_assert(WS_WIN + (size_t)2 * PLD * D * 2 <= WS_WOUT && WS_WOUT + (size_t)2 * D * D * 2 <= WS_WGU && WS_WGU + (size_t)2 * FFH * D * 2 <= WS_WD && WS_WD + (size_t)D * FFH * 2 <= WS_MWGU, "ws map 1");
static_assert(WS_MWGU + (size_t)NEXP * 2 * FFH * D * 2 <= WS_MWD && WS_MWD + (size_t)NEXP * D * FFH * 2 <= WS_G && WS_G + (size_t)MROWS * 16 * 4 <= WS_XC && WS_XC + (size_t)NCTX * D * 4 <= WS_TOK, "ws map 2");
static_assert(WS_TOK + 3 * 256 * 1024 + (size_t)MAXPAIR * 4 * 2 <= WS_R1 && WS_Y + (size_t)MROWS * D * 2 <= WS_HF && WS_HF + (size_t)MROWS * 512 * 4 <= WS_R2 && WS_ASORT + (size_t)MAXPAIR * D * 2 <= WS_R2, "ws map 3");
static_assert(WS_P + (size_t)MROWS * PLD * 2 <= WS_A && WS_A + (size_t)MROWS * D * 2 <= WS_HB && WS_HB + (size_t)MROWS * 512 * 4 <= WS_END && WS_HSORT + (size_t)MAXPAIR * FFH * 2 <= WS_END && WS_H + (size_t)MROWS * FFH * 2 <= WS_A, "ws map 4");
constexpr int CW_BAR = 4096;
constexpr int RW_HIST = 0;
constexpr int RW_TILE_E = 4096;
constexpr int RW_NTILES = 4096 + 512;
constexpr int LDS_STAGE = 131072, LDSCTL_OFF = LDS_STAGE, LDS_BYTES = 147456;

#define GAS __attribute__((address_space(1)))
#define LAS __attribute__((address_space(3)))
typedef unsigned short bf16;
typedef unsigned v4u __attribute__((ext_vector_type(4)));
typedef unsigned v2u __attribute__((ext_vector_type(2)));
typedef float f32x4 __attribute__((ext_vector_type(4)));
__device__ __forceinline__ unsigned f2bf(float f) { unsigned u = __builtin_bit_cast(unsigned, f); return (u + 0x7fffu + ((u >> 16) & 1u)) >> 16; }
__device__ __forceinline__ unsigned pk2(float lo, float hi) { return f2bf(lo) | (f2bf(hi) << 16); }
__device__ __forceinline__ float bf2f(unsigned short b) { return __builtin_bit_cast(float, (unsigned)b << 16); }
__device__ __forceinline__ float bflo(unsigned w) { return __builtin_bit_cast(float, w << 16); }
__device__ __forceinline__ float bfhi(unsigned w) { return __builtin_bit_cast(float, w & 0xffff0000u); }
__device__ __forceinline__ float wave_sum(float v) {
#pragma unroll
    for (int o = 1; o < 64; o <<= 1) v += __shfl_xor(v, o);
    return v;
}
__device__ __forceinline__ float sigmoid_f(float x) { return 1.0f / (1.0f + __expf(-x)); }
__device__ __forceinline__ float log_sigmoid_f(float x) { return fminf(x, 0.0f) - log1pf(__expf(-fabsf(x))); }

#define XB_TMO      128
#define XB_XCNT(j)  (256  + 64 * (j))
#define XB_XSUB(j)  (1280 + 64 * (j))
#define XB_XGEN(j)  (2304 + 64 * (j))
#define XB_TOP      3328
#define XB_TOPGEN   3392
#define XCD_BAR_WORDS 3456
#define XB_SPIN_CAP (1u << 18)
#define LAS __attribute__((address_space(3)))

__device__ __forceinline__ unsigned xb_ld(unsigned* p)              { return __hip_atomic_load(p, __ATOMIC_RELAXED, __HIP_MEMORY_SCOPE_AGENT); }
__device__ __forceinline__ unsigned xb_add(unsigned* p, unsigned v) { return __hip_atomic_fetch_add(p, v, __ATOMIC_RELAXED, __HIP_MEMORY_SCOPE_AGENT); }
__device__ __forceinline__ unsigned xb_xcc_id() { return (unsigned)__builtin_amdgcn_s_getreg((3 << 11) | 20) & 0xFu; }
#define XB_SPIN(cond, bar) do { unsigned _sp = 0; while (cond) { __builtin_amdgcn_s_sleep(1); \
    if ((++_sp & 255u) == 0u) { if (xb_ld(&(bar)[XB_TMO])) break; if (_sp > XB_SPIN_CAP) { atomicAdd(&(bar)[XB_TMO], 1u); break; } } } } while (0)

struct XcdBarrier {
    unsigned* bar; unsigned x;
    volatile LAS unsigned* st;
};

__device__ __forceinline__ XcdBarrier xcd_barrier_post(unsigned* bar, volatile LAS unsigned* st) {
    XcdBarrier b; b.bar = bar; b.x = xb_xcc_id(); b.st = st;
    if (threadIdx.x == 0) (void)xb_add(&bar[XB_XCNT(b.x)], 1u);
    return b;
}
__device__ __forceinline__ void xcd_barrier_complete(unsigned* bar, unsigned x, unsigned& nloc, unsigned& nx) {
    const unsigned G = gridDim.x * gridDim.y * gridDim.z;
    unsigned sum, cnt, mine, sp = 0u;
    for (;;) {
        sum = 0u; cnt = 0u; mine = 0u;
#pragma unroll
        for (unsigned j = 0; j < 16; ++j) { const unsigned c = xb_ld(&bar[XB_XCNT(j)]); sum += c; cnt += (c > 0u) ? 1u : 0u; mine = (j == x) ? c : mine; }
        if (sum == G) break;
        __builtin_amdgcn_s_sleep(1);
        if ((++sp & 255u) == 0u) { if (xb_ld(&bar[XB_TMO])) break; if (sp > XB_SPIN_CAP) { atomicAdd(&bar[XB_TMO], 1u); break; } }
    }
    nloc = mine > 0u ? mine : 1u; nx = cnt > 0u ? cnt : 1u;
}

__device__ __forceinline__ void xcd_barrier(const XcdBarrier& b) {
    asm volatile("s_waitcnt vmcnt(0)" ::: "memory");
    __syncthreads();
    if (threadIdx.x == 0) {
        unsigned* bar = b.bar;
        __builtin_amdgcn_s_waitcnt(0);
        unsigned nloc = b.st[0], nx = b.st[1];
        if (nloc == 0u) { xcd_barrier_complete(bar, b.x, nloc, nx); b.st[0] = nloc; b.st[1] = nx; }
        const unsigned old = xb_add(&bar[XB_XSUB(b.x)], 1u);
        const unsigned gen = old / nloc;
        if (old + 1u == (gen + 1u) * nloc) {
            __builtin_amdgcn_fence(__ATOMIC_RELEASE, "agent");
            asm volatile("s_waitcnt vmcnt(0)" ::: "memory");
            const unsigned og = xb_add(&bar[XB_TOP], 1u);
            const unsigned tg = og / nx;
            if (og + 1u == (tg + 1u) * nx) xb_add(&bar[XB_TOPGEN], 1u);
            else XB_SPIN(xb_ld(&bar[XB_TOPGEN]) == tg, bar);
            __builtin_amdgcn_fence(__ATOMIC_ACQUIRE, "agent");
            xb_add(&bar[XB_XGEN(b.x)], 1u);
            asm volatile("s_waitcnt vmcnt(0)" ::: "memory");
        } else {
            XB_SPIN(xb_ld(&bar[XB_XGEN(b.x)]) == gen, bar);
            __builtin_amdgcn_fence(__ATOMIC_ACQUIRE, "agent");
            asm volatile("s_waitcnt vmcnt(0)" ::: "memory");
        }
    }
    __syncthreads();
}
#define LDS_WAIT() asm volatile("s_waitcnt lgkmcnt(0)" ::: "memory")

__device__ __forceinline__ void transpose_item(const float* W, int K, int N, bf16* WT, int dst_row0, int src_col0, int nvalid, int kb, LAS float* scr, int lane) {
    const int k0 = 64 * kb, nl = lane & 31;
#pragma unroll 8
    for (int i = 0; i < 32; ++i) { const int kk = 2 * i + (lane >> 5); scr[kk * 33 + nl] = nl < nvalid ? W[(size_t)(k0 + kk) * N + src_col0 + nl] : 0.f; }
    LDS_WAIT();
    const int c = lane & 7;
#pragma unroll
    for (int j = 0; j < 4; ++j) { const int n = (lane >> 3) + 8 * j; const LAS float* s = scr + (8 * c) * 33 + n;
        v4u o; o.x = pk2(s[0 * 33], s[1 * 33]); o.y = pk2(s[2 * 33], s[3 * 33]); o.z = pk2(s[4 * 33], s[5 * 33]); o.w = pk2(s[6 * 33], s[7 * 33]);
        *(v4u*)(WT + (size_t)(dst_row0 + n) * K + k0 + 8 * c) = o; }
    LDS_WAIT();
}
__device__ __forceinline__ void win_map(int nb, int& src, int& nvalid) { const int v0 = 32 * nb; if (v0 < 2048) { src = v0; nvalid = 32; } else if (v0 < 2816) { src = v0 + 16; nvalid = 32; } else if (v0 == 2816) { src = 2048; nvalid = 16; } else { src = 0; nvalid = 0; } }
__device__ __forceinline__ int gu_map(int nb) { const int v0 = 32 * nb; return ((v0 >> 7) & 1) * FFH + (v0 >> 8) * 128 + (v0 & 127); }

__device__ __forceinline__ void prologue_phase(const float* const* in, unsigned char* ws, LAS unsigned char* lds, int wg, int G, int tid) {
    const int lane = tid & 63, wave = tid >> 6, gw = wg * NWAVES + wave, NGW = G * NWAVES;
    LAS float* scr = (LAS float*)(lds + wave * 16384);
    constexpr int I_WIN = 16 * 96, I_WOUT = 16 * 32, I_GU = 16 * 176, I_DN = 44 * 32;
    constexpr int NITEMS = 2 * I_WIN + 2 * I_WOUT + 9 * I_GU + 9 * I_DN;
    for (int it = gw; it < NITEMS; it += NGW) {
        int r = it;
        if (r < 2 * I_WIN) { const int L = r / I_WIN; r -= L * I_WIN; const int kb = r / 96, nb = r % 96; int src, nv; win_map(nb, src, nv);
            transpose_item(in[8] + (size_t)L * D * PIN_SRC, D, PIN_SRC, (bf16*)(ws + WS_WIN) + (size_t)L * PLD * D, 32 * nb, src, nv, kb, scr, lane); continue; }
        r -= 2 * I_WIN;
        if (r < 2 * I_WOUT) { const int L = r / I_WOUT; r -= L * I_WOUT; const int kb = r / 32, nb = r % 32;
            transpose_item(in[15] + (size_t)L * D * D, D, D, (bf16*)(ws + WS_WOUT) + (size_t)L * D * D, 32 * nb, 32 * nb, 32, kb, scr, lane); continue; }
        r -= 2 * I_WOUT;
        if (r < 9 * I_GU) { const int e = r / I_GU; r -= e * I_GU; const int kb = r / 176, nb = r % 176;
            const float* W = e == 0 ? in[16] : in[20] + (size_t)(e - 1) * D * 2 * FFH; bf16* WT = e == 0 ? (bf16*)(ws + WS_WGU) : (bf16*)(ws + WS_MWGU) + (size_t)(e - 1) * 2 * FFH * D;
            transpose_item(W, D, 2 * FFH, WT, 32 * nb, gu_map(nb), 32, kb, scr, lane); continue; }
        r -= 9 * I_GU;
        { const int e = r / I_DN; r -= e * I_DN; const int kb = r / 32, nb = r % 32;
            const float* W = e == 0 ? in[17] : in[21] + (size_t)(e - 1) * FFH * D; bf16* WT = e == 0 ? (bf16*)(ws + WS_WD) : (bf16*)(ws + WS_MWD) + (size_t)(e - 1) * D * FFH;
            transpose_item(W, FFH, D, WT, 32 * nb, 32 * nb, 32, kb, scr, lane); }
    }
    __syncthreads();
    LAS float* cond_s = (LAS float*)lds;
    LAS float* part = (LAS float*)(lds + 32768);
    for (int i = tid; i < 5 * D; i += NTHR) { const int r = i >> 10, k = i & 1023; const float v = r < 4 ? in[1][r * D + k] : in[3][k]; cond_s[i] = silu_f(v); }
    __syncthreads();
    float* MOD = (float*)(ws + WS_MOD);
    for (int t = wg; t < 192; t += G) {
        const int L = t / 96, nb = t % 96; const float* W = in[6] + (size_t)L * D * 6144 + nb * 64 + lane;
        float a0 = 0.f, a1 = 0.f, a2 = 0.f, a3 = 0.f, a4 = 0.f;
#pragma unroll 8
        for (int kk = 0; kk < 128; ++kk) { const int k = wave * 128 + kk; const float w = W[(size_t)k * 6144];
            a0 += cond_s[k] * w; a1 += cond_s[D + k] * w; a2 += cond_s[2 * D + k] * w; a3 += cond_s[3 * D + k] * w; a4 += cond_s[4 * D + k] * w; }
        part[(wave * 5 + 0) * 64 + lane] = a0; part[(wave * 5 + 1) * 64 + lane] = a1; part[(wave * 5 + 2) * 64 + lane] = a2; part[(wave * 5 + 3) * 64 + lane] = a3; part[(wave * 5 + 4) * 64 + lane] = a4;
        __syncthreads();
        if (tid < 320) { const int r = tid >> 6, l = tid & 63; float s = in[7][L * 6144 + nb * 64 + l];
#pragma unroll
            for (int w = 0; w < 8; ++w) s += part[(w * 5 + r) * 64 + l];
            MOD[(size_t)(L * 5 + r) * 6144 + nb * 64 + l] = s; }
        __syncthreads();
    }
}

template <bool ROUTER>
__device__ __forceinline__ void norm_phase(const float* xlat, const float* xctx, bool do_ctx, const float* ng, const float* modL, int chunk_shift, bf16* A,
                                           const float* w_router, const float* b_router, int* tok_e, float* tok_w, int* hist, LAS unsigned char* lds, int wg, int G, int tid) {
    const int lane = tid & 63, wave = tid >> 6;
    LAS float* wr_s = (LAS float*)lds;
    LAS int* lh = (LAS int*)(lds + 32768);
    if (ROUTER) { for (int i = tid; i < D * NEXP; i += NTHR) wr_s[i] = w_router[i]; }
    for (int blk = wg; blk < 256; blk += G) {
        if (ROUTER) { if (tid < 8) lh[tid] = 0; __syncthreads(); }
        for (int pass = 0; pass < (do_ctx ? 2 : 1); ++pass) {
            const int b = pass == 0 ? (blk >> 6) : 4;
            const float* sh = modL + (size_t)b * 6144 + chunk_shift * D; const float* sc = sh + D;
            f32x4 mul[4], add[4];
#pragma unroll
            for (int j = 0; j < 4; ++j) { const int c = 4 * lane + 256 * j; const f32x4 g = *(const f32x4*)(ng + c), s = *(const f32x4*)(sc + c); mul[j] = g * (s + 1.0f); add[j] = *(const f32x4*)(sh + c); }
            const int nrow = pass == 0 ? 16 : (wave < 4 ? 1 : 0);
            for (int i = 0; i < nrow; ++i) {
                const int lrow = pass == 0 ? blk * 128 + wave * 16 + i : blk * 4 + wave;
                const float* xr = (pass == 0 ? xlat : xctx) + (size_t)lrow * D; const int arow = pass == 0 ? lrow : NLAT + lrow;
                f32x4 v[4]; float ss = 0.f;
#pragma unroll
                for (int j = 0; j < 4; ++j) { v[j] = *(const f32x4*)(xr + 4 * lane + 256 * j); ss += (v[j].x * v[j].x + v[j].y * v[j].y) + (v[j].z * v[j].z + v[j].w * v[j].w); }
                const float rstd = 1.0f / sqrtf(wave_sum(ss) * (1.0f / D) + EPS);
                unsigned long long* o8 = (unsigned long long*)(A + (size_t)arow * D) + lane;
#pragma unroll
                for (int j = 0; j < 4; ++j) { v[j] = v[j] * rstd * mul[j] + add[j]; o8[64 * j] = (unsigned long long)pk2(v[j].x, v[j].y) | ((unsigned long long)pk2(v[j].z, v[j].w) << 32); }
                if (ROUTER && pass == 0) {
                    float lg[8];
#pragma unroll
                    for (int e = 0; e < 8; ++e) lg[e] = 0.f;
#pragma unroll
                    for (int j = 0; j < 4; ++j)
#pragma unroll
                        for (int q = 0; q < 4; ++q) { const int c = 4 * lane + 256 * j + q; const f32x4 w0 = *(const LAS f32x4*)(wr_s + c * 8), w1 = *(const LAS f32x4*)(wr_s + c * 8 + 4); const float y = v[j][q];
                            lg[0] += y * w0.x; lg[1] += y * w0.y; lg[2] += y * w0.z; lg[3] += y * w0.w; lg[4] += y * w1.x; lg[5] += y * w1.y; lg[6] += y * w1.z; lg[7] += y * w1.w; }
#pragma unroll
                    for (int e = 0; e < 8; ++e) lg[e] = wave_sum(lg[e]) + b_router[e];
                    if (lane == 0) {
                        int e1 = 0; float v1 = lg[0];
#pragma unroll
                        for (int e = 1; e < 8; ++e) if (lg[e] > v1) { v1 = lg[e]; e1 = e; }
                        int e2 = -1; float v2 = -3.0e38f;
#pragma unroll
                        for (int e = 0; e < 8; ++e) if (e != e1 && lg[e] > v2) { v2 = lg[e]; e2 = e; }
                        const float w2 = 1.0f / (1.0f + __expf(v1 - v2)), w1 = 1.0f - w2;
                        tok_e[lrow * 2] = e1; tok_e[lrow * 2 + 1] = e2; tok_w[lrow * 2] = w1; tok_w[lrow * 2 + 1] = w2;
                        __hip_atomic_fetch_add(&lh[e1], 1, __ATOMIC_RELAXED, __HIP_MEMORY_SCOPE_WORKGROUP); __hip_atomic_fetch_add(&lh[e2], 1, __ATOMIC_RELAXED, __HIP_MEMORY_SCOPE_WORKGROUP);
                    }
                }
            }
        }
        if (ROUTER) { __syncthreads(); if (tid < 8) hist[blk * 8 + tid] = lh[tid]; __syncthreads(); }
    }
}

__device__ __forceinline__ void route_phase(unsigned char* ws, LAS unsigned char* lds, int wg, int G, int tid) {
    const int lane = tid & 63, wave = tid >> 6;
    int* rw = (int*)(ws + WS_ROUTE); const int* hist = rw + RW_HIST;
    const int* tok_e = (const int*)(ws + WS_TOK); const float* tok_w = (const float*)(ws + WS_TOK + 256 * 1024); int* pair_pos = (int*)(ws + WS_TOK + 512 * 1024); float* row_w = (float*)(ws + WS_TOK + 768 * 1024);
    const bf16* A = (const bf16*)(ws + WS_A); bf16* AS = (bf16*)(ws + WS_ASORT);
    LAS int* hs = (LAS int*)lds;
    LAS int* tot = hs + 2048;
    LAS int* te = hs + 2048 + 32;
    LAS int* ps = te + 256;
    for (int blk = wg; blk < 256; blk += G) {
        __syncthreads();
        for (int i = tid; i < 2048; i += NTHR) hs[i] = hist[i];
        if (tid < 256) te[tid] = tok_e[blk * 256 + tid];
        __syncthreads();
        if (tid < 8) { int t = 0, mb = 0; for (int b = 0; b < 256; ++b) { const int h = hs[b * 8 + tid]; t += h; mb += (b < blk) ? h : 0; } tot[tid] = t; tot[16 + tid] = mb; }
        __syncthreads();
        if (tid == 0) { int s = 0; for (int e = 0; e < 8; ++e) { tot[8 + e] = s; s += (tot[e] + 255) & ~255; } tot[24] = s >> 8; }
        __syncthreads();
        if (tid < 256) { const int e = te[tid]; int rank = 0; for (int q = 0; q < tid; ++q) rank += (te[q] == e) ? 1 : 0;
            const int pos = tot[8 + e] + tot[16 + e] + rank; ps[tid] = pos; pair_pos[blk * 256 + tid] = pos; row_w[pos] = tok_w[blk * 256 + tid]; }
        __syncthreads();
        for (int q = wave * 32; q < wave * 32 + 32; ++q) { const int token = blk * 128 + (q >> 1), pos = ps[q];
            const v4u* s = (const v4u*)(A + (size_t)token * D); v4u* d = (v4u*)(AS + (size_t)pos * D); const v4u a = s[lane], b = s[lane + 64]; d[lane] = a; d[lane + 64] = b; }
        if (blk == 0) {
            if (tid < 264) { int e = 0; for (int e2 = 1; e2 < 8; ++e2) if (tid * 256 >= tot[8 + e2]) e = e2; rw[RW_TILE_E + tid] = e; }
            if (tid == 0) rw[RW_NTILES] = tot[24];
        }
        if (blk < 8) { const int e = blk, r0 = tot[8 + e] + tot[e], r1 = tot[8 + e] + ((tot[e] + 255) & ~255);
            for (int r = r0 + wave; r < r1; r += NWAVES) { v4u* d = (v4u*)(AS + (size_t)r * D); const v4u z = {0u, 0u, 0u, 0u}; d[lane] = z; d[lane + 64] = z; if (lane == 0) row_w[r] = 0.f; } }
    }
}

__device__ __forceinline__ void mout_phase(const float* HF, const float* HB, const bf16* P, const float* ng, bf16* Y, int nrows, int wg, int G, int tid) {
    const int lane = tid & 63, wave = tid >> 6;
    const f32x4 g0 = *(const f32x4*)(ng + 8 * lane), g1 = *(const f32x4*)(ng + 8 * lane + 4);
    for (int row = wg * NWAVES + wave; row < nrows; row += G * NWAVES) {
        const f32x4 a0 = *(const f32x4*)(HF + (size_t)row * 512 + 8 * lane), a1 = *(const f32x4*)(HF + (size_t)row * 512 + 8 * lane + 4);
        const f32x4 b0 = *(const f32x4*)(HB + (size_t)row * 512 + 8 * lane), b1 = *(const f32x4*)(HB + (size_t)row * 512 + 8 * lane + 4);
        const v4u o = *(const v4u*)(P + (size_t)row * PLD + PO_O + 8 * lane);
        const f32x4 s0 = a0 + b0, s1 = a1 + b1;
        float ss = (s0.x * s0.x + s0.y * s0.y) + (s0.z * s0.z + s0.w * s0.w) + (s1.x * s1.x + s1.y * s1.y) + (s1.z * s1.z + s1.w * s1.w);
        ss += __shfl_xor(ss, 1); ss += __shfl_xor(ss, 2); ss += __shfl_xor(ss, 4); ss += __shfl_xor(ss, 8);
        const float rstd = 1.0f / sqrtf(ss * (1.0f / 128.0f) + EPS);
        v4u w;
        w.x = pk2(sigmoid_f(bflo(o.x)) * s0.x * rstd * g0.x, sigmoid_f(bfhi(o.x)) * s0.y * rstd * g0.y);
        w.y = pk2(sigmoid_f(bflo(o.y)) * s0.z * rstd * g0.z, sigmoid_f(bfhi(o.y)) * s0.w * rstd * g0.w);
        w.z = pk2(sigmoid_f(bflo(o.z)) * s1.x * rstd * g1.x, sigmoid_f(bfhi(o.z)) * s1.y * rstd * g1.y);
        w.w = pk2(sigmoid_f(bflo(o.w)) * s1.z * rstd * g1.z, sigmoid_f(bfhi(o.w)) * s1.w * rstd * g1.w);
        *(v4u*)(Y + (size_t)row * D + 8 * lane) = w;
    }
}

__device__ __forceinline__ void final_phase(float* X, const bf16* O, const int* pair_pos, const float* modL, const float* fg, int wg, int G, int tid) {
    const int lane = tid & 63, wave = tid >> 6;
    for (int row = wg * NWAVES + wave; row < NLAT; row += G * NWAVES) {
        const int b = row >> 13; const float* g2 = modL + (size_t)b * 6144 + 5 * D;
        const int p1 = pair_pos[row * 2], p2 = pair_pos[row * 2 + 1];
        float* xr = X + (size_t)row * D; const v2u* o1 = (const v2u*)(O + (size_t)p1 * D) + lane; const v2u* o2 = (const v2u*)(O + (size_t)p2 * D) + lane;
        f32x4 v[4]; float ss = 0.f;
#pragma unroll
        for (int j = 0; j < 4; ++j) { const f32x4 x = *(const f32x4*)(xr + 4 * lane + 256 * j), g = *(const f32x4*)(g2 + 4 * lane + 256 * j); const v2u a = o1[64 * j], c = o2[64 * j];
            f32x4 m; m.x = bflo(a.x) + bflo(c.x); m.y = bfhi(a.x) + bfhi(c.x); m.z = bflo(a.y) + bflo(c.y); m.w = bfhi(a.y) + bfhi(c.y);
            v[j] = x + g * m; ss += (v[j].x * v[j].x + v[j].y * v[j].y) + (v[j].z * v[j].z + v[j].w * v[j].w); }
        const float rstd = 1.0f / sqrtf(wave_sum(ss) * (1.0f / D) + EPS);
#pragma unroll
        for (int j = 0; j < 4; ++j) { const f32x4 g = *(const f32x4*)(fg + 4 * lane + 256 * j); *(f32x4*)(xr + 4 * lane + 256 * j) = v[j] * rstd * g; }
    }
}

__device__ __forceinline__ void mlstm_naive_task(const bf16* P, const float* Gt, const float* bgate, float* HF, float* HB, LAS unsigned char* lds, int task, int tid) {
    const int bb = task >> 6, h = (task >> 4) & 3, dir = (task >> 3) & 1, sl = task & 7;
    const int e = tid & 15, dg = tid >> 4, d0 = dg * 4, wave = tid >> 6, lane = tid & 63;
    float C0 = 0.f, C1 = 0.f, C2 = 0.f, C3 = 0.f, n0 = 0.f, n1 = 0.f, n2 = 0.f, n3 = 0.f, m = -1e30f;
    const float bi = bgate[dir * 8 + h], bfg = bgate[dir * 8 + 4 + h];
    float* HS = dir ? HB : HF;
    LAS float* red = (LAS float*)lds;
    constexpr int NSTEP = CTXL + SEQ;
    constexpr float KSC = 0.08838834764831845f;
    __syncthreads();
#define MLSTM_ROW(s) ((s) < CTXL ? NLAT + bb * CTXL + (dir ? CTXL - 1 - (s) : (s)) : bb * SEQ + (dir ? SEQ - 1 - ((s) - CTXL) : ((s) - CTXL)))
    int rown = MLSTM_ROW(0);
    v2u qn = *(const v2u*)(P + (size_t)rown * PLD + PO_Q + h * 128 + d0), kn = *(const v2u*)(P + (size_t)rown * PLD + PO_K + h * 128 + d0);
    unsigned short vn = P[(size_t)rown * PLD + PO_V + h * 128 + sl * 16 + e]; float gin = Gt[(size_t)rown * 16 + dir * 8 + h], gfn = Gt[(size_t)rown * 16 + dir * 8 + 4 + h];
    for (int s = 0; s < NSTEP; ++s) {
        const int row = rown; const v2u q2 = qn, k2 = kn; const float v = bf2f(vn), ipre = gin + bi, fpre = gfn + bfg;
        if (s + 1 < NSTEP) { rown = MLSTM_ROW(s + 1);
            qn = *(const v2u*)(P + (size_t)rown * PLD + PO_Q + h * 128 + d0); kn = *(const v2u*)(P + (size_t)rown * PLD + PO_K + h * 128 + d0);
            vn = P[(size_t)rown * PLD + PO_V + h * 128 + sl * 16 + e]; gin = Gt[(size_t)rown * 16 + dir * 8 + h]; gfn = Gt[(size_t)rown * 16 + dir * 8 + 4 + h]; }
        const float q0 = bflo(q2.x), q1 = bfhi(q2.x), q2f = bflo(q2.y), q3 = bfhi(q2.y);
        const float k0 = bflo(k2.x) * KSC, k1 = bfhi(k2.x) * KSC, k2f = bflo(k2.y) * KSC, k3 = bfhi(k2.y) * KSC;
        const float lf = log_sigmoid_f(fpre), mn = fmaxf(lf + m, ipre), fw = __expf(lf + m - mn), iw = __expf(ipre - mn); m = mn;
        const float kv = iw * v;
        C0 = fw * C0 + k0 * kv; C1 = fw * C1 + k1 * kv; C2 = fw * C2 + k2f * kv; C3 = fw * C3 + k3 * kv;
        n0 = fw * n0 + iw * k0; n1 = fw * n1 + iw * k1; n2 = fw * n2 + iw * k2f; n3 = fw * n3 + iw * k3;
        float pn = (q0 * C0 + q1 * C1) + (q2f * C2 + q3 * C3), pd = (q0 * n0 + q1 * n1) + (q2f * n2 + q3 * n3);
        pn += __shfl_xor(pn, 16); pn += __shfl_xor(pn, 32); pd += __shfl_xor(pd, 16); pd += __shfl_xor(pd, 32);
        const int par = s & 1;
        if (lane < 16) red[(par * 8 + wave) * 17 + lane] = pn;
        if (lane == 0) red[(par * 8 + wave) * 17 + 16] = pd;
        __syncthreads();
        if (tid < 16) { float num = 0.f, den = 0.f;
#pragma unroll
            for (int w = 0; w < 8; ++w) { num += red[(par * 8 + w) * 17 + tid]; den += red[(par * 8 + w) * 17 + 16]; }
            HS[(size_t)row * 512 + h * 128 + sl * 16 + tid] = num / fmaxf(fabsf(den), __expf(-m)); }
    }
#undef MLSTM_ROW
    __syncthreads();
}
typedef float f32x2 __attribute__((ext_vector_type(2)));
__device__ __forceinline__ void fourier_naive_task(const bf16* P, bf16* Y, LAS unsigned char* lds, int task, bool ctx, int tid) {
    const int lane = tid & 63, wave = tid >> 6;
    LAS f32x2* tab = (LAS f32x2*)lds;
    LAS unsigned short* zb = (LAS unsigned short*)(lds + 65536);
    LAS float* ure_s = (LAS float*)(lds + 98304);
    LAS float* uim_s = ure_s + 4096;
    const int N = ctx ? CTXL : SEQ, nkb = N / 64, tstride = 8192 / N;
    const int b = task / (4 * nkb), g = (task / nkb) & 3, kb = task % nkb;
    const int rowbase = ctx ? NLAT + b * CTXL : b * SEQ;
    float ure[8], uim[8]; int idx[8], stp[8];
#pragma unroll
    for (int j = 0; j < 8; ++j) { ure[j] = 0.f; uim[j] = 0.f; idx[j] = 0; stp[j] = ((kb * 64 + wave * 8 + j) * tstride) & 8191; }
    for (int nb0 = 0; nb0 < N; nb0 += 256) {
        __syncthreads();
#pragma unroll
        for (int i = 0; i < 4; ++i) { const int p = tid + NTHR * i, r = p >> 3, ch = p & 7;
            *(LAS v4u*)(zb + r * 64 + ch * 8) = *(const v4u*)(P + (size_t)(rowbase + nb0 + r) * PLD + PO_F + g * 64 + ch * 8); }
        __syncthreads();
#pragma unroll 2
        for (int nn = 0; nn < 256; ++nn) { const float z = bf2f(zb[nn * 64 + lane]);
#pragma unroll
            for (int j = 0; j < 8; ++j) { const f32x2 t = tab[idx[j]]; ure[j] += z * t.x; uim[j] -= z * t.y; idx[j] = (idx[j] + stp[j]) & 8191; } }
    }
    __syncthreads();
#pragma unroll
    for (int j = 0; j < 8; ++j) { ure_s[(wave * 8 + j) * 64 + lane] = ure[j]; uim_s[(wave * 8 + j) * 64 + lane] = uim[j]; }
    __syncthreads();
    const float scale = 1.0f / sqrtf((float)N * 64.0f);
#pragma unroll 1
    for (int j = 0; j < 8; ++j) { const int kl = wave * 8 + j; float acc = 0.f;
#pragma unroll 4
        for (int c = 0; c < 64; ++c) { const f32x2 t = tab[((c * lane) & 63) * 128]; acc += ure_s[kl * 64 + c] * t.x + uim_s[kl * 64 + c] * t.y; }
        Y[(size_t)(rowbase + kb * 64 + kl) * D + 512 + g * 64 + lane] = (bf16)f2bf(acc * scale); }
}
__device__ __forceinline__ void conv_task(const bf16* P, bf16* Y, const float* dw, const float* db, const float* lg, const float* lb, LAS unsigned char* lds, int task, bool ctx, int tid) {
    const int lane = tid & 63, wave = tid >> 6;
    const int N = ctx ? CTXL : SEQ, ntile = N / 32, b = task / ntile, t0 = (task % ntile) * 32, rowbase = ctx ? NLAT + b * CTXL : b * SEQ;
    LAS float* a = (LAS float*)lds;
    LAS float* o = a + 62 * 256;
    __syncthreads();
    for (int i = tid; i < 62 * 256; i += NTHR) { const int r = i >> 8, ch = i & 255, t = t0 - 15 + r; float v = 0.f;
        if (t >= 0 && t < N) { const bf16* pr = P + (size_t)(rowbase + t) * PLD; v = bf2f(pr[PO_CU + ch]) * sigmoid_f(bf2f(pr[PO_CG + ch])); }
        a[i] = v; }
    __syncthreads();
    { const int ch = tid & 255, th = tid >> 8; float w[31];
#pragma unroll
        for (int j = 0; j < 31; ++j) w[j] = dw[j * 256 + ch];
        const float bias = db[ch];
        for (int tt = 0; tt < 16; ++tt) { const int t = th * 16 + tt; float s = bias;
#pragma unroll
            for (int j = 0; j < 31; ++j) s += a[(t + j) * 256 + ch] * w[j];
            o[t * 256 + ch] = s; } }
    __syncthreads();
    for (int i = 0; i < 16; ++i) { const int p = wave * 16 + i, t = p >> 2, g = p & 3; const float v = o[t * 256 + g * 64 + lane];
        const float mu = wave_sum(v) * (1.0f / 64.0f), d = v - mu, var = wave_sum(d * d) * (1.0f / 64.0f);
        const float yn = d * (1.0f / sqrtf(var + EPS)) * lg[g * 64 + lane] + lb[g * 64 + lane];
        Y[(size_t)(rowbase + t0 + t) * D + 768 + g * 64 + lane] = (bf16)f2bf(silu_f(yn)); }
}
__device__ __forceinline__ void mix_naive_phase(const float* const* in, unsigned char* ws, int L, bool do_ctx, LAS unsigned char* lds, int wg, int G, int tid) {
    const bf16* P = (const bf16*)(ws + WS_P); bf16* Y = (bf16*)(ws + WS_Y);
#ifndef MIXSEL
#define MIXSEL 7
#endif
    if (MIXSEL & 1) for (int t = wg; t < 256; t += G) mlstm_naive_task(P, (const float*)(ws + WS_G), in[9] + L * 16, (float*)(ws + WS_HF), (float*)(ws + WS_HB), lds, t, tid);
    __syncthreads();
    { LAS f32x2* tab = (LAS f32x2*)lds; for (int i = tid; i < 8192; i += NTHR) { float s, c; sincospif((float)i * (1.0f / 4096.0f), &s, &c); tab[i] = (f32x2){c, s}; } }
    __syncthreads();
    if (MIXSEL & 2) for (int t = wg; t < 16 * 128; t += G) fourier_naive_task(P, Y, lds, t, false, tid);
    if ((MIXSEL & 2) && do_ctx) for (int t = wg; t < 16 * 4; t += G) fourier_naive_task(P, Y, lds, t, true, tid);
    if (MIXSEL & 4) for (int t = wg; t < 4 * 256; t += G) conv_task(P, Y, in[11] + L * 31 * 256, in[12] + L * 256, in[13] + L * 256, in[14] + L * 256, lds, t, false, tid);
    if ((MIXSEL & 4) && do_ctx) for (int t = wg; t < 4 * 8; t += G) conv_task(P, Y, in[11] + L * 31 * 256, in[12] + L * 256, in[13] + L * 256, in[14] + L * 256, lds, t, true, tid);
}

__device__ __forceinline__ void fourier_ctx_task(const bf16* P, bf16* Y, LAS unsigned char* lds, int task, int tid) {
    const int lane = tid & 63, wave = tid >> 6;
    LAS f32x2* tab = (LAS f32x2*)lds;
    LAS unsigned short* zb = (LAS unsigned short*)(lds + 65536);
    LAS float* ure_s = (LAS float*)(lds + 98304);
    LAS float* uim_s = ure_s + 1024;
    const int b = task >> 6, g = (task >> 4) & 3, kb = task & 15;
    const int rowbase = NLAT + b * CTXL;
    float ure[2] = {0.f, 0.f}, uim[2] = {0.f, 0.f}; int idx[2] = {0, 0}, stp[2];
#pragma unroll
    for (int j = 0; j < 2; ++j) stp[j] = ((kb * 16 + wave * 2 + j) * 32) & 8191;
    __syncthreads();
#pragma unroll
    for (int i = 0; i < 4; ++i) { const int p = tid + NTHR * i, r = p >> 3, ch = p & 7;
        *(LAS v4u*)(zb + r * 64 + ch * 8) = *(const v4u*)(P + (size_t)(rowbase + r) * PLD + PO_F + g * 64 + ch * 8); }
    __syncthreads();
#pragma unroll 4
    for (int nn = 0; nn < 256; ++nn) { const float z = bf2f(zb[nn * 64 + lane]);
#pragma unroll
        for (int j = 0; j < 2; ++j) { const f32x2 t = tab[idx[j]]; ure[j] += z * t.x; uim[j] -= z * t.y; idx[j] = (idx[j] + stp[j]) & 8191; } }
#pragma unroll
    for (int j = 0; j < 2; ++j) { ure_s[(wave * 2 + j) * 64 + lane] = ure[j]; uim_s[(wave * 2 + j) * 64 + lane] = uim[j]; }
    __syncthreads();
    const float scale = 1.0f / sqrtf(256.0f * 64.0f);
#pragma unroll 1
    for (int j = 0; j < 2; ++j) { const int kl = wave * 2 + j; float acc = 0.f;
#pragma unroll 4
        for (int c = 0; c < 64; ++c) { const f32x2 t = tab[((c * lane) & 63) * 128]; acc += ure_s[kl * 64 + c] * t.x + uim_s[kl * 64 + c] * t.y; }
        Y[(size_t)(rowbase + kb * 16 + kl) * D + 512 + g * 64 + lane] = (bf16)f2bf(acc * scale); }
}

typedef short bf16x8v __attribute__((ext_vector_type(8)));
constexpr size_t WS_NS = WS_R2 + 330 * MiB;
constexpr size_t WS_SC = WS_R2 + 333 * MiB;
static_assert(WS_HB + (size_t)16 * 132 * 16384 * 2 <= WS_NS && WS_NS + (size_t)2 * 16 * 132 * 128 * 4 <= WS_SC && WS_SC + (size_t)2 * 16 * 132 * 16 <= WS_END && WS_HF + (size_t)16 * 132 * 16384 * 2 <= WS_R2, "mlstm state map");
constexpr int NCHK = 132;
constexpr float KSC = 0.08838834764831845f;
__device__ __forceinline__ int chunk_rowbase(int b, int c) { return c < 128 ? b * SEQ + 64 * c : NLAT + b * CTXL + 64 * (c - 128); }
__device__ __forceinline__ float scan_add(float x, int lane, bool rev) {
#pragma unroll
    for (int o = 1; o < 64; o <<= 1) { const float y = rev ? __shfl_down(x, o) : __shfl_up(x, o); const bool ok = rev ? (lane + o < 64) : (lane >= o); x = ok ? x + y : x; }
    return x;
}
__device__ __forceinline__ float scan_max(float x, int lane, bool rev) {
#pragma unroll
    for (int o = 1; o < 64; o <<= 1) { const float y = rev ? __shfl_down(x, o) : __shfl_up(x, o); const bool ok = rev ? (lane + o < 64) : (lane >= o); x = ok ? fmaxf(x, y) : x; }
    return x;
}
__device__ __forceinline__ float wave_max(float v) {
#pragma unroll
    for (int o = 1; o < 64; o <<= 1) v = fmaxf(v, __shfl_xor(v, o));
    return v;
}
#define MFMA16(a, b, c) __builtin_amdgcn_mfma_f32_16x16x32_bf16((a), (b), (c), 0, 0, 0)

__device__ __forceinline__ void mlstm_m1_task(const bf16* P, const float* Gt, const float* bg, unsigned char* ws, LAS unsigned char* lds, int task, int tid) {
    const int lane = tid & 63, wave = tid >> 6, r = lane & 15, g = lane >> 4;
    const int bh = task / NCHK, c = task % NCHK, b = bh >> 2, h = bh & 3, rowbase = chunk_rowbase(b, c);
    LAS unsigned short* KT0 = (LAS unsigned short*)lds;
    LAS unsigned short* VT = (LAS unsigned short*)(lds + 36864);
    LAS float* gw = (LAS float*)(lds + 55296);
    float* SC = (float*)(ws + WS_SC); float* NS = (float*)(ws + WS_NS);
    __syncthreads();
    if (wave < 2) { const int dir = wave; const float* gr = Gt + (size_t)(rowbase + lane) * 16 + dir * 8 + h;
        const float a = gr[0] + bg[dir * 8 + h], lf = log_sigmoid_f(gr[4] + bg[dir * 8 + 4 + h]);
        const float cum = scan_add(lf, lane, dir != 0), gg = a - cum, gmax = wave_max(gg);
        gw[dir * 64 + lane] = __expf(gg - gmax) * KSC;
        const float tot = __shfl(cum, dir ? 0 : 63);
        if (lane == 0) { float* sc = SC + ((size_t)(dir * 16 + bh) * NCHK + c) * 4; sc[0] = tot; sc[1] = tot + gmax; } }
    __syncthreads();
#pragma unroll
    for (int i2 = 0; i2 < 2; ++i2) { const int p = tid + NTHR * i2, s = p >> 4, dg = p & 15;
        const v4u kq = *(const v4u*)(P + (size_t)(rowbase + s) * PLD + PO_K + h * 128 + dg * 8), vq = *(const v4u*)(P + (size_t)(rowbase + s) * PLD + PO_V + h * 128 + dg * 8);
        const float wf = gw[s], wb = gw[64 + s];
        const unsigned kk[4] = {kq.x, kq.y, kq.z, kq.w}, vv[4] = {vq.x, vq.y, vq.z, vq.w};
#pragma unroll
        for (int j = 0; j < 4; ++j) { const float k0 = bflo(kk[j]), k1 = bfhi(kk[j]); const int d = dg * 8 + 2 * j;
            KT0[d * 72 + s] = (unsigned short)f2bf(k0 * wf); KT0[(d + 1) * 72 + s] = (unsigned short)f2bf(k1 * wf);
            KT0[9216 + d * 72 + s] = (unsigned short)f2bf(k0 * wb); KT0[9216 + (d + 1) * 72 + s] = (unsigned short)f2bf(k1 * wb);
            VT[d * 72 + s] = (unsigned short)(vv[j] & 0xffffu); VT[(d + 1) * 72 + s] = (unsigned short)(vv[j] >> 16); } }
    __syncthreads();
    { const int dir = wave >> 2, dt0 = (wave & 3) * 2; LAS unsigned short* KT = KT0 + dir * 9216;
        bf16* CS = (bf16*)(ws + (dir ? WS_HB : WS_HF)) + ((size_t)bh * NCHK + c) * 16384;
        bf16x8v af[2][2];
#pragma unroll
        for (int m = 0; m < 2; ++m)
#pragma unroll
            for (int kk = 0; kk < 2; ++kk) af[m][kk] = *(const LAS bf16x8v*)(KT + ((dt0 + m) * 16 + r) * 72 + kk * 32 + 8 * g);
#pragma unroll
        for (int et = 0; et < 8; ++et) {
            const bf16x8v b0 = *(const LAS bf16x8v*)(VT + (et * 16 + r) * 72 + 8 * g), b1 = *(const LAS bf16x8v*)(VT + (et * 16 + r) * 72 + 32 + 8 * g);
#pragma unroll
            for (int m = 0; m < 2; ++m) { f32x4 acc = {0.f, 0.f, 0.f, 0.f}; acc = MFMA16(af[m][0], b0, acc); acc = MFMA16(af[m][1], b1, acc);
                v2u o; o.x = pk2(acc[0], acc[1]); o.y = pk2(acc[2], acc[3]);
                *(v2u*)(CS + (size_t)(et * 16 + r) * 128 + (dt0 + m) * 16 + 4 * g) = o; } }
    }
    if (tid < 256) { const int dir = tid >> 7, dd = tid & 127; const LAS unsigned short* kr = KT0 + dir * 9216 + dd * 72; float s = 0.f;
#pragma unroll
        for (int q = 0; q < 8; ++q) { const v4u w = *(const LAS v4u*)(kr + 8 * q); s += (bflo(w.x) + bfhi(w.x)) + (bflo(w.y) + bfhi(w.y)) + (bflo(w.z) + bfhi(w.z)) + (bflo(w.w) + bfhi(w.w)); }
        NS[((size_t)(dir * 16 + bh) * NCHK + c) * 128 + dd] = s; }
}

__device__ __forceinline__ void mlstm_m2_phase(unsigned char* ws, int wg, int G, int tid) {
    for (int u = wg; u < 256; u += G) {
        const int seq = u >> 3, part = u & 7, dir = seq >> 4, bh = seq & 15;
        bf16* base = (bf16*)(ws + (dir ? WS_HB : WS_HF)) + (size_t)bh * NCHK * 16384 + part * 2048 + tid * 4;
        float* SC = (float*)(ws + WS_SC) + (size_t)(dir * 16 + bh) * NCHK * 4;
        float* NSb = (float*)(ws + WS_NS) + (size_t)(dir * 16 + bh) * NCHK * 128 + tid * 4;
        const bool do_n = (part == 0 && tid < 32), do_m = (part == 0 && tid == 0);
        float s0 = 0.f, s1 = 0.f, s2 = 0.f, s3 = 0.f, m = -1e30f; f32x4 ns = {0.f, 0.f, 0.f, 0.f};
        for (int j0 = 0; j0 < NCHK; j0 += 4) {
            v2u dl[4]; float tot[4], ml[4]; int cc[4]; f32x4 dn[4];
#pragma unroll
            for (int q = 0; q < 4; ++q) { const int j = j0 + q; cc[q] = dir ? (NCHK - 1 - j) : ((j + 128) % NCHK);
                dl[q] = *(const v2u*)(base + (size_t)cc[q] * 16384); tot[q] = SC[cc[q] * 4]; ml[q] = SC[cc[q] * 4 + 1];
                if (do_n) dn[q] = *(const f32x4*)(NSb + (size_t)cc[q] * 128); }
#pragma unroll
            for (int q = 0; q < 4; ++q) {
                v2u o; o.x = pk2(s0, s1); o.y = pk2(s2, s3); *(v2u*)(base + (size_t)cc[q] * 16384) = o;
                if (do_n) *(f32x4*)(NSb + (size_t)cc[q] * 128) = ns;
                if (do_m) SC[cc[q] * 4 + 2] = m;
                const float me = fmaxf(tot[q] + m, ml[q]), al = __expf(tot[q] + m - me), be = __expf(ml[q] - me); m = me;
                s0 = al * s0 + be * bflo(dl[q].x); s1 = al * s1 + be * bfhi(dl[q].x); s2 = al * s2 + be * bflo(dl[q].y); s3 = al * s3 + be * bfhi(dl[q].y);
                if (do_n) ns = ns * al + dn[q] * be;
            }
        }
    }
}

__device__ __forceinline__ void mlstm_m3_task(const bf16* P, const float* Gt, const float* bg, const float* ngl, unsigned char* ws, bf16* Y, LAS unsigned char* lds, int task, int tid) {
    const int lane = tid & 63, wave = tid >> 6, r = lane & 15, g = lane >> 4;
    const int bh = task / NCHK, c = task % NCHK, b = bh >> 2, h = bh & 3, rowbase = chunk_rowbase(b, c);
    LAS unsigned short* Qs = (LAS unsigned short*)lds;
    LAS unsigned short* Ks = (LAS unsigned short*)(lds + 17408);
    LAS unsigned short* VT = (LAS unsigned short*)(lds + 34816);
    LAS unsigned short* CT = (LAS unsigned short*)(lds + 53248);
    LAS float* nsl = (LAS float*)(lds + 122880);
    LAS float* tok = (LAS float*)(lds + 123904);
    LAS float* dens = (LAS float*)(lds + 125952);
    LAS float* ssq = (LAS float*)(lds + 126976);
    const float* SC = (const float*)(ws + WS_SC); const float* NS = (const float*)(ws + WS_NS);
    __syncthreads();
    if (wave < 2) { const int dir = wave; const float* gr = Gt + (size_t)(rowbase + lane) * 16 + dir * 8 + h;
        const float a = gr[0] + bg[dir * 8 + h], lf = log_sigmoid_f(gr[4] + bg[dir * 8 + 4 + h]);
        const float cum = scan_add(lf, lane, dir != 0), gg = a - cum, pm = scan_max(gg, lane, dir != 0);
        const float mst = SC[((size_t)(dir * 16 + bh) * NCHK + c) * 4 + 2];
        tok[dir * 256 + lane] = -fmaxf(mst, pm); tok[dir * 256 + 64 + lane] = gg; tok[dir * 256 + 128 + lane] = cum; tok[dir * 256 + 192 + lane] = mst; }
    else if (wave < 4) { const int dir = wave - 2; const float* src = NS + ((size_t)(dir * 16 + bh) * NCHK + c) * 128; nsl[dir * 128 + lane] = src[lane]; nsl[dir * 128 + 64 + lane] = src[64 + lane]; }
#pragma unroll
    for (int i2 = 0; i2 < 2; ++i2) { const int p = tid + NTHR * i2, s = p >> 4, dg = p & 15; const bf16* pr = P + (size_t)(rowbase + s) * PLD + h * 128 + dg * 8;
        const v4u qq = *(const v4u*)(pr + PO_Q), kq = *(const v4u*)(pr + PO_K), vq = *(const v4u*)(pr + PO_V);
        *(LAS v4u*)(Qs + s * 136 + dg * 8) = qq; *(LAS v4u*)(Ks + s * 136 + dg * 8) = kq;
        const unsigned vv[4] = {vq.x, vq.y, vq.z, vq.w};
#pragma unroll
        for (int j = 0; j < 4; ++j) { const int d = dg * 8 + 2 * j; VT[d * 72 + s] = (unsigned short)(vv[j] & 0xffffu); VT[(d + 1) * 72 + s] = (unsigned short)(vv[j] >> 16); } }
#pragma unroll
    for (int i2 = 0; i2 < 8; ++i2) { const int p = tid + NTHR * i2, dir = p >> 11, e = (p >> 4) & 127, dg = p & 15;
        const bf16* CS = (const bf16*)(ws + (dir ? WS_HB : WS_HF)) + ((size_t)bh * NCHK + c) * 16384;
        *(LAS v4u*)(CT + dir * 17408 + e * 136 + dg * 8) = *(const v4u*)(CS + e * 128 + dg * 8); }
    __syncthreads();
    const int rt = wave & 3, ch = wave >> 2;
    bf16x8v qf[4];
#pragma unroll
    for (int kk = 0; kk < 4; ++kk) qf[kk] = *(const LAS bf16x8v*)(Qs + (16 * rt + r) * 136 + 32 * kk + 8 * g);
    f32x4 sT[4];
#pragma unroll
    for (int st = 0; st < 4; ++st) { f32x4 acc = {0.f, 0.f, 0.f, 0.f};
#pragma unroll
        for (int kk = 0; kk < 4; ++kk) { const bf16x8v a = *(const LAS bf16x8v*)(Ks + (16 * st + r) * 136 + 32 * kk + 8 * g); acc = MFMA16(a, qf[kk], acc); }
        sT[st] = acc; }
    const int t = 16 * rt + r;
    const float uf = tok[t], ub = tok[256 + t];
    float dsf = 0.f, dsb = 0.f; f32x4 Sf[4], Sb[4];
#pragma unroll
    for (int st = 0; st < 4; ++st)
#pragma unroll
        for (int i = 0; i < 4; ++i) { const int s = 16 * st + 4 * g + i; const float sv = sT[st][i] * KSC;
            const float wf = (s <= t) ? __expf(uf + tok[64 + s]) : 0.f, wb = (s >= t) ? __expf(ub + tok[256 + 64 + s]) : 0.f;
            Sf[st][i] = sv * wf; Sb[st][i] = sv * wb; dsf += Sf[st][i]; dsb += Sb[st][i]; }
    float qnf = 0.f, qnb = 0.f;
#pragma unroll
    for (int kk = 0; kk < 4; ++kk)
#pragma unroll
        for (int i = 0; i < 8; ++i) { const float qv = bf2f((unsigned short)qf[kk][i]); const int d = 32 * kk + 8 * g + i; qnf += qv * nsl[d]; qnb += qv * nsl[128 + d]; }
    dsf += __shfl_xor(dsf, 16); dsf += __shfl_xor(dsf, 32); dsb += __shfl_xor(dsb, 16); dsb += __shfl_xor(dsb, 32);
    qnf += __shfl_xor(qnf, 16); qnf += __shfl_xor(qnf, 32); qnb += __shfl_xor(qnb, 16); qnb += __shfl_xor(qnb, 32);
    if (g == 0) { dens[(wave * 2 + 0) * 16 + r] = dsf + __expf(uf + tok[192 + t]) * qnf; dens[(wave * 2 + 1) * 16 + r] = dsb + __expf(ub + tok[256 + 192 + t]) * qnb; }
    bf16x8v paf[2], pab[2];
#pragma unroll
    for (int k2 = 0; k2 < 2; ++k2) {
        v4u w; w.x = pk2(Sf[2 * k2][0], Sf[2 * k2][1]); w.y = pk2(Sf[2 * k2][2], Sf[2 * k2][3]); w.z = pk2(Sf[2 * k2 + 1][0], Sf[2 * k2 + 1][1]); w.w = pk2(Sf[2 * k2 + 1][2], Sf[2 * k2 + 1][3]); paf[k2] = __builtin_bit_cast(bf16x8v, w);
        v4u x; x.x = pk2(Sb[2 * k2][0], Sb[2 * k2][1]); x.y = pk2(Sb[2 * k2][2], Sb[2 * k2][3]); x.z = pk2(Sb[2 * k2 + 1][0], Sb[2 * k2 + 1][1]); x.w = pk2(Sb[2 * k2 + 1][2], Sb[2 * k2 + 1][3]); pab[k2] = __builtin_bit_cast(bf16x8v, x); }
    LDS_WAIT();
    float intf[4], intb[4], rdf[4], rdb[4];
#pragma unroll
    for (int i = 0; i < 4; ++i) { const int tr = 16 * rt + 4 * g + i, tl = 4 * g + i;
        const float u0 = tok[tr], u1 = tok[256 + tr];
        intf[i] = __expf(u0 + tok[192 + tr]); intb[i] = __expf(u1 + tok[256 + 192 + tr]);
        rdf[i] = 1.0f / fmaxf(fabsf(dens[(wave * 2 + 0) * 16 + tl]), __expf(u0 - tok[128 + tr])); rdb[i] = 1.0f / fmaxf(fabsf(dens[(wave * 2 + 1) * 16 + tl]), __expf(u1 - tok[256 + 128 + tr])); }
    f32x4 hs[4]; float sq[4] = {0.f, 0.f, 0.f, 0.f};
#pragma unroll
    for (int ct = 0; ct < 4; ++ct) { const int e0 = 64 * ch + 16 * ct;
        f32x4 aPf = {0.f, 0.f, 0.f, 0.f}, aPb = aPf, aCf = aPf, aCb = aPf;
#pragma unroll
        for (int k2 = 0; k2 < 2; ++k2) { const v2u lo = *(const LAS v2u*)(VT + (e0 + r) * 72 + 32 * k2 + 4 * g), hi = *(const LAS v2u*)(VT + (e0 + r) * 72 + 32 * k2 + 16 + 4 * g);
            v4u bw; bw.x = lo.x; bw.y = lo.y; bw.z = hi.x; bw.w = hi.y; const bf16x8v bfr = __builtin_bit_cast(bf16x8v, bw);
            aPf = MFMA16(paf[k2], bfr, aPf); aPb = MFMA16(pab[k2], bfr, aPb); }
#pragma unroll
        for (int kk = 0; kk < 4; ++kk) { const bf16x8v cf = *(const LAS bf16x8v*)(CT + (e0 + r) * 136 + 32 * kk + 8 * g), cb = *(const LAS bf16x8v*)(CT + 17408 + (e0 + r) * 136 + 32 * kk + 8 * g);
            aCf = MFMA16(qf[kk], cf, aCf); aCb = MFMA16(qf[kk], cb, aCb); }
#pragma unroll
        for (int i = 0; i < 4; ++i) { const float hv = (aPf[i] + intf[i] * aCf[i]) * rdf[i] + (aPb[i] + intb[i] * aCb[i]) * rdb[i]; hs[ct][i] = hv; sq[i] += hv * hv; } }
#pragma unroll
    for (int i = 0; i < 4; ++i) { float v = sq[i]; v += __shfl_xor(v, 1); v += __shfl_xor(v, 2); v += __shfl_xor(v, 4); v += __shfl_xor(v, 8); sq[i] = v; }
    if (r == 0) {
#pragma unroll
        for (int i = 0; i < 4; ++i) ssq[wave * 16 + 4 * g + i] = sq[i]; }
    __syncthreads();
#pragma unroll
    for (int i = 0; i < 4; ++i) { const int tl = 4 * g + i, row = rowbase + 16 * rt + tl;
        const float rstd = 1.0f / sqrtf((ssq[wave * 16 + tl] + ssq[(wave ^ 4) * 16 + tl]) * (1.0f / 128.0f) + EPS);
#pragma unroll
        for (int ct = 0; ct < 4; ++ct) { const int e = 64 * ch + 16 * ct + r; const float o = bf2f(P[(size_t)row * PLD + PO_O + h * 128 + e]);
            Y[(size_t)row * D + h * 128 + e] = (bf16)f2bf(hs[ct][i] * rstd * ngl[h * 128 + e] * sigmoid_f(o)); } }
}


struct ConvRegs { v4u u[6], g[6]; };
__device__ __forceinline__ void conv_issue(ConvRegs& R, const bf16* P, int task, bool ctx, int tid) {
    const int N = ctx ? CTXL : SEQ, ntile = N / 64, b = task / ntile, t0 = (task % ntile) * 64, rowbase = ctx ? NLAT + b * CTXL : b * SEQ;
#pragma unroll
    for (int k = 0; k < 6; ++k) { const int p = tid + NTHR * k, rr = p >> 5, cg = p & 31, t = t0 - 15 + rr; const v4u z = {0u, 0u, 0u, 0u}; R.u[k] = z; R.g[k] = z;
        if (rr < 94 && t >= 0 && t < N) { const bf16* pr = P + (size_t)(rowbase + t) * PLD; R.u[k] = *(const v4u*)(pr + PO_CU + 8 * cg); R.g[k] = *(const v4u*)(pr + PO_CG + 8 * cg); } }
}
__device__ __forceinline__ void conv_phase(const bf16* P, bf16* Y, const float* dw, const float* db, const float* lg, const float* lb, LAS unsigned char* lds, int ntask, bool ctx, int wg, int G, int tid) {
    const int lane = tid & 63, wave = tid >> 6;
    const int N = ctx ? CTXL : SEQ, ntile = N / 64;
    LAS float* a = (LAS float*)lds;
    const int grp = wave & 3, th = wave >> 2, ch = grp * 64 + lane;
    if (wg >= ntask) return;
    float w[31];
#pragma unroll
    for (int j = 0; j < 31; ++j) w[j] = dw[j * 256 + ch];
    const float bias = db[ch], gam = lg[ch], bet = lb[ch];
    ConvRegs R; conv_issue(R, P, wg, ctx, tid);
    for (int task = wg; task < ntask; task += G) {
        const int b = task / ntile, t0 = (task % ntile) * 64, rowbase = ctx ? NLAT + b * CTXL : b * SEQ;
        __syncthreads();
#pragma unroll
        for (int k = 0; k < 6; ++k) { const int p = tid + NTHR * k, rr = p >> 5, cg = p & 31; const v4u u = R.u[k], gq = R.g[k]; f32x4 o0, o1;
            o0.x = bflo(u.x) * sigmoid_f(bflo(gq.x)); o0.y = bfhi(u.x) * sigmoid_f(bfhi(gq.x)); o0.z = bflo(u.y) * sigmoid_f(bflo(gq.y)); o0.w = bfhi(u.y) * sigmoid_f(bfhi(gq.y));
            o1.x = bflo(u.z) * sigmoid_f(bflo(gq.z)); o1.y = bfhi(u.z) * sigmoid_f(bfhi(gq.z)); o1.z = bflo(u.w) * sigmoid_f(bflo(gq.w)); o1.w = bfhi(u.w) * sigmoid_f(bfhi(gq.w));
            if (rr < 94) { *(LAS f32x4*)(a + rr * 256 + 8 * cg) = o0; *(LAS f32x4*)(a + rr * 256 + 8 * cg + 4) = o1; } }
        __syncthreads();
        if (task + G < ntask) conv_issue(R, P, task + G, ctx, tid);
        float acc[32];
#pragma unroll
        for (int t = 0; t < 32; ++t) acc[t] = bias;
#pragma unroll
        for (int j = 0; j < 62; ++j) { const float v = a[(th * 32 + j) * 256 + ch];
#pragma unroll
            for (int t = 0; t < 32; ++t) if (j - t >= 0 && j - t <= 30) acc[t] += v * w[j - t]; }
#pragma unroll
        for (int t = 0; t < 32; ++t) { const float mu = wave_sum(acc[t]) * (1.0f / 64.0f), d = acc[t] - mu, var = wave_sum(d * d) * (1.0f / 64.0f);
            const float yn = d * (1.0f / sqrtf(var + EPS)) * gam + bet;
            Y[(size_t)(rowbase + t0 + th * 32 + t) * D + 768 + ch] = (bf16)f2bf(silu_f(yn)); }
    }
}

constexpr size_t WS_FA = WS_A;
__device__ __forceinline__ bf16x8v pack8(const float (&v)[8]) { v4u w; w.x = pk2(v[0], v[1]); w.y = pk2(v[2], v[3]); w.z = pk2(v[4], v[5]); w.w = pk2(v[6], v[7]); return __builtin_bit_cast(bf16x8v, w); }
__device__ __forceinline__ void fourier_a_phase(const bf16* P, bf16* FA, LAS unsigned char* lds, int wg, int G, int tid) {
    const int lane = tid & 63, wave = tid >> 6, r = lane & 15, g = lane >> 4;
    LAS unsigned short* ZT = (LAS unsigned short*)lds;
    bf16x8v cfr[4], nsfr[4];
    { const int k1 = 16 * wave + r;
#pragma unroll
        for (int kk = 0; kk < 4; ++kk) { float cv[8], sv[8];
#pragma unroll
            for (int i = 0; i < 8; ++i) { const int n1 = 32 * kk + 8 * g + i; float s, c; sincospif((float)((k1 * n1) & 127) * (1.0f / 64.0f), &s, &c); cv[i] = c; sv[i] = -s; }
            cfr[kk] = pack8(cv); nsfr[kk] = pack8(sv); } }
    for (int task = wg; task < 16 * 64; task += G) {
        const int bg = task >> 6, n2 = task & 63, b = bg >> 2, g4 = bg & 3;
        __syncthreads();
#pragma unroll
        for (int i2 = 0; i2 < 2; ++i2) { const int p = tid + NTHR * i2, n1 = p & 127, cg = p >> 7;
            const v4u z = *(const v4u*)(P + (size_t)(b * SEQ + 64 * n1 + n2) * PLD + PO_F + 64 * g4 + 8 * cg); const unsigned zz[4] = {z.x, z.y, z.z, z.w};
#pragma unroll
            for (int j = 0; j < 4; ++j) { ZT[(8 * cg + 2 * j) * 136 + n1] = (unsigned short)(zz[j] & 0xffffu); ZT[(8 * cg + 2 * j + 1) * 136 + n1] = (unsigned short)(zz[j] >> 16); } }
        __syncthreads();
        const int k1 = 16 * wave + r; float tc, ts; sincospif((float)(n2 * k1) * (1.0f / 4096.0f), &ts, &tc);
        bf16* dst = FA + ((size_t)(bg * 128 + k1) * 2) * 4096 + n2 * 64;
#pragma unroll
        for (int ct = 0; ct < 4; ++ct) { f32x4 aR = {0.f, 0.f, 0.f, 0.f}, aI = aR;
#pragma unroll
            for (int kk = 0; kk < 4; ++kk) { const bf16x8v a = *(const LAS bf16x8v*)(ZT + (16 * ct + r) * 136 + 32 * kk + 8 * g); aR = MFMA16(a, cfr[kk], aR); aI = MFMA16(a, nsfr[kk], aI); }
            v2u oR, oI; oR.x = pk2(aR[0] * tc + aI[0] * ts, aR[1] * tc + aI[1] * ts); oR.y = pk2(aR[2] * tc + aI[2] * ts, aR[3] * tc + aI[3] * ts);
            oI.x = pk2(aI[0] * tc - aR[0] * ts, aI[1] * tc - aR[1] * ts); oI.y = pk2(aI[2] * tc - aR[2] * ts, aI[3] * tc - aR[3] * ts);
            *(v2u*)(dst + 16 * ct + 4 * g) = oR; *(v2u*)(dst + 4096 + 16 * ct + 4 * g) = oI; }
    }
}
__device__ __forceinline__ void fourier_b_phase(const bf16* FA, bf16* Y, LAS unsigned char* lds, int wg, int G, int tid) {
    const int lane = tid & 63, wave = tid >> 6, r = lane & 15, g = lane >> 4, kt = wave & 3, kh = wave >> 2;
    LAS unsigned short* Ms = (LAS unsigned short*)lds;
    bf16x8v Cf[2], Sf[2], NSf[2], C2[2][2], S2[2][2];
    { const int kc = 16 * kt + r;
#pragma unroll
        for (int kk = 0; kk < 2; ++kk) { float cv[8], sv[8], nv[8];
#pragma unroll
            for (int i = 0; i < 8; ++i) { const int c = 32 * kk + 8 * g + i; float s, co; sincospif((float)((kc * c) & 63) * (1.0f / 32.0f), &s, &co); cv[i] = co; sv[i] = s; nv[i] = -s; }
            Cf[kk] = pack8(cv); Sf[kk] = pack8(sv); NSf[kk] = pack8(nv); }
#pragma unroll
        for (int m = 0; m < 2; ++m) { const int k2 = 16 * (2 * kh + m) + r;
#pragma unroll
            for (int kk = 0; kk < 2; ++kk) { float cv[8], sv[8];
#pragma unroll
                for (int i = 0; i < 8; ++i) { const int n2 = 32 * kk + 16 * (i >> 2) + 4 * g + (i & 3); float s, co; sincospif((float)((k2 * n2) & 63) * (1.0f / 32.0f), &s, &co); cv[i] = co; sv[i] = s; }
                C2[m][kk] = pack8(cv); S2[m][kk] = pack8(sv); } } }
    const float scale = 1.0f / sqrtf(8192.0f * 64.0f);
    for (int task = wg; task < 16 * 128; task += G) {
        const int bg = task >> 7, k1 = task & 127, b = bg >> 2, g4 = bg & 3;
        const bf16* src = FA + (size_t)(bg * 128 + k1) * 8192;
        __syncthreads();
#pragma unroll
        for (int i2 = 0; i2 < 2; ++i2) { const int p = tid + NTHR * i2, plane = p >> 9, n2 = (p >> 3) & 63, cg = p & 7;
            *(LAS v4u*)(Ms + plane * 4608 + n2 * 72 + 8 * cg) = *(const v4u*)(src + plane * 4096 + n2 * 64 + 8 * cg); }
        __syncthreads();
        f32x4 tre[4], tim[4];
#pragma unroll
        for (int nt = 0; nt < 4; ++nt) { f32x4 a = {0.f, 0.f, 0.f, 0.f}, bq = a;
#pragma unroll
            for (int kk = 0; kk < 2; ++kk) { const bf16x8v are = *(const LAS bf16x8v*)(Ms + (16 * nt + r) * 72 + 32 * kk + 8 * g), aim = *(const LAS bf16x8v*)(Ms + 4608 + (16 * nt + r) * 72 + 32 * kk + 8 * g);
                a = MFMA16(are, Cf[kk], a); a = MFMA16(aim, Sf[kk], a); bq = MFMA16(aim, Cf[kk], bq); bq = MFMA16(are, NSf[kk], bq); }
            tre[nt] = a; tim[nt] = bq; }
        bf16x8v bre[2], bim[2];
#pragma unroll
        for (int kk = 0; kk < 2; ++kk) { const float v0[8] = {tre[2 * kk][0], tre[2 * kk][1], tre[2 * kk][2], tre[2 * kk][3], tre[2 * kk + 1][0], tre[2 * kk + 1][1], tre[2 * kk + 1][2], tre[2 * kk + 1][3]};
            const float v1[8] = {tim[2 * kk][0], tim[2 * kk][1], tim[2 * kk][2], tim[2 * kk][3], tim[2 * kk + 1][0], tim[2 * kk + 1][1], tim[2 * kk + 1][2], tim[2 * kk + 1][3]};
            bre[kk] = pack8(v0); bim[kk] = pack8(v1); }
#pragma unroll
        for (int m = 0; m < 2; ++m) { f32x4 y = {0.f, 0.f, 0.f, 0.f};
#pragma unroll
            for (int kk = 0; kk < 2; ++kk) { y = MFMA16(C2[m][kk], bre[kk], y); y = MFMA16(S2[m][kk], bim[kk], y); }
#pragma unroll
            for (int i = 0; i < 4; ++i) { const int k2 = 16 * (2 * kh + m) + 4 * g + i;
                Y[(size_t)(b * SEQ + k1 + 128 * k2) * D + 512 + 64 * g4 + 16 * kt + r] = (bf16)f2bf(y[i] * scale); } }
    }
}

__device__ __forceinline__ void mix_a_phase(const float* const* in, unsigned char* ws, int L, bool do_ctx, LAS unsigned char* lds, int wg, int G, int tid) {
    const bf16* P = (const bf16*)(ws + WS_P); bf16* Y = (bf16*)(ws + WS_Y);
#ifndef SUBDUP
#define SUBDUP 0
#endif
    _Pragma("unroll") for (int rep_ = 0; rep_ < ((SUBDUP & 1) ? 2 : 1); ++rep_) for (int t = wg; t < 16 * NCHK; t += G) mlstm_m1_task(P, (const float*)(ws + WS_G), in[9] + L * 16, ws, lds, t, tid);
    _Pragma("unroll") for (int rep_ = 0; rep_ < ((SUBDUP & 2) ? 2 : 1); ++rep_) fourier_a_phase(P, (bf16*)(ws + WS_FA), lds, wg, G, tid);
    if (do_ctx) {
        __syncthreads();
        { LAS f32x2* tab = (LAS f32x2*)lds; for (int i = tid; i < 8192; i += NTHR) { float s, c; sincospif((float)i * (1.0f / 4096.0f), &s, &c); tab[i] = (f32x2){c, s}; } }
        __syncthreads();
        for (int t = wg; t < 16 * 4 * 4; t += G) fourier_ctx_task(P, Y, lds, t, tid);
    }
    _Pragma("unroll") for (int rep_ = 0; rep_ < ((SUBDUP & 4) ? 2 : 1); ++rep_) conv_phase(P, Y, in[11] + L * 31 * 256, in[12] + L * 256, in[13] + L * 256, in[14] + L * 256, lds, 4 * 128, false, wg, G, tid);
    if (do_ctx) conv_phase(P, Y, in[11] + L * 31 * 256, in[12] + L * 256, in[13] + L * 256, in[14] + L * 256, lds, 4 * 4, true, (wg + 128) % G, G, tid);
}

constexpr int NPH = 21;
#ifndef MK_SINGLE
#define MK_SINGLE 1
#endif
struct Params { const float* in[23]; float* out; unsigned char* ws; int ph_lo, ph_hi; };
static_assert(sizeof(Params) == 23 * 8 + 8 + 8 + 8, "Params has no padding");

__global__ void __launch_bounds__(NTHR, 2) fwd_kernel(Params p) {
    extern __shared__ __attribute__((aligned(16))) unsigned char lds_raw[];
    LAS unsigned char* lds = (LAS unsigned char*)lds_raw;
    const int tid = threadIdx.x, wg = blockIdx.x, G = gridDim.x;
    unsigned char* ws = p.ws;
    const float* const* in = p.in;
    for (int u = tid; u < (LDS_BYTES - LDSCTL_OFF) / 4; u += NTHR) ((LAS unsigned*)(lds + LDSCTL_OFF))[u] = 0u;
    __syncthreads();
    XcdBarrier bar; bar.bar = (unsigned*)(ws + WS_CTL) + CW_BAR; bar.x = 0; bar.st = (volatile LAS unsigned*)(lds + LDSCTL_OFF + 64);
    if (MK_SINGLE) bar = xcd_barrier_post((unsigned*)(ws + WS_CTL) + CW_BAR, (volatile LAS unsigned*)(lds + LDSCTL_OFF + 64));
    const int lo = p.ph_lo, hi = p.ph_hi;
#ifndef PH_MASK
#define PH_MASK 0xFFFFFFFFu
#endif
#define IN(k) (((PH_MASK >> (k)) & 1u) && lo <= (k) && (k) < hi)
#ifndef DUP_MASK
#define DUP_MASK 0u
#endif
#define REP(k) _Pragma("unroll") for (int rep_ = 0; rep_ < ((((DUP_MASK) >> (k)) & 1u) ? 2 : 1); ++rep_)
#define SEAM(k) do { if (MK_SINGLE && IN((k) + 1)) xcd_barrier(bar); } while (0)
    const float* MOD = (const float*)(ws + WS_MOD);
    bf16* A = (bf16*)(ws + WS_A); bf16* Pb = (bf16*)(ws + WS_P); bf16* Yb = (bf16*)(ws + WS_Y); bf16* Hb = (bf16*)(ws + WS_H);
    float* Gt = (float*)(ws + WS_G); float* XC = (float*)(ws + WS_XC); float* HF = (float*)(ws + WS_HF); float* HB = (float*)(ws + WS_HB);
    int* rw = (int*)(ws + WS_ROUTE);
    int* tok_e = (int*)(ws + WS_TOK); float* tok_w = (float*)(ws + WS_TOK + 256 * 1024); int* pair_pos = (int*)(ws + WS_TOK + 512 * 1024); float* row_w = (float*)(ws + WS_TOK + 768 * 1024);

    if (IN(0)) { REP(0) { if (rep_) __syncthreads(); prologue_phase(in, ws, lds, wg, G, tid); } SEAM(0); }
    if (IN(1)) { REP(1) { if (rep_) __syncthreads(); norm_phase<false>(in[0], in[2], true, in[4], MOD, 0, A, nullptr, nullptr, nullptr, nullptr, nullptr, lds, wg, G, tid); } SEAM(1); }
    if (IN(2)) { REP(2) { if (rep_) __syncthreads(); pg8::Gemm g{A, (const bf16*)(ws + WS_WIN), MROWS, PLD, D}; pg8::StaticOrder S; S.init(MROWS, PLD, G, wg); pg8::EpiP E{Pb, Gt};
        pg8::gemm_phase<pg8::EpiP, pg8::StaticOrder, true, true>(lds, g, S, E); } SEAM(2); }
    if (IN(3)) { REP(3) { if (rep_) __syncthreads(); mix_a_phase(in, ws, 0, true, lds, wg, G, tid); } SEAM(3); }
    if (IN(4)) { REP(4) { if (rep_) __syncthreads(); mlstm_m2_phase(ws, wg, G, tid); REP(21) { if (rep_) __syncthreads(); fourier_b_phase((const bf16*)(ws + WS_FA), Yb, lds, wg, G, tid); } } SEAM(4); }
    if (IN(5)) { REP(5) { if (rep_) __syncthreads(); for (int t = wg; t < 16 * NCHK; t += G) mlstm_m3_task(Pb, Gt, in[9], in[10], ws, Yb, lds, t, tid); } SEAM(5); }
    if (IN(6)) { REP(6) { if (rep_) __syncthreads(); pg8::Gemm g{Yb, (const bf16*)(ws + WS_WOUT), MROWS, D, D}; pg8::StaticOrder S; S.init(MROWS, D, G, wg); pg8::EpiRes E{in[0], p.out, in[2], XC, MOD + 2 * D};
        pg8::gemm_phase<pg8::EpiRes, pg8::StaticOrder, true, true>(lds, g, S, E); } SEAM(6); }
    if (IN(7)) { REP(7) { if (rep_) __syncthreads(); norm_phase<false>(p.out, XC, true, in[5], MOD, 3, A, nullptr, nullptr, nullptr, nullptr, nullptr, lds, wg, G, tid); } SEAM(7); }
    if (IN(8)) { REP(8) { if (rep_) __syncthreads(); pg8::Gemm g{A, (const bf16*)(ws + WS_WGU), MROWS, 2 * FFH, D}; pg8::StaticOrder S; S.init(MROWS, 2 * FFH, G, wg); pg8::EpiSwiglu E{Hb};
        pg8::gemm_phase<pg8::EpiSwiglu, pg8::StaticOrder, true, true>(lds, g, S, E); } SEAM(8); }
    if (IN(9)) { REP(9) { if (rep_) __syncthreads(); pg8::Gemm g{Hb, (const bf16*)(ws + WS_WD), MROWS, D, FFH}; pg8::StaticOrder S; S.init(MROWS, D, G, wg); pg8::EpiRes E{p.out, p.out, XC, XC, MOD + 5 * D};
        pg8::gemm_phase<pg8::EpiRes, pg8::StaticOrder, true, true>(lds, g, S, E); } SEAM(9); }
    const float* MOD1 = MOD + 5 * 6144;
    if (IN(10)) { REP(10) { if (rep_) __syncthreads(); norm_phase<false>(p.out, XC, true, in[4] + D, MOD1, 0, A, nullptr, nullptr, nullptr, nullptr, nullptr, lds, wg, G, tid); } SEAM(10); }
    if (IN(11)) { REP(11) { if (rep_) __syncthreads(); pg8::Gemm g{A, (const bf16*)(ws + WS_WIN) + (size_t)PLD * D, MROWS, PLD, D}; pg8::StaticOrder S; S.init(MROWS, PLD, G, wg); pg8::EpiP E{Pb, Gt};
        pg8::gemm_phase<pg8::EpiP, pg8::StaticOrder, true, true>(lds, g, S, E); } SEAM(11); }
    if (IN(12)) { REP(12) { if (rep_) __syncthreads(); mix_a_phase(in, ws, 1, false, lds, wg, G, tid); } SEAM(12); }
    if (IN(13)) { REP(13) { if (rep_) __syncthreads(); mlstm_m2_phase(ws, wg, G, tid); REP(21) { if (rep_) __syncthreads(); fourier_b_phase((const bf16*)(ws + WS_FA), Yb, lds, wg, G, tid); } } SEAM(13); }
    if (IN(14)) { REP(14) { if (rep_) __syncthreads(); for (int t = wg; t < 16 * 128; t += G) mlstm_m3_task(Pb, Gt, in[9] + 16, in[10] + 512, ws, Yb, lds, (t >> 7) * NCHK + (t & 127), tid); } SEAM(14); }
    if (IN(15)) { REP(15) { if (rep_) __syncthreads(); pg8::Gemm g{Yb, (const bf16*)(ws + WS_WOUT) + (size_t)D * D, NLAT, D, D}; pg8::StaticOrder S; S.init(NLAT, D, G, wg); pg8::EpiRes E{p.out, p.out, XC, XC, MOD1 + 2 * D};
        pg8::gemm_phase<pg8::EpiRes, pg8::StaticOrder, true, true>(lds, g, S, E); } SEAM(15); }
    if (IN(16)) { REP(16) { if (rep_) __syncthreads(); norm_phase<true>(p.out, XC, false, in[5] + D, MOD1, 3, A, in[18], in[19], tok_e, tok_w, rw + RW_HIST, lds, wg, G, tid); } SEAM(16); }
    if (IN(17)) { REP(17) { if (rep_) __syncthreads(); route_phase(ws, lds, wg, G, tid); } SEAM(17); }
    if (IN(18)) { REP(18) { if (rep_) __syncthreads(); const int nT = rw[RW_NTILES]; pg8::Gemm g{(const bf16*)(ws + WS_ASORT), (const bf16*)(ws + WS_MWGU), nT * 256, NEXP * 2 * FFH, D};
        pg8::MoeOrder S; S.init_moe(nT, 22, rw + RW_TILE_E, G, wg); pg8::EpiSwiglu E{(bf16*)(ws + WS_HSORT)};
        pg8::gemm_phase<pg8::EpiSwiglu, pg8::MoeOrder, true, true>(lds, g, S, E); } SEAM(18); }
    if (IN(19)) { REP(19) { if (rep_) __syncthreads(); const int nT = rw[RW_NTILES]; pg8::Gemm g{(const bf16*)(ws + WS_HSORT), (const bf16*)(ws + WS_MWD), nT * 256, NEXP * D, FFH};
        pg8::MoeOrder S; S.init_moe(nT, 4, rw + RW_TILE_E, G, wg); pg8::EpiMoeDown E{(bf16*)(ws + WS_OPAIR), row_w};
        pg8::gemm_phase<pg8::EpiMoeDown, pg8::MoeOrder, true, true>(lds, g, S, E); } SEAM(19); }
    if (IN(20)) { final_phase(p.out, (const bf16*)(ws + WS_OPAIR), pair_pos, MOD1, in[22], wg, G, tid); }
#undef IN
#undef SEAM
}

extern "C" void kernel_launch(void* const* d_in, const int* in_sizes, int n_in, void* d_out, int out_size, void* d_ws, size_t ws_size, hipStream_t stream) {
    static int grid = 0;
    if (grid == 0) {
        if (n_in != 23 || in_sizes[0] != NLAT * D || out_size != NLAT * D || ws_size < WS_END) { fprintf(stderr, "kernel_launch: unexpected problem shape (n_in %d, out %d, ws %zu); nothing launched\n", n_in, out_size, ws_size); grid = -1; return; }
        int dev = 0, cus = 0;
        if (hipGetDevice(&dev) != hipSuccess || hipDeviceGetAttribute(&cus, hipDeviceAttributeMultiprocessorCount, dev) != hipSuccess) { grid = -1; return; }
        if (hipFuncSetAttribute((const void*)fwd_kernel, hipFuncAttributeMaxDynamicSharedMemorySize, LDS_BYTES) != hipSuccess) { fprintf(stderr, "kernel_launch: hipFuncSetAttribute failed\n"); grid = -1; return; }
        int per_cu = 0;
        if (hipOccupancyMaxActiveBlocksPerMultiprocessor(&per_cu, (const void*)fwd_kernel, NTHR, LDS_BYTES) != hipSuccess || per_cu < 1) { fprintf(stderr, "kernel_launch: occupancy query says %d blocks per CU\n", per_cu); }
        (void)hipGetLastError();
        grid = cus;
    }
    if (grid < 0) return;
    if (hipMemsetAsync((char*)d_ws + WS_CTL, 0, CTL_ZERO_BYTES, stream) != hipSuccess) return;
    Params p{};
    for (int i = 0; i < 23; ++i) p.in[i] = (const float*)d_in[i];
    p.out = (float*)d_out; p.ws = (unsigned char*)d_ws;
#if MK_SINGLE
    p.ph_lo = 0; p.ph_hi = NPH;
    hipLaunchKernelGGL(fwd_kernel, dim3(grid), dim3(NTHR), LDS_BYTES, stream, p);
#else
    for (int k = 0; k < NPH; ++k) { p.ph_lo = k; p.ph_hi = k + 1; hipLaunchKernelGGL(fwd_kernel, dim3(grid), dim3(NTHR), LDS_BYTES, stream, p); }
#endif
}
```

```cpp
#include <hip/hip_runtime.h>
#include <cstdio>
#include <cstdint>
namespace pg8 {
#define PG8_LAS __attribute__((address_space(3)))
typedef unsigned short bf16_t;
typedef short bf16x8 __attribute__((ext_vector_type(8)));
typedef float f32x4 __attribute__((ext_vector_type(4)));
typedef unsigned u32x4 __attribute__((ext_vector_type(4)));
constexpr int BM = 256, BK = 64, HALF = 128, HTB = HALF * BK * 2  , STAGE_BYTES = 8 * HTB, NXCD = 8, WGM = 8;

__host__ __device__ __forceinline__ int lds_byte(int r, int c) { const int st = (r >> 4) * 2 + (c >> 5), rr = r & 15, cc = c & 31, ob = rr * 64 + cc * 2; return st * 1024 + (ob ^ (((ob >> 9) & 1) << 5)); }
__host__ __device__ __forceinline__ void stage_rc(int b, int& R, int& C) { const int st = b / 1024, sb = b % 1024, swz = sb ^ (((sb >> 9) & 1) << 5); R = (st >> 1) * 16 + swz / 64; C = (st & 1) * 32 + (swz % 64) / 2; }
__host__ __device__ __forceinline__ int perm32(int rho) { const int n = rho >> 4, i = rho & 15; return 8 * (i >> 2) + 4 * n + (i & 3); }

struct Unit { int pm, pn; };
struct Gemm { const bf16_t* A; const bf16_t* Bt; int M, N, K; const int* rt = nullptr; };

struct StaticOrder {
    int nM, nN, nwg, G, c;
    __host__ __device__ void init(int M, int N, int G_, int c_) { nM = M / BM; nN = N / BM; nwg = nM * nN; G = G_; c = c_; }
    __host__ __device__ bool next(int i, Unit& u) const {
        const int L = i * G + c; if (L >= nwg) return false;
        int wgid = L; { const int q = nwg / NXCD, r = nwg % NXCD, xcd = wgid % NXCD, off = wgid / NXCD; wgid = (xcd < r ? xcd * (q + 1) : r * (q + 1) + (xcd - r) * q) + off; }
        const int nig = WGM * nN, gid = wgid / nig, fm = gid * WGM, gsz = (nM - fm) < WGM ? (nM - fm) : WGM;
        u.pm = fm + ((wgid % nig) % gsz); u.pn = (wgid % nig) / gsz; return true;
    }
    __device__ __forceinline__ void a_ready(const Unit&) const {}
    __device__ __forceinline__ void done(const Unit&) const {}
};

typedef float f32x2c __attribute__((ext_vector_type(2))); typedef __bf16 bf16x2c __attribute__((ext_vector_type(2)));
__device__ __forceinline__ unsigned cvt_pk_bf16(float lo, float hi) { const f32x2c v = {lo, hi}; const bf16x2c b = __builtin_convertvector(v, bf16x2c); return __builtin_bit_cast(unsigned, b); }
typedef int i32x8 __attribute__((ext_vector_type(8)));
typedef int i32x4 __attribute__((ext_vector_type(4)));
__device__ __forceinline__ i32x8 cat8(bf16x8 lo, bf16x8 hi) { const i32x4 a = __builtin_bit_cast(i32x4, lo), c = __builtin_bit_cast(i32x4, hi); return __builtin_shufflevector(a, c, 0, 1, 2, 3, 4, 5, 6, 7); }
__device__ __forceinline__ unsigned pk4_fp8(float a, float c, float d, float e) {
    a = __builtin_amdgcn_fmed3f(a, -448.f, 448.f); c = __builtin_amdgcn_fmed3f(c, -448.f, 448.f); d = __builtin_amdgcn_fmed3f(d, -448.f, 448.f); e = __builtin_amdgcn_fmed3f(e, -448.f, 448.f);
    int w = __builtin_amdgcn_cvt_pk_fp8_f32(a, c, 0, false); w = __builtin_amdgcn_cvt_pk_fp8_f32(d, e, w, true); return (unsigned)w; }
__device__ __forceinline__ float silu_f(float x) { return x * __builtin_amdgcn_rcpf(1.0f + __expf(-x)); }
struct EpiP {
    static constexpr bool PERM = true, AFTER_DRAIN = false;
    bf16_t* P; float* G;
    __device__ __forceinline__ void operator()(const f32x4 (&acc)[2][2][4][2], const Unit& u, int wr, int wc, int fr, int fq) const {
        const int row0 = u.pm * BM + wr * 64 + fr, col0 = u.pn * BM + wc * 32 + 8 * fq;
#pragma unroll
        for (int ai = 0; ai < 2; ++ai)
#pragma unroll
            for (int m = 0; m < 4; ++m) { bf16_t* rowp = P + (size_t)(row0 + ai * HALF + m * 16) * 3072 + col0;
#pragma unroll
                for (int bj = 0; bj < 2; ++bj) { const f32x4 v0 = acc[ai][bj][m][0], v1 = acc[ai][bj][m][1];
                    u32x4 w; w.x = cvt_pk_bf16(v0[0], v0[1]); w.y = cvt_pk_bf16(v0[2], v0[3]); w.z = cvt_pk_bf16(v1[0], v1[1]); w.w = cvt_pk_bf16(v1[2], v1[3]);
                    *(u32x4*)(rowp + bj * HALF) = w; } }
    }
};
struct EpiRes {
    static constexpr bool PERM = false, AFTER_DRAIN = false;
    const float* base_lat; float* out_lat; const float* base_ctx; float* out_ctx; const float* gate; float scale;
    __device__ __forceinline__ void operator()(const f32x4 (&acc)[2][2][4][2], const Unit& u, int wr, int wc, int fr, int fq) const {
        const bool lat = u.pm < 128;
        const float* base = lat ? base_lat + (size_t)u.pm * BM * 1024 : base_ctx + (size_t)(u.pm - 128) * BM * 1024;
        float* out = lat ? out_lat + (size_t)u.pm * BM * 1024 : out_ctx + (size_t)(u.pm - 128) * BM * 1024;
        const float* gv = gate + (size_t)(lat ? (u.pm >> 5) : 4) * 6144;
        const int row0 = wr * 64 + fr, col0 = u.pn * BM + wc * 32 + 4 * fq;
        f32x4 g4[2][2];
#pragma unroll
        for (int bj = 0; bj < 2; ++bj)
#pragma unroll
            for (int n = 0; n < 2; ++n) g4[bj][n] = *(const f32x4*)(gv + col0 + bj * HALF + n * 16) * scale;
#pragma unroll
        for (int ai = 0; ai < 2; ++ai)
#pragma unroll
            for (int m = 0; m < 4; ++m) { const size_t off = (size_t)(row0 + ai * HALF + m * 16) * 1024 + col0;
#pragma unroll
                for (int bj = 0; bj < 2; ++bj)
#pragma unroll
                    for (int n = 0; n < 2; ++n) { const f32x4 bv = *(const f32x4*)(base + off + bj * HALF + n * 16);
                        *(f32x4*)(out + off + bj * HALF + n * 16) = bv + g4[bj][n] * acc[ai][bj][m][n]; }
                asm volatile("" ::: "memory"); }
    }
};
struct MoeOrder : StaticOrder {
    const PG8_LAS int* tile_e; int nNe;
    __device__ void init_moe(int nTiles, int nNe_, const PG8_LAS int* te, int G_, int c_) { nM = nTiles; nN = nNe_; nwg = nM * nN; G = G_; c = c_; tile_e = te; nNe = nNe_; }
    __device__ bool next(int i, Unit& u) const { if (!StaticOrder::next(i, u)) return false; u.pn += __builtin_amdgcn_readfirstlane(tile_e[u.pm]) * nNe; return true; }
};
constexpr float F8_SWGU = 32.f, F8_SH = 8.f, F8_SWD = 64.f;
struct EpiSwigluF8 {
    static constexpr bool PERM = true, AFTER_DRAIN = false;
    unsigned char* H;
    __device__ __forceinline__ void operator()(const f32x4 (&acc)[2][2][4][2], const Unit& u, int wr, int wc, int fr, int fq) const {
        asm volatile("" : "+v"(fr), "+v"(fq));
        const int row0 = u.pm * BM + wr * 64 + fr, col0 = (u.pn % 22) * HALF + wc * 32 + 8 * fq; constexpr float inv = 1.0f / F8_SWGU;
#pragma unroll
        for (int ai = 0; ai < 2; ++ai)
#pragma unroll
            for (int m = 0; m < 4; ++m) { unsigned char* rowp = H + (size_t)(row0 + ai * HALF + m * 16) * 2816 + col0;
                float h[8];
#pragma unroll
                for (int n = 0; n < 2; ++n) { const f32x4 G4 = acc[ai][0][m][n], U4 = acc[ai][1][m][n]; constexpr float c1 = -1.4426950408889634f * inv, kk = 1.0f / (inv * inv * F8_SH);
                    const f32x4 t = G4 * c1; const f32x4 e = {__builtin_amdgcn_exp2f(t[0]), __builtin_amdgcn_exp2f(t[1]), __builtin_amdgcn_exp2f(t[2]), __builtin_amdgcn_exp2f(t[3])};
                    const f32x4 d = e * kk + kk; const f32x4 rr = {__builtin_amdgcn_rcpf(d[0]), __builtin_amdgcn_rcpf(d[1]), __builtin_amdgcn_rcpf(d[2]), __builtin_amdgcn_rcpf(d[3])};
                    const f32x4 hv = (G4 * U4) * rr; h[4 * n] = hv[0]; h[4 * n + 1] = hv[1]; h[4 * n + 2] = hv[2]; h[4 * n + 3] = hv[3]; }
                typedef unsigned u32x2v __attribute__((ext_vector_type(2))); u32x2v w; w.x = pk4_fp8(h[0], h[1], h[2], h[3]); w.y = pk4_fp8(h[4], h[5], h[6], h[7]);
                *(u32x2v*)rowp = w; }
    }
};
struct EpiMoeDownF8 {
    static constexpr bool PERM = true, AFTER_DRAIN = false;
    bf16_t* O; const float* roww;
    __device__ __forceinline__ void operator()(const f32x4 (&acc)[2][2][4][2], const Unit& u, int wr, int wc, int fr, int fq) const {
        asm volatile("" : "+v"(fr), "+v"(fq));
        const int row0 = u.pm * BM + wr * 64 + fr, col0 = (u.pn & 3) * BM + wc * 32 + 8 * fq;
#pragma unroll
        for (int ai = 0; ai < 2; ++ai)
#pragma unroll
            for (int m = 0; m < 4; ++m) { const int r = row0 + ai * HALF + m * 16; const float s = roww[r] * (1.0f / (F8_SH * F8_SWD)); bf16_t* rowp = O + (size_t)r * 1024 + col0;
#pragma unroll
                for (int bj = 0; bj < 2; ++bj) { const f32x4 v0 = acc[ai][bj][m][0] * s, v1 = acc[ai][bj][m][1] * s;
                    u32x4 w; w.x = cvt_pk_bf16(v0[0], v0[1]); w.y = cvt_pk_bf16(v0[2], v0[3]); w.z = cvt_pk_bf16(v1[0], v1[1]); w.w = cvt_pk_bf16(v1[2], v1[3]);
                    *(u32x4*)(rowp + bj * HALF) = w; }
                asm volatile("" ::: "memory"); }
    }
};
struct EpiSwigluToF8 {
    static constexpr bool PERM = true, AFTER_DRAIN = false;
    unsigned char* H;
    __device__ __forceinline__ void operator()(const f32x4 (&acc)[2][2][4][2], const Unit& u, int wr, int wc, int fr, int fq) const {
        asm volatile("" : "+v"(fr), "+v"(fq));
        const int row0 = u.pm * BM + wr * 64 + fr, col0 = (u.pn % 22) * HALF + wc * 32 + 8 * fq;
#pragma unroll
        for (int ai = 0; ai < 2; ++ai)
#pragma unroll
            for (int m = 0; m < 4; ++m) { unsigned char* rowp = H + (size_t)(row0 + ai * HALF + m * 16) * 2816 + col0;
                float h[8];
#pragma unroll
                for (int n = 0; n < 2; ++n) { const f32x4 G4 = acc[ai][0][m][n], U4 = acc[ai][1][m][n]; constexpr float c1 = -1.4426950408889634f, kk = 1.0f / F8_SH;
                    const f32x4 t = G4 * c1; const f32x4 e = {__builtin_amdgcn_exp2f(t[0]), __builtin_amdgcn_exp2f(t[1]), __builtin_amdgcn_exp2f(t[2]), __builtin_amdgcn_exp2f(t[3])};
                    const f32x4 d = e * kk + kk; const f32x4 rr = {__builtin_amdgcn_rcpf(d[0]), __builtin_amdgcn_rcpf(d[1]), __builtin_amdgcn_rcpf(d[2]), __builtin_amdgcn_rcpf(d[3])};
                    const f32x4 hv = (G4 * U4) * rr; h[4 * n] = hv[0]; h[4 * n + 1] = hv[1]; h[4 * n + 2] = hv[2]; h[4 * n + 3] = hv[3]; }
                typedef unsigned u32x2v __attribute__((ext_vector_type(2))); u32x2v w; w.x = pk4_fp8(h[0], h[1], h[2], h[3]); w.y = pk4_fp8(h[4], h[5], h[6], h[7]);
                *(u32x2v*)rowp = w; }
    }
};
struct EpiResLean {
    static constexpr bool PERM = false, AFTER_DRAIN = false;
    const float* base_lat; float* out_lat; const float* base_ctx; float* out_ctx; const float* gate; float scale;
    __device__ __forceinline__ void operator()(const f32x4 (&acc)[2][2][4][2], const Unit& u, int wr, int wc, int fr, int fq) const {
        asm volatile("" : "+v"(fr), "+v"(fq));
        const bool lat = u.pm < 128;
        const float* base = lat ? base_lat + (size_t)u.pm * BM * 1024 : base_ctx + (size_t)(u.pm - 128) * BM * 1024;
        float* out = lat ? out_lat + (size_t)u.pm * BM * 1024 : out_ctx + (size_t)(u.pm - 128) * BM * 1024;
        const float* gv = gate + (size_t)(lat ? (u.pm >> 5) : 4) * 6144;
        const int row0 = wr * 64 + fr, col0 = u.pn * BM + wc * 32 + 4 * fq;
#pragma unroll
        for (int bj = 0; bj < 2; ++bj)
#pragma unroll
            for (int n = 0; n < 2; ++n) { const f32x4 g4 = *(const f32x4*)(gv + col0 + bj * HALF + n * 16) * scale;
#pragma unroll
                for (int ai = 0; ai < 2; ++ai)
#pragma unroll
                    for (int m = 0; m < 4; ++m) { const size_t off = (size_t)(row0 + ai * HALF + m * 16) * 1024 + col0 + bj * HALF + n * 16;
                        const f32x4 bv = *(const f32x4*)(base + off); *(f32x4*)(out + off) = bv + g4 * acc[ai][bj][m][n]; }
                asm volatile("" ::: "memory"); }
    }
};
template <bool BASE_F32> struct EpiResB {
    static constexpr bool PERM = true, AFTER_DRAIN = false;
    const void* base_lat; bf16_t* out_lat; const void* base_ctx; bf16_t* out_ctx; const float* gate; float scale;
    __device__ __forceinline__ void operator()(const f32x4 (&acc)[2][2][4][2], const Unit& u, int wr, int wc, int fr, int fq) const {
        asm volatile("" : "+v"(fr), "+v"(fq));
        const bool lat = u.pm < 128; const size_t ro = (size_t)(lat ? u.pm : u.pm - 128) * BM * 1024;
        const void* base = lat ? base_lat : base_ctx; bf16_t* out = lat ? out_lat : out_ctx;
        const float* gv = gate + (size_t)(lat ? (u.pm >> 5) : 4) * 6144;
        const int row0 = wr * 64 + fr, col0 = u.pn * BM + wc * 32 + 8 * fq;
#pragma unroll
        for (int bj = 0; bj < 2; ++bj) { const f32x4 g0 = *(const f32x4*)(gv + col0 + bj * HALF) * scale, g1 = *(const f32x4*)(gv + col0 + bj * HALF + 4) * scale;
#pragma unroll
            for (int ai = 0; ai < 2; ++ai)
#pragma unroll
                for (int m = 0; m < 4; ++m) { const size_t off = ro + (size_t)(row0 + ai * HALF + m * 16) * 1024 + col0 + bj * HALF; f32x4 b0, b1;
                    if constexpr (BASE_F32) { b0 = *(const f32x4*)((const float*)base + off); b1 = *(const f32x4*)((const float*)base + off + 4); }
                    else { const u32x4 w = *(const u32x4*)((const bf16_t*)base + off);
                        b0 = (f32x4){__builtin_bit_cast(float, w.x << 16), __builtin_bit_cast(float, w.x & 0xffff0000u), __builtin_bit_cast(float, w.y << 16), __builtin_bit_cast(float, w.y & 0xffff0000u)};
                        b1 = (f32x4){__builtin_bit_cast(float, w.z << 16), __builtin_bit_cast(float, w.z & 0xffff0000u), __builtin_bit_cast(float, w.w << 16), __builtin_bit_cast(float, w.w & 0xffff0000u)}; }
                    const f32x4 v0 = b0 + g0 * acc[ai][bj][m][0], v1 = b1 + g1 * acc[ai][bj][m][1];
                    u32x4 o; o.x = cvt_pk_bf16(v0[0], v0[1]); o.y = cvt_pk_bf16(v0[2], v0[3]); o.z = cvt_pk_bf16(v1[0], v1[1]); o.w = cvt_pk_bf16(v1[2], v1[3]);
                    *(u32x4*)(out + off) = o; }
            asm volatile("" ::: "memory"); }
    }
};
#ifndef F8_SCALE
#define F8_SCALE 0
#endif
template <class Epi, class Sched, bool ALIGN_EPI = false, bool SP2 = false, bool F8 = false, bool GA = false>
__device__ __forceinline__ void gemm_phase(PG8_LAS unsigned char* lds, const Gemm g, const Sched& S, const Epi& E, const int tid) {
    const int wid = __builtin_amdgcn_readfirstlane(tid >> 6), lane = tid & 63, wr = wid >> 2, wc = wid & 3, fr = lane & 15, fq = lane >> 4;
    const int K = g.K, nt = K / BK;
    unsigned voffA[2], voffB[2];
#pragma unroll
    for (int i = 0; i < 2; ++i) { int R, C; stage_rc(tid * 16 + i * 8192, R, C); const int Rb = Epi::PERM ? ((R & ~31) + perm32(R & 31)) : R;
        voffA[i] = (unsigned)(R * K + C) * 2u; voffB[i] = (unsigned)(Rb * K + C) * 2u; }
    const unsigned kstep = (unsigned)(BK * 2);
    const unsigned hstep = (unsigned)HALF * (unsigned)K * 2u;
    const unsigned tstep = 2u * hstep;
    const unsigned ldsw = (unsigned)wid * 1024u;
    const __amdgpu_buffer_rsrc_t rsA = __builtin_amdgcn_make_buffer_rsrc((void*)g.A, 0, 0x7fffffff, 0x00020000), rsB = __builtin_amdgcn_make_buffer_rsrc((void*)g.Bt, 0, 0x7fffffff, 0x00020000);
    static_assert(!GA || SP2, "gathered A: SP2 body only");
    constexpr int GA_TAB = STAGE_BYTES + 4096;
    const __amdgpu_buffer_rsrc_t rsT = __builtin_amdgcn_make_buffer_rsrc((void*)g.rt, 0, 0x7fffffff, 0x00020000);
    unsigned vG[2][2]; int gaR = 0; unsigned gaC = 0;
    if constexpr (GA) { int R, C; stage_rc(tid * 16, R, C); gaR = R; gaC = (unsigned)C * 2u; }
#define PG8_GA_FETCH(pm_) do { const unsigned so_ = (unsigned)__builtin_amdgcn_readfirstlane((int)((unsigned)(pm_) * 1024u)); \
        __builtin_amdgcn_raw_ptr_buffer_load_lds(rsT, (PG8_LAS unsigned*)(lds + GA_TAB + wid * 256), 4, (unsigned)(((wid & 3) * 64 + lane) * 4), so_, 0, 0); } while (0)
#define PG8_GA_TAKE() do { const PG8_LAS int* tb_ = (const PG8_LAS int*)(lds + GA_TAB); _Pragma("unroll") for (int h_ = 0; h_ < 2; ++h_) _Pragma("unroll") for (int i_ = 0; i_ < 2; ++i_) \
        vG[h_][i_] = (unsigned)tb_[h_ * 128 + i_ * 64 + gaR] * (unsigned)(K * 2) + gaC; } while (0)
    const int aoff = lds_byte(wr * 64 + fr, fq * 8), boff = lds_byte(wc * 32 + fr, fq * 8);
#define PG8_SA(b, h) (((b) * 2 + (h)) * HTB)
#define PG8_SB(b, h) ((4 + (b) * 2 + (h)) * HTB)
#define PG8_STAGE(rs, bufoff, soff, voff) do { const unsigned so_ = (unsigned)__builtin_amdgcn_readfirstlane((int)(soff)); _Pragma("unroll") for (int _i = 0; _i < 2; ++_i) \
        __builtin_amdgcn_raw_ptr_buffer_load_lds(rs, (PG8_LAS unsigned*)(lds + (bufoff) + ldsw + _i * 8192), 16, (voff)[_i], so_, 0, 0); } while (0)
#define PG8_STA(bufoff, soff, h_) do { if constexpr (GA) { const unsigned so_ = (unsigned)__builtin_amdgcn_readfirstlane((int)(soff)); _Pragma("unroll") for (int _i = 0; _i < 2; ++_i) \
        __builtin_amdgcn_raw_ptr_buffer_load_lds(rsA, (PG8_LAS unsigned*)(lds + (bufoff) + ldsw + _i * 8192), 16, vG[h_][_i], so_, 0, 0); } else PG8_STAGE(rsA, bufoff, (soff) + (h_) * hstep, voffA); } while (0)
#define PG8_WAIT_V8(first_) do { if (GA && (first_)) PG8_WAIT_V(9); else PG8_WAIT_V(8); } while (0)
#define PG8_LDA(dst, b, h) do { if constexpr (F8) { _Pragma("unroll") for (int m = 0; m < 4; ++m) dst##8[m] = cat8(*(const PG8_LAS bf16x8*)(lds + PG8_SA(b, h) + aoff + m * 2048), *(const PG8_LAS bf16x8*)(lds + PG8_SA(b, h) + aoff + m * 2048 + 1024)); } \
        else { _Pragma("unroll") for (int m = 0; m < 4; ++m) _Pragma("unroll") for (int k = 0; k < 2; ++k) dst[m][k] = *(const PG8_LAS bf16x8*)(lds + PG8_SA(b, h) + aoff + m * 2048 + k * 1024); } } while (0)
#define PG8_LDB(dst, b, h) do { if constexpr (F8) { _Pragma("unroll") for (int n = 0; n < 2; ++n) dst##8[n] = cat8(*(const PG8_LAS bf16x8*)(lds + PG8_SB(b, h) + boff + n * 2048), *(const PG8_LAS bf16x8*)(lds + PG8_SB(b, h) + boff + n * 2048 + 1024)); } \
        else { _Pragma("unroll") for (int n = 0; n < 2; ++n) _Pragma("unroll") for (int k = 0; k < 2; ++k) dst[n][k] = *(const PG8_LAS bf16x8*)(lds + PG8_SB(b, h) + boff + n * 2048 + k * 1024); } } while (0)
#define PG8_MMA(ai, bj, At, Bt) do { __builtin_amdgcn_s_setprio(1); if constexpr (F8) { _Pragma("unroll") for (int m = 0; m < 4; ++m) _Pragma("unroll") for (int n = 0; n < 2; ++n) \
        acc[ai][bj][m][n] = __builtin_amdgcn_mfma_scale_f32_16x16x128_f8f6f4(Bt##8[n], At##8[m], acc[ai][bj][m][n], 0, 0, 0, F8_SCALE, 0, F8_SCALE); } \
        else { _Pragma("unroll") for (int m = 0; m < 4; ++m) _Pragma("unroll") for (int n = 0; n < 2; ++n) _Pragma("unroll") for (int k = 0; k < 2; ++k) \
        acc[ai][bj][m][n] = __builtin_amdgcn_mfma_f32_16x16x32_bf16(Bt[n][k], At[m][k], acc[ai][bj][m][n], 0, 0, 0); } __builtin_amdgcn_s_setprio(0); } while (0)
#define PG8_WAIT_V(n) asm volatile("s_waitcnt vmcnt(" #n ")" ::: "memory")
#define PG8_WAIT_L(n) asm volatile("s_waitcnt lgkmcnt(" #n ")" ::: "memory")
#define PG8_BAR __builtin_amdgcn_s_barrier()
#define PG8_SCHED __builtin_amdgcn_sched_barrier(0)
    Unit cur, nxt; int ui = 0;
    if (!S.next(0, cur)) return;
    f32x4 acc[2][2][4][2];
#pragma unroll
    for (int a = 0; a < 2; ++a)
#pragma unroll
        for (int b = 0; b < 2; ++b)
#pragma unroll
            for (int m = 0; m < 4; ++m)
#pragma unroll
                for (int n = 0; n < 2; ++n) acc[a][b][m][n] = (f32x4){0.f, 0.f, 0.f, 0.f};
    bf16x8 At[4][2], B0[2][2], B1[2][2]; i32x8 At8[4], B08[2], B18[2];
    unsigned cA = GA ? 0u : (unsigned)cur.pm * tstep, cB = (unsigned)cur.pn * tstep;
    if constexpr (GA) { _Pragma("unroll") for (int h_ = 0; h_ < 2; ++h_) _Pragma("unroll") for (int i_ = 0; i_ < 2; ++i_) vG[h_][i_] = (unsigned)g.rt[cur.pm * 256 + h_ * 128 + i_ * 64 + gaR] * (unsigned)(K * 2) + gaC; }
    S.a_ready(cur);
    if constexpr (SP2) {
        PG8_STAGE(rsB, PG8_SB(0, 0), cB, voffB); PG8_STAGE(rsB, PG8_SB(0, 1), cB + hstep, voffB); PG8_STA(PG8_SA(0, 0), cA, 0); PG8_STA(PG8_SA(0, 1), cA, 1);
        if (wr == 1) PG8_BAR;
        PG8_WAIT_V(2); PG8_BAR;
        PG8_STAGE(rsB, PG8_SB(1, 0), cB + kstep, voffB); PG8_STA(PG8_SA(1, 0), cA + kstep, 0); PG8_STAGE(rsB, PG8_SB(1, 1), cB + hstep + kstep, voffB);
        PG8_WAIT_V(6); PG8_BAR;
    } else {
        PG8_STAGE(rsB, PG8_SB(0, 0), cB, voffB); PG8_STAGE(rsA, PG8_SA(0, 0), cA, voffA); PG8_STAGE(rsB, PG8_SB(0, 1), cB + hstep, voffB); PG8_STAGE(rsA, PG8_SA(0, 1), cA + hstep, voffA);
        if (wr == 1) PG8_BAR;
        PG8_WAIT_V(4); PG8_BAR;
        PG8_STAGE(rsB, PG8_SB(1, 0), cB + kstep, voffB); PG8_STAGE(rsA, PG8_SA(1, 0), cA + kstep, voffA); PG8_STAGE(rsB, PG8_SB(1, 1), cB + hstep + kstep, voffB);
        PG8_WAIT_V(6); PG8_BAR;
    }
    for (;;) {
        const bool has_next = S.next(ui + 1, nxt);
        const unsigned nA = (has_next && !GA) ? (unsigned)nxt.pm * tstep : cA, nB = has_next ? (unsigned)nxt.pn * tstep : cB;
        if constexpr (GA) PG8_GA_FETCH(has_next ? nxt.pm : cur.pm);
#pragma unroll 1
        for (int t = 0; t < nt; t += 2) {
            const bool last = (t == nt - 2);
            const unsigned a1 = cA + (unsigned)(t + 1) * kstep;
            const unsigned a2 = last ? nA : cA + (unsigned)(t + 2) * kstep, b2 = last ? nB : cB + (unsigned)(t + 2) * kstep;
            const unsigned a3 = a2 + kstep, b3 = b2 + kstep;
            if (last && has_next) S.a_ready(nxt);
            if constexpr (SP2) {
            PG8_LDB(B0, 0, 0); PG8_LDB(B1, 0, 1); PG8_SCHED; PG8_LDA(At, 0, 0); PG8_STA(PG8_SA(1, 1), a1, 1);
            PG8_WAIT_V8(t == 0); PG8_WAIT_L(0); PG8_BAR; PG8_MMA(0, 0, At, B0); PG8_MMA(0, 1, At, B1); PG8_BAR; PG8_SCHED;
            if constexpr (GA) { if (last) PG8_GA_TAKE(); }
            PG8_LDA(At, 0, 1); PG8_STAGE(rsB, PG8_SB(0, 0), b2, voffB); PG8_STAGE(rsB, PG8_SB(0, 1), b2 + hstep, voffB); PG8_STA(PG8_SA(0, 0), a2, 0);
            PG8_WAIT_V8(t == 0); PG8_WAIT_L(0); PG8_BAR; PG8_MMA(1, 0, At, B0); PG8_MMA(1, 1, At, B1); PG8_BAR; PG8_SCHED;
            PG8_LDB(B0, 1, 0); PG8_LDB(B1, 1, 1); PG8_SCHED; PG8_LDA(At, 1, 0); PG8_STA(PG8_SA(0, 1), a2, 1);
            PG8_WAIT_V(8); PG8_WAIT_L(0); PG8_BAR; PG8_MMA(0, 0, At, B0); PG8_MMA(0, 1, At, B1); PG8_BAR; PG8_SCHED;
            PG8_LDA(At, 1, 1); PG8_STAGE(rsB, PG8_SB(1, 0), b3, voffB); PG8_STAGE(rsB, PG8_SB(1, 1), b3 + hstep, voffB); PG8_STA(PG8_SA(1, 0), a3, 0);
            PG8_WAIT_V(8); PG8_WAIT_L(0); PG8_BAR; PG8_MMA(1, 0, At, B0); PG8_MMA(1, 1, At, B1); PG8_BAR; PG8_SCHED;
            } else {
            PG8_LDB(B0, 0, 0); PG8_SCHED; PG8_LDA(At, 0, 0); PG8_STAGE(rsA, PG8_SA(1, 1), a1 + hstep, voffA);
            PG8_WAIT_L(8); PG8_BAR; PG8_WAIT_L(0); PG8_MMA(0, 0, At, B0); PG8_BAR; PG8_SCHED;
            PG8_LDB(B1, 0, 1); PG8_STAGE(rsB, PG8_SB(0, 0), b2, voffB);
            PG8_BAR; PG8_WAIT_L(0); PG8_MMA(0, 1, At, B1); PG8_BAR;
            PG8_LDA(At, 0, 1); PG8_STAGE(rsA, PG8_SA(0, 0), a2, voffA);
            PG8_BAR; PG8_WAIT_L(0); PG8_MMA(1, 0, At, B0); PG8_BAR; PG8_SCHED;
            PG8_STAGE(rsB, PG8_SB(0, 1), b2 + hstep, voffB);
            PG8_WAIT_V(6); PG8_BAR; PG8_MMA(1, 1, At, B1); PG8_BAR;
            PG8_LDB(B0, 1, 0); PG8_SCHED; PG8_LDA(At, 1, 0); PG8_STAGE(rsA, PG8_SA(0, 1), a2 + hstep, voffA);
            PG8_WAIT_L(8); PG8_BAR; PG8_WAIT_L(0); PG8_MMA(0, 0, At, B0); PG8_BAR; PG8_SCHED;
            PG8_LDB(B1, 1, 1); PG8_STAGE(rsB, PG8_SB(1, 0), b3, voffB);
            PG8_BAR; PG8_WAIT_L(0); PG8_MMA(0, 1, At, B1); PG8_BAR;
            PG8_LDA(At, 1, 1); PG8_STAGE(rsA, PG8_SA(1, 0), a3, voffA);
            PG8_BAR; PG8_WAIT_L(0); PG8_MMA(1, 0, At, B0); PG8_BAR; PG8_SCHED;
            PG8_STAGE(rsB, PG8_SB(1, 1), b3 + hstep, voffB);
            PG8_WAIT_V(6); PG8_BAR; PG8_MMA(1, 1, At, B1); PG8_BAR;
            }
        }
        if constexpr (ALIGN_EPI) { if (wr == 0) PG8_BAR; }
        if constexpr (!Epi::AFTER_DRAIN) { E(acc, cur, wr, wc, fr, fq);
#if defined(EPI_DUP) && EPI_DUP
            if constexpr (Epi::PERM) { asm volatile("" ::: "memory"); E(acc, cur, wr, wc, fr, fq); }
#endif
            S.done(cur); }
        if (!has_next) break;
#pragma unroll
        for (int a = 0; a < 2; ++a)
#pragma unroll
            for (int b = 0; b < 2; ++b)
#pragma unroll
                for (int m = 0; m < 4; ++m)
#pragma unroll
                    for (int n = 0; n < 2; ++n) acc[a][b][m][n] = (f32x4){0.f, 0.f, 0.f, 0.f};
        cur = nxt; cA = nA; cB = nB; ++ui;
        if constexpr (ALIGN_EPI) { if (wr == 1) PG8_BAR; }
    }
    PG8_WAIT_V(0);
    if constexpr (!ALIGN_EPI) { if (wr == 0) PG8_BAR; }
    PG8_BAR;
    if constexpr (Epi::AFTER_DRAIN) { E.fused(acc, cur, wr, wc, fr, fq, lds, wid, lane); S.done(cur); }
#undef PG8_SA
#undef PG8_SB
#undef PG8_STAGE
#undef PG8_STA
#undef PG8_WAIT_V8
#undef PG8_GA_FETCH
#undef PG8_GA_TAKE
#undef PG8_LDA
#undef PG8_LDB
#undef PG8_MMA
#undef PG8_WAIT_V
#undef PG8_WAIT_L
#undef PG8_BAR
#undef PG8_SCHED
}
}
using pg8::silu_f;

constexpr int D = 1024, BATCH = 4, SEQ = 8192, CTXL = 256, NLAT = BATCH * SEQ, NCTX = BATCH * CTXL, MROWS = NLAT + NCTX;
constexpr int PIN_SRC = 2832, PLD = 3072, FFH = 2816, NEXP = 8;
constexpr int PO_Q = 0, PO_K = 512, PO_V = 1024, PO_O = 1536, PO_F = 2048, PO_CU = 2304, PO_CG = 2560;
constexpr float EPS = 1e-6f;
constexpr int NWAVES = 8, NTHR = 512;
constexpr size_t MiB = 1u << 20;
constexpr size_t WS_CTL = 0, CTL_ZERO_BYTES = 64 * 1024;
constexpr size_t WS_MOD = 1 * MiB;
constexpr size_t WS_ROUTE = 1 * MiB + 512 * 1024;
constexpr size_t WS_WIN = 2 * MiB;
constexpr size_t WS_WOUT = 14 * MiB;
constexpr size_t WS_WGU = 18 * MiB;
constexpr size_t WS_WD = 29 * MiB;
constexpr size_t WS_MWGU = 35 * MiB;
constexpr size_t WS_MWD = 79 * MiB;
constexpr size_t WS_XB = 101 * MiB;
constexpr size_t WS_XCB = 165 * MiB;
constexpr size_t WS_G = 167 * MiB;
constexpr size_t WS_XC = 170 * MiB;
constexpr size_t WS_TOK = 174 * MiB;
constexpr size_t WS_R1 = 176 * MiB;
constexpr size_t WS_Y = WS_R1, WS_HF = WS_R1 + 66 * MiB, WS_ASORT = WS_R1, WS_OPAIR = WS_R1;
constexpr size_t WS_R2 = 308 * MiB;
constexpr size_t WS_P = WS_R2, WS_H = WS_R2, WS_A = WS_R2 + 198 * MiB, WS_HB = WS_R2 + 264 * MiB, WS_HSORT = WS_R2;
constexpr size_t WS_END = 671 * MiB;
constexpr int MAXPAIR = 2 * NLAT + NEXP * 256;
static_assert(WS_WIN + (size_t)2 * PLD * D * 2 <= WS_WOUT && WS_WOUT + (size_t)2 * D * D * 2 <= WS_WGU && WS_WGU + (size_t)2 * FFH * D * 2 <= WS_WD && WS_WD + (size_t)D * FFH * 2 <= WS_MWGU, "ws map 1");
static_assert(WS_MWGU + (size_t)NEXP * 2 * FFH * D <= WS_MWD && WS_MWD + (size_t)NEXP * D * FFH <= WS_XB && WS_XB + (size_t)NLAT * D * 2 <= WS_XCB && WS_XCB + (size_t)NCTX * D * 2 <= WS_G && WS_G + (size_t)MROWS * 16 * 4 <= WS_XC && WS_XC + (size_t)NCTX * D * 4 <= WS_TOK, "ws map 2");
constexpr size_t WS_ROWTOK = WS_TOK + (768 + 264) * 1024;
static_assert(WS_TOK + 3 * 256 * 1024 + (size_t)MAXPAIR * 4 * 2 <= WS_R1 && WS_Y + (size_t)MROWS * D * 2 <= WS_HF && WS_HF + (size_t)MROWS * 512 * 4 <= WS_R2 && WS_ASORT + (size_t)MAXPAIR * D * 2 <= WS_R2, "ws map 3");
static_assert(WS_P + (size_t)MROWS * PLD * 2 <= WS_A && WS_A + (size_t)MROWS * D * 2 <= WS_HB && WS_HB + (size_t)MROWS * 512 * 4 <= WS_END && WS_HSORT + (size_t)MAXPAIR * FFH * 2 <= WS_END && WS_H + (size_t)MROWS * FFH * 2 <= WS_A, "ws map 4");
constexpr int CW_BAR = 4096;
static_assert((size_t)(CW_BAR + 3456) * 4 <= CTL_ZERO_BYTES, "barrier words inside the per-call memset");
constexpr int RW_HIST = 0;
constexpr int RW_TILE_E = 4096;
constexpr int RW_NTILES = 4096 + 512;
constexpr int LDS_STAGE = 131072, LDSCTL_OFF = LDS_STAGE, LDS_BYTES = 147456;

#define GAS __attribute__((address_space(1)))
#define LAS __attribute__((address_space(3)))
typedef unsigned short bf16;
typedef unsigned v4u __attribute__((ext_vector_type(4)));
typedef unsigned v2u __attribute__((ext_vector_type(2)));
typedef float f32x4 __attribute__((ext_vector_type(4)));
typedef float f32x2_t __attribute__((ext_vector_type(2))); typedef __bf16 bf16x2_t __attribute__((ext_vector_type(2)));
__device__ __forceinline__ unsigned pk2(float lo, float hi) { const f32x2_t v = {lo, hi}; const bf16x2_t b = __builtin_convertvector(v, bf16x2_t); return __builtin_bit_cast(unsigned, b); }
__device__ __forceinline__ unsigned f2bf(float f) { return pk2(f, f) & 0xffffu; }
__device__ __forceinline__ float bf2f(unsigned short b) { return __builtin_bit_cast(float, (unsigned)b << 16); }
__device__ __forceinline__ float bflo(unsigned w) { return __builtin_bit_cast(float, w << 16); }
__device__ __forceinline__ float bfhi(unsigned w) { return __builtin_bit_cast(float, w & 0xffff0000u); }
__device__ __forceinline__ float dpp_f(float v, const int ctrl_sel) {
    const int x = __builtin_bit_cast(int, v); int r;
    if (ctrl_sel == 0) r = __builtin_amdgcn_update_dpp(0, x, 0xB1, 0xF, 0xF, true);
    else if (ctrl_sel == 1) r = __builtin_amdgcn_update_dpp(0, x, 0x4E, 0xF, 0xF, true);
    else if (ctrl_sel == 2) r = __builtin_amdgcn_update_dpp(0, x, 0x141, 0xF, 0xF, true);
    else r = __builtin_amdgcn_update_dpp(0, x, 0x140, 0xF, 0xF, true);
    return __builtin_bit_cast(float, r);
}
__device__ __forceinline__ float row16_sum(float v) { v += dpp_f(v, 0); v += dpp_f(v, 1); v += dpp_f(v, 2); v += dpp_f(v, 3); return v; }
__device__ __forceinline__ float wave_sum(float v) {
    v = row16_sum(v);
    const int x = __builtin_bit_cast(int, v);
    const float r0 = __builtin_bit_cast(float, __builtin_amdgcn_readlane(x, 0)), r1 = __builtin_bit_cast(float, __builtin_amdgcn_readlane(x, 16));
    const float r2 = __builtin_bit_cast(float, __builtin_amdgcn_readlane(x, 32)), r3 = __builtin_bit_cast(float, __builtin_amdgcn_readlane(x, 48));
    return (r0 + r1) + (r2 + r3);
}
__device__ __forceinline__ float wave_total63(float v) {
    v = row16_sum(v);
    v += __builtin_bit_cast(float, __builtin_amdgcn_update_dpp(0, __builtin_bit_cast(int, v), 0x142, 0xA, 0xF, false));
    v += __builtin_bit_cast(float, __builtin_amdgcn_update_dpp(0, __builtin_bit_cast(int, v), 0x143, 0xC, 0xF, false));
    return __builtin_bit_cast(float, __builtin_amdgcn_readlane(__builtin_bit_cast(int, v), 63));
}
__device__ __forceinline__ float sigmoid_f(float x) { return __builtin_amdgcn_rcpf(1.0f + __expf(-x)); }
__device__ __forceinline__ float log_sigmoid_f(float x) { return fminf(x, 0.0f) - log1pf(__expf(-fabsf(x))); }

#define XB_TMO      128
#define XB_XCNT(j)  (256  + 64 * (j))
#define XB_XSUB(j)  (1280 + 64 * (j))
#define XB_XGEN(j)  (2304 + 64 * (j))
#define XB_TOP      3328
#define XB_TOPGEN   3392
#define XCD_BAR_WORDS 3456
#define XB_SPIN_CAP (1u << 18)
#define LAS __attribute__((address_space(3)))

__device__ __forceinline__ unsigned xb_ld(unsigned* p)              { return __hip_atomic_load(p, __ATOMIC_RELAXED, __HIP_MEMORY_SCOPE_AGENT); }
__device__ __forceinline__ unsigned xb_add(unsigned* p, unsigned v) { return __hip_atomic_fetch_add(p, v, __ATOMIC_RELAXED, __HIP_MEMORY_SCOPE_AGENT); }
__device__ __forceinline__ unsigned xb_xcc_id() { return (unsigned)__builtin_amdgcn_s_getreg((3 << 11) | 20) & 0xFu; }
#define XB_SPIN(cond, bar) do { unsigned _sp = 0; while (cond) { __builtin_amdgcn_s_sleep(1); \
    if ((++_sp & 255u) == 0u) { if (xb_ld(&(bar)[XB_TMO])) break; if (_sp > XB_SPIN_CAP) { atomicAdd(&(bar)[XB_TMO], 1u); break; } } } } while (0)

struct XcdBarrier {
    unsigned* bar; unsigned x;
    volatile LAS unsigned* st;
};

__device__ __forceinline__ XcdBarrier xcd_barrier_post(unsigned* bar, volatile LAS unsigned* st) {
    XcdBarrier b; b.bar = bar; b.x = xb_xcc_id(); b.st = st;
    if (threadIdx.x == 0) (void)xb_add(&bar[XB_XCNT(b.x)], 1u);
    return b;
}
__device__ __forceinline__ void xcd_barrier_complete(unsigned* bar, unsigned x, unsigned& nloc, unsigned& nx) {
    const unsigned G = gridDim.x * gridDim.y * gridDim.z;
    unsigned sum, cnt, mine, sp = 0u;
    for (;;) {
        sum = 0u; cnt = 0u; mine = 0u;
#pragma unroll
        for (unsigned j = 0; j < 16; ++j) { const unsigned c = xb_ld(&bar[XB_XCNT(j)]); sum += c; cnt += (c > 0u) ? 1u : 0u; mine = (j == x) ? c : mine; }
        if (sum == G) break;
        __builtin_amdgcn_s_sleep(1);
        if ((++sp & 255u) == 0u) { if (xb_ld(&bar[XB_TMO])) break; if (sp > XB_SPIN_CAP) { atomicAdd(&bar[XB_TMO], 1u); break; } }
    }
    nloc = mine > 0u ? mine : 1u; nx = cnt > 0u ? cnt : 1u;
}

__device__ __forceinline__ void xcd_barrier(const XcdBarrier& b, const int tid) {
    asm volatile("s_waitcnt vmcnt(0)" ::: "memory");
    __syncthreads();
    if (tid == 0) {
        unsigned* bar = b.bar;
        __builtin_amdgcn_s_waitcnt(0);
        unsigned nloc = b.st[0], nx = b.st[1];
        if (nloc == 0u) { xcd_barrier_complete(bar, b.x, nloc, nx); b.st[0] = nloc; b.st[1] = nx; }
        const unsigned old = xb_add(&bar[XB_XSUB(b.x)], 1u);
        const unsigned gen = old / nloc;
        if (old + 1u == (gen + 1u) * nloc) {
            __builtin_amdgcn_fence(__ATOMIC_RELEASE, "agent");
            asm volatile("s_waitcnt vmcnt(0)" ::: "memory");
            const unsigned og = xb_add(&bar[XB_TOP], 1u);
            const unsigned tg = og / nx;
            if (og + 1u == (tg + 1u) * nx) xb_add(&bar[XB_TOPGEN], 1u);
            else XB_SPIN(xb_ld(&bar[XB_TOPGEN]) == tg, bar);
            __builtin_amdgcn_fence(__ATOMIC_ACQUIRE, "agent");
            xb_add(&bar[XB_XGEN(b.x)], 1u);
            asm volatile("s_waitcnt vmcnt(0)" ::: "memory");
        } else {
            XB_SPIN(xb_ld(&bar[XB_XGEN(b.x)]) == gen, bar);
            __builtin_amdgcn_fence(__ATOMIC_ACQUIRE, "agent");
            asm volatile("s_waitcnt vmcnt(0)" ::: "memory");
        }
    }
    __syncthreads();
}
#define LDS_WAIT() asm volatile("s_waitcnt lgkmcnt(0)" ::: "memory")

__device__ __forceinline__ void transpose_item(const float* W, int K, int N, bf16* WT, int dst_row0, int src_col0, int nvalid, int kb, LAS float* scr, int lane) {
    const int k0 = 64 * kb, nl = lane & 31;
#pragma unroll 8
    for (int i = 0; i < 32; ++i) { const int kk = 2 * i + (lane >> 5); scr[kk * 33 + nl] = nl < nvalid ? W[(size_t)(k0 + kk) * N + src_col0 + nl] : 0.f; }
    LDS_WAIT();
    const int c = lane & 7;
#pragma unroll
    for (int j = 0; j < 4; ++j) { const int n = (lane >> 3) + 8 * j; const LAS float* s = scr + (8 * c) * 33 + n;
        v4u o; o.x = pk2(s[0 * 33], s[1 * 33]); o.y = pk2(s[2 * 33], s[3 * 33]); o.z = pk2(s[4 * 33], s[5 * 33]); o.w = pk2(s[6 * 33], s[7 * 33]);
        *(v4u*)(WT + (size_t)(dst_row0 + n) * K + k0 + 8 * c) = o; }
    LDS_WAIT();
}
__device__ __forceinline__ void transpose_item_f8(const float* W, int K, int N, unsigned char* WT, int dst_row0, int src_col0, int kb, float scale, LAS float* scr, int lane) {
    const int k0 = 64 * kb, nl = lane & 31;
#pragma unroll 8
    for (int i = 0; i < 32; ++i) { const int kk = 2 * i + (lane >> 5); scr[kk * 33 + nl] = W[(size_t)(k0 + kk) * N + src_col0 + nl] * scale; }
    LDS_WAIT();
    const int kh = lane >> 5; const LAS float* s = scr + (32 * kh) * 33 + nl; v4u o0, o1;
    o0.x = pg8::pk4_fp8(s[0 * 33], s[1 * 33], s[2 * 33], s[3 * 33]); o0.y = pg8::pk4_fp8(s[4 * 33], s[5 * 33], s[6 * 33], s[7 * 33]); o0.z = pg8::pk4_fp8(s[8 * 33], s[9 * 33], s[10 * 33], s[11 * 33]); o0.w = pg8::pk4_fp8(s[12 * 33], s[13 * 33], s[14 * 33], s[15 * 33]);
    o1.x = pg8::pk4_fp8(s[16 * 33], s[17 * 33], s[18 * 33], s[19 * 33]); o1.y = pg8::pk4_fp8(s[20 * 33], s[21 * 33], s[22 * 33], s[23 * 33]); o1.z = pg8::pk4_fp8(s[24 * 33], s[25 * 33], s[26 * 33], s[27 * 33]); o1.w = pg8::pk4_fp8(s[28 * 33], s[29 * 33], s[30 * 33], s[31 * 33]);
    unsigned char* dst = WT + (size_t)(dst_row0 + nl) * K + k0 + 32 * kh; *(v4u*)dst = o0; *(v4u*)(dst + 16) = o1;
    LDS_WAIT();
}
__device__ __forceinline__ void win_map(int nb, int& src, int& nvalid) { const int v0 = 32 * nb; if (v0 < 2048) { src = v0; nvalid = 32; } else if (v0 < 2816) { src = v0 + 16; nvalid = 32; } else if (v0 == 2816) { src = 2048; nvalid = 16; } else { src = 0; nvalid = 0; } }
__device__ __forceinline__ int gu_map(int nb) { const int v0 = 32 * nb; return ((v0 >> 7) & 1) * FFH + (v0 >> 8) * 128 + (v0 & 127); }

__device__ __forceinline__ void prologue_phase(const float* const* in, unsigned char* ws, LAS unsigned char* lds, int wg, int G, int tid) {
    const int lane = tid & 63, wave = tid >> 6, gw = wg * NWAVES + wave, NGW = G * NWAVES;
    LAS float* scr = (LAS float*)(lds + wave * 16384);
    constexpr int I_WIN = 16 * 96, I_WOUT = 16 * 32, I_GU = 16 * 176, I_DN = 44 * 32;
    constexpr int NITEMS = 2 * I_WIN + 2 * I_WOUT + I_GU + I_DN;
    for (int it = gw; it < NITEMS; it += NGW) {
        int r = it;
        if (r < 2 * I_WIN) { const int L = r / I_WIN; r -= L * I_WIN; const int kb = r / 96, nb = r % 96; int src, nv; win_map(nb, src, nv);
            transpose_item(in[8] + (size_t)L * D * PIN_SRC, D, PIN_SRC, (bf16*)(ws + WS_WIN) + (size_t)L * PLD * D, 32 * nb, src, nv, kb, scr, lane); continue; }
        r -= 2 * I_WIN;
        if (r < 2 * I_WOUT) { const int L = r / I_WOUT; r -= L * I_WOUT; const int kb = r / 32, nb = r % 32;
            transpose_item(in[15] + (size_t)L * D * D, D, D, (bf16*)(ws + WS_WOUT) + (size_t)L * D * D, 32 * nb, 32 * nb, 32, kb, scr, lane); continue; }
        r -= 2 * I_WOUT;
        if (r < I_GU) { const int kb = r / 176, nb = r % 176; transpose_item(in[16], D, 2 * FFH, (bf16*)(ws + WS_WGU), 32 * nb, gu_map(nb), 32, kb, scr, lane); continue; }
        r -= I_GU;
        { const int kb = r / 32, nb = r % 32; transpose_item_f8(in[17], FFH, D, (unsigned char*)(ws + WS_WD), 32 * nb, 32 * nb, kb, pg8::F8_SWD, scr, lane); }
    }
    __syncthreads();
    LAS float* cond_s = (LAS float*)lds;
    LAS float* part = (LAS float*)(lds + 32768);
    for (int i = tid; i < 5 * D; i += NTHR) { const int r = i >> 10, k = i & 1023; const float v = r < 4 ? in[1][r * D + k] : in[3][k]; cond_s[i] = silu_f(v); }
    __syncthreads();
    float* MOD = (float*)(ws + WS_MOD);
    for (int t = wg; t < 192; t += G) {
        const int L = t / 96, nb = t % 96; const float* W = in[6] + (size_t)L * D * 6144 + nb * 64 + lane;
        float a0 = 0.f, a1 = 0.f, a2 = 0.f, a3 = 0.f, a4 = 0.f;
#pragma unroll 8
        for (int kk = 0; kk < 128; ++kk) { const int k = wave * 128 + kk; const float w = W[(size_t)k * 6144];
            a0 += cond_s[k] * w; a1 += cond_s[D + k] * w; a2 += cond_s[2 * D + k] * w; a3 += cond_s[3 * D + k] * w; a4 += cond_s[4 * D + k] * w; }
        part[(wave * 5 + 0) * 64 + lane] = a0; part[(wave * 5 + 1) * 64 + lane] = a1; part[(wave * 5 + 2) * 64 + lane] = a2; part[(wave * 5 + 3) * 64 + lane] = a3; part[(wave * 5 + 4) * 64 + lane] = a4;
        __syncthreads();
        if (tid < 320) { const int r = tid >> 6, l = tid & 63; float s = in[7][L * 6144 + nb * 64 + l];
#pragma unroll
            for (int w = 0; w < 8; ++w) s += part[(w * 5 + r) * 64 + l];
            MOD[(size_t)(L * 5 + r) * 6144 + nb * 64 + l] = s; }
        __syncthreads();
    }
}

__device__ __forceinline__ void moe_convert_items(const float* const* in, unsigned char* ws, LAS unsigned char* lds, int which, int widx, int nw, int tid, int it0 = 0, int it1 = 1 << 30) {
    const int lane = tid & 63, wave = tid >> 6, gw = widx * NWAVES + wave, NGW = nw * NWAVES;
    LAS float* scr = (LAS float*)(lds + wave * 16384);
    constexpr int I_GU = 16 * 176, I_DN = 44 * 32;
    if (which == 0) { for (int it = gw; it < 8 * I_DN; it += NGW) { const int e = it / I_DN, r = it - e * I_DN, kb = r / 32, nb = r % 32;
            transpose_item_f8(in[21] + (size_t)e * FFH * D, FFH, D, (unsigned char*)(ws + WS_MWD) + (size_t)e * D * FFH, 32 * nb, 32 * nb, kb, pg8::F8_SWD, scr, lane); } }
    else { const int hi = it1 < 8 * I_GU ? it1 : 8 * I_GU; for (int it = it0 + gw; it < hi; it += NGW) { const int e = it / I_GU, r = it - e * I_GU, kb = r / 176, nb = r % 176;
            transpose_item_f8(in[20] + (size_t)e * D * 2 * FFH, D, 2 * FFH, (unsigned char*)(ws + WS_MWGU) + (size_t)e * 2 * FFH * D, 32 * nb, gu_map(nb), kb, pg8::F8_SWGU, scr, lane); } }
}

typedef float f32x2w __attribute__((ext_vector_type(2)));
template <bool ROUTER, bool F8OUT = false, bool XB16 = false>
__device__ __forceinline__ void norm_phase(const void* xlat, const void* xctx, bool do_ctx, const float* ng, const float* modL, int chunk_shift, bf16* A,
                                           const float* w_router, const float* b_router, int* tok_e, float* tok_w, int* hist, LAS unsigned char* lds, int wg, int G, int tid) {
    const int lane = tid & 63, wave = tid >> 6;
    LAS int* lh = (LAS int*)(lds + 73728);
    LAS float* RS = (LAS float*)lds + wave * (32 * 65 + 128); LAS float* RT = RS + 32 * 65;
    f32x4 wr0[16], wr1[16];
    if (ROUTER) {
#pragma unroll
        for (int j = 0; j < 4; ++j)
#pragma unroll
            for (int q = 0; q < 4; ++q) { const int c = 4 * lane + 256 * j + q; wr0[4 * j + q] = *(const f32x4*)(w_router + c * 8); wr1[4 * j + q] = *(const f32x4*)(w_router + c * 8 + 4); } }
    for (int blk = wg; blk < 256; blk += G) {
        if (ROUTER) { if (tid < 8) lh[tid] = 0; __syncthreads(); }
        for (int pass = 0; pass < (do_ctx ? 2 : 1); ++pass) {
            const int b = pass == 0 ? (blk >> 6) : 4;
            const float* sh = modL + (size_t)b * 6144 + chunk_shift * D; const float* sc = sh + D;
            f32x4 mul[4], add[4];
#pragma unroll
            for (int j = 0; j < 4; ++j) { const int c = 4 * lane + 256 * j; const f32x4 g = *(const f32x4*)(ng + c), s = *(const f32x4*)(sc + c); mul[j] = g * (s + 1.0f); add[j] = *(const f32x4*)(sh + c); }
            const int nrow = pass == 0 ? 16 : (wave < 4 ? 1 : 0);
            const int lrow0 = pass == 0 ? blk * 128 + wave * 16 : blk * 4 + wave;
            const unsigned char* xbase = (const unsigned char*)(pass == 0 ? xlat : xctx) + ((size_t)lrow0 * D + 4 * lane) * (XB16 ? 2 : 4);
#define NORM_LD(dst_, rowi_) do { _Pragma("unroll") for (int j = 0; j < 4; ++j) { if constexpr (XB16) { const v2u w_ = *(const v2u*)(xbase + ((size_t)(rowi_) * D + 256 * j) * 2); \
                dst_[j] = (f32x4){bflo(w_.x), bfhi(w_.x), bflo(w_.y), bfhi(w_.y)}; } else dst_[j] = *(const f32x4*)(xbase + ((size_t)(rowi_) * D + 256 * j) * 4); } } while (0)
            f32x4 vnA[4], vnB[4];
            if (nrow > 0) NORM_LD(vnA, 0);
            if (nrow > 1) NORM_LD(vnB, 1);
            auto do_row = [&](const int i, f32x4 (&vn)[4]) {
                const int lrow = lrow0 + i; const int arow = pass == 0 ? lrow : NLAT + lrow;
                f32x4 v[4]; float ss = 0.f;
#pragma unroll
                for (int j = 0; j < 4; ++j) { v[j] = vn[j]; ss += (v[j].x * v[j].x + v[j].y * v[j].y) + (v[j].z * v[j].z + v[j].w * v[j].w); }
                if (i + 2 < nrow) NORM_LD(vn, i + 2);
                const float rstd = 1.0f / sqrtf(wave_sum(ss) * (1.0f / D) + EPS);
                unsigned long long* o8 = (unsigned long long*)(A + (size_t)arow * D) + lane;
#pragma unroll
                for (int j = 0; j < 4; ++j) { v[j] = v[j] * rstd * mul[j] + add[j];
                    if constexpr (F8OUT) ((unsigned*)((unsigned char*)A + (size_t)arow * D))[lane + 64 * j] = pg8::pk4_fp8(v[j].x, v[j].y, v[j].z, v[j].w);
                    else o8[64 * j] = (unsigned long long)pk2(v[j].x, v[j].y) | ((unsigned long long)pk2(v[j].z, v[j].w) << 32); }
                if (ROUTER && pass == 0) {
                    typedef float f2r __attribute__((ext_vector_type(2)));
                    f2r l2[4] = {(f2r){0.f, 0.f}, (f2r){0.f, 0.f}, (f2r){0.f, 0.f}, (f2r){0.f, 0.f}};
#pragma unroll
                    for (int j = 0; j < 4; ++j)
#pragma unroll
                        for (int q = 0; q < 4; ++q) { const f32x4 w0 = wr0[4 * j + q], w1 = wr1[4 * j + q]; const float y = v[j][q]; const f2r yy = {y, y};
                            l2[0] += yy * (f2r){w0.x, w0.y}; l2[1] += yy * (f2r){w0.z, w0.w}; l2[2] += yy * (f2r){w1.x, w1.y}; l2[3] += yy * (f2r){w1.z, w1.w}; }
#pragma unroll
                    for (int e = 0; e < 8; ++e) RS[((i & 3) * 8 + e) * 65 + lane] = (e & 1) ? l2[e >> 1].y : l2[e >> 1].x;
                    if ((i & 3) == 3) { LDS_WAIT();
                        const int idx = lane & 31, c0 = (lane >> 5) * 32; float s = 0.f;
#pragma unroll
                        for (int c = 0; c < 32; ++c) s += RS[idx * 65 + c0 + c];
                        s += __shfl_xor(s, 32);
                        if (lane < 32) RT[(i >> 2) * 32 + idx] = s;
                        LDS_WAIT(); }
                }
            };
            for (int i = 0; i < nrow; i += 2) { do_row(i, vnA); if (i + 1 < nrow) do_row(i + 1, vnB); }
            if (ROUTER && pass == 0) LDS_WAIT();
            if (ROUTER && pass == 0 && lane < 16) {
                const int lrow = lrow0 + lane; float lg[8];
#pragma unroll
                for (int e = 0; e < 8; ++e) lg[e] = RT[lane * 8 + e] + b_router[e];
                int e1 = 0; float v1 = lg[0];
#pragma unroll
                for (int e = 1; e < 8; ++e) if (lg[e] > v1) { v1 = lg[e]; e1 = e; }
                int e2 = -1; float v2 = -3.0e38f;
#pragma unroll
                for (int e = 0; e < 8; ++e) if (e != e1 && lg[e] > v2) { v2 = lg[e]; e2 = e; }
                const float w2 = 1.0f / (1.0f + __expf(v1 - v2)), w1 = 1.0f - w2;
                *(v2u*)(tok_e + lrow * 2) = (v2u){(unsigned)e1, (unsigned)e2}; *(f32x2w*)(tok_w + lrow * 2) = (f32x2w){w1, w2};
                __hip_atomic_fetch_add(&lh[e1], 1, __ATOMIC_RELAXED, __HIP_MEMORY_SCOPE_WORKGROUP); __hip_atomic_fetch_add(&lh[e2], 1, __ATOMIC_RELAXED, __HIP_MEMORY_SCOPE_WORKGROUP);
            }
        }
        if (ROUTER) { __syncthreads(); if (tid < 8) hist[blk * 8 + tid] = lh[tid]; __syncthreads(); }
    }
}

__device__ __forceinline__ void route_phase(unsigned char* ws, LAS unsigned char* lds, int wg, int G, int tid) {
    const int lane = tid & 63, wave = tid >> 6;
    int* rw = (int*)(ws + WS_ROUTE); const int* hist = rw + RW_HIST;
    const int* tok_e = (const int*)(ws + WS_TOK); const float* tok_w = (const float*)(ws + WS_TOK + 256 * 1024); int* pair_pos = (int*)(ws + WS_TOK + 512 * 1024); float* row_w = (float*)(ws + WS_TOK + 768 * 1024); int* row_tok = (int*)(ws + WS_ROWTOK);
    LAS int* hs = (LAS int*)lds;
    LAS int* tot = hs + 2048;
    LAS int* te = hs + 2048 + 32;
    LAS int* ps = te + 256;
    for (int blk = wg; blk < 256; blk += G) {
        __syncthreads();
        for (int i = tid; i < 2048; i += NTHR) hs[i] = hist[i];
        if (tid < 256) te[tid] = tok_e[blk * 256 + tid];
        __syncthreads();
        { const int e = tid & 7, b0 = (tid >> 3) * 4; int t = 0, mb = 0;
#pragma unroll
            for (int j = 0; j < 4; ++j) { const int h = hs[(b0 + j) * 8 + e]; t += h; mb += (b0 + j < blk) ? h : 0; }
            t += __shfl_xor(t, 8); mb += __shfl_xor(mb, 8); t += __shfl_xor(t, 16); mb += __shfl_xor(mb, 16); t += __shfl_xor(t, 32); mb += __shfl_xor(mb, 32);
            if (lane < 8) { ps[wave * 16 + lane] = t; ps[wave * 16 + 8 + lane] = mb; } }
        __syncthreads();
        if (tid < 8) { int t = 0, mb = 0;
#pragma unroll
            for (int w = 0; w < NWAVES; ++w) { t += ps[w * 16 + tid]; mb += ps[w * 16 + 8 + tid]; } tot[tid] = t; tot[16 + tid] = mb; }
        __syncthreads();
        if (tid == 0) { int s = 0; for (int e = 0; e < 8; ++e) { tot[8 + e] = s; s += (tot[e] + 255) & ~255; } tot[24] = s >> 8; }
        int my_e = 0, my_rank = 0;
        if (tid < 256) { my_e = te[tid];
#pragma unroll
            for (int x = 0; x < 8; ++x) { const unsigned long long m = __ballot(my_e == x); if (my_e == x) my_rank = __popcll(m & ((1ull << lane) - 1ull)); if (lane == x) ps[128 + wave * 8 + x] = __popcll(m); } }
        __syncthreads();
        if (tid < 256) { const int e = my_e; int rank = my_rank; for (int w = 0; w < wave; ++w) rank += ps[128 + w * 8 + e];
            const int pos = tot[8 + e] + tot[16 + e] + rank; pair_pos[blk * 256 + tid] = pos; row_w[pos] = tok_w[blk * 256 + tid]; row_tok[pos] = blk * 128 + (tid >> 1); }
        if (blk == 0) {
            if (tid < 264) { int e = 0; for (int e2 = 1; e2 < 8; ++e2) if (tid * 256 >= tot[8 + e2]) e = e2; rw[RW_TILE_E + tid] = e; }
            if (tid == 0) rw[RW_NTILES] = tot[24];
        }
        if (blk < 8) { const int e = blk, r0 = tot[8 + e] + tot[e], r1 = tot[8 + e] + ((tot[e] + 255) & ~255);
            for (int r = r0 + tid; r < r1; r += NTHR) { row_tok[r] = 0; row_w[r] = 0.f; } }
    }
}

__device__ __forceinline__ void final_phase(const bf16* XB, float* X, const bf16* O, const int* pair_pos, const float* modL, const float* fg, int wg, int G, int tid) {
    const int lane = tid & 63, wave = tid >> 6;
    f32x4 fgv[4];
#pragma unroll
    for (int j = 0; j < 4; ++j) fgv[j] = *(const f32x4*)(fg + 4 * lane + 256 * j);
    const int nw = G * NWAVES, gw = wg * NWAVES + wave, per = (NLAT + nw - 1) / nw, r0 = gw * per, r1 = (r0 + per < NLAT) ? r0 + per : NLAT;
    if (r0 >= r1) return;
    v2u xn[4]; v2u an[4], cn[4]; int p1n = pair_pos[r0 * 2], p2n = pair_pos[r0 * 2 + 1];
#define FIN_ISSUE(row_, p1_, p2_) do { const v2u* xr_ = (const v2u*)(XB + (size_t)(row_) * D) + lane; const v2u* o1_ = (const v2u*)(O + (size_t)(p1_) * D) + lane; const v2u* o2_ = (const v2u*)(O + (size_t)(p2_) * D) + lane; \
        _Pragma("unroll") for (int j = 0; j < 4; ++j) { xn[j] = xr_[64 * j]; an[j] = o1_[64 * j]; cn[j] = o2_[64 * j]; } } while (0)
    FIN_ISSUE(r0, p1n, p2n);
    if (r0 + 1 < r1) { p1n = pair_pos[(r0 + 1) * 2]; p2n = pair_pos[(r0 + 1) * 2 + 1]; }
    for (int row = r0; row < r1; ++row) {
        const int b = row >> 13; const float* g2 = modL + (size_t)b * 6144 + 5 * D;
        f32x4 v[4]; float ss = 0.f;
#pragma unroll
        for (int j = 0; j < 4; ++j) { const f32x4 g = *(const f32x4*)(g2 + 4 * lane + 256 * j); const v2u a = an[j], c = cn[j];
            f32x4 m; m.x = bflo(a.x) + bflo(c.x); m.y = bfhi(a.x) + bfhi(c.x); m.z = bflo(a.y) + bflo(c.y); m.w = bfhi(a.y) + bfhi(c.y);
            v[j] = (f32x4){bflo(xn[j].x), bfhi(xn[j].x), bflo(xn[j].y), bfhi(xn[j].y)} + g * m; ss += (v[j].x * v[j].x + v[j].y * v[j].y) + (v[j].z * v[j].z + v[j].w * v[j].w); }
        if (row + 1 < r1) { FIN_ISSUE(row + 1, p1n, p2n); if (row + 2 < r1) { p1n = pair_pos[(row + 2) * 2]; p2n = pair_pos[(row + 2) * 2 + 1]; } }
        const float rstd = 1.0f / sqrtf(wave_sum(ss) * (1.0f / D) + EPS);
        float* xr = X + (size_t)row * D;
#pragma unroll
        for (int j = 0; j < 4; ++j) *(f32x4*)(xr + 4 * lane + 256 * j) = v[j] * rstd * fgv[j];
    }
#undef FIN_ISSUE
}

typedef float f32x2 __attribute__((ext_vector_type(2)));
__device__ __forceinline__ void fourier_ctx_task(const bf16* P, bf16* Y, LAS unsigned char* lds, int task, int tid) {
    const int lane = tid & 63, wave = tid >> 6;
    LAS f32x2* tab = (LAS f32x2*)lds;
    LAS unsigned short* zb = (LAS unsigned short*)(lds + 65536);
    LAS float* ure_s = (LAS float*)(lds + 98304);
    LAS float* uim_s = ure_s + 1024;
    const int b = task >> 6, g = (task >> 4) & 3, kb = task & 15;
    const int rowbase = NLAT + b * CTXL;
    float ure[2] = {0.f, 0.f}, uim[2] = {0.f, 0.f}; int idx[2] = {0, 0}, stp[2];
#pragma unroll
    for (int j = 0; j < 2; ++j) stp[j] = ((kb * 16 + wave * 2 + j) * 32) & 8191;
    __syncthreads();
#pragma unroll
    for (int i = 0; i < 4; ++i) { const int p = tid + NTHR * i, r = p >> 3, ch = p & 7;
        *(LAS v4u*)(zb + r * 64 + ch * 8) = *(const v4u*)(P + (size_t)(rowbase + r) * PLD + PO_F + g * 64 + ch * 8); }
    __syncthreads();
#pragma unroll 4
    for (int nn = 0; nn < 256; ++nn) { const float z = bf2f(zb[nn * 64 + lane]);
#pragma unroll
        for (int j = 0; j < 2; ++j) { const f32x2 t = tab[idx[j]]; ure[j] += z * t.x; uim[j] -= z * t.y; idx[j] = (idx[j] + stp[j]) & 8191; } }
#pragma unroll
    for (int j = 0; j < 2; ++j) { ure_s[(wave * 2 + j) * 64 + lane] = ure[j]; uim_s[(wave * 2 + j) * 64 + lane] = uim[j]; }
    __syncthreads();
    const float scale = 1.0f / sqrtf(256.0f * 64.0f);
#pragma unroll 1
    for (int j = 0; j < 2; ++j) { const int kl = wave * 2 + j; float acc = 0.f;
#pragma unroll 4
        for (int c = 0; c < 64; ++c) { const f32x2 t = tab[((c * lane) & 63) * 128]; acc += ure_s[kl * 64 + c] * t.x + uim_s[kl * 64 + c] * t.y; }
        Y[(size_t)(rowbase + kb * 16 + kl) * D + 512 + g * 64 + lane] = (bf16)f2bf(acc * scale); }
}

typedef short bf16x8v __attribute__((ext_vector_type(8)));
constexpr size_t WS_TKS = WS_R2 + 335 * MiB;
constexpr size_t WS_NS = WS_R2 + 330 * MiB;
constexpr size_t WS_SC = WS_R2 + 333 * MiB;
static_assert(WS_HB + (size_t)16 * 132 * 16384 * 2 <= WS_NS && WS_NS + (size_t)2 * 16 * 132 * 128 * 4 <= WS_SC && WS_SC + (size_t)2 * 16 * 132 * 16 <= WS_END && WS_HF + (size_t)16 * 132 * 16384 * 2 <= WS_R2, "mlstm state map");
constexpr int NCHK = 132;
constexpr float KSC = 0.08838834764831845f;
constexpr float F8_ST = 8.f;
typedef float f32x2s __attribute__((ext_vector_type(2)));
__device__ __forceinline__ int chunk_rowbase(int b, int c) { return c < 128 ? b * SEQ + 64 * c : NLAT + b * CTXL + 64 * (c - 128); }
#define DPP_SHR(x_, id_, n_) __builtin_bit_cast(float, __builtin_amdgcn_update_dpp(__builtin_bit_cast(int, (float)(id_)), __builtin_bit_cast(int, (float)(x_)), 0x110 + (n_), 0xF, 0xF, false))
__device__ __forceinline__ float rl_f(float v, int l) { return __builtin_bit_cast(float, __builtin_amdgcn_readlane(__builtin_bit_cast(int, v), l)); }
__device__ __forceinline__ float scan_add_fwd(float x, int lane) {
    x += DPP_SHR(x, 0.f, 1); x += DPP_SHR(x, 0.f, 2); x += DPP_SHR(x, 0.f, 4); x += DPP_SHR(x, 0.f, 8);
    const float t0 = rl_f(x, 15), t1 = rl_f(x, 31), t2 = rl_f(x, 47); const int row = lane >> 4;
    return x + (row == 0 ? 0.f : row == 1 ? t0 : row == 2 ? t0 + t1 : (t0 + t1) + t2);
}
__device__ __forceinline__ float scan_max_fwd(float x, int lane) {
    const float NI = -3.0e38f;
    x = fmaxf(x, DPP_SHR(x, NI, 1)); x = fmaxf(x, DPP_SHR(x, NI, 2)); x = fmaxf(x, DPP_SHR(x, NI, 4)); x = fmaxf(x, DPP_SHR(x, NI, 8));
    const float t0 = rl_f(x, 15), t1 = rl_f(x, 31), t2 = rl_f(x, 47); const int row = lane >> 4;
    return fmaxf(x, row == 0 ? NI : row == 1 ? t0 : row == 2 ? fmaxf(t0, t1) : fmaxf(fmaxf(t0, t1), t2));
}
#define MFMA16(a, b, c) __builtin_amdgcn_mfma_f32_16x16x32_bf16((a), (b), (c), 0, 0, 0)
__device__ __forceinline__ bf16x8v pack8(const float (&v)[8]) { v4u w; w.x = pk2(v[0], v[1]); w.y = pk2(v[2], v[3]); w.z = pk2(v[4], v[5]); w.w = pk2(v[6], v[7]); return __builtin_bit_cast(bf16x8v, w); }


__device__ __forceinline__ void gate_proj_tasks(const bf16* A, const bf16* WinT, float* Gt, int widx, int nw, int tid) {
    const int lane = tid & 63, wave = tid >> 6, r = lane & 15, g = lane >> 4;
    const bf16* wrow = WinT + (size_t)(2816 + r) * D + 8 * g;
    for (int t = widx; t < MROWS / 256; t += nw) {
        const int row0 = t * 256 + wave * 32;
        const bf16* a0 = A + (size_t)(row0 + r) * D + 8 * g; const bf16* a1 = a0 + (size_t)16 * D;
        f32x4 c0 = {0.f, 0.f, 0.f, 0.f}, c1 = c0;
#pragma unroll 8
        for (int kk = 0; kk < 32; ++kk) { const bf16x8v b = *(const bf16x8v*)(wrow + 32 * kk), x0 = *(const bf16x8v*)(a0 + 32 * kk), x1 = *(const bf16x8v*)(a1 + 32 * kk);
            c0 = MFMA16(x0, b, c0); c1 = MFMA16(x1, b, c1); }
#pragma unroll
        for (int i = 0; i < 4; ++i) { Gt[(size_t)(row0 + 4 * g + i) * 16 + r] = c0[i]; Gt[(size_t)(row0 + 16 + 4 * g + i) * 16 + r] = c1[i]; }
    }
}
__device__ __forceinline__ int swz72(int row, int s) { return row * 72 + ((((s >> 3) ^ ((row >> 3) & 7))) << 3) + (s & 7); }
struct M1Regs { v4u k[2], v[2]; float ga, gf; };
__device__ __forceinline__ void m1_issue(M1Regs& R, const bf16* P, const float* Gt, int task, int tid) {
    const int lane = tid & 63, wave = tid >> 6;
    const int bh = task / NCHK, c = task % NCHK, b = bh >> 2, h = bh & 3, rowbase = chunk_rowbase(b, c);
#pragma unroll
    for (int i2 = 0; i2 < 2; ++i2) { const int p = tid + NTHR * i2, s = p >> 4, dg = p & 15;
        R.k[i2] = *(const v4u*)(P + (size_t)(rowbase + s) * PLD + PO_K + h * 128 + dg * 8); R.v[i2] = *(const v4u*)(P + (size_t)(rowbase + s) * PLD + PO_V + h * 128 + dg * 8); }
    R.ga = 0.f; R.gf = 0.f;
    if (wave < 2) { const float* gr = Gt + (size_t)(rowbase + (wave ? 63 - lane : lane)) * 16 + wave * 8 + h; R.ga = gr[0]; R.gf = gr[4]; }
}
__device__ __forceinline__ void mlstm_m1_phase(const bf16* P, const float* Gt, const float* bg, unsigned char* ws, LAS unsigned char* lds, int ntask, int wg, int G, int tid) {
    const int lane = tid & 63, wave = tid >> 6, r = lane & 15, g = lane >> 4;
    LAS unsigned short* KT0 = (LAS unsigned short*)lds;
    LAS unsigned short* VT = (LAS unsigned short*)(lds + 36864);
    LAS float* gw = (LAS float*)(lds + 55296);
    float* SC = (float*)(ws + WS_SC); float* NS = (float*)(ws + WS_NS);
    if (wg >= ntask) return;
    M1Regs R; m1_issue(R, P, Gt, wg, tid);
    for (int task = wg; task < ntask; task += G) {
        const int bh = task / NCHK, c = task % NCHK, h = bh & 3;
        __syncthreads();
        if (wave < 2) { const int dir = wave, tk = dir ? 63 - lane : lane;
            const float a = R.ga + bg[dir * 8 + h], lf = log_sigmoid_f(R.gf + bg[dir * 8 + 4 + h]);
            const float cum = scan_add_fwd(lf, lane), gg = a - cum, pm = scan_max_fwd(gg, lane), gmax = rl_f(pm, 63);
            { float* tks = (float*)(ws + WS_TKS) + ((size_t)(dir * 16 + bh) * NCHK + c) * 192 + lane; tks[0] = cum; tks[64] = gg; tks[128] = pm; }
            gw[dir * 64 + tk] = __expf(gg - gmax) * (KSC * F8_ST);
            const float tot = rl_f(cum, 63);
            if (lane == 0) { float* sc = SC + ((size_t)(dir * 16 + bh) * NCHK + c) * 4; sc[0] = tot; sc[1] = tot + gmax; } }
        __syncthreads();
#pragma unroll
        for (int i2 = 0; i2 < 2; ++i2) { const int p = tid + NTHR * i2, s = p >> 4, dg = p & 15;
            const float wf = gw[s], wb = gw[64 + s];
            const unsigned kk[4] = {R.k[i2].x, R.k[i2].y, R.k[i2].z, R.k[i2].w}, vv[4] = {R.v[i2].x, R.v[i2].y, R.v[i2].z, R.v[i2].w};
#pragma unroll
            for (int j = 0; j < 4; ++j) { const float k0 = bflo(kk[j]), k1 = bfhi(kk[j]); const int d = dg * 8 + 2 * j, o0 = swz72(d, s), o1 = swz72(d + 1, s);
                const unsigned pf = pk2(k0 * wf, k1 * wf), pb = pk2(k0 * wb, k1 * wb);
                KT0[o0] = (unsigned short)(pf & 0xffffu); KT0[o1] = (unsigned short)(pf >> 16);
                KT0[9216 + o0] = (unsigned short)(pb & 0xffffu); KT0[9216 + o1] = (unsigned short)(pb >> 16);
                VT[o0] = (unsigned short)(vv[j] & 0xffffu); VT[o1] = (unsigned short)(vv[j] >> 16); } }
        __syncthreads();
        if (task + G < ntask) m1_issue(R, P, Gt, task + G, tid);
        { const int dir = wave >> 2, w4 = wave & 3; LAS unsigned short* KT = KT0 + dir * 9216;
            unsigned char* CS = ws + (dir ? WS_HB : WS_HF) + ((size_t)bh * NCHK + c) * 16384;
            bf16x8v af[2][2];
#pragma unroll
            for (int m = 0; m < 2; ++m)
#pragma unroll
                for (int kk = 0; kk < 2; ++kk) af[m][kk] = *(const LAS bf16x8v*)(KT + swz72(32 * w4 + 8 * (r >> 2) + 4 * m + (r & 3), kk * 32 + 8 * g));
#pragma unroll
            for (int et = 0; et < 8; ++et) {
                const bf16x8v b0 = *(const LAS bf16x8v*)(VT + swz72(et * 16 + r, 8 * g)), b1 = *(const LAS bf16x8v*)(VT + swz72(et * 16 + r, 32 + 8 * g)); v2u o;
#pragma unroll
                for (int m = 0; m < 2; ++m) { f32x4 acc = {0.f, 0.f, 0.f, 0.f}; acc = MFMA16(af[m][0], b0, acc); acc = MFMA16(af[m][1], b1, acc);
                    const unsigned w8 = pg8::pk4_fp8(acc[0], acc[1], acc[2], acc[3]); if (m == 0) o.x = w8; else o.y = w8; }
                *(v2u*)(CS + (size_t)(et * 16 + r) * 128 + 32 * w4 + 8 * g) = o; }
        }
        if (tid < 256) { const int dir = tid >> 7, dd = tid & 127; const LAS unsigned short* kr = KT0 + dir * 9216 + dd * 72; float s = 0.f;
#pragma unroll
            for (int q = 0; q < 8; ++q) { const v4u w = *(const LAS v4u*)(kr + 8 * q); s += (bflo(w.x) + bfhi(w.x)) + (bflo(w.y) + bfhi(w.y)) + (bflo(w.z) + bfhi(w.z)) + (bflo(w.w) + bfhi(w.w)); }
            NS[((size_t)(dir * 16 + bh) * NCHK + c) * 128 + dd] = s * (1.0f / F8_ST); }
    }
}

__device__ __forceinline__ void mlstm_m2_phase(unsigned char* ws, int wg, int G, int tid) {
    for (int u = wg; u < 256; u += G) {
        const int seq = u >> 3, part = u & 7, dir = seq >> 4, bh = seq & 15;
        unsigned char* base = ws + (dir ? WS_HB : WS_HF) + (size_t)bh * NCHK * 16384 + part * 2048 + tid * 4;
        float* SC = (float*)(ws + WS_SC) + (size_t)(dir * 16 + bh) * NCHK * 4;
        float* NSb = (float*)(ws + WS_NS) + (size_t)(dir * 16 + bh) * NCHK * 128 + tid;
        const bool do_n = (part == 0 && tid < 128), do_m = (part == 0 && tid == 0);
        float s0 = 0.f, s1 = 0.f, s2 = 0.f, s3 = 0.f, m = -1e30f, ns = 0.f;
        unsigned dlA[12], dlB[12]; float totA[12], totB[12], mlA[12], mlB[12], dnA[12], dnB[12];
#define M2_CC(j_) (dir ? (NCHK - 1 - (j_)) : (((j_) + 128) % NCHK))
#define M2_LOAD(X_, j0_) { _Pragma("unroll") for (int q = 0; q < 12; ++q) { const int cq = M2_CC((j0_) + q); \
            dl##X_[q] = *(const unsigned*)(base + (size_t)cq * 16384); tot##X_[q] = SC[cq * 4]; ml##X_[q] = SC[cq * 4 + 1]; dn##X_[q] = 0.f; if (do_n) dn##X_[q] = NSb[(size_t)cq * 128]; } }
#define M2_PROC(X_, j0_) { _Pragma("unroll") for (int q = 0; q < 12; ++q) { const int cq = M2_CC((j0_) + q); \
            *(unsigned*)(base + (size_t)cq * 16384) = pg8::pk4_fp8(s0, s1, s2, s3); \
            if (do_n) NSb[(size_t)cq * 128] = ns; \
            if (do_m) SC[cq * 4 + 2] = m; \
            const float me = fmaxf(tot##X_[q] + m, ml##X_[q]), al = __expf(tot##X_[q] + m - me), be = __expf(ml##X_[q] - me); m = me; \
            const f32x2s dlo = __builtin_amdgcn_cvt_pk_f32_fp8((int)dl##X_[q], false), dhi = __builtin_amdgcn_cvt_pk_f32_fp8((int)dl##X_[q], true); \
            s0 = al * s0 + be * dlo.x; s1 = al * s1 + be * dlo.y; s2 = al * s2 + be * dhi.x; s3 = al * s3 + be * dhi.y; ns = ns * al + dn##X_[q] * be; } }
        M2_LOAD(A, 0)
#pragma unroll 1
        for (int j0 = 0; j0 < NCHK; j0 += 24) {
            if (j0 + 12 < NCHK) M2_LOAD(B, j0 + 12)
            M2_PROC(A, j0)
            if (j0 + 12 < NCHK) { if (j0 + 24 < NCHK) M2_LOAD(A, j0 + 24)
                M2_PROC(B, j0 + 12) }
        }
#undef M2_CC
#undef M2_LOAD
#undef M2_PROC
    }
}

struct M3Regs { v4u q[2], k[2], v[2]; float ga, gf, pm, mst; };
__device__ __forceinline__ void m3_issue(M3Regs& R, const bf16* P, const float* TKS, const float* SC, int task, int tid) {
    const int lane = tid & 63, wave = tid >> 6;
    const int bh = task / NCHK, c = task % NCHK, b = bh >> 2, h = bh & 3, rowbase = chunk_rowbase(b, c);
#pragma unroll
    for (int i2 = 0; i2 < 2; ++i2) { const int p = tid + NTHR * i2, s = p >> 4, dg = p & 15; const bf16* pr = P + (size_t)(rowbase + s) * PLD + h * 128 + dg * 8;
        R.q[i2] = *(const v4u*)(pr + PO_Q); R.k[i2] = *(const v4u*)(pr + PO_K); R.v[i2] = *(const v4u*)(pr + PO_V); }
    R.ga = 0.f; R.gf = 0.f; R.pm = 0.f; R.mst = 0.f;
    if (wave < 2) { const float* tk = TKS + ((size_t)(wave * 16 + bh) * NCHK + c) * 192 + lane; R.ga = tk[0]; R.gf = tk[64]; R.pm = tk[128]; R.mst = SC[((size_t)(wave * 16 + bh) * NCHK + c) * 4 + 2]; }
}
__device__ __forceinline__ void mlstm_m3_phase(const bf16* P, const float* Gt, const float* bg, const float* ngl, unsigned char* ws, bf16* Y, LAS unsigned char* lds, int nchunk, int wg, int G, int tid) {
    const int lane = tid & 63, wave = tid >> 6, r = lane & 15, g = lane >> 4;
    LAS unsigned short* Qs = (LAS unsigned short*)lds;
    LAS unsigned short* Ks = (LAS unsigned short*)(lds + 17408);
    LAS unsigned short* VT = (LAS unsigned short*)(lds + 34816);
    LAS unsigned short* CT = (LAS unsigned short*)(lds + 53248);
    LAS float* nsl = (LAS float*)(lds + 122880);
    LAS float* tok = (LAS float*)(lds + 123904);
    LAS float* dens = (LAS float*)(lds + 125952);
    LAS float* HS = (LAS float*)lds;
    const float* SC = (const float*)(ws + WS_SC); const float* NS = (const float*)(ws + WS_NS); const float* TKS = (const float*)(ws + WS_TKS);
    const int ntask = 16 * nchunk;
    if (wg >= ntask) return;
#define M3_TASK(t_) (((t_) / nchunk) * NCHK + ((t_) % nchunk))
    M3Regs R; m3_issue(R, P, TKS, SC, M3_TASK(wg), tid);
    for (int tt = wg; tt < ntask; tt += G) {
        const int task = M3_TASK(tt), bh = task / NCHK, c = task % NCHK, b = bh >> 2, h = bh & 3, rowbase = chunk_rowbase(b, c);
        __syncthreads();
        v4u cr[4]; float nsv0 = 0.f, nsv1 = 0.f;
#pragma unroll
        for (int i2 = 0; i2 < 4; ++i2) { const int p = tid + NTHR * i2, dir = p >> 10, e = (p >> 3) & 127, dg = p & 7;
            const unsigned char* CS = ws + (dir ? WS_HB : WS_HF) + ((size_t)bh * NCHK + c) * 16384; cr[i2] = *(const v4u*)(CS + e * 128 + dg * 16); }
        if (wave >= 2 && wave < 4) { const float* src = NS + ((size_t)((wave - 2) * 16 + bh) * NCHK + c) * 128; nsv0 = src[lane]; nsv1 = src[64 + lane]; }
        if (wave < 2) { const int dir = wave, tk = dir ? 63 - lane : lane;
            tok[dir * 256 + tk] = -fmaxf(R.mst, R.pm); tok[dir * 256 + 64 + tk] = R.gf; tok[dir * 256 + 128 + tk] = R.ga; tok[dir * 256 + 192 + tk] = R.mst; }
#pragma unroll
        for (int i2 = 0; i2 < 2; ++i2) { const int p = tid + NTHR * i2, s = p >> 4, dg = p & 15;
            *(LAS v4u*)(Qs + s * 136 + dg * 8) = R.q[i2]; *(LAS v4u*)(Ks + s * 136 + dg * 8) = R.k[i2];
            const unsigned vv[4] = {R.v[i2].x, R.v[i2].y, R.v[i2].z, R.v[i2].w};
#pragma unroll
            for (int j = 0; j < 4; ++j) { const int d = dg * 8 + 2 * j; VT[swz72(d, s)] = (unsigned short)(vv[j] & 0xffffu); VT[swz72(d + 1, s)] = (unsigned short)(vv[j] >> 16); } }
        __syncthreads();
        const int rt = wave & 3, ch = wave >> 2;
        bf16x8v qf[4];
#pragma unroll
        for (int kk = 0; kk < 4; ++kk) qf[kk] = *(const LAS bf16x8v*)(Qs + (16 * rt + r) * 136 + 32 * kk + 8 * g);
        const int t = 16 * rt + r;
        const float uf = tok[t], ub = tok[256 + t];
        float dsf = 0.f, dsb = 0.f;
        f32x4 aPf[4], aPb[4];
#pragma unroll
        for (int ct = 0; ct < 4; ++ct) { const f32x4 z = {0.f, 0.f, 0.f, 0.f}; aPf[ct] = z; aPb[ct] = z; }
#pragma unroll 1
        for (int k2 = 0; k2 < 2; ++k2) { float vf[8], vb[8];
#pragma unroll
            for (int hh = 0; hh < 2; ++hh) { const int st = 2 * k2 + hh; f32x4 acc = {0.f, 0.f, 0.f, 0.f};
#pragma unroll
                for (int kk = 0; kk < 4; ++kk) { const bf16x8v a = *(const LAS bf16x8v*)(Ks + (16 * st + r) * 136 + 32 * kk + 8 * g); acc = MFMA16(a, qf[kk], acc); }
#pragma unroll
                for (int i = 0; i < 4; ++i) { const int s = 16 * st + 4 * g + i; const float sv = acc[i] * KSC;
                    const float wf = (s <= t) ? __expf(uf + tok[64 + s]) : 0.f, wb = (s >= t) ? __expf(ub + tok[256 + 64 + s]) : 0.f;
                    vf[4 * hh + i] = sv * wf; vb[4 * hh + i] = sv * wb; dsf += vf[4 * hh + i]; dsb += vb[4 * hh + i]; } }
            const bf16x8v paf = pack8(vf), pab = pack8(vb);
#pragma unroll
            for (int ct = 0; ct < 4; ++ct) { const int e = 64 * ch + 16 * ct + r;
                const v2u lo = *(const LAS v2u*)(VT + swz72(e, 32 * k2 + 4 * g)), hi = *(const LAS v2u*)(VT + swz72(e, 32 * k2 + 16 + 4 * g));
                v4u bw; bw.x = lo.x; bw.y = lo.y; bw.z = hi.x; bw.w = hi.y; const bf16x8v bfr = __builtin_bit_cast(bf16x8v, bw);
                aPf[ct] = MFMA16(paf, bfr, aPf[ct]); aPb[ct] = MFMA16(pab, bfr, aPb[ct]); } }
#pragma unroll
        for (int i2 = 0; i2 < 4; ++i2) { const int p = tid + NTHR * i2, dir = p >> 10, e = (p >> 3) & 127, dg = p & 7;
            const unsigned cw[4] = {cr[i2].x, cr[i2].y, cr[i2].z, cr[i2].w}; unsigned ob[8];
#pragma unroll
            for (int j = 0; j < 4; ++j) { const f32x2s lo = __builtin_amdgcn_cvt_pk_f32_fp8((int)cw[j], false), hi = __builtin_amdgcn_cvt_pk_f32_fp8((int)cw[j], true); ob[2 * j] = pk2(lo.x, lo.y); ob[2 * j + 1] = pk2(hi.x, hi.y); }
            v4u o0, o1; o0.x = ob[0]; o0.y = ob[1]; o0.z = ob[2]; o0.w = ob[3]; o1.x = ob[4]; o1.y = ob[5]; o1.z = ob[6]; o1.w = ob[7];
            *(LAS v4u*)(CT + dir * 17408 + e * 136 + dg * 16) = o0; *(LAS v4u*)(CT + dir * 17408 + e * 136 + dg * 16 + 8) = o1; }
        if (wave >= 2 && wave < 4) { nsl[2 * lane + (wave - 2)] = nsv0; nsl[2 * (64 + lane) + (wave - 2)] = nsv1; }
        __syncthreads();
        v4u ocur[2];
#pragma unroll
        for (int i2 = 0; i2 < 2; ++i2) { const int p = tid + NTHR * i2, s = p >> 4, dg = p & 15; ocur[i2] = *(const v4u*)(P + (size_t)(rowbase + s) * PLD + PO_O + h * 128 + dg * 8); }
        if (tt + G < ntask) m3_issue(R, P, TKS, SC, M3_TASK(tt + G), tid);
        f32x2s qn2 = {0.f, 0.f};
#pragma unroll
        for (int kk = 0; kk < 4; ++kk)
#pragma unroll
            for (int i = 0; i < 8; ++i) { const float qv = bf2f((unsigned short)qf[kk][i]); const f32x2s qq = {qv, qv}; qn2 += qq * *(const LAS f32x2s*)(nsl + 2 * (32 * kk + 8 * g + i)); }
        float qnf = qn2.x, qnb = qn2.y;
        dsf += __shfl_xor(dsf, 16); dsf += __shfl_xor(dsf, 32); dsb += __shfl_xor(dsb, 16); dsb += __shfl_xor(dsb, 32);
        qnf += __shfl_xor(qnf, 16); qnf += __shfl_xor(qnf, 32); qnb += __shfl_xor(qnb, 16); qnb += __shfl_xor(qnb, 32);
        if (g == 0) { dens[(wave * 2 + 0) * 16 + r] = dsf + __expf(uf + tok[192 + t]) * qnf; dens[(wave * 2 + 1) * 16 + r] = dsb + __expf(ub + tok[256 + 192 + t]) * qnb; }
        LDS_WAIT();
        f32x4 intf, intb, rdf, rdb;
#pragma unroll
        for (int i = 0; i < 4; ++i) { const int tr = 16 * rt + 4 * g + i, tl = 4 * g + i;
            const float u0 = tok[tr], u1 = tok[256 + tr];
            intf[i] = __expf(u0 + tok[192 + tr]) * (1.0f / F8_ST); intb[i] = __expf(u1 + tok[256 + 192 + tr]) * (1.0f / F8_ST);
            rdf[i] = __builtin_amdgcn_rcpf(fmaxf(fabsf(dens[(wave * 2 + 0) * 16 + tl]), __expf(u0 - tok[128 + tr]))); rdb[i] = __builtin_amdgcn_rcpf(fmaxf(fabsf(dens[(wave * 2 + 1) * 16 + tl]), __expf(u1 - tok[256 + 128 + tr]))); }
#pragma unroll
        for (int ct = 0; ct < 4; ++ct) { const int e0 = 64 * ch + 16 * ct; f32x4 aCf = {0.f, 0.f, 0.f, 0.f}, aCb = aCf;
#pragma unroll
            for (int kk = 0; kk < 4; ++kk) { const bf16x8v cf = *(const LAS bf16x8v*)(CT + (e0 + r) * 136 + 32 * kk + 8 * g), cb = *(const LAS bf16x8v*)(CT + 17408 + (e0 + r) * 136 + 32 * kk + 8 * g);
                aCf = MFMA16(qf[kk], cf, aCf); aCb = MFMA16(qf[kk], cb, aCb); }
            const f32x4 hv = (aPf[ct] + intf * aCf) * rdf + (aPb[ct] + intb * aCb) * rdb;
#pragma unroll
            for (int i = 0; i < 4; ++i) HS[(16 * rt + 4 * g + i) * 132 + e0 + r] = hv[i]; }
        __syncthreads();
#pragma unroll
        for (int i2 = 0; i2 < 2; ++i2) { const int p = tid + NTHR * i2, tk = p >> 4, c8 = p & 15;
            const f32x4 h0 = *(const LAS f32x4*)(HS + tk * 132 + 8 * c8), h1 = *(const LAS f32x4*)(HS + tk * 132 + 8 * c8 + 4);
            const f32x4 sq = h0 * h0 + h1 * h1; float ss = (sq.x + sq.y) + (sq.z + sq.w);
            ss = row16_sum(ss);
            const float rstd = __builtin_amdgcn_rsqf(ss * (1.0f / 128.0f) + EPS);
            const f32x4 g0 = *(const f32x4*)(ngl + h * 128 + 8 * c8), g1 = *(const f32x4*)(ngl + h * 128 + 8 * c8 + 4); const v4u o = ocur[i2];
            const f32x4 s0 = {sigmoid_f(bflo(o.x)), sigmoid_f(bfhi(o.x)), sigmoid_f(bflo(o.y)), sigmoid_f(bfhi(o.y))}, s1 = {sigmoid_f(bflo(o.z)), sigmoid_f(bfhi(o.z)), sigmoid_f(bflo(o.w)), sigmoid_f(bfhi(o.w))};
            const f32x4 y0 = s0 * h0 * (g0 * rstd), y1 = s1 * h1 * (g1 * rstd);
            v4u w; w.x = pk2(y0.x, y0.y); w.y = pk2(y0.z, y0.w); w.z = pk2(y1.x, y1.y); w.w = pk2(y1.z, y1.w);
            *(v4u*)(Y + (size_t)(rowbase + tk) * D + h * 128 + 8 * c8) = w; }
    }
#undef M3_TASK
}

struct ConvRegs { v4u u[6], g[6]; };
__device__ __forceinline__ void conv_issue(ConvRegs& R, const bf16* P, int task_, bool ctx_unused, int tid) {
    (void)ctx_unused; const bool ctx = task_ >= 512; const int task = ctx ? task_ - 512 : task_;
    const int N = ctx ? CTXL : SEQ, ntile = N / 64, b = task / ntile, t0 = (task % ntile) * 64, rowbase = ctx ? NLAT + b * CTXL : b * SEQ;
#pragma unroll
    for (int k = 0; k < 6; ++k) { const int p = tid + NTHR * k, rr = p >> 5, cg = p & 31, t = t0 - 15 + rr; const v4u z = {0u, 0u, 0u, 0u}; R.u[k] = z; R.g[k] = z;
        if (rr < 94 && t >= 0 && t < N) { const bf16* pr = P + (size_t)(rowbase + t) * PLD; R.u[k] = *(const v4u*)(pr + PO_CU + 8 * cg); R.g[k] = *(const v4u*)(pr + PO_CG + 8 * cg); } }
}
__device__ __forceinline__ void conv_phase(const bf16* P, bf16* Y, const float* dw, const float* db, const float* lg, const float* lb, LAS unsigned char* lds, int ntask, bool ctx, int wg, int G, int tid) {
    const int lane = tid & 63, wave = tid >> 6;
    (void)ctx;
    LAS float* a = (LAS float*)lds;
    const int grp = wave & 3, th = wave >> 2, ch = grp * 64 + lane;
    if (wg >= ntask) return;
    typedef float f2c __attribute__((ext_vector_type(2)));
    f2c wp[32];
#pragma unroll
    for (int k = 0; k < 32; ++k) { wp[k].x = k < 31 ? dw[k * 256 + ch] : 0.f; wp[k].y = k > 0 ? dw[(k - 1) * 256 + ch] : 0.f; }
    const float bias = db[ch], gam = lg[ch], bet = lb[ch];
    ConvRegs R; conv_issue(R, P, wg, ctx, tid);
    for (int task = wg; task < ntask; task += G) {
        const bool cx = task >= 512; const int tk = cx ? task - 512 : task, ntile = (cx ? CTXL : SEQ) / 64; const int b = tk / ntile, t0 = (tk % ntile) * 64, rowbase = cx ? NLAT + b * CTXL : b * SEQ;
        __syncthreads();
#pragma unroll
        for (int k = 0; k < 6; ++k) { const int p = tid + NTHR * k, rr = p >> 5, cg = p & 31; const v4u u = R.u[k], gq = R.g[k]; f32x4 o0, o1;
            o0.x = bflo(u.x) * sigmoid_f(bflo(gq.x)); o0.y = bfhi(u.x) * sigmoid_f(bfhi(gq.x)); o0.z = bflo(u.y) * sigmoid_f(bflo(gq.y)); o0.w = bfhi(u.y) * sigmoid_f(bfhi(gq.y));
            o1.x = bflo(u.z) * sigmoid_f(bflo(gq.z)); o1.y = bfhi(u.z) * sigmoid_f(bfhi(gq.z)); o1.z = bflo(u.w) * sigmoid_f(bflo(gq.w)); o1.w = bfhi(u.w) * sigmoid_f(bfhi(gq.w));
            if (rr < 94) { *(LAS f32x4*)(a + rr * 256 + 8 * cg) = o0; *(LAS f32x4*)(a + rr * 256 + 8 * cg + 4) = o1; } }
        __syncthreads();
        if (task + G < ntask) conv_issue(R, P, task + G, ctx, tid);
        f2c acc2[16];
#pragma unroll
        for (int p = 0; p < 16; ++p) acc2[p] = (f2c){bias, bias};
        float vq[4];
#pragma unroll
        for (int j = 0; j < 4; ++j) vq[j] = a[(th * 32 + j) * 256 + ch];
#pragma unroll
        for (int j = 0; j < 62; ++j) { const float v = vq[j & 3]; const f2c vv = {v, v};
            if (j + 4 < 62) vq[j & 3] = a[(th * 32 + j + 4) * 256 + ch];
#pragma unroll
            for (int p = 0; p < 16; ++p) if (j - 2 * p >= 0 && j - 2 * p <= 31) acc2[p] += vv * wp[j - 2 * p];
            asm volatile("" ::: "memory"); }
        __syncthreads();
        LAS float* S = (LAS float*)lds + wave * (32 * 65 + 64); LAS float* St = S + 32 * 65;
#pragma unroll
        for (int p = 0; p < 16; ++p) { S[(2 * p) * 65 + lane] = acc2[p].x; S[(2 * p + 1) * 65 + lane] = acc2[p].y; }
        LDS_WAIT();
        { const int tt = lane & 31, c0 = (lane >> 5) * 32; float s1 = 0.f, s2 = 0.f;
#pragma unroll
            for (int c = 0; c < 32; ++c) { const float x = S[tt * 65 + c0 + c]; s1 += x; s2 += x * x; }
            s1 += __shfl_xor(s1, 32); s2 += __shfl_xor(s2, 32);
            const float mu = s1 * (1.0f / 64.0f), var = fmaxf(s2 * (1.0f / 64.0f) - mu * mu, 0.f);
            if (lane < 32) { St[tt] = mu; St[32 + tt] = __builtin_amdgcn_rsqf(var + EPS); } }
        LDS_WAIT();
#pragma unroll
        for (int t = 0; t < 32; ++t) { const float x = (t & 1) ? acc2[t >> 1].y : acc2[t >> 1].x;
            const float yn = (x - St[t]) * St[32 + t] * gam + bet;
            Y[(size_t)(rowbase + t0 + th * 32 + t) * D + 768 + ch] = (bf16)f2bf(silu_f(yn)); }
    }
}

constexpr size_t WS_FA = WS_A;
__device__ __forceinline__ void fourier_a_phase(const bf16* P, bf16* FA, LAS unsigned char* lds, int wg, int G, int tid) {
    const int lane = tid & 63, wave = tid >> 6, r = lane & 15, g = lane >> 4;
    LAS unsigned short* ZT = (LAS unsigned short*)lds;
    bf16x8v cfr[4], nsfr[4];
    { const int k1 = 16 * wave + r;
#pragma unroll
        for (int kk = 0; kk < 4; ++kk) { float cv[8], sv[8];
#pragma unroll
            for (int i = 0; i < 8; ++i) { const int n1 = 32 * kk + 8 * g + i; float s, c; sincospif((float)((k1 * n1) & 127) * (1.0f / 64.0f), &s, &c); cv[i] = c; sv[i] = -s; }
            cfr[kk] = pack8(cv); nsfr[kk] = pack8(sv); } }
    if (wg >= 16 * 64) return;
    v4u zr[2];
#define FA_ISSUE(task_) do { const int bg_ = (task_) >> 6, n2_ = (task_) & 63, b_ = bg_ >> 2, g4_ = bg_ & 3; _Pragma("unroll") for (int i2 = 0; i2 < 2; ++i2) { const int p = tid + NTHR * i2, n1 = p >> 3, cg = p & 7; \
        zr[i2] = *(const v4u*)(P + (size_t)(b_ * SEQ + 64 * n1 + n2_) * PLD + PO_F + 64 * g4_ + 8 * cg); } } while (0)
    FA_ISSUE(wg);
    for (int task = wg; task < 16 * 64; task += G) {
        const int bg = task >> 6, n2 = task & 63;
        __syncthreads();
#pragma unroll
        for (int i2 = 0; i2 < 2; ++i2) { const int p = tid + NTHR * i2, n1 = p >> 3, cg = p & 7; const unsigned zz[4] = {zr[i2].x, zr[i2].y, zr[i2].z, zr[i2].w};
#pragma unroll
            for (int j = 0; j < 4; ++j) { const int c0 = 8 * cg + 2 * j; const int blk = (((n1 >> 3) ^ cg) << 3) + (n1 & 7);
                ZT[c0 * 136 + blk] = (unsigned short)(zz[j] & 0xffffu); ZT[(c0 + 1) * 136 + blk] = (unsigned short)(zz[j] >> 16); } }
        __syncthreads();
        if (task + G < 16 * 64) FA_ISSUE(task + G);
        const int k1 = 16 * wave + r; float tc, ts; sincospif((float)(n2 * k1) * (1.0f / 4096.0f), &ts, &tc);
        bf16* dst = FA + ((size_t)(bg * 128 + k1) * 2) * 4096 + n2 * 64;
        if (wave < 5)
#pragma unroll
        for (int ct = 0; ct < 4; ++ct) { f32x4 aR = {0.f, 0.f, 0.f, 0.f}, aI = aR;
#pragma unroll
            for (int kk = 0; kk < 4; ++kk) { const bf16x8v a = *(const LAS bf16x8v*)(ZT + (16 * ct + r) * 136 + (((4 * kk + g) ^ ((2 * ct + (r >> 3)) & 7)) << 3)); aR = MFMA16(a, cfr[kk], aR); aI = MFMA16(a, nsfr[kk], aI); }
            v2u oR, oI; oR.x = pk2(aR[0] * tc + aI[0] * ts, aR[1] * tc + aI[1] * ts); oR.y = pk2(aR[2] * tc + aI[2] * ts, aR[3] * tc + aI[3] * ts);
            oI.x = pk2(aI[0] * tc - aR[0] * ts, aI[1] * tc - aR[1] * ts); oI.y = pk2(aI[2] * tc - aR[2] * ts, aI[3] * tc - aR[3] * ts);
            if (k1 <= 64) { *(v2u*)(dst + 16 * ct + 4 * g) = oR; *(v2u*)(dst + 4096 + 16 * ct + 4 * g) = oI; } }
    }
}
__device__ __forceinline__ void fourier_b_phase(const bf16* FA, bf16* Y, LAS unsigned char* lds, int wg, int G, int tid) {
    const int lane = tid & 63, wave = tid >> 6, r = lane & 15, g = lane >> 4, kt = wave & 3, kh = wave >> 2;
    LAS unsigned short* Ms = (LAS unsigned short*)lds;
    LAS unsigned short* Ys = (LAS unsigned short*)(lds + 32768);
    bf16x8v Cf[2], Sf[2], NSf[2], C2[2][2], S2[2][2];
    { const int kc = 16 * kt + r;
#pragma unroll
        for (int kk = 0; kk < 2; ++kk) { float cv[8], sv[8], nv[8];
#pragma unroll
            for (int i = 0; i < 8; ++i) { const int c = 32 * kk + 8 * g + i; float s, co; sincospif((float)((kc * c) & 63) * (1.0f / 32.0f), &s, &co); cv[i] = co; sv[i] = s; nv[i] = -s; }
            Cf[kk] = pack8(cv); Sf[kk] = pack8(sv); NSf[kk] = pack8(nv); }
#pragma unroll
        for (int m = 0; m < 2; ++m) { const int k2 = 16 * (2 * kh + m) + r;
#pragma unroll
            for (int kk = 0; kk < 2; ++kk) { float cv[8], sv[8];
#pragma unroll
                for (int i = 0; i < 8; ++i) { const int n2 = 32 * kk + 16 * (i >> 2) + 4 * g + (i & 3); float s, co; sincospif((float)((k2 * n2) & 63) * (1.0f / 32.0f), &s, &co); cv[i] = co; sv[i] = s; }
                C2[m][kk] = pack8(cv); S2[m][kk] = pack8(sv); } } }
    const float scale = 1.0f / sqrtf(8192.0f * 64.0f);
    if (wg >= 16 * 65) return;
    v4u mr[2];
#define FB_ISSUE(task_) do { const bf16* src_ = FA + (size_t)(((task_) / 65) * 128 + (task_) % 65) * 8192; _Pragma("unroll") for (int i2 = 0; i2 < 2; ++i2) { const int p = tid + NTHR * i2; mr[i2] = *(const v4u*)(src_ + 8 * p); } } while (0)
    FB_ISSUE(wg);
    for (int task = wg; task < 16 * 65; task += G) {
        const int bg = task / 65, k1 = task % 65, b = bg >> 2, g4 = bg & 3;
        __syncthreads();
#pragma unroll
        for (int i2 = 0; i2 < 2; ++i2) { const int p = tid + NTHR * i2, plane = p >> 9, n2 = (p >> 3) & 63, cg = p & 7; *(LAS v4u*)(Ms + plane * 4608 + n2 * 72 + 8 * cg) = mr[i2]; }
        __syncthreads();
        if (task + G < 16 * 65) FB_ISSUE(task + G);
        f32x4 tre[4], tim[4];
#pragma unroll
        for (int nt = 0; nt < 4; ++nt) { f32x4 a = {0.f, 0.f, 0.f, 0.f}, bq = a;
#pragma unroll
            for (int kk = 0; kk < 2; ++kk) { const bf16x8v are = *(const LAS bf16x8v*)(Ms + (16 * nt + r) * 72 + 32 * kk + 8 * g), aim = *(const LAS bf16x8v*)(Ms + 4608 + (16 * nt + r) * 72 + 32 * kk + 8 * g);
                a = MFMA16(are, Cf[kk], a); a = MFMA16(aim, Sf[kk], a); bq = MFMA16(aim, Cf[kk], bq); bq = MFMA16(are, NSf[kk], bq); }
            tre[nt] = a; tim[nt] = bq; }
        bf16x8v bre[2], bim[2];
#pragma unroll
        for (int kk = 0; kk < 2; ++kk) { const float v0[8] = {tre[2 * kk][0], tre[2 * kk][1], tre[2 * kk][2], tre[2 * kk][3], tre[2 * kk + 1][0], tre[2 * kk + 1][1], tre[2 * kk + 1][2], tre[2 * kk + 1][3]};
            const float v1[8] = {tim[2 * kk][0], tim[2 * kk][1], tim[2 * kk][2], tim[2 * kk][3], tim[2 * kk + 1][0], tim[2 * kk + 1][1], tim[2 * kk + 1][2], tim[2 * kk + 1][3]};
            bre[kk] = pack8(v0); bim[kk] = pack8(v1); }
#pragma unroll
        for (int m = 0; m < 2; ++m) { f32x4 y = {0.f, 0.f, 0.f, 0.f};
#pragma unroll
            for (int kk = 0; kk < 2; ++kk) { y = MFMA16(C2[m][kk], bre[kk], y); y = MFMA16(S2[m][kk], bim[kk], y); }
#pragma unroll
            for (int i = 0; i < 4; ++i) { const int k2 = 16 * (2 * kh + m) + 4 * g + i; Ys[k2 * 72 + 16 * kt + r] = (unsigned short)f2bf(y[i] * scale); } }
        __syncthreads();
        { const int row = tid >> 3, ch = tid & 7;
            *(v4u*)(Y + (size_t)(b * SEQ + k1 + 128 * row) * D + 512 + 64 * g4 + 8 * ch) = *(const LAS v4u*)(Ys + row * 72 + 8 * ch);
            if (k1 != 0 && k1 != 64) {
                const LAS unsigned short* sr = Ys + (63 - row) * 72; unsigned short e[8];
#pragma unroll
                for (int j = 0; j < 8; ++j) e[j] = sr[(64 - (8 * ch + j)) & 63];
                v4u w; w.x = (unsigned)e[0] | ((unsigned)e[1] << 16); w.y = (unsigned)e[2] | ((unsigned)e[3] << 16); w.z = (unsigned)e[4] | ((unsigned)e[5] << 16); w.w = (unsigned)e[6] | ((unsigned)e[7] << 16);
                *(v4u*)(Y + (size_t)(b * SEQ + (128 - k1) + 128 * row) * D + 512 + 64 * g4 + 8 * ch) = w; } }
    }
}

__device__ __forceinline__ void mix_a_phase(const float* const* in, unsigned char* ws, int L, bool do_ctx, LAS unsigned char* lds, int wg, int G, int tid) {
    const bf16* P = (const bf16*)(ws + WS_P); bf16* Y = (bf16*)(ws + WS_Y);
#ifndef SUBDUP
#define SUBDUP 0
#endif
    _Pragma("unroll") for (int rep_ = 0; rep_ < ((SUBDUP & 1) ? 2 : 1); ++rep_) mlstm_m1_phase(P, (const float*)(ws + WS_G), in[9] + L * 16, ws, lds, 16 * NCHK, wg, G, tid);
    _Pragma("unroll") for (int rep_ = 0; rep_ < ((SUBDUP & 2) ? 2 : 1); ++rep_) fourier_a_phase(P, (bf16*)(ws + WS_FA), lds, wg, G, tid);
    if (do_ctx) {
        __syncthreads();
        { LAS f32x2* tab = (LAS f32x2*)lds; for (int i = tid; i < 8192; i += NTHR) { float s, c; sincospif((float)i * (1.0f / 4096.0f), &s, &c); tab[i] = (f32x2){c, s}; } }
        __syncthreads();
        for (int t = wg; t < 16 * 4 * 4; t += G) fourier_ctx_task(P, Y, lds, t, tid);
    }
    _Pragma("unroll") for (int rep_ = 0; rep_ < ((SUBDUP & 4) ? 2 : 1); ++rep_) conv_phase(P, Y, in[11] + L * 31 * 256, in[12] + L * 256, in[13] + L * 256, in[14] + L * 256, lds, do_ctx ? 4 * 128 + 4 * 4 : 4 * 128, false, wg, G, tid);
}

constexpr int NPH = 21;
constexpr int GU_SPLIT = 9000;
#ifndef MK_SINGLE
#define MK_SINGLE 1
#endif
struct Params { const float* in[23]; float* out; unsigned char* ws; int ph_lo, ph_hi; };
static_assert(sizeof(Params) == 23 * 8 + 8 + 8 + 8, "Params has no padding");

__global__ void __launch_bounds__(NTHR, 2) fwd_kernel(Params p) {
    extern __shared__ __attribute__((aligned(16))) unsigned char lds_raw[];
    LAS unsigned char* lds = (LAS unsigned char*)lds_raw;
    const int wg = blockIdx.x, G = gridDim.x;
    const int wave_s = __builtin_amdgcn_readfirstlane((int)(threadIdx.x >> 6));
#define FRESH_TID() ([&]() { int w_ = wave_s; asm volatile("" : "+s"(w_)); __builtin_assume(w_ >= 0 && w_ < 8); const int l_ = (int)__builtin_amdgcn_mbcnt_hi(~0u, __builtin_amdgcn_mbcnt_lo(~0u, 0u)); __builtin_assume(l_ >= 0 && l_ < 64); return w_ * 64 + l_; }())
    unsigned char* ws = p.ws;
    const float* const* in = p.in;
    for (int u = (int)threadIdx.x; u < (LDS_BYTES - LDSCTL_OFF) / 4; u += NTHR) ((LAS unsigned*)(lds + LDSCTL_OFF))[u] = 0u;
    __syncthreads();
    if (threadIdx.x == 0) { const unsigned xq = xb_xcc_id() & 7u; ((volatile LAS unsigned*)(lds + LDSCTL_OFF + 128))[0] = xq; ((volatile LAS unsigned*)(lds + LDSCTL_OFF + 128))[1] = xb_add((unsigned*)(ws + WS_CTL) + 64 * xq, 1u); }
    __syncthreads();
    XcdBarrier bar; bar.bar = (unsigned*)(ws + WS_CTL) + CW_BAR; bar.x = 0; bar.st = (volatile LAS unsigned*)(lds + LDSCTL_OFF + 64);
    if (MK_SINGLE) bar = xcd_barrier_post((unsigned*)(ws + WS_CTL) + CW_BAR, (volatile LAS unsigned*)(lds + LDSCTL_OFF + 64));
    const int lo = p.ph_lo, hi = p.ph_hi;
#ifndef PH_MASK
#define PH_MASK 0xFFFFFFFFu
#endif
#define IN(k) (((PH_MASK >> (k)) & 1u) && lo <= (k) && (k) < hi)
#ifndef DUP_MASK
#define DUP_MASK 0u
#endif
#define REP(k) _Pragma("unroll") for (int rep_ = 0; rep_ < ((((DUP_MASK) >> (k)) & 1u) ? 2 : 1); ++rep_)
#define ORDER_ID() ([&]() { const unsigned* cw_ = (const unsigned*)(ws + WS_CTL); bool ok_ = (G % 8) == 0; _Pragma("unroll") for (int j_ = 0; j_ < 8; ++j_) ok_ = ok_ && (xb_ld((unsigned*)cw_ + 64 * j_) == (unsigned)(G / 8)); \
        const unsigned xq_ = ((volatile LAS unsigned*)(lds + LDSCTL_OFF + 128))[0], rk_ = ((volatile LAS unsigned*)(lds + LDSCTL_OFF + 128))[1]; return __builtin_amdgcn_readfirstlane(ok_ ? (int)(xq_ + 8u * rk_) : wg); }())
#define SEAM(k) do { if (MK_SINGLE && IN((k) + 1)) xcd_barrier(bar, FRESH_TID()); } while (0)
#ifndef DEPHASE_Q
#define DEPHASE_Q 0
#endif
#define DEPHASE(K_) do { if (DEPHASE_Q) { const unsigned long long t0_ = __builtin_amdgcn_s_memrealtime(); const unsigned long long d_ = (unsigned long long)((wg >> 3) & 3) * (unsigned long long)(DEPHASE_Q * (K_) / 1024); while (__builtin_amdgcn_s_memrealtime() - t0_ < d_) __builtin_amdgcn_s_sleep(8); } } while (0)
#define MOD ((const float*)(ws + WS_MOD))
#define A ((bf16*)(ws + WS_A))
#define Pb ((bf16*)(ws + WS_P))
#define Yb ((bf16*)(ws + WS_Y))
#define Hb ((bf16*)(ws + WS_H))
#define Gt ((float*)(ws + WS_G))
#define XC ((float*)(ws + WS_XC))
#define XB ((bf16*)(ws + WS_XB))
#define XCB ((bf16*)(ws + WS_XCB))
#define HF ((float*)(ws + WS_HF))
#define HB ((float*)(ws + WS_HB))
#define rw ((int*)(ws + WS_ROUTE))
#define tok_e ((int*)(ws + WS_TOK))
#define tok_w ((float*)(ws + WS_TOK + 256 * 1024))
#define pair_pos ((int*)(ws + WS_TOK + 512 * 1024))
#define row_w ((float*)(ws + WS_TOK + 768 * 1024))
#define MOD1 (MOD + 5 * 6144)

    if (IN(0)) { const int tid = FRESH_TID(); REP(0) { if (rep_) __syncthreads(); prologue_phase(in, ws, lds, wg, G, tid); } SEAM(0); }
#if defined(BARDUP) && BARDUP
    if (MK_SINGLE && IN(1)) { _Pragma("unroll 1") for (int q_ = 0; q_ < BARDUP; ++q_) xcd_barrier(bar, FRESH_TID()); }
#endif
    if (IN(1)) { const int tid = FRESH_TID(); REP(1) { if (rep_) __syncthreads(); norm_phase<false>(in[0], in[2], true, in[4], MOD, 0, A, nullptr, nullptr, nullptr, nullptr, nullptr, lds, wg, G, tid); } SEAM(1); }
    if (IN(2)) { const int tid = FRESH_TID(); REP(2) { if (rep_) __syncthreads(); DEPHASE(D); pg8::Gemm g{A, (const bf16*)(ws + WS_WIN), MROWS, 2816, D}; pg8::StaticOrder S; S.init(MROWS, 2816, G, ORDER_ID()); pg8::EpiP E{Pb, Gt};
        pg8::gemm_phase<pg8::EpiP, pg8::StaticOrder, true, true>(lds, g, S, E, tid);
        { const int nu = (MROWS / 256) * 11, busy = nu % G; if (busy == 0) gate_proj_tasks(A, (const bf16*)(ws + WS_WIN), Gt, ORDER_ID(), G, tid); else if (ORDER_ID() >= busy) gate_proj_tasks(A, (const bf16*)(ws + WS_WIN), Gt, ORDER_ID() - busy, G - busy, tid); }
        } SEAM(2); }
    if (IN(3)) { const int tid = FRESH_TID(); REP(3) { if (rep_) __syncthreads(); mix_a_phase(in, ws, 0, true, lds, wg, G, tid); } SEAM(3); }
    if (IN(4)) { const int tid = FRESH_TID(); REP(4) { if (rep_) __syncthreads(); mlstm_m2_phase(ws, wg, G, tid); REP(21) { if (rep_) __syncthreads(); fourier_b_phase((const bf16*)(ws + WS_FA), Yb, lds, wg, G, tid); } } SEAM(4); }
    if (IN(5)) { const int tid = FRESH_TID(); REP(5) { if (rep_) __syncthreads(); mlstm_m3_phase(Pb, Gt, in[9], in[10], ws, Yb, lds, NCHK, wg, G, tid); } SEAM(5); }
    if (IN(6)) { const int tid = FRESH_TID(); REP(6) { if (rep_) __syncthreads(); DEPHASE(D); pg8::Gemm g{Yb, (const bf16*)(ws + WS_WOUT), MROWS, D, D}; pg8::StaticOrder S; S.init(MROWS, D, G, ORDER_ID()); pg8::EpiResB<true> E{in[0], XB, in[2], XCB, MOD + 2 * D, 1.0f};
        pg8::gemm_phase<pg8::EpiResB<true>, pg8::StaticOrder, true, true>(lds, g, S, E, tid);
        if (G == 256) { if (ORDER_ID() >= 16) moe_convert_items(in, ws, lds, 0, ORDER_ID() - 16, G - 16, tid); } else moe_convert_items(in, ws, lds, 0, wg, G, tid); } SEAM(6); }
    if (IN(7)) { const int tid = FRESH_TID(); REP(7) { if (rep_) __syncthreads(); norm_phase<false, false, true>(XB, XCB, true, in[5], MOD, 3, A, nullptr, nullptr, nullptr, nullptr, nullptr, lds, wg, G, tid); } SEAM(7); }
    if (IN(8)) { const int tid = FRESH_TID(); REP(8) { if (rep_) __syncthreads(); DEPHASE(D); pg8::Gemm g{A, (const bf16*)(ws + WS_WGU), MROWS, 2 * FFH, D}; pg8::StaticOrder S; S.init(MROWS, 2 * FFH, G, ORDER_ID()); pg8::EpiSwigluToF8 E{(unsigned char*)(ws + WS_H)};
        pg8::gemm_phase<pg8::EpiSwigluToF8, pg8::StaticOrder, true, true>(lds, g, S, E, tid);
        if (G == 256 && ORDER_ID() >= 88) moe_convert_items(in, ws, lds, 1, ORDER_ID() - 88, G - 88, tid, 0, GU_SPLIT); } SEAM(8); }
    if (IN(9)) { const int tid = FRESH_TID(); REP(9) { if (rep_) __syncthreads(); DEPHASE(FFH); pg8::Gemm g{Hb, (const bf16*)(ws + WS_WD), MROWS, D, FFH / 2}; pg8::StaticOrder S; S.init(MROWS, D, G, ORDER_ID()); pg8::EpiResB<false> E{XB, XB, XCB, XCB, MOD + 5 * D, 1.0f / (pg8::F8_SH * pg8::F8_SWD)};
        pg8::gemm_phase<pg8::EpiResB<false>, pg8::StaticOrder, true, true, true>(lds, g, S, E, tid);
        if (G == 256) { if (ORDER_ID() >= 16) moe_convert_items(in, ws, lds, 1, ORDER_ID() - 16, G - 16, tid, GU_SPLIT); } else moe_convert_items(in, ws, lds, 1, wg, G, tid); } SEAM(9); }
    if (IN(10)) { const int tid = FRESH_TID(); REP(10) { if (rep_) __syncthreads(); norm_phase<false, false, true>(XB, XCB, true, in[4] + D, MOD1, 0, A, nullptr, nullptr, nullptr, nullptr, nullptr, lds, wg, G, tid); } SEAM(10); }
    if (IN(11)) { const int tid = FRESH_TID(); REP(11) { if (rep_) __syncthreads(); DEPHASE(D); pg8::Gemm g{A, (const bf16*)(ws + WS_WIN) + (size_t)PLD * D, MROWS, 2816, D}; pg8::StaticOrder S; S.init(MROWS, 2816, G, ORDER_ID()); pg8::EpiP E{Pb, Gt};
        pg8::gemm_phase<pg8::EpiP, pg8::StaticOrder, true, true>(lds, g, S, E, tid);
        { const int nu = (MROWS / 256) * 11, busy = nu % G; if (busy == 0) gate_proj_tasks(A, (const bf16*)(ws + WS_WIN) + (size_t)PLD * D, Gt, ORDER_ID(), G, tid); else if (ORDER_ID() >= busy) gate_proj_tasks(A, (const bf16*)(ws + WS_WIN) + (size_t)PLD * D, Gt, ORDER_ID() - busy, G - busy, tid); } } SEAM(11); }
    if (IN(12)) { const int tid = FRESH_TID(); REP(12) { if (rep_) __syncthreads(); mix_a_phase(in, ws, 1, false, lds, wg, G, tid); } SEAM(12); }
    if (IN(13)) { const int tid = FRESH_TID(); REP(13) { if (rep_) __syncthreads(); mlstm_m2_phase(ws, wg, G, tid); REP(21) { if (rep_) __syncthreads(); fourier_b_phase((const bf16*)(ws + WS_FA), Yb, lds, wg, G, tid); } } SEAM(13); }
    if (IN(14)) { const int tid = FRESH_TID(); REP(14) { if (rep_) __syncthreads(); mlstm_m3_phase(Pb, Gt, in[9] + 16, in[10] + 512, ws, Yb, lds, 128, wg, G, tid); } SEAM(14); }
    if (IN(15)) { const int tid = FRESH_TID(); REP(15) { if (rep_) __syncthreads(); DEPHASE(D); pg8::Gemm g{Yb, (const bf16*)(ws + WS_WOUT) + (size_t)D * D, NLAT, D, D}; pg8::StaticOrder S; S.init(NLAT, D, G, ORDER_ID()); pg8::EpiResB<false> E{XB, XB, XCB, XCB, MOD1 + 2 * D, 1.0f};
        pg8::gemm_phase<pg8::EpiResB<false>, pg8::StaticOrder, true, true>(lds, g, S, E, tid); } SEAM(15); }
    if (IN(16)) { const int tid = FRESH_TID(); REP(16) { if (rep_) __syncthreads(); norm_phase<true, true, true>(XB, XCB, false, in[5] + D, MOD1, 3, A, in[18], in[19], tok_e, tok_w, rw + RW_HIST, lds, wg, G, tid); } SEAM(16); }
    if (IN(17)) { const int tid = FRESH_TID(); REP(17) { if (rep_) __syncthreads(); route_phase(ws, lds, wg, G, tid); } SEAM(17); }
    if (IN(18)) { const int tid = FRESH_TID(); REP(18) { if (rep_) __syncthreads(); const int nT = __builtin_amdgcn_readfirstlane(rw[RW_NTILES]); DEPHASE(D); pg8::Gemm g{(const bf16*)(ws + WS_A), (const bf16*)(ws + WS_MWGU), nT * 256, NEXP * 2 * FFH, D / 2, (const int*)(ws + WS_ROWTOK)};
        LAS int* te_l = (LAS int*)(lds + LDSCTL_OFF + 1024); for (int i = tid; i < 264; i += NTHR) te_l[i] = rw[RW_TILE_E + i]; __syncthreads();
        pg8::MoeOrder S; S.init_moe(nT, 22, te_l, G, ORDER_ID()); pg8::EpiSwigluF8 E{(unsigned char*)(ws + WS_HSORT)};
        pg8::gemm_phase<pg8::EpiSwigluF8, pg8::MoeOrder, true, true, true, true>(lds, g, S, E, tid); } SEAM(18); }
    if (IN(19)) { const int tid = FRESH_TID(); REP(19) { if (rep_) __syncthreads(); const int nT = __builtin_amdgcn_readfirstlane(rw[RW_NTILES]); DEPHASE(FFH); pg8::Gemm g{(const bf16*)(ws + WS_HSORT), (const bf16*)(ws + WS_MWD), nT * 256, NEXP * D, FFH / 2};
        LAS int* te_l = (LAS int*)(lds + LDSCTL_OFF + 1024); for (int i = tid; i < 264; i += NTHR) te_l[i] = rw[RW_TILE_E + i]; __syncthreads();
        pg8::MoeOrder S; S.init_moe(nT, 4, te_l, G, ORDER_ID()); pg8::EpiMoeDownF8 E{(bf16*)(ws + WS_OPAIR), row_w};
        pg8::gemm_phase<pg8::EpiMoeDownF8, pg8::MoeOrder, true, true, true>(lds, g, S, E, tid); } SEAM(19); }
    if (IN(20)) { const int tid = FRESH_TID(); final_phase(XB, p.out, (const bf16*)(ws + WS_OPAIR), pair_pos, MOD1, in[22], wg, G, tid); }
#undef IN
#undef MOD
#undef A
#undef Pb
#undef Yb
#undef Hb
#undef Gt
#undef XC
#undef XB
#undef XCB
#undef HF
#undef HB
#undef rw
#undef tok_e
#undef tok_w
#undef pair_pos
#undef row_w
#undef MOD1
#undef SEAM
}

extern "C" void kernel_launch(void* const* d_in, const int* in_sizes, int n_in, void* d_out, int out_size, void* d_ws, size_t ws_size, hipStream_t stream) {
    static int grid = 0;
    if (grid == 0) {
        if (n_in != 23 || in_sizes[0] != NLAT * D || out_size != NLAT * D || ws_size < WS_END) { fprintf(stderr, "kernel_launch: unexpected problem shape (n_in %d, out %d, ws %zu); nothing launched\n", n_in, out_size, ws_size); grid = -1; return; }
        int dev = 0, cus = 0;
        if (hipGetDevice(&dev) != hipSuccess || hipDeviceGetAttribute(&cus, hipDeviceAttributeMultiprocessorCount, dev) != hipSuccess) { grid = -1; return; }
        if (hipFuncSetAttribute((const void*)fwd_kernel, hipFuncAttributeMaxDynamicSharedMemorySize, LDS_BYTES) != hipSuccess) { fprintf(stderr, "kernel_launch: hipFuncSetAttribute failed\n"); grid = -1; return; }
        int per_cu = 0;
        if (hipOccupancyMaxActiveBlocksPerMultiprocessor(&per_cu, (const void*)fwd_kernel, NTHR, LDS_BYTES) != hipSuccess || per_cu < 1) { fprintf(stderr, "kernel_launch: occupancy query says %d blocks per CU\n", per_cu); }
        (void)hipGetLastError();
        grid = cus;
    }
    if (grid < 0) return;
    if (hipMemsetAsync((char*)d_ws + WS_CTL, 0, CTL_ZERO_BYTES, stream) != hipSuccess) return;
    Params p{};
    for (int i = 0; i < 23; ++i) p.in[i] = (const float*)d_in[i];
    p.out = (float*)d_out; p.ws = (unsigned char*)d_ws;
#if MK_SINGLE
    p.ph_lo = 0; p.ph_hi = NPH;
    hipLaunchKernelGGL(fwd_kernel, dim3(grid), dim3(NTHR), LDS_BYTES, stream, p);
#else
    for (int k = 0; k < NPH; ++k) { p.ph_lo = k; p.ph_hi = k + 1; hipLaunchKernelGGL(fwd_kernel, dim3(grid), dim3(NTHR), LDS_BYTES, stream, p); }
#endif
}
```

```cpp
#include <hip/hip_runtime.h>
#include <cstdio>
#include <cstdint>
namespace pg8 {
#define PG8_LAS __attribute__((address_space(3)))
typedef unsigned short bf16_t;
typedef short bf16x8 __attribute__((ext_vector_type(8)));
typedef float f32x4 __attribute__((ext_vector_type(4)));
typedef unsigned u32x4 __attribute__((ext_vector_type(4)));
constexpr int BM = 256, BK = 64, HALF = 128, HTB = HALF * BK * 2  , STAGE_BYTES = 8 * HTB, NXCD = 8, WGM = 8;

__host__ __device__ __forceinline__ int lds_byte(int r, int c) { const int st = (r >> 4) * 2 + (c >> 5), rr = r & 15, cc = c & 31, ob = rr * 64 + cc * 2; return st * 1024 + (ob ^ (((ob >> 9) & 1) << 5)); }
__host__ __device__ __forceinline__ void stage_rc(int b, int& R, int& C) { const int st = b / 1024, sb = b % 1024, swz = sb ^ (((sb >> 9) & 1) << 5); R = (st >> 1) * 16 + swz / 64; C = (st & 1) * 32 + (swz % 64) / 2; }
__host__ __device__ __forceinline__ int perm32(int rho) { const int n = rho >> 4, i = rho & 15; return 8 * (i >> 2) + 4 * n + (i & 3); }

struct Unit { int pm, pn; };
struct Gemm { const bf16_t* A; const bf16_t* Bt; int M, N, K; const int* rt = nullptr; };

struct StaticOrder {
    int nM, nN, nwg, G, c;
    __host__ __device__ void init(int M, int N, int G_, int c_) { nM = M / BM; nN = N / BM; nwg = nM * nN; G = G_; c = c_; }
    __host__ __device__ bool next(int i, Unit& u) const {
        const int L = i * G + c; if (L >= nwg) return false;
        int wgid = L; { const int q = nwg / NXCD, r = nwg % NXCD, xcd = wgid % NXCD, off = wgid / NXCD; wgid = (xcd < r ? xcd * (q + 1) : r * (q + 1) + (xcd - r) * q) + off; }
        const int nig = WGM * nN, gid = wgid / nig, fm = gid * WGM, gsz = (nM - fm) < WGM ? (nM - fm) : WGM;
        u.pm = fm + ((wgid % nig) % gsz); u.pn = (wgid % nig) / gsz; return true;
    }
    __device__ __forceinline__ void a_ready(const Unit&) const {}
    __device__ __forceinline__ void done(const Unit&) const {}
};

typedef float f32x2c __attribute__((ext_vector_type(2))); typedef __bf16 bf16x2c __attribute__((ext_vector_type(2)));
__device__ __forceinline__ unsigned cvt_pk_bf16(float lo, float hi) { const f32x2c v = {lo, hi}; const bf16x2c b = __builtin_convertvector(v, bf16x2c); return __builtin_bit_cast(unsigned, b); }
typedef int i32x8 __attribute__((ext_vector_type(8)));
typedef int i32x4 __attribute__((ext_vector_type(4)));
__device__ __forceinline__ i32x8 cat8(bf16x8 lo, bf16x8 hi) { const i32x4 a = __builtin_bit_cast(i32x4, lo), c = __builtin_bit_cast(i32x4, hi); return __builtin_shufflevector(a, c, 0, 1, 2, 3, 4, 5, 6, 7); }
__device__ __forceinline__ unsigned pk4_fp8(float a, float c, float d, float e) {
    a = __builtin_amdgcn_fmed3f(a, -448.f, 448.f); c = __builtin_amdgcn_fmed3f(c, -448.f, 448.f); d = __builtin_amdgcn_fmed3f(d, -448.f, 448.f); e = __builtin_amdgcn_fmed3f(e, -448.f, 448.f);
    int w = __builtin_amdgcn_cvt_pk_fp8_f32(a, c, 0, false); w = __builtin_amdgcn_cvt_pk_fp8_f32(d, e, w, true); return (unsigned)w; }
__device__ __forceinline__ float silu_f(float x) { return x * __builtin_amdgcn_rcpf(1.0f + __expf(-x)); }
struct EpiP {
    static constexpr bool PERM = true, AFTER_DRAIN = false;
    bf16_t* P; float* G;
    __device__ __forceinline__ void operator()(const f32x4 (&acc)[2][2][4][2], const Unit& u, int wr, int wc, int fr, int fq) const {
        const int row0 = u.pm * BM + wr * 64 + fr, col0 = u.pn * BM + wc * 32 + 8 * fq;
#pragma unroll
        for (int ai = 0; ai < 2; ++ai)
#pragma unroll
            for (int m = 0; m < 4; ++m) { bf16_t* rowp = P + (size_t)(row0 + ai * HALF + m * 16) * 3072 + col0;
#pragma unroll
                for (int bj = 0; bj < 2; ++bj) { const f32x4 v0 = acc[ai][bj][m][0], v1 = acc[ai][bj][m][1];
                    u32x4 w; w.x = cvt_pk_bf16(v0[0], v0[1]); w.y = cvt_pk_bf16(v0[2], v0[3]); w.z = cvt_pk_bf16(v1[0], v1[1]); w.w = cvt_pk_bf16(v1[2], v1[3]);
                    *(u32x4*)(rowp + bj * HALF) = w; } }
    }
};
struct EpiRes {
    static constexpr bool PERM = false, AFTER_DRAIN = false;
    const float* base_lat; float* out_lat; const float* base_ctx; float* out_ctx; const float* gate; float scale;
    __device__ __forceinline__ void operator()(const f32x4 (&acc)[2][2][4][2], const Unit& u, int wr, int wc, int fr, int fq) const {
        const bool lat = u.pm < 128;
        const float* base = lat ? base_lat + (size_t)u.pm * BM * 1024 : base_ctx + (size_t)(u.pm - 128) * BM * 1024;
        float* out = lat ? out_lat + (size_t)u.pm * BM * 1024 : out_ctx + (size_t)(u.pm - 128) * BM * 1024;
        const float* gv = gate + (size_t)(lat ? (u.pm >> 5) : 4) * 6144;
        const int row0 = wr * 64 + fr, col0 = u.pn * BM + wc * 32 + 4 * fq;
        f32x4 g4[2][2];
#pragma unroll
        for (int bj = 0; bj < 2; ++bj)
#pragma unroll
            for (int n = 0; n < 2; ++n) g4[bj][n] = *(const f32x4*)(gv + col0 + bj * HALF + n * 16) * scale;
#pragma unroll
        for (int ai = 0; ai < 2; ++ai)
#pragma unroll
            for (int m = 0; m < 4; ++m) { const size_t off = (size_t)(row0 + ai * HALF + m * 16) * 1024 + col0;
#pragma unroll
                for (int bj = 0; bj < 2; ++bj)
#pragma unroll
                    for (int n = 0; n < 2; ++n) { const f32x4 bv = *(const f32x4*)(base + off + bj * HALF + n * 16);
                        *(f32x4*)(out + off + bj * HALF + n * 16) = bv + g4[bj][n] * acc[ai][bj][m][n]; }
                asm volatile("" ::: "memory"); }
    }
};
struct MoeOrder : StaticOrder {
    const PG8_LAS int* tile_e; int nNe;
    __device__ void init_moe(int nTiles, int nNe_, const PG8_LAS int* te, int G_, int c_) { nM = nTiles; nN = nNe_; nwg = nM * nN; G = G_; c = c_; tile_e = te; nNe = nNe_; }
    __device__ bool next(int i, Unit& u) const { if (!StaticOrder::next(i, u)) return false; u.pn += __builtin_amdgcn_readfirstlane(tile_e[u.pm]) * nNe; return true; }
};
constexpr float F8_SWGU = 32.f, F8_SH = 8.f, F8_SWD = 64.f;
struct EpiSwigluF8 {
    static constexpr bool PERM = true, AFTER_DRAIN = false;
    unsigned char* H;
    __device__ __forceinline__ void operator()(const f32x4 (&acc)[2][2][4][2], const Unit& u, int wr, int wc, int fr, int fq) const {
        asm volatile("" : "+v"(fr), "+v"(fq));
        const int row0 = u.pm * BM + wr * 64 + fr, col0 = (u.pn % 22) * HALF + wc * 32 + 8 * fq; constexpr float inv = 1.0f / F8_SWGU;
#pragma unroll
        for (int ai = 0; ai < 2; ++ai)
#pragma unroll
            for (int m = 0; m < 4; ++m) { unsigned char* rowp = H + (size_t)(row0 + ai * HALF + m * 16) * 2816 + col0;
                float h[8];
#pragma unroll
                for (int n = 0; n < 2; ++n) { const f32x4 G4 = acc[ai][0][m][n], U4 = acc[ai][1][m][n]; constexpr float c1 = -1.4426950408889634f * inv, kk = 1.0f / (inv * inv * F8_SH);
                    const f32x4 t = G4 * c1; const f32x4 e = {__builtin_amdgcn_exp2f(t[0]), __builtin_amdgcn_exp2f(t[1]), __builtin_amdgcn_exp2f(t[2]), __builtin_amdgcn_exp2f(t[3])};
                    const f32x4 d = e * kk + kk; const f32x4 rr = {__builtin_amdgcn_rcpf(d[0]), __builtin_amdgcn_rcpf(d[1]), __builtin_amdgcn_rcpf(d[2]), __builtin_amdgcn_rcpf(d[3])};
                    const f32x4 hv = (G4 * U4) * rr; h[4 * n] = hv[0]; h[4 * n + 1] = hv[1]; h[4 * n + 2] = hv[2]; h[4 * n + 3] = hv[3]; }
                typedef unsigned u32x2v __attribute__((ext_vector_type(2))); u32x2v w; w.x = pk4_fp8(h[0], h[1], h[2], h[3]); w.y = pk4_fp8(h[4], h[5], h[6], h[7]);
                *(u32x2v*)rowp = w; }
    }
};
struct EpiMoeDownF8 {
    static constexpr bool PERM = true, AFTER_DRAIN = false;
    bf16_t* O; const float* roww;
    __device__ __forceinline__ void operator()(const f32x4 (&acc)[2][2][4][2], const Unit& u, int wr, int wc, int fr, int fq) const {
        asm volatile("" : "+v"(fr), "+v"(fq));
        const int row0 = u.pm * BM + wr * 64 + fr, col0 = (u.pn & 3) * BM + wc * 32 + 8 * fq;
#pragma unroll
        for (int ai = 0; ai < 2; ++ai)
#pragma unroll
            for (int m = 0; m < 4; ++m) { const int r = row0 + ai * HALF + m * 16; const float s = roww[r] * (1.0f / (F8_SH * F8_SWD)); bf16_t* rowp = O + (size_t)r * 1024 + col0;
#pragma unroll
                for (int bj = 0; bj < 2; ++bj) { const f32x4 v0 = acc[ai][bj][m][0] * s, v1 = acc[ai][bj][m][1] * s;
                    u32x4 w; w.x = cvt_pk_bf16(v0[0], v0[1]); w.y = cvt_pk_bf16(v0[2], v0[3]); w.z = cvt_pk_bf16(v1[0], v1[1]); w.w = cvt_pk_bf16(v1[2], v1[3]);
                    *(u32x4*)(rowp + bj * HALF) = w; }
                asm volatile("" ::: "memory"); }
    }
};
struct EpiSwigluToF8 {
    static constexpr bool PERM = true, AFTER_DRAIN = false;
    unsigned char* H;
    __device__ __forceinline__ void operator()(const f32x4 (&acc)[2][2][4][2], const Unit& u, int wr, int wc, int fr, int fq) const {
        asm volatile("" : "+v"(fr), "+v"(fq));
        const int row0 = u.pm * BM + wr * 64 + fr, col0 = (u.pn % 22) * HALF + wc * 32 + 8 * fq;
#pragma unroll
        for (int ai = 0; ai < 2; ++ai)
#pragma unroll
            for (int m = 0; m < 4; ++m) { unsigned char* rowp = H + (size_t)(row0 + ai * HALF + m * 16) * 2816 + col0;
                float h[8];
#pragma unroll
                for (int n = 0; n < 2; ++n) { const f32x4 G4 = acc[ai][0][m][n], U4 = acc[ai][1][m][n]; constexpr float c1 = -1.4426950408889634f, kk = 1.0f / F8_SH;
                    const f32x4 t = G4 * c1; const f32x4 e = {__builtin_amdgcn_exp2f(t[0]), __builtin_amdgcn_exp2f(t[1]), __builtin_amdgcn_exp2f(t[2]), __builtin_amdgcn_exp2f(t[3])};
                    const f32x4 d = e * kk + kk; const f32x4 rr = {__builtin_amdgcn_rcpf(d[0]), __builtin_amdgcn_rcpf(d[1]), __builtin_amdgcn_rcpf(d[2]), __builtin_amdgcn_rcpf(d[3])};
                    const f32x4 hv = (G4 * U4) * rr; h[4 * n] = hv[0]; h[4 * n + 1] = hv[1]; h[4 * n + 2] = hv[2]; h[4 * n + 3] = hv[3]; }
                typedef unsigned u32x2v __attribute__((ext_vector_type(2))); u32x2v w; w.x = pk4_fp8(h[0], h[1], h[2], h[3]); w.y = pk4_fp8(h[4], h[5], h[6], h[7]);
                *(u32x2v*)rowp = w; }
    }
};
struct EpiResLean {
    static constexpr bool PERM = false, AFTER_DRAIN = false;
    const float* base_lat; float* out_lat; const float* base_ctx; float* out_ctx; const float* gate; float scale;
    __device__ __forceinline__ void operator()(const f32x4 (&acc)[2][2][4][2], const Unit& u, int wr, int wc, int fr, int fq) const {
        asm volatile("" : "+v"(fr), "+v"(fq));
        const bool lat = u.pm < 128;
        const float* base = lat ? base_lat + (size_t)u.pm * BM * 1024 : base_ctx + (size_t)(u.pm - 128) * BM * 1024;
        float* out = lat ? out_lat + (size_t)u.pm * BM * 1024 : out_ctx + (size_t)(u.pm - 128) * BM * 1024;
        const float* gv = gate + (size_t)(lat ? (u.pm >> 5) : 4) * 6144;
        const int row0 = wr * 64 + fr, col0 = u.pn * BM + wc * 32 + 4 * fq;
#pragma unroll
        for (int bj = 0; bj < 2; ++bj)
#pragma unroll
            for (int n = 0; n < 2; ++n) { const f32x4 g4 = *(const f32x4*)(gv + col0 + bj * HALF + n * 16) * scale;
#pragma unroll
                for (int ai = 0; ai < 2; ++ai)
#pragma unroll
                    for (int m = 0; m < 4; ++m) { const size_t off = (size_t)(row0 + ai * HALF + m * 16) * 1024 + col0 + bj * HALF + n * 16;
                        const f32x4 bv = *(const f32x4*)(base + off); *(f32x4*)(out + off) = bv + g4 * acc[ai][bj][m][n]; }
                asm volatile("" ::: "memory"); }
    }
};
template <bool BASE_F32> struct EpiResB {
    static constexpr bool PERM = true, AFTER_DRAIN = false;
    const void* base_lat; bf16_t* out_lat; const void* base_ctx; bf16_t* out_ctx; const float* gate; float scale;
    __device__ __forceinline__ void operator()(const f32x4 (&acc)[2][2][4][2], const Unit& u, int wr, int wc, int fr, int fq) const {
        asm volatile("" : "+v"(fr), "+v"(fq));
        const bool lat = u.pm < 128; const size_t ro = (size_t)(lat ? u.pm : u.pm - 128) * BM * 1024;
        const void* base = lat ? base_lat : base_ctx; bf16_t* out = lat ? out_lat : out_ctx;
        const float* gv = gate + (size_t)(lat ? (u.pm >> 5) : 4) * 6144;
        const int row0 = wr * 64 + fr, col0 = u.pn * BM + wc * 32 + 8 * fq;
#pragma unroll
        for (int bj = 0; bj < 2; ++bj) { const f32x4 g0 = *(const f32x4*)(gv + col0 + bj * HALF) * scale, g1 = *(const f32x4*)(gv + col0 + bj * HALF + 4) * scale;
#pragma unroll
            for (int ai = 0; ai < 2; ++ai)
#pragma unroll
                for (int m = 0; m < 4; ++m) { const size_t off = ro + (size_t)(row0 + ai * HALF + m * 16) * 1024 + col0 + bj * HALF; f32x4 b0, b1;
                    if constexpr (BASE_F32) { b0 = *(const f32x4*)((const float*)base + off); b1 = *(const f32x4*)((const float*)base + off + 4); }
                    else { const u32x4 w = *(const u32x4*)((const bf16_t*)base + off);
                        b0 = (f32x4){__builtin_bit_cast(float, w.x << 16), __builtin_bit_cast(float, w.x & 0xffff0000u), __builtin_bit_cast(float, w.y << 16), __builtin_bit_cast(float, w.y & 0xffff0000u)};
                        b1 = (f32x4){__builtin_bit_cast(float, w.z << 16), __builtin_bit_cast(float, w.z & 0xffff0000u), __builtin_bit_cast(float, w.w << 16), __builtin_bit_cast(float, w.w & 0xffff0000u)}; }
                    const f32x4 v0 = b0 + g0 * acc[ai][bj][m][0], v1 = b1 + g1 * acc[ai][bj][m][1];
                    u32x4 o; o.x = cvt_pk_bf16(v0[0], v0[1]); o.y = cvt_pk_bf16(v0[2], v0[3]); o.z = cvt_pk_bf16(v1[0], v1[1]); o.w = cvt_pk_bf16(v1[2], v1[3]);
                    *(u32x4*)(out + off) = o; }
            asm volatile("" ::: "memory"); }
    }
};
#ifndef F8_SCALE
#define F8_SCALE 0
#endif
template <class Epi, class Sched, bool ALIGN_EPI = false, bool SP2 = false, bool F8 = false, bool GA = false>
__device__ __forceinline__ void gemm_phase(PG8_LAS unsigned char* lds, const Gemm g, const Sched& S, const Epi& E, const int tid) {
    const int wid = __builtin_amdgcn_readfirstlane(tid >> 6), lane = tid & 63, wr = wid >> 2, wc = wid & 3, fr = lane & 15, fq = lane >> 4;
    const int K = g.K, nt = K / BK;
    unsigned voffA[2], voffB[2];
#pragma unroll
    for (int i = 0; i < 2; ++i) { int R, C; stage_rc(tid * 16 + i * 8192, R, C); const int Rb = Epi::PERM ? ((R & ~31) + perm32(R & 31)) : R;
        voffA[i] = (unsigned)(R * K + C) * 2u; voffB[i] = (unsigned)(Rb * K + C) * 2u; }
    const unsigned kstep = (unsigned)(BK * 2);
    const unsigned hstep = (unsigned)HALF * (unsigned)K * 2u;
    const unsigned tstep = 2u * hstep;
    const unsigned ldsw = (unsigned)wid * 1024u;
    const __amdgpu_buffer_rsrc_t rsA = __builtin_amdgcn_make_buffer_rsrc((void*)g.A, 0, 0x7fffffff, 0x00020000), rsB = __builtin_amdgcn_make_buffer_rsrc((void*)g.Bt, 0, 0x7fffffff, 0x00020000);
    static_assert(!GA || SP2, "gathered A: SP2 body only");
    constexpr int GA_TAB = STAGE_BYTES + 4096;
    const __amdgpu_buffer_rsrc_t rsT = __builtin_amdgcn_make_buffer_rsrc((void*)g.rt, 0, 0x7fffffff, 0x00020000);
    unsigned vG[2][2]; int gaR = 0; unsigned gaC = 0;
    if constexpr (GA) { int R, C; stage_rc(tid * 16, R, C); gaR = R; gaC = (unsigned)C * 2u; }
#define PG8_GA_FETCH(pm_) do { const unsigned so_ = (unsigned)__builtin_amdgcn_readfirstlane((int)((unsigned)(pm_) * 1024u)); \
        __builtin_amdgcn_raw_ptr_buffer_load_lds(rsT, (PG8_LAS unsigned*)(lds + GA_TAB + wid * 256), 4, (unsigned)(((wid & 3) * 64 + lane) * 4), so_, 0, 0); } while (0)
#define PG8_GA_TAKE() do { const PG8_LAS int* tb_ = (const PG8_LAS int*)(lds + GA_TAB); _Pragma("unroll") for (int h_ = 0; h_ < 2; ++h_) _Pragma("unroll") for (int i_ = 0; i_ < 2; ++i_) \
        vG[h_][i_] = (unsigned)tb_[h_ * 128 + i_ * 64 + gaR] * (unsigned)(K * 2) + gaC; } while (0)
    const int aoff = lds_byte(wr * 64 + fr, fq * 8), boff = lds_byte(wc * 32 + fr, fq * 8);
#define PG8_SA(b, h) (((b) * 2 + (h)) * HTB)
#define PG8_SB(b, h) ((4 + (b) * 2 + (h)) * HTB)
#define PG8_STAGE(rs, bufoff, soff, voff) do { const unsigned so_ = (unsigned)__builtin_amdgcn_readfirstlane((int)(soff)); _Pragma("unroll") for (int _i = 0; _i < 2; ++_i) \
        __builtin_amdgcn_raw_ptr_buffer_load_lds(rs, (PG8_LAS unsigned*)(lds + (bufoff) + ldsw + _i * 8192), 16, (voff)[_i], so_, 0, 0); } while (0)
#define PG8_STA(bufoff, soff, h_) do { if constexpr (GA) { const unsigned so_ = (unsigned)__builtin_amdgcn_readfirstlane((int)(soff)); _Pragma("unroll") for (int _i = 0; _i < 2; ++_i) \
        __builtin_amdgcn_raw_ptr_buffer_load_lds(rsA, (PG8_LAS unsigned*)(lds + (bufoff) + ldsw + _i * 8192), 16, vG[h_][_i], so_, 0, 0); } else PG8_STAGE(rsA, bufoff, (soff) + (h_) * hstep, voffA); } while (0)
#define PG8_WAIT_V8(first_) do { if (GA && (first_)) PG8_WAIT_V(9); else PG8_WAIT_V(8); } while (0)
#define PG8_LDA(dst, b, h) do { if constexpr (F8) { _Pragma("unroll") for (int m = 0; m < 4; ++m) dst##8[m] = cat8(*(const PG8_LAS bf16x8*)(lds + PG8_SA(b, h) + aoff + m * 2048), *(const PG8_LAS bf16x8*)(lds + PG8_SA(b, h) + aoff + m * 2048 + 1024)); } \
        else { _Pragma("unroll") for (int m = 0; m < 4; ++m) _Pragma("unroll") for (int k = 0; k < 2; ++k) dst[m][k] = *(const PG8_LAS bf16x8*)(lds + PG8_SA(b, h) + aoff + m * 2048 + k * 1024); } } while (0)
#define PG8_LDB(dst, b, h) do { if constexpr (F8) { _Pragma("unroll") for (int n = 0; n < 2; ++n) dst##8[n] = cat8(*(const PG8_LAS bf16x8*)(lds + PG8_SB(b, h) + boff + n * 2048), *(const PG8_LAS bf16x8*)(lds + PG8_SB(b, h) + boff + n * 2048 + 1024)); } \
        else { _Pragma("unroll") for (int n = 0; n < 2; ++n) _Pragma("unroll") for (int k = 0; k < 2; ++k) dst[n][k] = *(const PG8_LAS bf16x8*)(lds + PG8_SB(b, h) + boff + n * 2048 + k * 1024); } } while (0)
#define PG8_MMA(ai, bj, At, Bt) do { __builtin_amdgcn_s_setprio(1); if constexpr (F8) { _Pragma("unroll") for (int m = 0; m < 4; ++m) _Pragma("unroll") for (int n = 0; n < 2; ++n) \
        acc[ai][bj][m][n] = __builtin_amdgcn_mfma_scale_f32_16x16x128_f8f6f4(Bt##8[n], At##8[m], acc[ai][bj][m][n], 0, 0, 0, F8_SCALE, 0, F8_SCALE); } \
        else { _Pragma("unroll") for (int m = 0; m < 4; ++m) _Pragma("unroll") for (int n = 0; n < 2; ++n) _Pragma("unroll") for (int k = 0; k < 2; ++k) \
        acc[ai][bj][m][n] = __builtin_amdgcn_mfma_f32_16x16x32_bf16(Bt[n][k], At[m][k], acc[ai][bj][m][n], 0, 0, 0); } __builtin_amdgcn_s_setprio(0); } while (0)
#define PG8_WAIT_V(n) asm volatile("s_waitcnt vmcnt(" #n ")" ::: "memory")
#define PG8_WAIT_L(n) asm volatile("s_waitcnt lgkmcnt(" #n ")" ::: "memory")
#define PG8_BAR __builtin_amdgcn_s_barrier()
#define PG8_SCHED __builtin_amdgcn_sched_barrier(0)
    Unit cur, nxt; int ui = 0;
    if (!S.next(0, cur)) return;
    f32x4 acc[2][2][4][2];
#pragma unroll
    for (int a = 0; a < 2; ++a)
#pragma unroll
        for (int b = 0; b < 2; ++b)
#pragma unroll
            for (int m = 0; m < 4; ++m)
#pragma unroll
                for (int n = 0; n < 2; ++n) acc[a][b][m][n] = (f32x4){0.f, 0.f, 0.f, 0.f};
    bf16x8 At[4][2], B0[2][2], B1[2][2]; i32x8 At8[4], B08[2], B18[2];
    unsigned cA = GA ? 0u : (unsigned)cur.pm * tstep, cB = (unsigned)cur.pn * tstep;
    if constexpr (GA) { _Pragma("unroll") for (int h_ = 0; h_ < 2; ++h_) _Pragma("unroll") for (int i_ = 0; i_ < 2; ++i_) vG[h_][i_] = (unsigned)g.rt[cur.pm * 256 + h_ * 128 + i_ * 64 + gaR] * (unsigned)(K * 2) + gaC; }
    S.a_ready(cur);
    if constexpr (SP2) {
        PG8_STAGE(rsB, PG8_SB(0, 0), cB, voffB); PG8_STAGE(rsB, PG8_SB(0, 1), cB + hstep, voffB); PG8_STA(PG8_SA(0, 0), cA, 0); PG8_STA(PG8_SA(0, 1), cA, 1);
        if (wr == 1) PG8_BAR;
        PG8_WAIT_V(2); PG8_BAR;
        PG8_STAGE(rsB, PG8_SB(1, 0), cB + kstep, voffB); PG8_STA(PG8_SA(1, 0), cA + kstep, 0); PG8_STAGE(rsB, PG8_SB(1, 1), cB + hstep + kstep, voffB);
        PG8_WAIT_V(6); PG8_BAR;
    } else {
        PG8_STAGE(rsB, PG8_SB(0, 0), cB, voffB); PG8_STAGE(rsA, PG8_SA(0, 0), cA, voffA); PG8_STAGE(rsB, PG8_SB(0, 1), cB + hstep, voffB); PG8_STAGE(rsA, PG8_SA(0, 1), cA + hstep, voffA);
        if (wr == 1) PG8_BAR;
        PG8_WAIT_V(4); PG8_BAR;
        PG8_STAGE(rsB, PG8_SB(1, 0), cB + kstep, voffB); PG8_STAGE(rsA, PG8_SA(1, 0), cA + kstep, voffA); PG8_STAGE(rsB, PG8_SB(1, 1), cB + hstep + kstep, voffB);
        PG8_WAIT_V(6); PG8_BAR;
    }
    for (;;) {
        const bool has_next = S.next(ui + 1, nxt);
        const unsigned nA = (has_next && !GA) ? (unsigned)nxt.pm * tstep : cA, nB = has_next ? (unsigned)nxt.pn * tstep : cB;
        if constexpr (GA) PG8_GA_FETCH(has_next ? nxt.pm : cur.pm);
#pragma unroll 1
        for (int t = 0; t < nt; t += 2) {
            const bool last = (t == nt - 2);
            const unsigned a1 = cA + (unsigned)(t + 1) * kstep;
            const unsigned a2 = last ? nA : cA + (unsigned)(t + 2) * kstep, b2 = last ? nB : cB + (unsigned)(t + 2) * kstep;
            const unsigned a3 = a2 + kstep, b3 = b2 + kstep;
            if (last && has_next) S.a_ready(nxt);
            if constexpr (SP2) {
            PG8_LDB(B0, 0, 0); PG8_LDB(B1, 0, 1); PG8_SCHED; PG8_LDA(At, 0, 0); PG8_STA(PG8_SA(1, 1), a1, 1);
            PG8_WAIT_V8(t == 0); PG8_WAIT_L(0); PG8_BAR; PG8_MMA(0, 0, At, B0); PG8_MMA(0, 1, At, B1); PG8_BAR; PG8_SCHED;
            if constexpr (GA) { if (last) PG8_GA_TAKE(); }
            PG8_LDA(At, 0, 1); PG8_STAGE(rsB, PG8_SB(0, 0), b2, voffB); PG8_STAGE(rsB, PG8_SB(0, 1), b2 + hstep, voffB); PG8_STA(PG8_SA(0, 0), a2, 0);
            PG8_WAIT_V8(t == 0); PG8_WAIT_L(0); PG8_BAR; PG8_MMA(1, 0, At, B0); PG8_MMA(1, 1, At, B1); PG8_BAR; PG8_SCHED;
            PG8_LDB(B0, 1, 0); PG8_LDB(B1, 1, 1); PG8_SCHED; PG8_LDA(At, 1, 0); PG8_STA(PG8_SA(0, 1), a2, 1);
            PG8_WAIT_V(8); PG8_WAIT_L(0); PG8_BAR; PG8_MMA(0, 0, At, B0); PG8_MMA(0, 1, At, B1); PG8_BAR; PG8_SCHED;
            PG8_LDA(At, 1, 1); PG8_STAGE(rsB, PG8_SB(1, 0), b3, voffB); PG8_STAGE(rsB, PG8_SB(1, 1), b3 + hstep, voffB); PG8_STA(PG8_SA(1, 0), a3, 0);
            PG8_WAIT_V(8); PG8_WAIT_L(0); PG8_BAR; PG8_MMA(1, 0, At, B0); PG8_MMA(1, 1, At, B1); PG8_BAR; PG8_SCHED;
            } else {
            PG8_LDB(B0, 0, 0); PG8_SCHED; PG8_LDA(At, 0, 0); PG8_STAGE(rsA, PG8_SA(1, 1), a1 + hstep, voffA);
            PG8_WAIT_L(8); PG8_BAR; PG8_WAIT_L(0); PG8_MMA(0, 0, At, B0); PG8_BAR; PG8_SCHED;
            PG8_LDB(B1, 0, 1); PG8_STAGE(rsB, PG8_SB(0, 0), b2, voffB);
            PG8_BAR; PG8_WAIT_L(0); PG8_MMA(0, 1, At, B1); PG8_BAR;
            PG8_LDA(At, 0, 1); PG8_STAGE(rsA, PG8_SA(0, 0), a2, voffA);
            PG8_BAR; PG8_WAIT_L(0); PG8_MMA(1, 0, At, B0); PG8_BAR; PG8_SCHED;
            PG8_STAGE(rsB, PG8_SB(0, 1), b2 + hstep, voffB);
            PG8_WAIT_V(6); PG8_BAR; PG8_MMA(1, 1, At, B1); PG8_BAR;
            PG8_LDB(B0, 1, 0); PG8_SCHED; PG8_LDA(At, 1, 0); PG8_STAGE(rsA, PG8_SA(0, 1), a2 + hstep, voffA);
            PG8_WAIT_L(8); PG8_BAR; PG8_WAIT_L(0); PG8_MMA(0, 0, At, B0); PG8_BAR; PG8_SCHED;
            PG8_LDB(B1, 1, 1); PG8_STAGE(rsB, PG8_SB(1, 0), b3, voffB);
            PG8_BAR; PG8_WAIT_L(0); PG8_MMA(0, 1, At, B1); PG8_BAR;
            PG8_LDA(At, 1, 1); PG8_STAGE(rsA, PG8_SA(1, 0), a3, voffA);
            PG8_BAR; PG8_WAIT_L(0); PG8_MMA(1, 0, At, B0); PG8_BAR; PG8_SCHED;
            PG8_STAGE(rsB, PG8_SB(1, 1), b3 + hstep, voffB);
            PG8_WAIT_V(6); PG8_BAR; PG8_MMA(1, 1, At, B1); PG8_BAR;
            }
        }
        if constexpr (ALIGN_EPI) { if (wr == 0) PG8_BAR; }
        if constexpr (!Epi::AFTER_DRAIN) { E(acc, cur, wr, wc, fr, fq);
#if defined(EPI_DUP) && EPI_DUP
            if constexpr (Epi::PERM) { asm volatile("" ::: "memory"); E(acc, cur, wr, wc, fr, fq); }
#endif
            S.done(cur); }
        if (!has_next) break;
#pragma unroll
        for (int a = 0; a < 2; ++a)
#pragma unroll
            for (int b = 0; b < 2; ++b)
#pragma unroll
                for (int m = 0; m < 4; ++m)
#pragma unroll
                    for (int n = 0; n < 2; ++n) acc[a][b][m][n] = (f32x4){0.f, 0.f, 0.f, 0.f};
        cur = nxt; cA = nA; cB = nB; ++ui;
        if constexpr (ALIGN_EPI) { if (wr == 1) PG8_BAR; }
    }
    PG8_WAIT_V(0);
    if constexpr (!ALIGN_EPI) { if (wr == 0) PG8_BAR; }
    PG8_BAR;
    if constexpr (Epi::AFTER_DRAIN) { E.fused(acc, cur, wr, wc, fr, fq, lds, wid, lane); S.done(cur); }
#undef PG8_SA
#undef PG8_SB
#undef PG8_STAGE
#undef PG8_STA
#undef PG8_WAIT_V8
#undef PG8_GA_FETCH
#undef PG8_GA_TAKE
#undef PG8_LDA
#undef PG8_LDB
#undef PG8_MMA
#undef PG8_WAIT_V
#undef PG8_WAIT_L
#undef PG8_BAR
#undef PG8_SCHED
}
}
using pg8::silu_f;

constexpr int D = 1024, BATCH = 4, SEQ = 8192, CTXL = 256, NLAT = BATCH * SEQ, NCTX = BATCH * CTXL, MROWS = NLAT + NCTX;
constexpr int PIN_SRC = 2832, PLD = 3072, FFH = 2816, NEXP = 8;
constexpr int PO_Q = 0, PO_K = 512, PO_V = 1024, PO_O = 1536, PO_F = 2048, PO_CU = 2304, PO_CG = 2560;
constexpr float EPS = 1e-6f;
constexpr int NWAVES = 8, NTHR = 512;
constexpr size_t MiB = 1u << 20;
constexpr size_t WS_CTL = 0, CTL_ZERO_BYTES = 64 * 1024;
constexpr size_t WS_MOD = 1 * MiB;
constexpr size_t WS_ROUTE = 1 * MiB + 512 * 1024;
constexpr size_t WS_WIN = 2 * MiB;
constexpr size_t WS_WOUT = 14 * MiB;
constexpr size_t WS_WGU = 18 * MiB;
constexpr size_t WS_WD = 29 * MiB;
constexpr size_t WS_MWGU = 35 * MiB;
constexpr size_t WS_MWD = 79 * MiB;
constexpr size_t WS_XB = 101 * MiB;
constexpr size_t WS_XCB = 165 * MiB;
constexpr size_t WS_G = 167 * MiB;
constexpr size_t WS_XC = 170 * MiB;
constexpr size_t WS_TOK = 174 * MiB;
constexpr size_t WS_R1 = 176 * MiB;
constexpr size_t WS_Y = WS_R1, WS_HF = WS_R1 + 66 * MiB, WS_ASORT = WS_R1, WS_OPAIR = WS_R1;
constexpr size_t WS_R2 = 308 * MiB;
constexpr size_t WS_P = WS_R2, WS_H = WS_R2, WS_A = WS_R2 + 198 * MiB, WS_HB = WS_R2 + 264 * MiB, WS_HSORT = WS_R2;
constexpr size_t WS_END = 671 * MiB;
constexpr int MAXPAIR = 2 * NLAT + NEXP * 256;
static_assert(WS_WIN + (size_t)2 * PLD * D * 2 <= WS_WOUT && WS_WOUT + (size_t)2 * D * D * 2 <= WS_WGU && WS_WGU + (size_t)2 * FFH * D * 2 <= WS_WD && WS_WD + (size_t)D * FFH * 2 <= WS_MWGU, "ws map 1");
static_assert(WS_MWGU + (size_t)NEXP * 2 * FFH * D <= WS_MWD && WS_MWD + (size_t)NEXP * D * FFH <= WS_XB && WS_XB + (size_t)NLAT * D * 2 <= WS_XCB && WS_XCB + (size_t)NCTX * D * 2 <= WS_G && WS_G + (size_t)MROWS * 16 * 4 <= WS_XC && WS_XC + (size_t)NCTX * D * 4 <= WS_TOK, "ws map 2");
constexpr size_t WS_ROWTOK = WS_TOK + (768 + 264) * 1024;
static_assert(WS_TOK + 3 * 256 * 1024 + (size_t)MAXPAIR * 4 * 2 <= WS_R1 && WS_Y + (size_t)MROWS * D * 2 <= WS_HF && WS_HF + (size_t)MROWS * 512 * 4 <= WS_R2 && WS_ASORT + (size_t)MAXPAIR * D * 2 <= WS_R2, "ws map 3");
static_assert(WS_P + (size_t)MROWS * PLD * 2 <= WS_A && WS_A + (size_t)MROWS * D * 2 <= WS_HB && WS_HB + (size_t)MROWS * 512 * 4 <= WS_END && WS_HSORT + (size_t)MAXPAIR * FFH * 2 <= WS_END && WS_H + (size_t)MROWS * FFH * 2 <= WS_A, "ws map 4");
constexpr int CW_BAR = 4096;
static_assert((size_t)(CW_BAR + 3456) * 4 <= CTL_ZERO_BYTES, "barrier words inside the per-call memset");
constexpr int RW_HIST = 0;
constexpr int RW_TILE_E = 4096;
constexpr int RW_NTILES = 4096 + 512;
constexpr int LDS_STAGE = 131072, LDSCTL_OFF = LDS_STAGE, LDS_BYTES = 147456;

#define GAS __attribute__((address_space(1)))
#define LAS __attribute__((address_space(3)))
typedef unsigned short bf16;
typedef unsigned v4u __attribute__((ext_vector_type(4)));
typedef unsigned v2u __attribute__((ext_vector_type(2)));
typedef float f32x4 __attribute__((ext_vector_type(4)));
typedef float f32x2_t __attribute__((ext_vector_type(2))); typedef __bf16 bf16x2_t __attribute__((ext_vector_type(2)));
__device__ __forceinline__ unsigned pk2(float lo, float hi) { const f32x2_t v = {lo, hi}; const bf16x2_t b = __builtin_convertvector(v, bf16x2_t); return __builtin_bit_cast(unsigned, b); }
__device__ __forceinline__ unsigned f2bf(float f) { return pk2(f, f) & 0xffffu; }
__device__ __forceinline__ float bf2f(unsigned short b) { return __builtin_bit_cast(float, (unsigned)b << 16); }
__device__ __forceinline__ float bflo(unsigned w) { return __builtin_bit_cast(float, w << 16); }
__device__ __forceinline__ float bfhi(unsigned w) { return __builtin_bit_cast(float, w & 0xffff0000u); }
__device__ __forceinline__ float dpp_f(float v, const int ctrl_sel) {
    const int x = __builtin_bit_cast(int, v); int r;
    if (ctrl_sel == 0) r = __builtin_amdgcn_update_dpp(0, x, 0xB1, 0xF, 0xF, true);
    else if (ctrl_sel == 1) r = __builtin_amdgcn_update_dpp(0, x, 0x4E, 0xF, 0xF, true);
    else if (ctrl_sel == 2) r = __builtin_amdgcn_update_dpp(0, x, 0x141, 0xF, 0xF, true);
    else r = __builtin_amdgcn_update_dpp(0, x, 0x140, 0xF, 0xF, true);
    return __builtin_bit_cast(float, r);
}
__device__ __forceinline__ float row16_sum(float v) { v += dpp_f(v, 0); v += dpp_f(v, 1); v += dpp_f(v, 2); v += dpp_f(v, 3); return v; }
__device__ __forceinline__ float wave_sum(float v) {
    v = row16_sum(v);
    const int x = __builtin_bit_cast(int, v);
    const float r0 = __builtin_bit_cast(float, __builtin_amdgcn_readlane(x, 0)), r1 = __builtin_bit_cast(float, __builtin_amdgcn_readlane(x, 16));
    const float r2 = __builtin_bit_cast(float, __builtin_amdgcn_readlane(x, 32)), r3 = __builtin_bit_cast(float, __builtin_amdgcn_readlane(x, 48));
    return (r0 + r1) + (r2 + r3);
}
__device__ __forceinline__ float wave_total63(float v) {
    v = row16_sum(v);
    v += __builtin_bit_cast(float, __builtin_amdgcn_update_dpp(0, __builtin_bit_cast(int, v), 0x142, 0xA, 0xF, false));
    v += __builtin_bit_cast(float, __builtin_amdgcn_update_dpp(0, __builtin_bit_cast(int, v), 0x143, 0xC, 0xF, false));
    return __builtin_bit_cast(float, __builtin_amdgcn_readlane(__builtin_bit_cast(int, v), 63));
}
__device__ __forceinline__ float sigmoid_f(float x) { return __builtin_amdgcn_rcpf(1.0f + __expf(-x)); }
__device__ __forceinline__ float log_sigmoid_f(float x) { return fminf(x, 0.0f) - log1pf(__expf(-fabsf(x))); }

#define XB_TMO      128
#define XB_XCNT(j)  (256  + 64 * (j))
#define XB_XSUB(j)  (1280 + 64 * (j))
#define XB_XGEN(j)  (2304 + 64 * (j))
#define XB_TOP      3328
#define XB_TOPGEN   3392
#define XCD_BAR_WORDS 3456
#define XB_SPIN_CAP (1u << 18)
#define LAS __attribute__((address_space(3)))

__device__ __forceinline__ unsigned xb_ld(unsigned* p)              { return __hip_atomic_load(p, __ATOMIC_RELAXED, __HIP_MEMORY_SCOPE_AGENT); }
__device__ __forceinline__ unsigned xb_add(unsigned* p, unsigned v) { return __hip_atomic_fetch_add(p, v, __ATOMIC_RELAXED, __HIP_MEMORY_SCOPE_AGENT); }
__device__ __forceinline__ unsigned xb_xcc_id() { return (unsigned)__builtin_amdgcn_s_getreg((3 << 11) | 20) & 0xFu; }
#define XB_SPIN(cond, bar) do { unsigned _sp = 0; while (cond) { __builtin_amdgcn_s_sleep(1); \
    if ((++_sp & 255u) == 0u) { if (xb_ld(&(bar)[XB_TMO])) break; if (_sp > XB_SPIN_CAP) { atomicAdd(&(bar)[XB_TMO], 1u); break; } } } } while (0)

struct XcdBarrier {
    unsigned* bar; unsigned x;
    volatile LAS unsigned* st;
};

__device__ __forceinline__ XcdBarrier xcd_barrier_post(unsigned* bar, volatile LAS unsigned* st) {
    XcdBarrier b; b.bar = bar; b.x = xb_xcc_id(); b.st = st;
    if (threadIdx.x == 0) (void)xb_add(&bar[XB_XCNT(b.x)], 1u);
    return b;
}
__device__ __forceinline__ void xcd_barrier_complete(unsigned* bar, unsigned x, unsigned& nloc, unsigned& nx) {
    const unsigned G = gridDim.x * gridDim.y * gridDim.z;
    unsigned sum, cnt, mine, sp = 0u;
    for (;;) {
        sum = 0u; cnt = 0u; mine = 0u;
#pragma unroll
        for (unsigned j = 0; j < 16; ++j) { const unsigned c = xb_ld(&bar[XB_XCNT(j)]); sum += c; cnt += (c > 0u) ? 1u : 0u; mine = (j == x) ? c : mine; }
        if (sum == G) break;
        __builtin_amdgcn_s_sleep(1);
        if ((++sp & 255u) == 0u) { if (xb_ld(&bar[XB_TMO])) break; if (sp > XB_SPIN_CAP) { atomicAdd(&bar[XB_TMO], 1u); break; } }
    }
    nloc = mine > 0u ? mine : 1u; nx = cnt > 0u ? cnt : 1u;
}

__device__ __forceinline__ void xcd_barrier(const XcdBarrier& b, const int tid) {
    asm volatile("s_waitcnt vmcnt(0)" ::: "memory");
    __syncthreads();
    if (tid == 0) {
        unsigned* bar = b.bar;
        __builtin_amdgcn_s_waitcnt(0);
        unsigned nloc = b.st[0], nx = b.st[1];
        if (nloc == 0u) { xcd_barrier_complete(bar, b.x, nloc, nx); b.st[0] = nloc; b.st[1] = nx; }
        const unsigned old = xb_add(&bar[XB_XSUB(b.x)], 1u);
        const unsigned gen = old / nloc;
        if (old + 1u == (gen + 1u) * nloc) {
            __builtin_amdgcn_fence(__ATOMIC_RELEASE, "agent");
            asm volatile("s_waitcnt vmcnt(0)" ::: "memory");
            const unsigned og = xb_add(&bar[XB_TOP], 1u);
            const unsigned tg = og / nx;
            if (og + 1u == (tg + 1u) * nx) xb_add(&bar[XB_TOPGEN], 1u);
            else XB_SPIN(xb_ld(&bar[XB_TOPGEN]) == tg, bar);
            __builtin_amdgcn_fence(__ATOMIC_ACQUIRE, "agent");
            xb_add(&bar[XB_XGEN(b.x)], 1u);
            asm volatile("s_waitcnt vmcnt(0)" ::: "memory");
        } else {
            XB_SPIN(xb_ld(&bar[XB_XGEN(b.x)]) == gen, bar);
            __builtin_amdgcn_fence(__ATOMIC_ACQUIRE, "agent");
            asm volatile("s_waitcnt vmcnt(0)" ::: "memory");
        }
    }
    __syncthreads();
}
#define LDS_WAIT() asm volatile("s_waitcnt lgkmcnt(0)" ::: "memory")

__device__ __forceinline__ void transpose_item(const float* W, int K, int N, bf16* WT, int dst_row0, int src_col0, int nvalid, int kb, LAS float* scr, int lane) {
    const int k0 = 64 * kb, nl = lane & 31;
#pragma unroll 8
    for (int i = 0; i < 32; ++i) { const int kk = 2 * i + (lane >> 5); scr[kk * 33 + nl] = nl < nvalid ? W[(size_t)(k0 + kk) * N + src_col0 + nl] : 0.f; }
    LDS_WAIT();
    const int c = lane & 7;
#pragma unroll
    for (int j = 0; j < 4; ++j) { const int n = (lane >> 3) + 8 * j; const LAS float* s = scr + (8 * c) * 33 + n;
        v4u o; o.x = pk2(s[0 * 33], s[1 * 33]); o.y = pk2(s[2 * 33], s[3 * 33]); o.z = pk2(s[4 * 33], s[5 * 33]); o.w = pk2(s[6 * 33], s[7 * 33]);
        *(v4u*)(WT + (size_t)(dst_row0 + n) * K + k0 + 8 * c) = o; }
    LDS_WAIT();
}
__device__ __forceinline__ void transpose_item_f8(const float* W, int K, int N, unsigned char* WT, int dst_row0, int src_col0, int kb, float scale, LAS float* scr, int lane) {
    const int k0 = 64 * kb, nl = lane & 31;
#pragma unroll 8
    for (int i = 0; i < 32; ++i) { const int kk = 2 * i + (lane >> 5); scr[kk * 33 + nl] = W[(size_t)(k0 + kk) * N + src_col0 + nl] * scale; }
    LDS_WAIT();
    const int kh = lane >> 5; const LAS float* s = scr + (32 * kh) * 33 + nl; v4u o0, o1;
    o0.x = pg8::pk4_fp8(s[0 * 33], s[1 * 33], s[2 * 33], s[3 * 33]); o0.y = pg8::pk4_fp8(s[4 * 33], s[5 * 33], s[6 * 33], s[7 * 33]); o0.z = pg8::pk4_fp8(s[8 * 33], s[9 * 33], s[10 * 33], s[11 * 33]); o0.w = pg8::pk4_fp8(s[12 * 33], s[13 * 33], s[14 * 33], s[15 * 33]);
    o1.x = pg8::pk4_fp8(s[16 * 33], s[17 * 33], s[18 * 33], s[19 * 33]); o1.y = pg8::pk4_fp8(s[20 * 33], s[21 * 33], s[22 * 33], s[23 * 33]); o1.z = pg8::pk4_fp8(s[24 * 33], s[25 * 33], s[26 * 33], s[27 * 33]); o1.w = pg8::pk4_fp8(s[28 * 33], s[29 * 33], s[30 * 33], s[31 * 33]);
    unsigned char* dst = WT + (size_t)(dst_row0 + nl) * K + k0 + 32 * kh; *(v4u*)dst = o0; *(v4u*)(dst + 16) = o1;
    LDS_WAIT();
}
__device__ __forceinline__ void win_map(int nb, int& src, int& nvalid) { const int v0 = 32 * nb; if (v0 < 2048) { src = v0; nvalid = 32; } else if (v0 < 2816) { src = v0 + 16; nvalid = 32; } else if (v0 == 2816) { src = 2048; nvalid = 16; } else { src = 0; nvalid = 0; } }
__device__ __forceinline__ int gu_map(int nb) { const int v0 = 32 * nb; return ((v0 >> 7) & 1) * FFH + (v0 >> 8) * 128 + (v0 & 127); }

__device__ __forceinline__ void prologue_phase(const float* const* in, unsigned char* ws, LAS unsigned char* lds, int wg, int G, int tid) {
    const int lane = tid & 63, wave = tid >> 6, gw = wg * NWAVES + wave, NGW = G * NWAVES;
    LAS float* scr = (LAS float*)(lds + wave * 16384);
    constexpr int I_WIN = 16 * 96, I_WOUT = 16 * 32, I_GU = 16 * 176, I_DN = 44 * 32;
    constexpr int NITEMS = 2 * I_WIN + 2 * I_WOUT + I_GU + I_DN;
    for (int it = gw; it < NITEMS; it += NGW) {
        int r = it;
        if (r < 2 * I_WIN) { const int L = r / I_WIN; r -= L * I_WIN; const int kb = r / 96, nb = r % 96; int src, nv; win_map(nb, src, nv);
            transpose_item(in[8] + (size_t)L * D * PIN_SRC, D, PIN_SRC, (bf16*)(ws + WS_WIN) + (size_t)L * PLD * D, 32 * nb, src, nv, kb, scr, lane); continue; }
        r -= 2 * I_WIN;
        if (r < 2 * I_WOUT) { const int L = r / I_WOUT; r -= L * I_WOUT; const int kb = r / 32, nb = r % 32;
            transpose_item(in[15] + (size_t)L * D * D, D, D, (bf16*)(ws + WS_WOUT) + (size_t)L * D * D, 32 * nb, 32 * nb, 32, kb, scr, lane); continue; }
        r -= 2 * I_WOUT;
        if (r < I_GU) { const int kb = r / 176, nb = r % 176; transpose_item(in[16], D, 2 * FFH, (bf16*)(ws + WS_WGU), 32 * nb, gu_map(nb), 32, kb, scr, lane); continue; }
        r -= I_GU;
        { const int kb = r / 32, nb = r % 32; transpose_item_f8(in[17], FFH, D, (unsigned char*)(ws + WS_WD), 32 * nb, 32 * nb, kb, pg8::F8_SWD, scr, lane); }
    }
    __syncthreads();
    LAS float* cond_s = (LAS float*)lds;
    LAS float* part = (LAS float*)(lds + 32768);
    for (int i = tid; i < 5 * D; i += NTHR) { const int r = i >> 10, k = i & 1023; const float v = r < 4 ? in[1][r * D + k] : in[3][k]; cond_s[i] = silu_f(v); }
    __syncthreads();
    float* MOD = (float*)(ws + WS_MOD);
    for (int t = wg; t < 192; t += G) {
        const int L = t / 96, nb = t % 96; const float* W = in[6] + (size_t)L * D * 6144 + nb * 64 + lane;
        float a0 = 0.f, a1 = 0.f, a2 = 0.f, a3 = 0.f, a4 = 0.f;
#pragma unroll 8
        for (int kk = 0; kk < 128; ++kk) { const int k = wave * 128 + kk; const float w = W[(size_t)k * 6144];
            a0 += cond_s[k] * w; a1 += cond_s[D + k] * w; a2 += cond_s[2 * D + k] * w; a3 += cond_s[3 * D + k] * w; a4 += cond_s[4 * D + k] * w; }
        part[(wave * 5 + 0) * 64 + lane] = a0; part[(wave * 5 + 1) * 64 + lane] = a1; part[(wave * 5 + 2) * 64 + lane] = a2; part[(wave * 5 + 3) * 64 + lane] = a3; part[(wave * 5 + 4) * 64 + lane] = a4;
        __syncthreads();
        if (tid < 320) { const int r = tid >> 6, l = tid & 63; float s = in[7][L * 6144 + nb * 64 + l];
#pragma unroll
            for (int w = 0; w < 8; ++w) s += part[(w * 5 + r) * 64 + l];
            MOD[(size_t)(L * 5 + r) * 6144 + nb * 64 + l] = s; }
        __syncthreads();
    }
}

__device__ __forceinline__ void moe_convert_items(const float* const* in, unsigned char* ws, LAS unsigned char* lds, int which, int widx, int nw, int tid, int it0 = 0, int it1 = 1 << 30) {
    const int lane = tid & 63, wave = tid >> 6, gw = widx * NWAVES + wave, NGW = nw * NWAVES;
    LAS float* scr = (LAS float*)(lds + wave * 16384);
    constexpr int I_GU = 16 * 176, I_DN = 44 * 32;
    if (which == 0) { for (int it = gw; it < 8 * I_DN; it += NGW) { const int e = it / I_DN, r = it - e * I_DN, kb = r / 32, nb = r % 32;
            transpose_item_f8(in[21] + (size_t)e * FFH * D, FFH, D, (unsigned char*)(ws + WS_MWD) + (size_t)e * D * FFH, 32 * nb, 32 * nb, kb, pg8::F8_SWD, scr, lane); } }
    else { const int hi = it1 < 8 * I_GU ? it1 : 8 * I_GU; for (int it = it0 + gw; it < hi; it += NGW) { const int e = it / I_GU, r = it - e * I_GU, kb = r / 176, nb = r % 176;
            transpose_item_f8(in[20] + (size_t)e * D * 2 * FFH, D, 2 * FFH, (unsigned char*)(ws + WS_MWGU) + (size_t)e * 2 * FFH * D, 32 * nb, gu_map(nb), kb, pg8::F8_SWGU, scr, lane); } }
}

typedef float f32x2w __attribute__((ext_vector_type(2)));
template <bool ROUTER, bool F8OUT = false, bool XB16 = false>
__device__ __forceinline__ void norm_phase(const void* xlat, const void* xctx, bool do_ctx, const float* ng, const float* modL, int chunk_shift, bf16* A,
                                           const float* w_router, const float* b_router, int* tok_e, float* tok_w, int* hist, LAS unsigned char* lds, int wg, int G, int tid) {
    const int lane = tid & 63, wave = tid >> 6;
    LAS int* lh = (LAS int*)(lds + 73728);
    LAS float* RS = (LAS float*)lds + wave * (32 * 65 + 128); LAS float* RT = RS + 32 * 65;
    f32x4 wr0[16], wr1[16];
    if (ROUTER) {
#pragma unroll
        for (int j = 0; j < 4; ++j)
#pragma unroll
            for (int q = 0; q < 4; ++q) { const int c = 4 * lane + 256 * j + q; wr0[4 * j + q] = *(const f32x4*)(w_router + c * 8); wr1[4 * j + q] = *(const f32x4*)(w_router + c * 8 + 4); } }
    for (int blk = wg; blk < 256; blk += G) {
        if (ROUTER) { if (tid < 8) lh[tid] = 0; __syncthreads(); }
        for (int pass = 0; pass < (do_ctx ? 2 : 1); ++pass) {
            const int b = pass == 0 ? (blk >> 6) : 4;
            const float* sh = modL + (size_t)b * 6144 + chunk_shift * D; const float* sc = sh + D;
            f32x4 mul[4], add[4];
#pragma unroll
            for (int j = 0; j < 4; ++j) { const int c = 4 * lane + 256 * j; const f32x4 g = *(const f32x4*)(ng + c), s = *(const f32x4*)(sc + c); mul[j] = g * (s + 1.0f); add[j] = *(const f32x4*)(sh + c); }
            const int nrow = pass == 0 ? 16 : (wave < 4 ? 1 : 0);
            const int lrow0 = pass == 0 ? blk * 128 + wave * 16 : blk * 4 + wave;
            const unsigned char* xbase = (const unsigned char*)(pass == 0 ? xlat : xctx) + ((size_t)lrow0 * D + 4 * lane) * (XB16 ? 2 : 4);
#define NORM_LD(dst_, rowi_) do { _Pragma("unroll") for (int j = 0; j < 4; ++j) { if constexpr (XB16) { const v2u w_ = *(const v2u*)(xbase + ((size_t)(rowi_) * D + 256 * j) * 2); \
                dst_[j] = (f32x4){bflo(w_.x), bfhi(w_.x), bflo(w_.y), bfhi(w_.y)}; } else dst_[j] = *(const f32x4*)(xbase + ((size_t)(rowi_) * D + 256 * j) * 4); } } while (0)
            f32x4 vn[4];
            if (nrow > 0) NORM_LD(vn, 0);
            for (int i = 0; i < nrow; ++i) {
                const int lrow = lrow0 + i; const int arow = pass == 0 ? lrow : NLAT + lrow;
                f32x4 v[4]; float ss = 0.f;
#pragma unroll
                for (int j = 0; j < 4; ++j) { v[j] = vn[j]; ss += (v[j].x * v[j].x + v[j].y * v[j].y) + (v[j].z * v[j].z + v[j].w * v[j].w); }
                if (i + 1 < nrow) NORM_LD(vn, i + 1);
                const float rstd = 1.0f / sqrtf(wave_sum(ss) * (1.0f / D) + EPS);
                unsigned long long* o8 = (unsigned long long*)(A + (size_t)arow * D) + lane;
#pragma unroll
                for (int j = 0; j < 4; ++j) { v[j] = v[j] * rstd * mul[j] + add[j];
                    if constexpr (F8OUT) ((unsigned*)((unsigned char*)A + (size_t)arow * D))[lane + 64 * j] = pg8::pk4_fp8(v[j].x, v[j].y, v[j].z, v[j].w);
                    else o8[64 * j] = (unsigned long long)pk2(v[j].x, v[j].y) | ((unsigned long long)pk2(v[j].z, v[j].w) << 32); }
                if (ROUTER && pass == 0) {
                    typedef float f2r __attribute__((ext_vector_type(2)));
                    f2r l2[4] = {(f2r){0.f, 0.f}, (f2r){0.f, 0.f}, (f2r){0.f, 0.f}, (f2r){0.f, 0.f}};
#pragma unroll
                    for (int j = 0; j < 4; ++j)
#pragma unroll
                        for (int q = 0; q < 4; ++q) { const f32x4 w0 = wr0[4 * j + q], w1 = wr1[4 * j + q]; const float y = v[j][q]; const f2r yy = {y, y};
                            l2[0] += yy * (f2r){w0.x, w0.y}; l2[1] += yy * (f2r){w0.z, w0.w}; l2[2] += yy * (f2r){w1.x, w1.y}; l2[3] += yy * (f2r){w1.z, w1.w}; }
#pragma unroll
                    for (int e = 0; e < 8; ++e) RS[((i & 3) * 8 + e) * 65 + lane] = (e & 1) ? l2[e >> 1].y : l2[e >> 1].x;
                    if ((i & 3) == 3) { LDS_WAIT();
                        const int idx = lane & 31, c0 = (lane >> 5) * 32; float s = 0.f;
#pragma unroll
                        for (int c = 0; c < 32; ++c) s += RS[idx * 65 + c0 + c];
                        s += __shfl_xor(s, 32);
                        if (lane < 32) RT[(i >> 2) * 32 + idx] = s;
                        LDS_WAIT(); }
                }
            }
            if (ROUTER && pass == 0) LDS_WAIT();
            if (ROUTER && pass == 0 && lane < 16) {
                const int lrow = lrow0 + lane; float lg[8];
#pragma unroll
                for (int e = 0; e < 8; ++e) lg[e] = RT[lane * 8 + e] + b_router[e];
                int e1 = 0; float v1 = lg[0];
#pragma unroll
                for (int e = 1; e < 8; ++e) if (lg[e] > v1) { v1 = lg[e]; e1 = e; }
                int e2 = -1; float v2 = -3.0e38f;
#pragma unroll
                for (int e = 0; e < 8; ++e) if (e != e1 && lg[e] > v2) { v2 = lg[e]; e2 = e; }
                const float w2 = 1.0f / (1.0f + __expf(v1 - v2)), w1 = 1.0f - w2;
                *(v2u*)(tok_e + lrow * 2) = (v2u){(unsigned)e1, (unsigned)e2}; *(f32x2w*)(tok_w + lrow * 2) = (f32x2w){w1, w2};
                __hip_atomic_fetch_add(&lh[e1], 1, __ATOMIC_RELAXED, __HIP_MEMORY_SCOPE_WORKGROUP); __hip_atomic_fetch_add(&lh[e2], 1, __ATOMIC_RELAXED, __HIP_MEMORY_SCOPE_WORKGROUP);
            }
        }
        if (ROUTER) { __syncthreads(); if (tid < 8) hist[blk * 8 + tid] = lh[tid]; __syncthreads(); }
    }
}

__device__ __forceinline__ void route_phase(unsigned char* ws, LAS unsigned char* lds, int wg, int G, int tid) {
    const int lane = tid & 63, wave = tid >> 6;
    int* rw = (int*)(ws + WS_ROUTE); const int* hist = rw + RW_HIST;
    const int* tok_e = (const int*)(ws + WS_TOK); const float* tok_w = (const float*)(ws + WS_TOK + 256 * 1024); int* pair_pos = (int*)(ws + WS_TOK + 512 * 1024); float* row_w = (float*)(ws + WS_TOK + 768 * 1024); int* row_tok = (int*)(ws + WS_ROWTOK);
    LAS int* hs = (LAS int*)lds;
    LAS int* tot = hs + 2048;
    LAS int* te = hs + 2048 + 32;
    LAS int* ps = te + 256;
    for (int blk = wg; blk < 256; blk += G) {
        __syncthreads();
        for (int i = tid; i < 2048; i += NTHR) hs[i] = hist[i];
        if (tid < 256) te[tid] = tok_e[blk * 256 + tid];
        __syncthreads();
        { const int e = tid & 7, b0 = (tid >> 3) * 4; int t = 0, mb = 0;
#pragma unroll
            for (int j = 0; j < 4; ++j) { const int h = hs[(b0 + j) * 8 + e]; t += h; mb += (b0 + j < blk) ? h : 0; }
            t += __shfl_xor(t, 8); mb += __shfl_xor(mb, 8); t += __shfl_xor(t, 16); mb += __shfl_xor(mb, 16); t += __shfl_xor(t, 32); mb += __shfl_xor(mb, 32);
            if (lane < 8) { ps[wave * 16 + lane] = t; ps[wave * 16 + 8 + lane] = mb; } }
        __syncthreads();
        if (tid < 8) { int t = 0, mb = 0;
#pragma unroll
            for (int w = 0; w < NWAVES; ++w) { t += ps[w * 16 + tid]; mb += ps[w * 16 + 8 + tid]; } tot[tid] = t; tot[16 + tid] = mb; }
        __syncthreads();
        if (tid == 0) { int s = 0; for (int e = 0; e < 8; ++e) { tot[8 + e] = s; s += (tot[e] + 255) & ~255; } tot[24] = s >> 8; }
        int my_e = 0, my_rank = 0;
        if (tid < 256) { my_e = te[tid];
#pragma unroll
            for (int x = 0; x < 8; ++x) { const unsigned long long m = __ballot(my_e == x); if (my_e == x) my_rank = __popcll(m & ((1ull << lane) - 1ull)); if (lane == x) ps[128 + wave * 8 + x] = __popcll(m); } }
        __syncthreads();
        if (tid < 256) { const int e = my_e; int rank = my_rank; for (int w = 0; w < wave; ++w) rank += ps[128 + w * 8 + e];
            const int pos = tot[8 + e] + tot[16 + e] + rank; pair_pos[blk * 256 + tid] = pos; row_w[pos] = tok_w[blk * 256 + tid]; row_tok[pos] = blk * 128 + (tid >> 1); }
        if (blk == 0) {
            if (tid < 264) { int e = 0; for (int e2 = 1; e2 < 8; ++e2) if (tid * 256 >= tot[8 + e2]) e = e2; rw[RW_TILE_E + tid] = e; }
            if (tid == 0) rw[RW_NTILES] = tot[24];
        }
        if (blk < 8) { const int e = blk, r0 = tot[8 + e] + tot[e], r1 = tot[8 + e] + ((tot[e] + 255) & ~255);
            for (int r = r0 + tid; r < r1; r += NTHR) { row_tok[r] = 0; row_w[r] = 0.f; } }
    }
}

__device__ __forceinline__ void final_phase(const bf16* XB, float* X, const bf16* O, const int* pair_pos, const float* modL, const float* fg, int wg, int G, int tid) {
    const int lane = tid & 63, wave = tid >> 6;
    f32x4 fgv[4];
#pragma unroll
    for (int j = 0; j < 4; ++j) fgv[j] = *(const f32x4*)(fg + 4 * lane + 256 * j);
    const int nw = G * NWAVES, gw = wg * NWAVES + wave, per = (NLAT + nw - 1) / nw, r0 = gw * per, r1 = (r0 + per < NLAT) ? r0 + per : NLAT;
    if (r0 >= r1) return;
    v2u xn[4]; v2u an[4], cn[4]; int p1n = pair_pos[r0 * 2], p2n = pair_pos[r0 * 2 + 1];
#define FIN_ISSUE(row_, p1_, p2_) do { const v2u* xr_ = (const v2u*)(XB + (size_t)(row_) * D) + lane; const v2u* o1_ = (const v2u*)(O + (size_t)(p1_) * D) + lane; const v2u* o2_ = (const v2u*)(O + (size_t)(p2_) * D) + lane; \
        _Pragma("unroll") for (int j = 0; j < 4; ++j) { xn[j] = xr_[64 * j]; an[j] = o1_[64 * j]; cn[j] = o2_[64 * j]; } } while (0)
    FIN_ISSUE(r0, p1n, p2n);
    if (r0 + 1 < r1) { p1n = pair_pos[(r0 + 1) * 2]; p2n = pair_pos[(r0 + 1) * 2 + 1]; }
    for (int row = r0; row < r1; ++row) {
        const int b = row >> 13; const float* g2 = modL + (size_t)b * 6144 + 5 * D;
        f32x4 v[4]; float ss = 0.f;
#pragma unroll
        for (int j = 0; j < 4; ++j) { const f32x4 g = *(const f32x4*)(g2 + 4 * lane + 256 * j); const v2u a = an[j], c = cn[j];
            f32x4 m; m.x = bflo(a.x) + bflo(c.x); m.y = bfhi(a.x) + bfhi(c.x); m.z = bflo(a.y) + bflo(c.y); m.w = bfhi(a.y) + bfhi(c.y);
            v[j] = (f32x4){bflo(xn[j].x), bfhi(xn[j].x), bflo(xn[j].y), bfhi(xn[j].y)} + g * m; ss += (v[j].x * v[j].x + v[j].y * v[j].y) + (v[j].z * v[j].z + v[j].w * v[j].w); }
        if (row + 1 < r1) { FIN_ISSUE(row + 1, p1n, p2n); if (row + 2 < r1) { p1n = pair_pos[(row + 2) * 2]; p2n = pair_pos[(row + 2) * 2 + 1]; } }
        const float rstd = 1.0f / sqrtf(wave_sum(ss) * (1.0f / D) + EPS);
        float* xr = X + (size_t)row * D;
#pragma unroll
        for (int j = 0; j < 4; ++j) *(f32x4*)(xr + 4 * lane + 256 * j) = v[j] * rstd * fgv[j];
    }
#undef FIN_ISSUE
}

typedef float f32x2 __attribute__((ext_vector_type(2)));
__device__ __forceinline__ void fourier_ctx_task(const bf16* P, bf16* Y, LAS unsigned char* lds, int task, int tid) {
    const int lane = tid & 63, wave = tid >> 6;
    LAS f32x2* tab = (LAS f32x2*)lds;
    LAS unsigned short* zb = (LAS unsigned short*)(lds + 65536);
    LAS float* ure_s = (LAS float*)(lds + 98304);
    LAS float* uim_s = ure_s + 1024;
    const int b = task >> 6, g = (task >> 4) & 3, kb = task & 15;
    const int rowbase = NLAT + b * CTXL;
    float ure[2] = {0.f, 0.f}, uim[2] = {0.f, 0.f}; int idx[2] = {0, 0}, stp[2];
#pragma unroll
    for (int j = 0; j < 2; ++j) stp[j] = ((kb * 16 + wave * 2 + j) * 32) & 8191;
    __syncthreads();
#pragma unroll
    for (int i = 0; i < 4; ++i) { const int p = tid + NTHR * i, r = p >> 3, ch = p & 7;
        *(LAS v4u*)(zb + r * 64 + ch * 8) = *(const v4u*)(P + (size_t)(rowbase + r) * PLD + PO_F + g * 64 + ch * 8); }
    __syncthreads();
#pragma unroll 4
    for (int nn = 0; nn < 256; ++nn) { const float z = bf2f(zb[nn * 64 + lane]);
#pragma unroll
        for (int j = 0; j < 2; ++j) { const f32x2 t = tab[idx[j]]; ure[j] += z * t.x; uim[j] -= z * t.y; idx[j] = (idx[j] + stp[j]) & 8191; } }
#pragma unroll
    for (int j = 0; j < 2; ++j) { ure_s[(wave * 2 + j) * 64 + lane] = ure[j]; uim_s[(wave * 2 + j) * 64 + lane] = uim[j]; }
    __syncthreads();
    const float scale = 1.0f / sqrtf(256.0f * 64.0f);
#pragma unroll 1
    for (int j = 0; j < 2; ++j) { const int kl = wave * 2 + j; float acc = 0.f;
#pragma unroll 4
        for (int c = 0; c < 64; ++c) { const f32x2 t = tab[((c * lane) & 63) * 128]; acc += ure_s[kl * 64 + c] * t.x + uim_s[kl * 64 + c] * t.y; }
        Y[(size_t)(rowbase + kb * 16 + kl) * D + 512 + g * 64 + lane] = (bf16)f2bf(acc * scale); }
}

typedef short bf16x8v __attribute__((ext_vector_type(8)));
constexpr size_t WS_GW = WS_R2 + 340 * MiB;
constexpr size_t WS_TKS = WS_R2 + 335 * MiB;
constexpr size_t WS_NS = WS_R2 + 330 * MiB;
constexpr size_t WS_SC = WS_R2 + 333 * MiB;
static_assert(WS_HB + (size_t)16 * 132 * 16384 * 2 <= WS_NS && WS_NS + (size_t)2 * 16 * 132 * 128 * 4 <= WS_SC && WS_SC + (size_t)2 * 16 * 132 * 16 <= WS_END && WS_HF + (size_t)16 * 132 * 16384 * 2 <= WS_R2, "mlstm state map");
constexpr int NCHK = 132;
constexpr float KSC = 0.08838834764831845f;
constexpr float F8_ST = 8.f;
typedef float f32x2s __attribute__((ext_vector_type(2)));
__device__ __forceinline__ int chunk_rowbase(int b, int c) { return c < 128 ? b * SEQ + 64 * c : NLAT + b * CTXL + 64 * (c - 128); }
#define DPP_SHR(x_, id_, n_) __builtin_bit_cast(float, __builtin_amdgcn_update_dpp(__builtin_bit_cast(int, (float)(id_)), __builtin_bit_cast(int, (float)(x_)), 0x110 + (n_), 0xF, 0xF, false))
__device__ __forceinline__ float rl_f(float v, int l) { return __builtin_bit_cast(float, __builtin_amdgcn_readlane(__builtin_bit_cast(int, v), l)); }
__device__ __forceinline__ float scan_add_fwd(float x, int lane) {
    x += DPP_SHR(x, 0.f, 1); x += DPP_SHR(x, 0.f, 2); x += DPP_SHR(x, 0.f, 4); x += DPP_SHR(x, 0.f, 8);
    const float t0 = rl_f(x, 15), t1 = rl_f(x, 31), t2 = rl_f(x, 47); const int row = lane >> 4;
    return x + (row == 0 ? 0.f : row == 1 ? t0 : row == 2 ? t0 + t1 : (t0 + t1) + t2);
}
__device__ __forceinline__ float scan_max_fwd(float x, int lane) {
    const float NI = -3.0e38f;
    x = fmaxf(x, DPP_SHR(x, NI, 1)); x = fmaxf(x, DPP_SHR(x, NI, 2)); x = fmaxf(x, DPP_SHR(x, NI, 4)); x = fmaxf(x, DPP_SHR(x, NI, 8));
    const float t0 = rl_f(x, 15), t1 = rl_f(x, 31), t2 = rl_f(x, 47); const int row = lane >> 4;
    return fmaxf(x, row == 0 ? NI : row == 1 ? t0 : row == 2 ? fmaxf(t0, t1) : fmaxf(fmaxf(t0, t1), t2));
}
#define MFMA16(a, b, c) __builtin_amdgcn_mfma_f32_16x16x32_bf16((a), (b), (c), 0, 0, 0)
__device__ __forceinline__ bf16x8v pack8(const float (&v)[8]) { v4u w; w.x = pk2(v[0], v[1]); w.y = pk2(v[2], v[3]); w.z = pk2(v[4], v[5]); w.w = pk2(v[6], v[7]); return __builtin_bit_cast(bf16x8v, w); }


__device__ __forceinline__ void gate_proj_tasks(const bf16* A, const bf16* WinT, const float* bg, unsigned char* ws, LAS unsigned char* lds, int widx, int nw, int tid) {
    const int lane = tid & 63, wave = tid >> 6, r = lane & 15, g = lane >> 4;
    const bf16* wrow = WinT + (size_t)(2816 + r) * D + 8 * g;
    LAS float* GS = (LAS float*)lds;
    float* TKS = (float*)(ws + WS_TKS); float* GWt = (float*)(ws + WS_GW); float* SC = (float*)(ws + WS_SC);
    for (int t = widx; t < MROWS / 256; t += nw) {
        const int row0 = t * 256 + wave * 32;
        const bf16* a0 = A + (size_t)(row0 + r) * D + 8 * g; const bf16* a1 = a0 + (size_t)16 * D;
        f32x4 c0 = {0.f, 0.f, 0.f, 0.f}, c1 = c0;
#pragma unroll 8
        for (int kk = 0; kk < 32; ++kk) { const bf16x8v b = *(const bf16x8v*)(wrow + 32 * kk), x0 = *(const bf16x8v*)(a0 + 32 * kk), x1 = *(const bf16x8v*)(a1 + 32 * kk);
            c0 = MFMA16(x0, b, c0); c1 = MFMA16(x1, b, c1); }
        __syncthreads();
#pragma unroll
        for (int i = 0; i < 4; ++i) { GS[(wave * 32 + 4 * g + i) * 17 + r] = c0[i]; GS[(wave * 32 + 16 + 4 * g + i) * 17 + r] = c1[i]; }
        __syncthreads();
        const int b = t < 128 ? (t >> 5) : (t - 128), cbase = t < 128 ? 4 * (t & 31) : 128;
        for (int j = wave; j < 32; j += NWAVES) { const int cc = j >> 3, dir = (j >> 2) & 1, h = j & 3, tk = dir ? 63 - lane : lane;
            const LAS float* gr = GS + (64 * cc + tk) * 17 + dir * 8 + h;
            const float a = gr[0] + bg[dir * 8 + h], lf = log_sigmoid_f(gr[4] + bg[dir * 8 + 4 + h]);
            const float cum = scan_add_fwd(lf, lane), gg = a - cum, pm = scan_max_fwd(gg, lane), gmax = rl_f(pm, 63), tot = rl_f(cum, 63);
            const size_t base = (size_t)(dir * 16 + b * 4 + h) * NCHK + cbase + cc;
            TKS[base * 192 + lane] = cum; TKS[base * 192 + 64 + lane] = gg; TKS[base * 192 + 128 + lane] = pm;
            GWt[base * 64 + lane] = __expf(gg - gmax) * (KSC * F8_ST);
            if (lane == 0) { SC[base * 4] = tot; SC[base * 4 + 1] = tot + gmax; } }
    }
}
__device__ __forceinline__ int swz72(int row, int s) { return row * 72 + ((((s >> 3) ^ ((row >> 3) & 7))) << 3) + (s & 7); }
struct M1Regs { v4u k[2], v[2]; float ga, gf; };
__device__ __forceinline__ void m1_issue(M1Regs& R, const bf16* P, const float* Gt, int task, int tid) {
    const int lane = tid & 63, wave = tid >> 6;
    const int bh = task / NCHK, c = task % NCHK, b = bh >> 2, h = bh & 3, rowbase = chunk_rowbase(b, c);
#pragma unroll
    for (int i2 = 0; i2 < 2; ++i2) { const int p = tid + NTHR * i2, s = p >> 4, dg = p & 15;
        R.k[i2] = *(const v4u*)(P + (size_t)(rowbase + s) * PLD + PO_K + h * 128 + dg * 8); R.v[i2] = *(const v4u*)(P + (size_t)(rowbase + s) * PLD + PO_V + h * 128 + dg * 8); }
    R.ga = 0.f; R.gf = 0.f;
    if (wave < 2) R.ga = Gt[((size_t)(wave * 16 + bh) * NCHK + c) * 64 + lane];
}
__device__ __forceinline__ void mlstm_m1_phase(const bf16* P, const float* Gt, const float* bg, unsigned char* ws, LAS unsigned char* lds, int ntask, int wg, int G, int tid) {
    const int lane = tid & 63, wave = tid >> 6, r = lane & 15, g = lane >> 4;
    LAS unsigned short* KT0 = (LAS unsigned short*)lds;
    LAS unsigned short* VT = (LAS unsigned short*)(lds + 36864);
    LAS float* gw = (LAS float*)(lds + 55296);
    float* SC = (float*)(ws + WS_SC); float* NS = (float*)(ws + WS_NS);
    if (wg >= ntask) return;
    M1Regs R; m1_issue(R, P, Gt, wg, tid);
    for (int task = wg; task < ntask; task += G) {
        const int bh = task / NCHK, c = task % NCHK, h = bh & 3;
        __syncthreads();
        if (wave < 2) { const int dir = wave, tk = dir ? 63 - lane : lane; gw[dir * 64 + tk] = R.ga; }
        __syncthreads();
#pragma unroll
        for (int i2 = 0; i2 < 2; ++i2) { const int p = tid + NTHR * i2, s = p >> 4, dg = p & 15;
            const float wf = gw[s], wb = gw[64 + s];
            const unsigned kk[4] = {R.k[i2].x, R.k[i2].y, R.k[i2].z, R.k[i2].w}, vv[4] = {R.v[i2].x, R.v[i2].y, R.v[i2].z, R.v[i2].w};
#pragma unroll
            for (int j = 0; j < 4; ++j) { const float k0 = bflo(kk[j]), k1 = bfhi(kk[j]); const int d = dg * 8 + 2 * j, o0 = swz72(d, s), o1 = swz72(d + 1, s);
                const unsigned pf = pk2(k0 * wf, k1 * wf), pb = pk2(k0 * wb, k1 * wb);
                KT0[o0] = (unsigned short)(pf & 0xffffu); KT0[o1] = (unsigned short)(pf >> 16);
                KT0[9216 + o0] = (unsigned short)(pb & 0xffffu); KT0[9216 + o1] = (unsigned short)(pb >> 16);
                VT[o0] = (unsigned short)(vv[j] & 0xffffu); VT[o1] = (unsigned short)(vv[j] >> 16); } }
        __syncthreads();
        if (task + G < ntask) m1_issue(R, P, Gt, task + G, tid);
        { const int dir = wave >> 2, w4 = wave & 3; LAS unsigned short* KT = KT0 + dir * 9216;
            unsigned char* CS = ws + (dir ? WS_HB : WS_HF) + ((size_t)bh * NCHK + c) * 16384;
            bf16x8v af[2][2];
#pragma unroll
            for (int m = 0; m < 2; ++m)
#pragma unroll
                for (int kk = 0; kk < 2; ++kk) af[m][kk] = *(const LAS bf16x8v*)(KT + swz72(32 * w4 + 8 * (r >> 2) + 4 * m + (r & 3), kk * 32 + 8 * g));
#pragma unroll
            for (int et = 0; et < 8; ++et) {
                const bf16x8v b0 = *(const LAS bf16x8v*)(VT + swz72(et * 16 + r, 8 * g)), b1 = *(const LAS bf16x8v*)(VT + swz72(et * 16 + r, 32 + 8 * g)); v2u o;
#pragma unroll
                for (int m = 0; m < 2; ++m) { f32x4 acc = {0.f, 0.f, 0.f, 0.f}; acc = MFMA16(af[m][0], b0, acc); acc = MFMA16(af[m][1], b1, acc);
                    const unsigned w8 = pg8::pk4_fp8(acc[0], acc[1], acc[2], acc[3]); if (m == 0) o.x = w8; else o.y = w8; }
                *(v2u*)(CS + (size_t)(et * 16 + r) * 128 + 32 * w4 + 8 * g) = o; }
        }
        if (tid < 256) { const int dir = tid >> 7, dd = tid & 127; const LAS unsigned short* kr = KT0 + dir * 9216 + dd * 72; float s = 0.f;
#pragma unroll
            for (int q = 0; q < 8; ++q) { const v4u w = *(const LAS v4u*)(kr + 8 * q); s += (bflo(w.x) + bfhi(w.x)) + (bflo(w.y) + bfhi(w.y)) + (bflo(w.z) + bfhi(w.z)) + (bflo(w.w) + bfhi(w.w)); }
            NS[((size_t)(dir * 16 + bh) * NCHK + c) * 128 + dd] = s * (1.0f / F8_ST); }
    }
}

__device__ __forceinline__ void mlstm_m2_phase(unsigned char* ws, int wg, int G, int tid) {
    for (int u = wg; u < 256; u += G) {
        const int seq = u >> 3, part = u & 7, dir = seq >> 4, bh = seq & 15;
        unsigned char* base = ws + (dir ? WS_HB : WS_HF) + (size_t)bh * NCHK * 16384 + part * 2048 + tid * 4;
        float* SC = (float*)(ws + WS_SC) + (size_t)(dir * 16 + bh) * NCHK * 4;
        float* NSb = (float*)(ws + WS_NS) + (size_t)(dir * 16 + bh) * NCHK * 128 + tid;
        const bool do_n = (part == 0 && tid < 128), do_m = (part == 0 && tid == 0);
        float s0 = 0.f, s1 = 0.f, s2 = 0.f, s3 = 0.f, m = -1e30f, ns = 0.f;
        unsigned dlA[12], dlB[12]; float totA[12], totB[12], mlA[12], mlB[12], dnA[12], dnB[12];
#define M2_CC(j_) (dir ? (NCHK - 1 - (j_)) : (((j_) + 128) % NCHK))
#define M2_LOAD(X_, j0_) { _Pragma("unroll") for (int q = 0; q < 12; ++q) { const int cq = M2_CC((j0_) + q); \
            dl##X_[q] = *(const unsigned*)(base + (size_t)cq * 16384); tot##X_[q] = SC[cq * 4]; ml##X_[q] = SC[cq * 4 + 1]; dn##X_[q] = 0.f; if (do_n) dn##X_[q] = NSb[(size_t)cq * 128]; } }
#define M2_PROC(X_, j0_) { _Pragma("unroll") for (int q = 0; q < 12; ++q) { const int cq = M2_CC((j0_) + q); \
            *(unsigned*)(base + (size_t)cq * 16384) = pg8::pk4_fp8(s0, s1, s2, s3); \
            if (do_n) NSb[(size_t)cq * 128] = ns; \
            if (do_m) SC[cq * 4 + 2] = m; \
            const float me = fmaxf(tot##X_[q] + m, ml##X_[q]), al = __expf(tot##X_[q] + m - me), be = __expf(ml##X_[q] - me); m = me; \
            const f32x2s dlo = __builtin_amdgcn_cvt_pk_f32_fp8((int)dl##X_[q], false), dhi = __builtin_amdgcn_cvt_pk_f32_fp8((int)dl##X_[q], true); \
            s0 = al * s0 + be * dlo.x; s1 = al * s1 + be * dlo.y; s2 = al * s2 + be * dhi.x; s3 = al * s3 + be * dhi.y; ns = ns * al + dn##X_[q] * be; } }
        M2_LOAD(A, 0)
#pragma unroll 1
        for (int j0 = 0; j0 < NCHK; j0 += 24) {
            if (j0 + 12 < NCHK) M2_LOAD(B, j0 + 12)
            M2_PROC(A, j0)
            if (j0 + 12 < NCHK) { if (j0 + 24 < NCHK) M2_LOAD(A, j0 + 24)
                M2_PROC(B, j0 + 12) }
        }
#undef M2_CC
#undef M2_LOAD
#undef M2_PROC
    }
}

struct M3Regs { v4u q[2], k[2], v[2]; float ga, gf, pm, mst; };
__device__ __forceinline__ void m3_issue(M3Regs& R, const bf16* P, const float* TKS, const float* SC, int task, int tid) {
    const int lane = tid & 63, wave = tid >> 6;
    const int bh = task / NCHK, c = task % NCHK, b = bh >> 2, h = bh & 3, rowbase = chunk_rowbase(b, c);
#pragma unroll
    for (int i2 = 0; i2 < 2; ++i2) { const int p = tid + NTHR * i2, s = p >> 4, dg = p & 15; const bf16* pr = P + (size_t)(rowbase + s) * PLD + h * 128 + dg * 8;
        R.q[i2] = *(const v4u*)(pr + PO_Q); R.k[i2] = *(const v4u*)(pr + PO_K); R.v[i2] = *(const v4u*)(pr + PO_V); }
    R.ga = 0.f; R.gf = 0.f; R.pm = 0.f; R.mst = 0.f;
    if (wave < 2) { const float* tk = TKS + ((size_t)(wave * 16 + bh) * NCHK + c) * 192 + lane; R.ga = tk[0]; R.gf = tk[64]; R.pm = tk[128]; R.mst = SC[((size_t)(wave * 16 + bh) * NCHK + c) * 4 + 2]; }
}
__device__ __forceinline__ void mlstm_m3_phase(const bf16* P, const float* Gt, const float* bg, const float* ngl, unsigned char* ws, bf16* Y, LAS unsigned char* lds, int nchunk, int wg, int G, int tid) {
    const int lane = tid & 63, wave = tid >> 6, r = lane & 15, g = lane >> 4;
    LAS unsigned short* Qs = (LAS unsigned short*)lds;
    LAS unsigned short* Ks = (LAS unsigned short*)(lds + 17408);
    LAS unsigned short* VT = (LAS unsigned short*)(lds + 34816);
    LAS unsigned short* CT = (LAS unsigned short*)(lds + 53248);
    LAS float* nsl = (LAS float*)(lds + 122880);
    LAS float* tok = (LAS float*)(lds + 123904);
    LAS float* dens = (LAS float*)(lds + 125952);
    LAS float* HS = (LAS float*)lds;
    const float* SC = (const float*)(ws + WS_SC); const float* NS = (const float*)(ws + WS_NS); const float* TKS = (const float*)(ws + WS_TKS);
    const int ntask = 16 * nchunk;
    if (wg >= ntask) return;
#define M3_TASK(t_) (((t_) / nchunk) * NCHK + ((t_) % nchunk))
    M3Regs R; m3_issue(R, P, TKS, SC, M3_TASK(wg), tid);
    for (int tt = wg; tt < ntask; tt += G) {
        const int task = M3_TASK(tt), bh = task / NCHK, c = task % NCHK, b = bh >> 2, h = bh & 3, rowbase = chunk_rowbase(b, c);
        __syncthreads();
        v4u cr[4]; float nsv0 = 0.f, nsv1 = 0.f;
#pragma unroll
        for (int i2 = 0; i2 < 4; ++i2) { const int p = tid + NTHR * i2, dir = p >> 10, e = (p >> 3) & 127, dg = p & 7;
            const unsigned char* CS = ws + (dir ? WS_HB : WS_HF) + ((size_t)bh * NCHK + c) * 16384; cr[i2] = *(const v4u*)(CS + e * 128 + dg * 16); }
        if (wave >= 2 && wave < 4) { const float* src = NS + ((size_t)((wave - 2) * 16 + bh) * NCHK + c) * 128; nsv0 = src[lane]; nsv1 = src[64 + lane]; }
        if (wave < 2) { const int dir = wave, tk = dir ? 63 - lane : lane;
            tok[dir * 256 + tk] = -fmaxf(R.mst, R.pm); tok[dir * 256 + 64 + tk] = R.gf; tok[dir * 256 + 128 + tk] = R.ga; tok[dir * 256 + 192 + tk] = R.mst; }
#pragma unroll
        for (int i2 = 0; i2 < 2; ++i2) { const int p = tid + NTHR * i2, s = p >> 4, dg = p & 15;
            *(LAS v4u*)(Qs + s * 136 + dg * 8) = R.q[i2]; *(LAS v4u*)(Ks + s * 136 + dg * 8) = R.k[i2];
            const unsigned vv[4] = {R.v[i2].x, R.v[i2].y, R.v[i2].z, R.v[i2].w};
#pragma unroll
            for (int j = 0; j < 4; ++j) { const int d = dg * 8 + 2 * j; VT[swz72(d, s)] = (unsigned short)(vv[j] & 0xffffu); VT[swz72(d + 1, s)] = (unsigned short)(vv[j] >> 16); } }
        __syncthreads();
        const int rt = wave & 3, ch = wave >> 2;
        bf16x8v qf[4];
#pragma unroll
        for (int kk = 0; kk < 4; ++kk) qf[kk] = *(const LAS bf16x8v*)(Qs + (16 * rt + r) * 136 + 32 * kk + 8 * g);
        const int t = 16 * rt + r;
        const float uf = tok[t], ub = tok[256 + t];
        float dsf = 0.f, dsb = 0.f;
        f32x4 aPf[4], aPb[4];
#pragma unroll
        for (int ct = 0; ct < 4; ++ct) { const f32x4 z = {0.f, 0.f, 0.f, 0.f}; aPf[ct] = z; aPb[ct] = z; }
#pragma unroll 1
        for (int k2 = 0; k2 < 2; ++k2) { float vf[8], vb[8];
#pragma unroll
            for (int hh = 0; hh < 2; ++hh) { const int st = 2 * k2 + hh; f32x4 acc = {0.f, 0.f, 0.f, 0.f};
#pragma unroll
                for (int kk = 0; kk < 4; ++kk) { const bf16x8v a = *(const LAS bf16x8v*)(Ks + (16 * st + r) * 136 + 32 * kk + 8 * g); acc = MFMA16(a, qf[kk], acc); }
#pragma unroll
                for (int i = 0; i < 4; ++i) { const int s = 16 * st + 4 * g + i; const float sv = acc[i] * KSC;
                    const float wf = (s <= t) ? __expf(uf + tok[64 + s]) : 0.f, wb = (s >= t) ? __expf(ub + tok[256 + 64 + s]) : 0.f;
                    vf[4 * hh + i] = sv * wf; vb[4 * hh + i] = sv * wb; dsf += vf[4 * hh + i]; dsb += vb[4 * hh + i]; } }
            const bf16x8v paf = pack8(vf), pab = pack8(vb);
#pragma unroll
            for (int ct = 0; ct < 4; ++ct) { const int e = 64 * ch + 16 * ct + r;
                const v2u lo = *(const LAS v2u*)(VT + swz72(e, 32 * k2 + 4 * g)), hi = *(const LAS v2u*)(VT + swz72(e, 32 * k2 + 16 + 4 * g));
                v4u bw; bw.x = lo.x; bw.y = lo.y; bw.z = hi.x; bw.w = hi.y; const bf16x8v bfr = __builtin_bit_cast(bf16x8v, bw);
                aPf[ct] = MFMA16(paf, bfr, aPf[ct]); aPb[ct] = MFMA16(pab, bfr, aPb[ct]); } }
#pragma unroll
        for (int i2 = 0; i2 < 4; ++i2) { const int p = tid + NTHR * i2, dir = p >> 10, e = (p >> 3) & 127, dg = p & 7;
            const unsigned cw[4] = {cr[i2].x, cr[i2].y, cr[i2].z, cr[i2].w}; unsigned ob[8];
#pragma unroll
            for (int j = 0; j < 4; ++j) { const f32x2s lo = __builtin_amdgcn_cvt_pk_f32_fp8((int)cw[j], false), hi = __builtin_amdgcn_cvt_pk_f32_fp8((int)cw[j], true); ob[2 * j] = pk2(lo.x, lo.y); ob[2 * j + 1] = pk2(hi.x, hi.y); }
            v4u o0, o1; o0.x = ob[0]; o0.y = ob[1]; o0.z = ob[2]; o0.w = ob[3]; o1.x = ob[4]; o1.y = ob[5]; o1.z = ob[6]; o1.w = ob[7];
            *(LAS v4u*)(CT + dir * 17408 + e * 136 + dg * 16) = o0; *(LAS v4u*)(CT + dir * 17408 + e * 136 + dg * 16 + 8) = o1; }
        if (wave >= 2 && wave < 4) { nsl[2 * lane + (wave - 2)] = nsv0; nsl[2 * (64 + lane) + (wave - 2)] = nsv1; }
        __syncthreads();
        v4u ocur[2];
#pragma unroll
        for (int i2 = 0; i2 < 2; ++i2) { const int p = tid + NTHR * i2, s = p >> 4, dg = p & 15; ocur[i2] = *(const v4u*)(P + (size_t)(rowbase + s) * PLD + PO_O + h * 128 + dg * 8); }
        if (tt + G < ntask) m3_issue(R, P, TKS, SC, M3_TASK(tt + G), tid);
        f32x2s qn2 = {0.f, 0.f};
#pragma unroll
        for (int kk = 0; kk < 4; ++kk)
#pragma unroll
            for (int i = 0; i < 8; ++i) { const float qv = bf2f((unsigned short)qf[kk][i]); const f32x2s qq = {qv, qv}; qn2 += qq * *(const LAS f32x2s*)(nsl + 2 * (32 * kk + 8 * g + i)); }
        float qnf = qn2.x, qnb = qn2.y;
        dsf += __shfl_xor(dsf, 16); dsf += __shfl_xor(dsf, 32); dsb += __shfl_xor(dsb, 16); dsb += __shfl_xor(dsb, 32);
        qnf += __shfl_xor(qnf, 16); qnf += __shfl_xor(qnf, 32); qnb += __shfl_xor(qnb, 16); qnb += __shfl_xor(qnb, 32);
        if (g == 0) { dens[(wave * 2 + 0) * 16 + r] = dsf + __expf(uf + tok[192 + t]) * qnf; dens[(wave * 2 + 1) * 16 + r] = dsb + __expf(ub + tok[256 + 192 + t]) * qnb; }
        LDS_WAIT();
        f32x4 intf, intb, rdf, rdb;
#pragma unroll
        for (int i = 0; i < 4; ++i) { const int tr = 16 * rt + 4 * g + i, tl = 4 * g + i;
            const float u0 = tok[tr], u1 = tok[256 + tr];
            intf[i] = __expf(u0 + tok[192 + tr]) * (1.0f / F8_ST); intb[i] = __expf(u1 + tok[256 + 192 + tr]) * (1.0f / F8_ST);
            rdf[i] = __builtin_amdgcn_rcpf(fmaxf(fabsf(dens[(wave * 2 + 0) * 16 + tl]), __expf(u0 - tok[128 + tr]))); rdb[i] = __builtin_amdgcn_rcpf(fmaxf(fabsf(dens[(wave * 2 + 1) * 16 + tl]), __expf(u1 - tok[256 + 128 + tr]))); }
#pragma unroll
        for (int ct = 0; ct < 4; ++ct) { const int e0 = 64 * ch + 16 * ct; f32x4 aCf = {0.f, 0.f, 0.f, 0.f}, aCb = aCf;
#pragma unroll
            for (int kk = 0; kk < 4; ++kk) { const bf16x8v cf = *(const LAS bf16x8v*)(CT + (e0 + r) * 136 + 32 * kk + 8 * g), cb = *(const LAS bf16x8v*)(CT + 17408 + (e0 + r) * 136 + 32 * kk + 8 * g);
                aCf = MFMA16(qf[kk], cf, aCf); aCb = MFMA16(qf[kk], cb, aCb); }
            const f32x4 hv = (aPf[ct] + intf * aCf) * rdf + (aPb[ct] + intb * aCb) * rdb;
#pragma unroll
            for (int i = 0; i < 4; ++i) HS[(16 * rt + 4 * g + i) * 132 + e0 + r] = hv[i]; }
        __syncthreads();
#pragma unroll
        for (int i2 = 0; i2 < 2; ++i2) { const int p = tid + NTHR * i2, tk = p >> 4, c8 = p & 15;
            const f32x4 h0 = *(const LAS f32x4*)(HS + tk * 132 + 8 * c8), h1 = *(const LAS f32x4*)(HS + tk * 132 + 8 * c8 + 4);
            const f32x4 sq = h0 * h0 + h1 * h1; float ss = (sq.x + sq.y) + (sq.z + sq.w);
            ss = row16_sum(ss);
            const float rstd = __builtin_amdgcn_rsqf(ss * (1.0f / 128.0f) + EPS);
            const f32x4 g0 = *(const f32x4*)(ngl + h * 128 + 8 * c8), g1 = *(const f32x4*)(ngl + h * 128 + 8 * c8 + 4); const v4u o = ocur[i2];
            const f32x4 s0 = {sigmoid_f(bflo(o.x)), sigmoid_f(bfhi(o.x)), sigmoid_f(bflo(o.y)), sigmoid_f(bfhi(o.y))}, s1 = {sigmoid_f(bflo(o.z)), sigmoid_f(bfhi(o.z)), sigmoid_f(bflo(o.w)), sigmoid_f(bfhi(o.w))};
            const f32x4 y0 = s0 * h0 * (g0 * rstd), y1 = s1 * h1 * (g1 * rstd);
            v4u w; w.x = pk2(y0.x, y0.y); w.y = pk2(y0.z, y0.w); w.z = pk2(y1.x, y1.y); w.w = pk2(y1.z, y1.w);
            *(v4u*)(Y + (size_t)(rowbase + tk) * D + h * 128 + 8 * c8) = w; }
    }
#undef M3_TASK
}

struct ConvRegs { v4u u[6], g[6]; };
__device__ __forceinline__ void conv_issue(ConvRegs& R, const bf16* P, int task_, bool ctx_unused, int tid) {
    (void)ctx_unused; const bool ctx = task_ >= 512; const int task = ctx ? task_ - 512 : task_;
    const int N = ctx ? CTXL : SEQ, ntile = N / 64, b = task / ntile, t0 = (task % ntile) * 64, rowbase = ctx ? NLAT + b * CTXL : b * SEQ;
#pragma unroll
    for (int k = 0; k < 6; ++k) { const int p = tid + NTHR * k, rr = p >> 5, cg = p & 31, t = t0 - 15 + rr; const v4u z = {0u, 0u, 0u, 0u}; R.u[k] = z; R.g[k] = z;
        if (rr < 94 && t >= 0 && t < N) { const bf16* pr = P + (size_t)(rowbase + t) * PLD; R.u[k] = *(const v4u*)(pr + PO_CU + 8 * cg); R.g[k] = *(const v4u*)(pr + PO_CG + 8 * cg); } }
}
__device__ __forceinline__ void conv_phase(const bf16* P, bf16* Y, const float* dw, const float* db, const float* lg, const float* lb, LAS unsigned char* lds, int ntask, bool ctx, int wg, int G, int tid) {
    const int lane = tid & 63, wave = tid >> 6;
    (void)ctx;
    LAS float* a = (LAS float*)lds;
    const int grp = wave & 3, th = wave >> 2, ch = grp * 64 + lane;
    if (wg >= ntask) return;
    typedef float f2c __attribute__((ext_vector_type(2)));
    f2c wp[32];
#pragma unroll
    for (int k = 0; k < 32; ++k) { wp[k].x = k < 31 ? dw[k * 256 + ch] : 0.f; wp[k].y = k > 0 ? dw[(k - 1) * 256 + ch] : 0.f; }
    const float bias = db[ch], gam = lg[ch], bet = lb[ch];
    ConvRegs R; conv_issue(R, P, wg, ctx, tid);
    for (int task = wg; task < ntask; task += G) {
        const bool cx = task >= 512; const int tk = cx ? task - 512 : task, ntile = (cx ? CTXL : SEQ) / 64; const int b = tk / ntile, t0 = (tk % ntile) * 64, rowbase = cx ? NLAT + b * CTXL : b * SEQ;
        __syncthreads();
#pragma unroll
        for (int k = 0; k < 6; ++k) { const int p = tid + NTHR * k, rr = p >> 5, cg = p & 31; const v4u u = R.u[k], gq = R.g[k]; f32x4 o0, o1;
            o0.x = bflo(u.x) * sigmoid_f(bflo(gq.x)); o0.y = bfhi(u.x) * sigmoid_f(bfhi(gq.x)); o0.z = bflo(u.y) * sigmoid_f(bflo(gq.y)); o0.w = bfhi(u.y) * sigmoid_f(bfhi(gq.y));
            o1.x = bflo(u.z) * sigmoid_f(bflo(gq.z)); o1.y = bfhi(u.z) * sigmoid_f(bfhi(gq.z)); o1.z = bflo(u.w) * sigmoid_f(bflo(gq.w)); o1.w = bfhi(u.w) * sigmoid_f(bfhi(gq.w));
            if (rr < 94) { *(LAS f32x4*)(a + rr * 256 + 8 * cg) = o0; *(LAS f32x4*)(a + rr * 256 + 8 * cg + 4) = o1; } }
        __syncthreads();
        if (task + G < ntask) conv_issue(R, P, task + G, ctx, tid);
        f2c acc2[16];
#pragma unroll
        for (int p = 0; p < 16; ++p) acc2[p] = (f2c){bias, bias};
        float vq[4];
#pragma unroll
        for (int j = 0; j < 4; ++j) vq[j] = a[(th * 32 + j) * 256 + ch];
#pragma unroll
        for (int j = 0; j < 62; ++j) { const float v = vq[j & 3]; const f2c vv = {v, v};
            if (j + 4 < 62) vq[j & 3] = a[(th * 32 + j + 4) * 256 + ch];
#pragma unroll
            for (int p = 0; p < 16; ++p) if (j - 2 * p >= 0 && j - 2 * p <= 31) acc2[p] += vv * wp[j - 2 * p];
            asm volatile("" ::: "memory"); }
        __syncthreads();
        LAS float* S = (LAS float*)lds + wave * (32 * 65 + 64); LAS float* St = S + 32 * 65;
#pragma unroll
        for (int p = 0; p < 16; ++p) { S[(2 * p) * 65 + lane] = acc2[p].x; S[(2 * p + 1) * 65 + lane] = acc2[p].y; }
        LDS_WAIT();
        { const int tt = lane & 31, c0 = (lane >> 5) * 32; float s1 = 0.f, s2 = 0.f;
#pragma unroll
            for (int c = 0; c < 32; ++c) { const float x = S[tt * 65 + c0 + c]; s1 += x; s2 += x * x; }
            s1 += __shfl_xor(s1, 32); s2 += __shfl_xor(s2, 32);
            const float mu = s1 * (1.0f / 64.0f), var = fmaxf(s2 * (1.0f / 64.0f) - mu * mu, 0.f);
            if (lane < 32) { St[tt] = mu; St[32 + tt] = __builtin_amdgcn_rsqf(var + EPS); } }
        LDS_WAIT();
#pragma unroll
        for (int t = 0; t < 32; ++t) { const float x = (t & 1) ? acc2[t >> 1].y : acc2[t >> 1].x;
            const float yn = (x - St[t]) * St[32 + t] * gam + bet;
            Y[(size_t)(rowbase + t0 + th * 32 + t) * D + 768 + ch] = (bf16)f2bf(silu_f(yn)); }
    }
}

constexpr size_t WS_FA = WS_A;
__device__ __forceinline__ void fourier_a_phase(const bf16* P, bf16* FA, LAS unsigned char* lds, int wg, int G, int tid) {
    const int lane = tid & 63, wave = tid >> 6, r = lane & 15, g = lane >> 4;
    LAS unsigned short* ZT = (LAS unsigned short*)lds;
    bf16x8v cfr[4], nsfr[4];
    { const int k1 = 16 * wave + r;
#pragma unroll
        for (int kk = 0; kk < 4; ++kk) { float cv[8], sv[8];
#pragma unroll
            for (int i = 0; i < 8; ++i) { const int n1 = 32 * kk + 8 * g + i; float s, c; sincospif((float)((k1 * n1) & 127) * (1.0f / 64.0f), &s, &c); cv[i] = c; sv[i] = -s; }
            cfr[kk] = pack8(cv); nsfr[kk] = pack8(sv); } }
    if (wg >= 16 * 64) return;
    v4u zr[2];
#define FA_ISSUE(task_) do { const int bg_ = (task_) >> 6, n2_ = (task_) & 63, b_ = bg_ >> 2, g4_ = bg_ & 3; _Pragma("unroll") for (int i2 = 0; i2 < 2; ++i2) { const int p = tid + NTHR * i2, n1 = p >> 3, cg = p & 7; \
        zr[i2] = *(const v4u*)(P + (size_t)(b_ * SEQ + 64 * n1 + n2_) * PLD + PO_F + 64 * g4_ + 8 * cg); } } while (0)
    FA_ISSUE(wg);
    for (int task = wg; task < 16 * 64; task += G) {
        const int bg = task >> 6, n2 = task & 63;
        __syncthreads();
#pragma unroll
        for (int i2 = 0; i2 < 2; ++i2) { const int p = tid + NTHR * i2, n1 = p >> 3, cg = p & 7; const unsigned zz[4] = {zr[i2].x, zr[i2].y, zr[i2].z, zr[i2].w};
#pragma unroll
            for (int j = 0; j < 4; ++j) { const int c0 = 8 * cg + 2 * j; const int blk = (((n1 >> 3) ^ cg) << 3) + (n1 & 7);
                ZT[c0 * 136 + blk] = (unsigned short)(zz[j] & 0xffffu); ZT[(c0 + 1) * 136 + blk] = (unsigned short)(zz[j] >> 16); } }
        __syncthreads();
        if (task + G < 16 * 64) FA_ISSUE(task + G);
        const int k1 = 16 * wave + r; float tc, ts; sincospif((float)(n2 * k1) * (1.0f / 4096.0f), &ts, &tc);
        bf16* dst = FA + ((size_t)(bg * 128 + k1) * 2) * 4096 + n2 * 64;
        if (wave < 5)
#pragma unroll
        for (int ct = 0; ct < 4; ++ct) { f32x4 aR = {0.f, 0.f, 0.f, 0.f}, aI = aR;
#pragma unroll
            for (int kk = 0; kk < 4; ++kk) { const bf16x8v a = *(const LAS bf16x8v*)(ZT + (16 * ct + r) * 136 + (((4 * kk + g) ^ ((2 * ct + (r >> 3)) & 7)) << 3)); aR = MFMA16(a, cfr[kk], aR); aI = MFMA16(a, nsfr[kk], aI); }
            v2u oR, oI; oR.x = pk2(aR[0] * tc + aI[0] * ts, aR[1] * tc + aI[1] * ts); oR.y = pk2(aR[2] * tc + aI[2] * ts, aR[3] * tc + aI[3] * ts);
            oI.x = pk2(aI[0] * tc - aR[0] * ts, aI[1] * tc - aR[1] * ts); oI.y = pk2(aI[2] * tc - aR[2] * ts, aI[3] * tc - aR[3] * ts);
            if (k1 <= 64) { *(v2u*)(dst + 16 * ct + 4 * g) = oR; *(v2u*)(dst + 4096 + 16 * ct + 4 * g) = oI; } }
    }
}
__device__ __forceinline__ void fourier_b_phase(const bf16* FA, bf16* Y, LAS unsigned char* lds, int wg, int G, int tid) {
    const int lane = tid & 63, wave = tid >> 6, r = lane & 15, g = lane >> 4, kt = wave & 3, kh = wave >> 2;
    LAS unsigned short* Ms = (LAS unsigned short*)lds;
    LAS unsigned short* Ys = (LAS unsigned short*)(lds + 32768);
    bf16x8v Cf[2], Sf[2], NSf[2], C2[2][2], S2[2][2];
    { const int kc = 16 * kt + r;
#pragma unroll
        for (int kk = 0; kk < 2; ++kk) { float cv[8], sv[8], nv[8];
#pragma unroll
            for (int i = 0; i < 8; ++i) { const int c = 32 * kk + 8 * g + i; float s, co; sincospif((float)((kc * c) & 63) * (1.0f / 32.0f), &s, &co); cv[i] = co; sv[i] = s; nv[i] = -s; }
            Cf[kk] = pack8(cv); Sf[kk] = pack8(sv); NSf[kk] = pack8(nv); }
#pragma unroll
        for (int m = 0; m < 2; ++m) { const int k2 = 16 * (2 * kh + m) + r;
#pragma unroll
            for (int kk = 0; kk < 2; ++kk) { float cv[8], sv[8];
#pragma unroll
                for (int i = 0; i < 8; ++i) { const int n2 = 32 * kk + 16 * (i >> 2) + 4 * g + (i & 3); float s, co; sincospif((float)((k2 * n2) & 63) * (1.0f / 32.0f), &s, &co); cv[i] = co; sv[i] = s; }
                C2[m][kk] = pack8(cv); S2[m][kk] = pack8(sv); } } }
    const float scale = 1.0f / sqrtf(8192.0f * 64.0f);
    if (wg >= 16 * 65) return;
    v4u mr[2];
#define FB_ISSUE(task_) do { const bf16* src_ = FA + (size_t)(((task_) / 65) * 128 + (task_) % 65) * 8192; _Pragma("unroll") for (int i2 = 0; i2 < 2; ++i2) { const int p = tid + NTHR * i2; mr[i2] = *(const v4u*)(src_ + 8 * p); } } while (0)
    FB_ISSUE(wg);
    for (int task = wg; task < 16 * 65; task += G) {
        const int bg = task / 65, k1 = task % 65, b = bg >> 2, g4 = bg & 3;
        __syncthreads();
#pragma unroll
        for (int i2 = 0; i2 < 2; ++i2) { const int p = tid + NTHR * i2, plane = p >> 9, n2 = (p >> 3) & 63, cg = p & 7; *(LAS v4u*)(Ms + plane * 4608 + n2 * 72 + 8 * cg) = mr[i2]; }
        __syncthreads();
        if (task + G < 16 * 65) FB_ISSUE(task + G);
        f32x4 tre[4], tim[4];
#pragma unroll
        for (int nt = 0; nt < 4; ++nt) { f32x4 a = {0.f, 0.f, 0.f, 0.f}, bq = a;
#pragma unroll
            for (int kk = 0; kk < 2; ++kk) { const bf16x8v are = *(const LAS bf16x8v*)(Ms + (16 * nt + r) * 72 + 32 * kk + 8 * g), aim = *(const LAS bf16x8v*)(Ms + 4608 + (16 * nt + r) * 72 + 32 * kk + 8 * g);
                a = MFMA16(are, Cf[kk], a); a = MFMA16(aim, Sf[kk], a); bq = MFMA16(aim, Cf[kk], bq); bq = MFMA16(are, NSf[kk], bq); }
            tre[nt] = a; tim[nt] = bq; }
        bf16x8v bre[2], bim[2];
#pragma unroll
        for (int kk = 0; kk < 2; ++kk) { const float v0[8] = {tre[2 * kk][0], tre[2 * kk][1], tre[2 * kk][2], tre[2 * kk][3], tre[2 * kk + 1][0], tre[2 * kk + 1][1], tre[2 * kk + 1][2], tre[2 * kk + 1][3]};
            const float v1[8] = {tim[2 * kk][0], tim[2 * kk][1], tim[2 * kk][2], tim[2 * kk][3], tim[2 * kk + 1][0], tim[2 * kk + 1][1], tim[2 * kk + 1][2], tim[2 * kk + 1][3]};
            bre[kk] = pack8(v0); bim[kk] = pack8(v1); }
#pragma unroll
        for (int m = 0; m < 2; ++m) { f32x4 y = {0.f, 0.f, 0.f, 0.f};
#pragma unroll
            for (int kk = 0; kk < 2; ++kk) { y = MFMA16(C2[m][kk], bre[kk], y); y = MFMA16(S2[m][kk], bim[kk], y); }
#pragma unroll
            for (int i = 0; i < 4; ++i) { const int k2 = 16 * (2 * kh + m) + 4 * g + i; Ys[k2 * 72 + 16 * kt + r] = (unsigned short)f2bf(y[i] * scale); } }
        __syncthreads();
        { const int row = tid >> 3, ch = tid & 7;
            *(v4u*)(Y + (size_t)(b * SEQ + k1 + 128 * row) * D + 512 + 64 * g4 + 8 * ch) = *(const LAS v4u*)(Ys + row * 72 + 8 * ch);
            if (k1 != 0 && k1 != 64) {
                const LAS unsigned short* sr = Ys + (63 - row) * 72; unsigned short e[8];
#pragma unroll
                for (int j = 0; j < 8; ++j) e[j] = sr[(64 - (8 * ch + j)) & 63];
                v4u w; w.x = (unsigned)e[0] | ((unsigned)e[1] << 16); w.y = (unsigned)e[2] | ((unsigned)e[3] << 16); w.z = (unsigned)e[4] | ((unsigned)e[5] << 16); w.w = (unsigned)e[6] | ((unsigned)e[7] << 16);
                *(v4u*)(Y + (size_t)(b * SEQ + (128 - k1) + 128 * row) * D + 512 + 64 * g4 + 8 * ch) = w; } }
    }
}

__device__ __forceinline__ void mix_a_phase(const float* const* in, unsigned char* ws, int L, bool do_ctx, LAS unsigned char* lds, int wg, int G, int tid) {
    const bf16* P = (const bf16*)(ws + WS_P); bf16* Y = (bf16*)(ws + WS_Y);
#ifndef SUBDUP
#define SUBDUP 0
#endif
    _Pragma("unroll") for (int rep_ = 0; rep_ < ((SUBDUP & 1) ? 2 : 1); ++rep_) mlstm_m1_phase(P, (const float*)(ws + WS_GW), in[9] + L * 16, ws, lds, 16 * NCHK, wg, G, tid);
    _Pragma("unroll") for (int rep_ = 0; rep_ < ((SUBDUP & 2) ? 2 : 1); ++rep_) fourier_a_phase(P, (bf16*)(ws + WS_FA), lds, wg, G, tid);
    if (do_ctx) {
        __syncthreads();
        { LAS f32x2* tab = (LAS f32x2*)lds; for (int i = tid; i < 8192; i += NTHR) { float s, c; sincospif((float)i * (1.0f / 4096.0f), &s, &c); tab[i] = (f32x2){c, s}; } }
        __syncthreads();
        for (int t = wg; t < 16 * 4 * 4; t += G) fourier_ctx_task(P, Y, lds, t, tid);
    }
    _Pragma("unroll") for (int rep_ = 0; rep_ < ((SUBDUP & 4) ? 2 : 1); ++rep_) conv_phase(P, Y, in[11] + L * 31 * 256, in[12] + L * 256, in[13] + L * 256, in[14] + L * 256, lds, do_ctx ? 4 * 128 + 4 * 4 : 4 * 128, false, wg, G, tid);
}

constexpr int NPH = 21;
constexpr int GU_SPLIT = 9000;
#ifndef MK_SINGLE
#define MK_SINGLE 1
#endif
struct Params { const float* in[23]; float* out; unsigned char* ws; int ph_lo, ph_hi; };
static_assert(sizeof(Params) == 23 * 8 + 8 + 8 + 8, "Params has no padding");

__global__ void __launch_bounds__(NTHR, 2) fwd_kernel(Params p) {
    extern __shared__ __attribute__((aligned(16))) unsigned char lds_raw[];
    LAS unsigned char* lds = (LAS unsigned char*)lds_raw;
    const int wg = blockIdx.x, G = gridDim.x;
    const int wave_s = __builtin_amdgcn_readfirstlane((int)(threadIdx.x >> 6));
#define FRESH_TID() ([&]() { int w_ = wave_s; asm volatile("" : "+s"(w_)); __builtin_assume(w_ >= 0 && w_ < 8); const int l_ = (int)__builtin_amdgcn_mbcnt_hi(~0u, __builtin_amdgcn_mbcnt_lo(~0u, 0u)); __builtin_assume(l_ >= 0 && l_ < 64); return w_ * 64 + l_; }())
    unsigned char* ws = p.ws;
    const float* const* in = p.in;
    for (int u = (int)threadIdx.x; u < (LDS_BYTES - LDSCTL_OFF) / 4; u += NTHR) ((LAS unsigned*)(lds + LDSCTL_OFF))[u] = 0u;
    __syncthreads();
    if (threadIdx.x == 0) { const unsigned xq = xb_xcc_id() & 7u; ((volatile LAS unsigned*)(lds + LDSCTL_OFF + 128))[0] = xq; ((volatile LAS unsigned*)(lds + LDSCTL_OFF + 128))[1] = xb_add((unsigned*)(ws + WS_CTL) + 64 * xq, 1u); }
    __syncthreads();
    XcdBarrier bar; bar.bar = (unsigned*)(ws + WS_CTL) + CW_BAR; bar.x = 0; bar.st = (volatile LAS unsigned*)(lds + LDSCTL_OFF + 64);
    if (MK_SINGLE) bar = xcd_barrier_post((unsigned*)(ws + WS_CTL) + CW_BAR, (volatile LAS unsigned*)(lds + LDSCTL_OFF + 64));
    const int lo = p.ph_lo, hi = p.ph_hi;
#ifndef PH_MASK
#define PH_MASK 0xFFFFFFFFu
#endif
#define IN(k) (((PH_MASK >> (k)) & 1u) && lo <= (k) && (k) < hi)
#ifndef DUP_MASK
#define DUP_MASK 0u
#endif
#define REP(k) _Pragma("unroll") for (int rep_ = 0; rep_ < ((((DUP_MASK) >> (k)) & 1u) ? 2 : 1); ++rep_)
#define ORDER_ID() ([&]() { const unsigned* cw_ = (const unsigned*)(ws + WS_CTL); bool ok_ = (G % 8) == 0; _Pragma("unroll") for (int j_ = 0; j_ < 8; ++j_) ok_ = ok_ && (xb_ld((unsigned*)cw_ + 64 * j_) == (unsigned)(G / 8)); \
        const unsigned xq_ = ((volatile LAS unsigned*)(lds + LDSCTL_OFF + 128))[0], rk_ = ((volatile LAS unsigned*)(lds + LDSCTL_OFF + 128))[1]; return __builtin_amdgcn_readfirstlane(ok_ ? (int)(xq_ + 8u * rk_) : wg); }())
#define SEAM(k) do { if (MK_SINGLE && IN((k) + 1)) xcd_barrier(bar, FRESH_TID()); } while (0)
#ifndef DEPHASE_Q
#define DEPHASE_Q 0
#endif
#define DEPHASE(K_) do { if (DEPHASE_Q) { const unsigned long long t0_ = __builtin_amdgcn_s_memrealtime(); const unsigned long long d_ = (unsigned long long)((wg >> 3) & 3) * (unsigned long long)(DEPHASE_Q * (K_) / 1024); while (__builtin_amdgcn_s_memrealtime() - t0_ < d_) __builtin_amdgcn_s_sleep(8); } } while (0)
#define MOD ((const float*)(ws + WS_MOD))
#define A ((bf16*)(ws + WS_A))
#define Pb ((bf16*)(ws + WS_P))
#define Yb ((bf16*)(ws + WS_Y))
#define Hb ((bf16*)(ws + WS_H))
#define Gt ((float*)(ws + WS_G))
#define XC ((float*)(ws + WS_XC))
#define XB ((bf16*)(ws + WS_XB))
#define XCB ((bf16*)(ws + WS_XCB))
#define HF ((float*)(ws + WS_HF))
#define HB ((float*)(ws + WS_HB))
#define rw ((int*)(ws + WS_ROUTE))
#define tok_e ((int*)(ws + WS_TOK))
#define tok_w ((float*)(ws + WS_TOK + 256 * 1024))
#define pair_pos ((int*)(ws + WS_TOK + 512 * 1024))
#define row_w ((float*)(ws + WS_TOK + 768 * 1024))
#define MOD1 (MOD + 5 * 6144)

    if (IN(0)) { const int tid = FRESH_TID(); REP(0) { if (rep_) __syncthreads(); prologue_phase(in, ws, lds, wg, G, tid); } SEAM(0); }
#if defined(BARDUP) && BARDUP
    if (MK_SINGLE && IN(1)) { _Pragma("unroll 1") for (int q_ = 0; q_ < BARDUP; ++q_) xcd_barrier(bar, FRESH_TID()); }
#endif
    if (IN(1)) { const int tid = FRESH_TID(); REP(1) { if (rep_) __syncthreads(); norm_phase<false>(in[0], in[2], true, in[4], MOD, 0, A, nullptr, nullptr, nullptr, nullptr, nullptr, lds, wg, G, tid); } SEAM(1); }
    if (IN(2)) { const int tid = FRESH_TID(); REP(2) { if (rep_) __syncthreads(); DEPHASE(D); pg8::Gemm g{A, (const bf16*)(ws + WS_WIN), MROWS, 2816, D}; pg8::StaticOrder S; S.init(MROWS, 2816, G, ORDER_ID()); pg8::EpiP E{Pb, Gt};
        pg8::gemm_phase<pg8::EpiP, pg8::StaticOrder, true, true>(lds, g, S, E, tid);
        { const int nu = (MROWS / 256) * 11, busy = nu % G; if (busy == 0) gate_proj_tasks(A, (const bf16*)(ws + WS_WIN), in[9], ws, lds, ORDER_ID(), G, tid); else if (ORDER_ID() >= busy) gate_proj_tasks(A, (const bf16*)(ws + WS_WIN), in[9], ws, lds, ORDER_ID() - busy, G - busy, tid); }
        } SEAM(2); }
    if (IN(3)) { const int tid = FRESH_TID(); REP(3) { if (rep_) __syncthreads(); mix_a_phase(in, ws, 0, true, lds, wg, G, tid); } SEAM(3); }
    if (IN(4)) { const int tid = FRESH_TID(); REP(4) { if (rep_) __syncthreads(); mlstm_m2_phase(ws, wg, G, tid); REP(21) { if (rep_) __syncthreads(); fourier_b_phase((const bf16*)(ws + WS_FA), Yb, lds, wg, G, tid); } } SEAM(4); }
    if (IN(5)) { const int tid = FRESH_TID(); REP(5) { if (rep_) __syncthreads(); mlstm_m3_phase(Pb, Gt, in[9], in[10], ws, Yb, lds, NCHK, wg, G, tid); } SEAM(5); }
    if (IN(6)) { const int tid = FRESH_TID(); REP(6) { if (rep_) __syncthreads(); DEPHASE(D); pg8::Gemm g{Yb, (const bf16*)(ws + WS_WOUT), MROWS, D, D}; pg8::StaticOrder S; S.init(MROWS, D, G, ORDER_ID()); pg8::EpiResB<true> E{in[0], XB, in[2], XCB, MOD + 2 * D, 1.0f};
        pg8::gemm_phase<pg8::EpiResB<true>, pg8::StaticOrder, true, true>(lds, g, S, E, tid);
        if (G == 256) { if (ORDER_ID() >= 16) moe_convert_items(in, ws, lds, 0, ORDER_ID() - 16, G - 16, tid); } else moe_convert_items(in, ws, lds, 0, wg, G, tid); } SEAM(6); }
    if (IN(7)) { const int tid = FRESH_TID(); REP(7) { if (rep_) __syncthreads(); norm_phase<false, false, true>(XB, XCB, true, in[5], MOD, 3, A, nullptr, nullptr, nullptr, nullptr, nullptr, lds, wg, G, tid); } SEAM(7); }
    if (IN(8)) { const int tid = FRESH_TID(); REP(8) { if (rep_) __syncthreads(); DEPHASE(D); pg8::Gemm g{A, (const bf16*)(ws + WS_WGU), MROWS, 2 * FFH, D}; pg8::StaticOrder S; S.init(MROWS, 2 * FFH, G, ORDER_ID()); pg8::EpiSwigluToF8 E{(unsigned char*)(ws + WS_H)};
        pg8::gemm_phase<pg8::EpiSwigluToF8, pg8::StaticOrder, true, true>(lds, g, S, E, tid);
        if (G == 256 && ORDER_ID() >= 88) moe_convert_items(in, ws, lds, 1, ORDER_ID() - 88, G - 88, tid, 0, GU_SPLIT); } SEAM(8); }
    if (IN(9)) { const int tid = FRESH_TID(); REP(9) { if (rep_) __syncthreads(); DEPHASE(FFH); pg8::Gemm g{Hb, (const bf16*)(ws + WS_WD), MROWS, D, FFH / 2}; pg8::StaticOrder S; S.init(MROWS, D, G, ORDER_ID()); pg8::EpiResB<false> E{XB, XB, XCB, XCB, MOD + 5 * D, 1.0f / (pg8::F8_SH * pg8::F8_SWD)};
        pg8::gemm_phase<pg8::EpiResB<false>, pg8::StaticOrder, true, true, true>(lds, g, S, E, tid);
        if (G == 256) { if (ORDER_ID() >= 16) moe_convert_items(in, ws, lds, 1, ORDER_ID() - 16, G - 16, tid, GU_SPLIT); } else moe_convert_items(in, ws, lds, 1, wg, G, tid); } SEAM(9); }
    if (IN(10)) { const int tid = FRESH_TID(); REP(10) { if (rep_) __syncthreads(); norm_phase<false, false, true>(XB, XCB, true, in[4] + D, MOD1, 0, A, nullptr, nullptr, nullptr, nullptr, nullptr, lds, wg, G, tid); } SEAM(10); }
    if (IN(11)) { const int tid = FRESH_TID(); REP(11) { if (rep_) __syncthreads(); DEPHASE(D); pg8::Gemm g{A, (const bf16*)(ws + WS_WIN) + (size_t)PLD * D, MROWS, 2816, D}; pg8::StaticOrder S; S.init(MROWS, 2816, G, ORDER_ID()); pg8::EpiP E{Pb, Gt};
        pg8::gemm_phase<pg8::EpiP, pg8::StaticOrder, true, true>(lds, g, S, E, tid);
        { const int nu = (MROWS / 256) * 11, busy = nu % G; if (busy == 0) gate_proj_tasks(A, (const bf16*)(ws + WS_WIN) + (size_t)PLD * D, in[9] + 16, ws, lds, ORDER_ID(), G, tid); else if (ORDER_ID() >= busy) gate_proj_tasks(A, (const bf16*)(ws + WS_WIN) + (size_t)PLD * D, in[9] + 16, ws, lds, ORDER_ID() - busy, G - busy, tid); } } SEAM(11); }
    if (IN(12)) { const int tid = FRESH_TID(); REP(12) { if (rep_) __syncthreads(); mix_a_phase(in, ws, 1, false, lds, wg, G, tid); } SEAM(12); }
    if (IN(13)) { const int tid = FRESH_TID(); REP(13) { if (rep_) __syncthreads(); mlstm_m2_phase(ws, wg, G, tid); REP(21) { if (rep_) __syncthreads(); fourier_b_phase((const bf16*)(ws + WS_FA), Yb, lds, wg, G, tid); } } SEAM(13); }
    if (IN(14)) { const int tid = FRESH_TID(); REP(14) { if (rep_) __syncthreads(); mlstm_m3_phase(Pb, Gt, in[9] + 16, in[10] + 512, ws, Yb, lds, 128, wg, G, tid); } SEAM(14); }
    if (IN(15)) { const int tid = FRESH_TID(); REP(15) { if (rep_) __syncthreads(); DEPHASE(D); pg8::Gemm g{Yb, (const bf16*)(ws + WS_WOUT) + (size_t)D * D, NLAT, D, D}; pg8::StaticOrder S; S.init(NLAT, D, G, ORDER_ID()); pg8::EpiResB<false> E{XB, XB, XCB, XCB, MOD1 + 2 * D, 1.0f};
        pg8::gemm_phase<pg8::EpiResB<false>, pg8::StaticOrder, true, true>(lds, g, S, E, tid); } SEAM(15); }
    if (IN(16)) { const int tid = FRESH_TID(); REP(16) { if (rep_) __syncthreads(); norm_phase<true, true, true>(XB, XCB, false, in[5] + D, MOD1, 3, A, in[18], in[19], tok_e, tok_w, rw + RW_HIST, lds, wg, G, tid); } SEAM(16); }
    if (IN(17)) { const int tid = FRESH_TID(); REP(17) { if (rep_) __syncthreads(); route_phase(ws, lds, wg, G, tid); } SEAM(17); }
    if (IN(18)) { const int tid = FRESH_TID(); REP(18) { if (rep_) __syncthreads(); const int nT = __builtin_amdgcn_readfirstlane(rw[RW_NTILES]); DEPHASE(D); pg8::Gemm g{(const bf16*)(ws + WS_A), (const bf16*)(ws + WS_MWGU), nT * 256, NEXP * 2 * FFH, D / 2, (const int*)(ws + WS_ROWTOK)};
        LAS int* te_l = (LAS int*)(lds + LDSCTL_OFF + 1024); for (int i = tid; i < 264; i += NTHR) te_l[i] = rw[RW_TILE_E + i]; __syncthreads();
        pg8::MoeOrder S; S.init_moe(nT, 22, te_l, G, ORDER_ID()); pg8::EpiSwigluF8 E{(unsigned char*)(ws + WS_HSORT)};
        pg8::gemm_phase<pg8::EpiSwigluF8, pg8::MoeOrder, true, true, true, true>(lds, g, S, E, tid); } SEAM(18); }
    if (IN(19)) { const int tid = FRESH_TID(); REP(19) { if (rep_) __syncthreads(); const int nT = __builtin_amdgcn_readfirstlane(rw[RW_NTILES]); DEPHASE(FFH); pg8::Gemm g{(const bf16*)(ws + WS_HSORT), (const bf16*)(ws + WS_MWD), nT * 256, NEXP * D, FFH / 2};
        LAS int* te_l = (LAS int*)(lds + LDSCTL_OFF + 1024); for (int i = tid; i < 264; i += NTHR) te_l[i] = rw[RW_TILE_E + i]; __syncthreads();
        pg8::MoeOrder S; S.init_moe(nT, 4, te_l, G, ORDER_ID()); pg8::EpiMoeDownF8 E{(bf16*)(ws + WS_OPAIR), row_w};
        pg8::gemm_phase<pg8::EpiMoeDownF8, pg8::MoeOrder, true, true, true>(lds, g, S, E, tid); } SEAM(19); }
    if (IN(20)) { const int tid = FRESH_TID(); final_phase(XB, p.out, (const bf16*)(ws + WS_OPAIR), pair_pos, MOD1, in[22], wg, G, tid); }
#undef IN
#undef MOD
#undef A
#undef Pb
#undef Yb
#undef Hb
#undef Gt
#undef XC
#undef XB
#undef XCB
#undef HF
#undef HB
#undef rw
#undef tok_e
#undef tok_w
#undef pair_pos
#undef row_w
#undef MOD1
#undef SEAM
}

extern "C" void kernel_launch(void* const* d_in, const int* in_sizes, int n_in, void* d_out, int out_size, void* d_ws, size_t ws_size, hipStream_t stream) {
    static int grid = 0;
    if (grid == 0) {
        if (n_in != 23 || in_sizes[0] != NLAT * D || out_size != NLAT * D || ws_size < WS_END) { fprintf(stderr, "kernel_launch: unexpected problem shape (n_in %d, out %d, ws %zu); nothing launched\n", n_in, out_size, ws_size); grid = -1; return; }
        int dev = 0, cus = 0;
        if (hipGetDevice(&dev) != hipSuccess || hipDeviceGetAttribute(&cus, hipDeviceAttributeMultiprocessorCount, dev) != hipSuccess) { grid = -1; return; }
        if (hipFuncSetAttribute((const void*)fwd_kernel, hipFuncAttributeMaxDynamicSharedMemorySize, LDS_BYTES) != hipSuccess) { fprintf(stderr, "kernel_launch: hipFuncSetAttribute failed\n"); grid = -1; return; }
        int per_cu = 0;
        if (hipOccupancyMaxActiveBlocksPerMultiprocessor(&per_cu, (const void*)fwd_kernel, NTHR, LDS_BYTES) != hipSuccess || per_cu < 1) { fprintf(stderr, "kernel_launch: occupancy query says %d blocks per CU\n", per_cu); }
        (void)hipGetLastError();
        grid = cus;
    }
    if (grid < 0) return;
    if (hipMemsetAsync((char*)d_ws + WS_CTL, 0, CTL_ZERO_BYTES, stream) != hipSuccess) return;
    Params p{};
    for (int i = 0; i < 23; ++i) p.in[i] = (const float*)d_in[i];
    p.out = (float*)d_out; p.ws = (unsigned char*)d_ws;
#if MK_SINGLE
    p.ph_lo = 0; p.ph_hi = NPH;
    hipLaunchKernelGGL(fwd_kernel, dim3(grid), dim3(NTHR), LDS_BYTES, stream, p);
#else
    for (int k = 0; k < NPH; ++k) { p.ph_lo = k; p.ph_hi = k + 1; hipLaunchKernelGGL(fwd_kernel, dim3(grid), dim3(NTHR), LDS_BYTES, stream, p); }
#endif
}
```

```cpp
#include <hip/hip_runtime.h>
#include <cstdio>
#include <cstdint>
namespace pg8 {
#define PG8_LAS __attribute__((address_space(3)))
typedef unsigned short bf16_t;
typedef short bf16x8 __attribute__((ext_vector_type(8)));
typedef float f32x4 __attribute__((ext_vector_type(4)));
typedef unsigned u32x4 __attribute__((ext_vector_type(4)));
constexpr int BM = 256, BK = 64, HALF = 128, HTB = HALF * BK * 2  , STAGE_BYTES = 8 * HTB, NXCD = 8, WGM = 8;

__host__ __device__ __forceinline__ int lds_byte(int r, int c) { const int st = (r >> 4) * 2 + (c >> 5), rr = r & 15, cc = c & 31, ob = rr * 64 + cc * 2; return st * 1024 + (ob ^ (((ob >> 9) & 1) << 5)); }
__host__ __device__ __forceinline__ void stage_rc(int b, int& R, int& C) { const int st = b / 1024, sb = b % 1024, swz = sb ^ (((sb >> 9) & 1) << 5); R = (st >> 1) * 16 + swz / 64; C = (st & 1) * 32 + (swz % 64) / 2; }
__host__ __device__ __forceinline__ int perm32(int rho) { const int n = rho >> 4, i = rho & 15; return 8 * (i >> 2) + 4 * n + (i & 3); }

struct Unit { int pm, pn; };
struct Gemm { const bf16_t* A; const bf16_t* Bt; int M, N, K; const int* rt = nullptr; };

struct StaticOrder {
    int nM, nN, nwg, G, c;
    __host__ __device__ void init(int M, int N, int G_, int c_) { nM = M / BM; nN = N / BM; nwg = nM * nN; G = G_; c = c_; }
    __host__ __device__ bool next(int i, Unit& u) const {
        const int L = i * G + c; if (L >= nwg) return false;
        int wgid = L; { const int q = nwg / NXCD, r = nwg % NXCD, xcd = wgid % NXCD, off = wgid / NXCD; wgid = (xcd < r ? xcd * (q + 1) : r * (q + 1) + (xcd - r) * q) + off; }
        const int nig = WGM * nN, gid = wgid / nig, fm = gid * WGM, gsz = (nM - fm) < WGM ? (nM - fm) : WGM;
        u.pm = fm + ((wgid % nig) % gsz); u.pn = (wgid % nig) / gsz; return true;
    }
    __device__ __forceinline__ void a_ready(const Unit&) const {}
    __device__ __forceinline__ void done(const Unit&) const {}
};

typedef float f32x2c __attribute__((ext_vector_type(2))); typedef __bf16 bf16x2c __attribute__((ext_vector_type(2)));
__device__ __forceinline__ unsigned cvt_pk_bf16(float lo, float hi) { const f32x2c v = {lo, hi}; const bf16x2c b = __builtin_convertvector(v, bf16x2c); return __builtin_bit_cast(unsigned, b); }
typedef int i32x8 __attribute__((ext_vector_type(8)));
typedef int i32x4 __attribute__((ext_vector_type(4)));
__device__ __forceinline__ i32x8 cat8(bf16x8 lo, bf16x8 hi) { const i32x4 a = __builtin_bit_cast(i32x4, lo), c = __builtin_bit_cast(i32x4, hi); return __builtin_shufflevector(a, c, 0, 1, 2, 3, 4, 5, 6, 7); }
__device__ __forceinline__ unsigned pk4_fp8(float a, float c, float d, float e) {
    a = __builtin_amdgcn_fmed3f(a, -448.f, 448.f); c = __builtin_amdgcn_fmed3f(c, -448.f, 448.f); d = __builtin_amdgcn_fmed3f(d, -448.f, 448.f); e = __builtin_amdgcn_fmed3f(e, -448.f, 448.f);
    int w = __builtin_amdgcn_cvt_pk_fp8_f32(a, c, 0, false); w = __builtin_amdgcn_cvt_pk_fp8_f32(d, e, w, true); return (unsigned)w; }
__device__ __forceinline__ float silu_f(float x) { return x * __builtin_amdgcn_rcpf(1.0f + __expf(-x)); }
struct EpiP {
    static constexpr bool PERM = true, AFTER_DRAIN = false;
    bf16_t* P; float* G;
    __device__ __forceinline__ void operator()(const f32x4 (&acc)[2][2][4][2], const Unit& u, int wr, int wc, int fr, int fq) const {
        const int row0 = u.pm * BM + wr * 64 + fr, col0 = u.pn * BM + wc * 32 + 8 * fq;
#pragma unroll
        for (int ai = 0; ai < 2; ++ai)
#pragma unroll
            for (int m = 0; m < 4; ++m) { bf16_t* rowp = P + (size_t)(row0 + ai * HALF + m * 16) * 3072 + col0;
#pragma unroll
                for (int bj = 0; bj < 2; ++bj) { const f32x4 v0 = acc[ai][bj][m][0], v1 = acc[ai][bj][m][1];
                    u32x4 w; w.x = cvt_pk_bf16(v0[0], v0[1]); w.y = cvt_pk_bf16(v0[2], v0[3]); w.z = cvt_pk_bf16(v1[0], v1[1]); w.w = cvt_pk_bf16(v1[2], v1[3]);
                    *(u32x4*)(rowp + bj * HALF) = w; } }
    }
};
struct EpiRes {
    static constexpr bool PERM = false, AFTER_DRAIN = false;
    const float* base_lat; float* out_lat; const float* base_ctx; float* out_ctx; const float* gate; float scale;
    __device__ __forceinline__ void operator()(const f32x4 (&acc)[2][2][4][2], const Unit& u, int wr, int wc, int fr, int fq) const {
        const bool lat = u.pm < 128;
        const float* base = lat ? base_lat + (size_t)u.pm * BM * 1024 : base_ctx + (size_t)(u.pm - 128) * BM * 1024;
        float* out = lat ? out_lat + (size_t)u.pm * BM * 1024 : out_ctx + (size_t)(u.pm - 128) * BM * 1024;
        const float* gv = gate + (size_t)(lat ? (u.pm >> 5) : 4) * 6144;
        const int row0 = wr * 64 + fr, col0 = u.pn * BM + wc * 32 + 4 * fq;
        f32x4 g4[2][2];
#pragma unroll
        for (int bj = 0; bj < 2; ++bj)
#pragma unroll
            for (int n = 0; n < 2; ++n) g4[bj][n] = *(const f32x4*)(gv + col0 + bj * HALF + n * 16) * scale;
#pragma unroll
        for (int ai = 0; ai < 2; ++ai)
#pragma unroll
            for (int m = 0; m < 4; ++m) { const size_t off = (size_t)(row0 + ai * HALF + m * 16) * 1024 + col0;
#pragma unroll
                for (int bj = 0; bj < 2; ++bj)
#pragma unroll
                    for (int n = 0; n < 2; ++n) { const f32x4 bv = *(const f32x4*)(base + off + bj * HALF + n * 16);
                        *(f32x4*)(out + off + bj * HALF + n * 16) = bv + g4[bj][n] * acc[ai][bj][m][n]; }
                asm volatile("" ::: "memory"); }
    }
};
struct MoeOrder : StaticOrder {
    const PG8_LAS int* tile_e; int nNe;
    __device__ void init_moe(int nTiles, int nNe_, const PG8_LAS int* te, int G_, int c_) { nM = nTiles; nN = nNe_; nwg = nM * nN; G = G_; c = c_; tile_e = te; nNe = nNe_; }
    __device__ bool next(int i, Unit& u) const { if (!StaticOrder::next(i, u)) return false; u.pn += __builtin_amdgcn_readfirstlane(tile_e[u.pm]) * nNe; return true; }
};
constexpr float F8_SWGU = 32.f, F8_SH = 8.f, F8_SWD = 64.f;
struct EpiSwigluF8 {
    static constexpr bool PERM = true, AFTER_DRAIN = false;
    unsigned char* H;
    __device__ __forceinline__ void operator()(const f32x4 (&acc)[2][2][4][2], const Unit& u, int wr, int wc, int fr, int fq) const {
        asm volatile("" : "+v"(fr), "+v"(fq));
        const int row0 = u.pm * BM + wr * 64 + fr, col0 = (u.pn % 22) * HALF + wc * 32 + 8 * fq; constexpr float inv = 1.0f / F8_SWGU;
#pragma unroll
        for (int ai = 0; ai < 2; ++ai)
#pragma unroll
            for (int m = 0; m < 4; ++m) { unsigned char* rowp = H + (size_t)(row0 + ai * HALF + m * 16) * 2816 + col0;
                float h[8];
#pragma unroll
                for (int n = 0; n < 2; ++n) { const f32x4 G4 = acc[ai][0][m][n], U4 = acc[ai][1][m][n]; constexpr float c1 = -1.4426950408889634f * inv, kk = 1.0f / (inv * inv * F8_SH);
                    const f32x4 t = G4 * c1; const f32x4 e = {__builtin_amdgcn_exp2f(t[0]), __builtin_amdgcn_exp2f(t[1]), __builtin_amdgcn_exp2f(t[2]), __builtin_amdgcn_exp2f(t[3])};
                    const f32x4 d = e * kk + kk; const f32x4 rr = {__builtin_amdgcn_rcpf(d[0]), __builtin_amdgcn_rcpf(d[1]), __builtin_amdgcn_rcpf(d[2]), __builtin_amdgcn_rcpf(d[3])};
                    const f32x4 hv = (G4 * U4) * rr; h[4 * n] = hv[0]; h[4 * n + 1] = hv[1]; h[4 * n + 2] = hv[2]; h[4 * n + 3] = hv[3]; }
                typedef unsigned u32x2v __attribute__((ext_vector_type(2))); u32x2v w; w.x = pk4_fp8(h[0], h[1], h[2], h[3]); w.y = pk4_fp8(h[4], h[5], h[6], h[7]);
                *(u32x2v*)rowp = w; }
    }
};
struct EpiMoeDownF8 {
    static constexpr bool PERM = true, AFTER_DRAIN = false;
    bf16_t* O; const float* roww;
    __device__ __forceinline__ void operator()(const f32x4 (&acc)[2][2][4][2], const Unit& u, int wr, int wc, int fr, int fq) const {
        asm volatile("" : "+v"(fr), "+v"(fq));
        const int row0 = u.pm * BM + wr * 64 + fr, col0 = (u.pn & 3) * BM + wc * 32 + 8 * fq;
#pragma unroll
        for (int ai = 0; ai < 2; ++ai)
#pragma unroll
            for (int m = 0; m < 4; ++m) { const int r = row0 + ai * HALF + m * 16; const float s = roww[r] * (1.0f / (F8_SH * F8_SWD)); bf16_t* rowp = O + (size_t)r * 1024 + col0;
#pragma unroll
                for (int bj = 0; bj < 2; ++bj) { const f32x4 v0 = acc[ai][bj][m][0] * s, v1 = acc[ai][bj][m][1] * s;
                    u32x4 w; w.x = cvt_pk_bf16(v0[0], v0[1]); w.y = cvt_pk_bf16(v0[2], v0[3]); w.z = cvt_pk_bf16(v1[0], v1[1]); w.w = cvt_pk_bf16(v1[2], v1[3]);
                    *(u32x4*)(rowp + bj * HALF) = w; }
                asm volatile("" ::: "memory"); }
    }
};
struct EpiSwigluToF8 {
    static constexpr bool PERM = true, AFTER_DRAIN = false;
    unsigned char* H;
    __device__ __forceinline__ void operator()(const f32x4 (&acc)[2][2][4][2], const Unit& u, int wr, int wc, int fr, int fq) const {
        asm volatile("" : "+v"(fr), "+v"(fq));
        const int row0 = u.pm * BM + wr * 64 + fr, col0 = (u.pn % 22) * HALF + wc * 32 + 8 * fq;
#pragma unroll
        for (int ai = 0; ai < 2; ++ai)
#pragma unroll
            for (int m = 0; m < 4; ++m) { unsigned char* rowp = H + (size_t)(row0 + ai * HALF + m * 16) * 2816 + col0;
                float h[8];
#pragma unroll
                for (int n = 0; n < 2; ++n) { const f32x4 G4 = acc[ai][0][m][n], U4 = acc[ai][1][m][n]; constexpr float c1 = -1.4426950408889634f, kk = 1.0f / F8_SH;
                    const f32x4 t = G4 * c1; const f32x4 e = {__builtin_amdgcn_exp2f(t[0]), __builtin_amdgcn_exp2f(t[1]), __builtin_amdgcn_exp2f(t[2]), __builtin_amdgcn_exp2f(t[3])};
                    const f32x4 d = e * kk + kk; const f32x4 rr = {__builtin_amdgcn_rcpf(d[0]), __builtin_amdgcn_rcpf(d[1]), __builtin_amdgcn_rcpf(d[2]), __builtin_amdgcn_rcpf(d[3])};
                    const f32x4 hv = (G4 * U4) * rr; h[4 * n] = hv[0]; h[4 * n + 1] = hv[1]; h[4 * n + 2] = hv[2]; h[4 * n + 3] = hv[3]; }
                typedef unsigned u32x2v __attribute__((ext_vector_type(2))); u32x2v w; w.x = pk4_fp8(h[0], h[1], h[2], h[3]); w.y = pk4_fp8(h[4], h[5], h[6], h[7]);
                *(u32x2v*)rowp = w; }
    }
};
struct EpiResLean {
    static constexpr bool PERM = false, AFTER_DRAIN = false;
    const float* base_lat; float* out_lat; const float* base_ctx; float* out_ctx; const float* gate; float scale;
    __device__ __forceinline__ void operator()(const f32x4 (&acc)[2][2][4][2], const Unit& u, int wr, int wc, int fr, int fq) const {
        asm volatile("" : "+v"(fr), "+v"(fq));
        const bool lat = u.pm < 128;
        const float* base = lat ? base_lat + (size_t)u.pm * BM * 1024 : base_ctx + (size_t)(u.pm - 128) * BM * 1024;
        float* out = lat ? out_lat + (size_t)u.pm * BM * 1024 : out_ctx + (size_t)(u.pm - 128) * BM * 1024;
        const float* gv = gate + (size_t)(lat ? (u.pm >> 5) : 4) * 6144;
        const int row0 = wr * 64 + fr, col0 = u.pn * BM + wc * 32 + 4 * fq;
#pragma unroll
        for (int bj = 0; bj < 2; ++bj)
#pragma unroll
            for (int n = 0; n < 2; ++n) { const f32x4 g4 = *(const f32x4*)(gv + col0 + bj * HALF + n * 16) * scale;
#pragma unroll
                for (int ai = 0; ai < 2; ++ai)
#pragma unroll
                    for (int m = 0; m < 4; ++m) { const size_t off = (size_t)(row0 + ai * HALF + m * 16) * 1024 + col0 + bj * HALF + n * 16;
                        const f32x4 bv = *(const f32x4*)(base + off); *(f32x4*)(out + off) = bv + g4 * acc[ai][bj][m][n]; }
                asm volatile("" ::: "memory"); }
    }
};
template <bool BASE_F32> struct EpiResB {
    static constexpr bool PERM = true, AFTER_DRAIN = false;
    const void* base_lat; bf16_t* out_lat; const void* base_ctx; bf16_t* out_ctx; const float* gate; float scale;
    __device__ __forceinline__ void operator()(const f32x4 (&acc)[2][2][4][2], const Unit& u, int wr, int wc, int fr, int fq) const {
        asm volatile("" : "+v"(fr), "+v"(fq));
        const bool lat = u.pm < 128; const size_t ro = (size_t)(lat ? u.pm : u.pm - 128) * BM * 1024;
        const void* base = lat ? base_lat : base_ctx; bf16_t* out = lat ? out_lat : out_ctx;
        const float* gv = gate + (size_t)(lat ? (u.pm >> 5) : 4) * 6144;
        const int row0 = wr * 64 + fr, col0 = u.pn * BM + wc * 32 + 8 * fq;
#pragma unroll
        for (int bj = 0; bj < 2; ++bj) { const f32x4 g0 = *(const f32x4*)(gv + col0 + bj * HALF) * scale, g1 = *(const f32x4*)(gv + col0 + bj * HALF + 4) * scale;
#pragma unroll
            for (int ai = 0; ai < 2; ++ai)
#pragma unroll
                for (int m = 0; m < 4; ++m) { const size_t off = ro + (size_t)(row0 + ai * HALF + m * 16) * 1024 + col0 + bj * HALF; f32x4 b0, b1;
                    if constexpr (BASE_F32) { b0 = *(const f32x4*)((const float*)base + off); b1 = *(const f32x4*)((const float*)base + off + 4); }
                    else { const u32x4 w = *(const u32x4*)((const bf16_t*)base + off);
                        b0 = (f32x4){__builtin_bit_cast(float, w.x << 16), __builtin_bit_cast(float, w.x & 0xffff0000u), __builtin_bit_cast(float, w.y << 16), __builtin_bit_cast(float, w.y & 0xffff0000u)};
                        b1 = (f32x4){__builtin_bit_cast(float, w.z << 16), __builtin_bit_cast(float, w.z & 0xffff0000u), __builtin_bit_cast(float, w.w << 16), __builtin_bit_cast(float, w.w & 0xffff0000u)}; }
                    const f32x4 v0 = b0 + g0 * acc[ai][bj][m][0], v1 = b1 + g1 * acc[ai][bj][m][1];
                    u32x4 o; o.x = cvt_pk_bf16(v0[0], v0[1]); o.y = cvt_pk_bf16(v0[2], v0[3]); o.z = cvt_pk_bf16(v1[0], v1[1]); o.w = cvt_pk_bf16(v1[2], v1[3]);
                    *(u32x4*)(out + off) = o; }
            asm volatile("" ::: "memory"); }
    }
};
#ifndef F8_SCALE
#define F8_SCALE 0
#endif
template <class Epi, class Sched, bool ALIGN_EPI = false, bool SP2 = false, bool F8 = false, bool GA = false>
__device__ __forceinline__ void gemm_phase(PG8_LAS unsigned char* lds, const Gemm g, const Sched& S, const Epi& E, const int tid) {
    const int wid = __builtin_amdgcn_readfirstlane(tid >> 6), lane = tid & 63, wr = wid >> 2, wc = wid & 3, fr = lane & 15, fq = lane >> 4;
    const int K = g.K, nt = K / BK;
    unsigned voffA[2], voffB[2];
#pragma unroll
    for (int i = 0; i < 2; ++i) { int R, C; stage_rc(tid * 16 + i * 8192, R, C); const int Rb = Epi::PERM ? ((R & ~31) + perm32(R & 31)) : R;
        voffA[i] = (unsigned)(R * K + C) * 2u; voffB[i] = (unsigned)(Rb * K + C) * 2u; }
    const unsigned kstep = (unsigned)(BK * 2);
    const unsigned hstep = (unsigned)HALF * (unsigned)K * 2u;
    const unsigned tstep = 2u * hstep;
    const unsigned ldsw = (unsigned)wid * 1024u;
    const __amdgpu_buffer_rsrc_t rsA = __builtin_amdgcn_make_buffer_rsrc((void*)g.A, 0, 0x7fffffff, 0x00020000), rsB = __builtin_amdgcn_make_buffer_rsrc((void*)g.Bt, 0, 0x7fffffff, 0x00020000);
    static_assert(!GA || SP2, "gathered A: SP2 body only");
    constexpr int GA_TAB = STAGE_BYTES + 4096;
    const __amdgpu_buffer_rsrc_t rsT = __builtin_amdgcn_make_buffer_rsrc((void*)g.rt, 0, 0x7fffffff, 0x00020000);
    unsigned vG[2][2]; int gaR = 0; unsigned gaC = 0;
    if constexpr (GA) { int R, C; stage_rc(tid * 16, R, C); gaR = R; gaC = (unsigned)C * 2u; }
#define PG8_GA_FETCH(pm_) do { const unsigned so_ = (unsigned)__builtin_amdgcn_readfirstlane((int)((unsigned)(pm_) * 1024u)); \
        __builtin_amdgcn_raw_ptr_buffer_load_lds(rsT, (PG8_LAS unsigned*)(lds + GA_TAB + wid * 256), 4, (unsigned)(((wid & 3) * 64 + lane) * 4), so_, 0, 0); } while (0)
#define PG8_GA_TAKE() do { const PG8_LAS int* tb_ = (const PG8_LAS int*)(lds + GA_TAB); _Pragma("unroll") for (int h_ = 0; h_ < 2; ++h_) _Pragma("unroll") for (int i_ = 0; i_ < 2; ++i_) \
        vG[h_][i_] = (unsigned)tb_[h_ * 128 + i_ * 64 + gaR] * (unsigned)(K * 2) + gaC; } while (0)
    const int aoff = lds_byte(wr * 64 + fr, fq * 8), boff = lds_byte(wc * 32 + fr, fq * 8);
#define PG8_SA(b, h) (((b) * 2 + (h)) * HTB)
#define PG8_SB(b, h) ((4 + (b) * 2 + (h)) * HTB)
#define PG8_STAGE(rs, bufoff, soff, voff) do { const unsigned so_ = (unsigned)__builtin_amdgcn_readfirstlane((int)(soff)); _Pragma("unroll") for (int _i = 0; _i < 2; ++_i) \
        __builtin_amdgcn_raw_ptr_buffer_load_lds(rs, (PG8_LAS unsigned*)(lds + (bufoff) + ldsw + _i * 8192), 16, (voff)[_i], so_, 0, 0); } while (0)
#define PG8_STA(bufoff, soff, h_) do { if constexpr (GA) { const unsigned so_ = (unsigned)__builtin_amdgcn_readfirstlane((int)(soff)); _Pragma("unroll") for (int _i = 0; _i < 2; ++_i) \
        __builtin_amdgcn_raw_ptr_buffer_load_lds(rsA, (PG8_LAS unsigned*)(lds + (bufoff) + ldsw + _i * 8192), 16, vG[h_][_i], so_, 0, 0); } else PG8_STAGE(rsA, bufoff, (soff) + (h_) * hstep, voffA); } while (0)
#define PG8_WAIT_V8(first_) do { if (GA && (first_)) PG8_WAIT_V(9); else PG8_WAIT_V(8); } while (0)
#define PG8_LDA(dst, b, h) do { if constexpr (F8) { _Pragma("unroll") for (int m = 0; m < 4; ++m) dst##8[m] = cat8(*(const PG8_LAS bf16x8*)(lds + PG8_SA(b, h) + aoff + m * 2048), *(const PG8_LAS bf16x8*)(lds + PG8_SA(b, h) + aoff + m * 2048 + 1024)); } \
        else { _Pragma("unroll") for (int m = 0; m < 4; ++m) _Pragma("unroll") for (int k = 0; k < 2; ++k) dst[m][k] = *(const PG8_LAS bf16x8*)(lds + PG8_SA(b, h) + aoff + m * 2048 + k * 1024); } } while (0)
#define PG8_LDB(dst, b, h) do { if constexpr (F8) { _Pragma("unroll") for (int n = 0; n < 2; ++n) dst##8[n] = cat8(*(const PG8_LAS bf16x8*)(lds + PG8_SB(b, h) + boff + n * 2048), *(const PG8_LAS bf16x8*)(lds + PG8_SB(b, h) + boff + n * 2048 + 1024)); } \
        else { _Pragma("unroll") for (int n = 0; n < 2; ++n) _Pragma("unroll") for (int k = 0; k < 2; ++k) dst[n][k] = *(const PG8_LAS bf16x8*)(lds + PG8_SB(b, h) + boff + n * 2048 + k * 1024); } } while (0)
#define PG8_MMA(ai, bj, At, Bt) do { __builtin_amdgcn_s_setprio(1); if constexpr (F8) { _Pragma("unroll") for (int m = 0; m < 4; ++m) _Pragma("unroll") for (int n = 0; n < 2; ++n) \
        acc[ai][bj][m][n] = __builtin_amdgcn_mfma_scale_f32_16x16x128_f8f6f4(Bt##8[n], At##8[m], acc[ai][bj][m][n], 0, 0, 0, F8_SCALE, 0, F8_SCALE); } \
        else { _Pragma("unroll") for (int m = 0; m < 4; ++m) _Pragma("unroll") for (int n = 0; n < 2; ++n) _Pragma("unroll") for (int k = 0; k < 2; ++k) \
        acc[ai][bj][m][n] = __builtin_amdgcn_mfma_f32_16x16x32_bf16(Bt[n][k], At[m][k], acc[ai][bj][m][n], 0, 0, 0); } __builtin_amdgcn_s_setprio(0); } while (0)
#define PG8_WAIT_V(n) asm volatile("s_waitcnt vmcnt(" #n ")" ::: "memory")
#define PG8_WAIT_L(n) asm volatile("s_waitcnt lgkmcnt(" #n ")" ::: "memory")
#define PG8_BAR __builtin_amdgcn_s_barrier()
#define PG8_SCHED __builtin_amdgcn_sched_barrier(0)
    Unit cur, nxt; int ui = 0;
    if (!S.next(0, cur)) return;
    f32x4 acc[2][2][4][2];
#pragma unroll
    for (int a = 0; a < 2; ++a)
#pragma unroll
        for (int b = 0; b < 2; ++b)
#pragma unroll
            for (int m = 0; m < 4; ++m)
#pragma unroll
                for (int n = 0; n < 2; ++n) acc[a][b][m][n] = (f32x4){0.f, 0.f, 0.f, 0.f};
    bf16x8 At[4][2], B0[2][2], B1[2][2]; i32x8 At8[4], B08[2], B18[2];
    unsigned cA = GA ? 0u : (unsigned)cur.pm * tstep, cB = (unsigned)cur.pn * tstep;
    if constexpr (GA) { _Pragma("unroll") for (int h_ = 0; h_ < 2; ++h_) _Pragma("unroll") for (int i_ = 0; i_ < 2; ++i_) vG[h_][i_] = (unsigned)g.rt[cur.pm * 256 + h_ * 128 + i_ * 64 + gaR] * (unsigned)(K * 2) + gaC; }
    S.a_ready(cur);
    if constexpr (SP2) {
        PG8_STAGE(rsB, PG8_SB(0, 0), cB, voffB); PG8_STAGE(rsB, PG8_SB(0, 1), cB + hstep, voffB); PG8_STA(PG8_SA(0, 0), cA, 0); PG8_STA(PG8_SA(0, 1), cA, 1);
        if (wr == 1) PG8_BAR;
        PG8_WAIT_V(2); PG8_BAR;
        PG8_STAGE(rsB, PG8_SB(1, 0), cB + kstep, voffB); PG8_STA(PG8_SA(1, 0), cA + kstep, 0); PG8_STAGE(rsB, PG8_SB(1, 1), cB + hstep + kstep, voffB);
        PG8_WAIT_V(6); PG8_BAR;
    } else {
        PG8_STAGE(rsB, PG8_SB(0, 0), cB, voffB); PG8_STAGE(rsA, PG8_SA(0, 0), cA, voffA); PG8_STAGE(rsB, PG8_SB(0, 1), cB + hstep, voffB); PG8_STAGE(rsA, PG8_SA(0, 1), cA + hstep, voffA);
        if (wr == 1) PG8_BAR;
        PG8_WAIT_V(4); PG8_BAR;
        PG8_STAGE(rsB, PG8_SB(1, 0), cB + kstep, voffB); PG8_STAGE(rsA, PG8_SA(1, 0), cA + kstep, voffA); PG8_STAGE(rsB, PG8_SB(1, 1), cB + hstep + kstep, voffB);
        PG8_WAIT_V(6); PG8_BAR;
    }
    for (;;) {
        const bool has_next = S.next(ui + 1, nxt);
        const unsigned nA = (has_next && !GA) ? (unsigned)nxt.pm * tstep : cA, nB = has_next ? (unsigned)nxt.pn * tstep : cB;
        if constexpr (GA) PG8_GA_FETCH(has_next ? nxt.pm : cur.pm);
#pragma unroll 1
        for (int t = 0; t < nt; t += 2) {
            const bool last = (t == nt - 2);
            const unsigned a1 = cA + (unsigned)(t + 1) * kstep;
            const unsigned a2 = last ? nA : cA + (unsigned)(t + 2) * kstep, b2 = last ? nB : cB + (unsigned)(t + 2) * kstep;
            const unsigned a3 = a2 + kstep, b3 = b2 + kstep;
            if (last && has_next) S.a_ready(nxt);
            if constexpr (SP2) {
            PG8_LDB(B0, 0, 0); PG8_LDB(B1, 0, 1); PG8_SCHED; PG8_LDA(At, 0, 0); PG8_STA(PG8_SA(1, 1), a1, 1);
            PG8_WAIT_V8(t == 0); PG8_WAIT_L(0); PG8_BAR; PG8_MMA(0, 0, At, B0); PG8_MMA(0, 1, At, B1); PG8_BAR; PG8_SCHED;
            if constexpr (GA) { if (last) PG8_GA_TAKE(); }
            PG8_LDA(At, 0, 1); PG8_STAGE(rsB, PG8_SB(0, 0), b2, voffB); PG8_STAGE(rsB, PG8_SB(0, 1), b2 + hstep, voffB); PG8_STA(PG8_SA(0, 0), a2, 0);
            PG8_WAIT_V8(t == 0); PG8_WAIT_L(0); PG8_BAR; PG8_MMA(1, 0, At, B0); PG8_MMA(1, 1, At, B1); PG8_BAR; PG8_SCHED;
            PG8_LDB(B0, 1, 0); PG8_LDB(B1, 1, 1); PG8_SCHED; PG8_LDA(At, 1, 0); PG8_STA(PG8_SA(0, 1), a2, 1);
            PG8_WAIT_V(8); PG8_WAIT_L(0); PG8_BAR; PG8_MMA(0, 0, At, B0); PG8_MMA(0, 1, At, B1); PG8_BAR; PG8_SCHED;
            PG8_LDA(At, 1, 1); PG8_STAGE(rsB, PG8_SB(1, 0), b3, voffB); PG8_STAGE(rsB, PG8_SB(1, 1), b3 + hstep, voffB); PG8_STA(PG8_SA(1, 0), a3, 0);
            PG8_WAIT_V(8); PG8_WAIT_L(0); PG8_BAR; PG8_MMA(1, 0, At, B0); PG8_MMA(1, 1, At, B1); PG8_BAR; PG8_SCHED;
            } else {
            PG8_LDB(B0, 0, 0); PG8_SCHED; PG8_LDA(At, 0, 0); PG8_STAGE(rsA, PG8_SA(1, 1), a1 + hstep, voffA);
            PG8_WAIT_L(8); PG8_BAR; PG8_WAIT_L(0); PG8_MMA(0, 0, At, B0); PG8_BAR; PG8_SCHED;
            PG8_LDB(B1, 0, 1); PG8_STAGE(rsB, PG8_SB(0, 0), b2, voffB);
            PG8_BAR; PG8_WAIT_L(0); PG8_MMA(0, 1, At, B1); PG8_BAR;
            PG8_LDA(At, 0, 1); PG8_STAGE(rsA, PG8_SA(0, 0), a2, voffA);
            PG8_BAR; PG8_WAIT_L(0); PG8_MMA(1, 0, At, B0); PG8_BAR; PG8_SCHED;
            PG8_STAGE(rsB, PG8_SB(0, 1), b2 + hstep, voffB);
            PG8_WAIT_V(6); PG8_BAR; PG8_MMA(1, 1, At, B1); PG8_BAR;
            PG8_LDB(B0, 1, 0); PG8_SCHED; PG8_LDA(At, 1, 0); PG8_STAGE(rsA, PG8_SA(0, 1), a2 + hstep, voffA);
            PG8_WAIT_L(8); PG8_BAR; PG8_WAIT_L(0); PG8_MMA(0, 0, At, B0); PG8_BAR; PG8_SCHED;
            PG8_LDB(B1, 1, 1); PG8_STAGE(rsB, PG8_SB(1, 0), b3, voffB);
            PG8_BAR; PG8_WAIT_L(0); PG8_MMA(0, 1, At, B1); PG8_BAR;
            PG8_LDA(At, 1, 1); PG8_STAGE(rsA, PG8_SA(1, 0), a3, voffA);
            PG8_BAR; PG8_WAIT_L(0); PG8_MMA(1, 0, At, B0); PG8_BAR; PG8_SCHED;
            PG8_STAGE(rsB, PG8_SB(1, 1), b3 + hstep, voffB);
            PG8_WAIT_V(6); PG8_BAR; PG8_MMA(1, 1, At, B1); PG8_BAR;
            }
        }
        if constexpr (ALIGN_EPI) { if (wr == 0) PG8_BAR; }
        if constexpr (!Epi::AFTER_DRAIN) { E(acc, cur, wr, wc, fr, fq);
#if defined(EPI_DUP) && EPI_DUP
            if constexpr (Epi::PERM) { asm volatile("" ::: "memory"); E(acc, cur, wr, wc, fr, fq); }
#endif
            S.done(cur); }
        if (!has_next) break;
#pragma unroll
        for (int a = 0; a < 2; ++a)
#pragma unroll
            for (int b = 0; b < 2; ++b)
#pragma unroll
                for (int m = 0; m < 4; ++m)
#pragma unroll
                    for (int n = 0; n < 2; ++n) acc[a][b][m][n] = (f32x4){0.f, 0.f, 0.f, 0.f};
        cur = nxt; cA = nA; cB = nB; ++ui;
        if constexpr (ALIGN_EPI) { if (wr == 1) PG8_BAR; }
    }
    PG8_WAIT_V(0);
    if constexpr (!ALIGN_EPI) { if (wr == 0) PG8_BAR; }
    PG8_BAR;
    if constexpr (Epi::AFTER_DRAIN) { E.fused(acc, cur, wr, wc, fr, fq, lds, wid, lane); S.done(cur); }
#undef PG8_SA
#undef PG8_SB
#undef PG8_STAGE
#undef PG8_STA
#undef PG8_WAIT_V8
#undef PG8_GA_FETCH
#undef PG8_GA_TAKE
#undef PG8_LDA
#undef PG8_LDB
#undef PG8_MMA
#undef PG8_WAIT_V
#undef PG8_WAIT_L
#undef PG8_BAR
#undef PG8_SCHED
}
}
using pg8::silu_f;

constexpr int D = 1024, BATCH = 4, SEQ = 8192, CTXL = 256, NLAT = BATCH * SEQ, NCTX = BATCH * CTXL, MROWS = NLAT + NCTX;
constexpr int PIN_SRC = 2832, PLD = 3072, FFH = 2816, NEXP = 8;
constexpr int PO_Q = 0, PO_K = 512, PO_V = 1024, PO_O = 1536, PO_F = 2048, PO_CU = 2304, PO_CG = 2560;
constexpr float EPS = 1e-6f;
constexpr int NWAVES = 8, NTHR = 512;
constexpr size_t MiB = 1u << 20;
constexpr size_t WS_CTL = 0, CTL_ZERO_BYTES = 64 * 1024;
constexpr size_t WS_MOD = 1 * MiB;
constexpr size_t WS_ROUTE = 1 * MiB + 512 * 1024;
constexpr size_t WS_WIN = 2 * MiB;
constexpr size_t WS_WOUT = 14 * MiB;
constexpr size_t WS_WGU = 18 * MiB;
constexpr size_t WS_WD = 29 * MiB;
constexpr size_t WS_MWGU = 35 * MiB;
constexpr size_t WS_MWD = 79 * MiB;
constexpr size_t WS_XB = 101 * MiB;
constexpr size_t WS_XCB = 165 * MiB;
constexpr size_t WS_G = 167 * MiB;
constexpr size_t WS_XC = 170 * MiB;
constexpr size_t WS_TOK = 174 * MiB;
constexpr size_t WS_R1 = 176 * MiB;
constexpr size_t WS_Y = WS_R1, WS_HF = WS_R1 + 66 * MiB, WS_ASORT = WS_R1, WS_OPAIR = WS_R1;
constexpr size_t WS_R2 = 308 * MiB;
constexpr size_t WS_P = WS_R2, WS_H = WS_R2, WS_A = WS_R2 + 198 * MiB, WS_HB = WS_R2 + 264 * MiB, WS_HSORT = WS_R2;
constexpr size_t WS_END = 671 * MiB;
constexpr int MAXPAIR = 2 * NLAT + NEXP * 256;
static_assert(WS_WIN + (size_t)2 * PLD * D * 2 <= WS_WOUT && WS_WOUT + (size_t)2 * D * D * 2 <= WS_WGU && WS_WGU + (size_t)2 * FFH * D * 2 <= WS_WD && WS_WD + (size_t)D * FFH * 2 <= WS_MWGU, "ws map 1");
static_assert(WS_MWGU + (size_t)NEXP * 2 * FFH * D <= WS_MWD && WS_MWD + (size_t)NEXP * D * FFH <= WS_XB && WS_XB + (size_t)NLAT * D * 2 <= WS_XCB && WS_XCB + (size_t)NCTX * D * 2 <= WS_G && WS_G + (size_t)MROWS * 16 * 4 <= WS_XC && WS_XC + (size_t)NCTX * D * 4 <= WS_TOK, "ws map 2");
constexpr size_t WS_ROWTOK = WS_TOK + (768 + 264) * 1024;
static_assert(WS_TOK + 3 * 256 * 1024 + (size_t)MAXPAIR * 4 * 2 <= WS_R1 && WS_Y + (size_t)MROWS * D * 2 <= WS_HF && WS_HF + (size_t)MROWS * 512 * 4 <= WS_R2 && WS_ASORT + (size_t)MAXPAIR * D * 2 <= WS_R2, "ws map 3");
static_assert(WS_P + (size_t)MROWS * PLD * 2 <= WS_A && WS_A + (size_t)MROWS * D * 2 <= WS_HB && WS_HB + (size_t)MROWS * 512 * 4 <= WS_END && WS_HSORT + (size_t)MAXPAIR * FFH * 2 <= WS_END && WS_H + (size_t)MROWS * FFH * 2 <= WS_A, "ws map 4");
constexpr int CW_BAR = 4096;
static_assert((size_t)(CW_BAR + 3456) * 4 <= CTL_ZERO_BYTES, "barrier words inside the per-call memset");
constexpr int RW_HIST = 0;
constexpr int RW_TILE_E = 4096;
constexpr int RW_NTILES = 4096 + 512;
constexpr int LDS_STAGE = 131072, LDSCTL_OFF = LDS_STAGE, LDS_BYTES = 147456;

#define GAS __attribute__((address_space(1)))
#define LAS __attribute__((address_space(3)))
typedef unsigned short bf16;
typedef unsigned v4u __attribute__((ext_vector_type(4)));
typedef unsigned v2u __attribute__((ext_vector_type(2)));
typedef float f32x4 __attribute__((ext_vector_type(4)));
typedef float f32x2_t __attribute__((ext_vector_type(2))); typedef __bf16 bf16x2_t __attribute__((ext_vector_type(2)));
__device__ __forceinline__ unsigned pk2(float lo, float hi) { const f32x2_t v = {lo, hi}; const bf16x2_t b = __builtin_convertvector(v, bf16x2_t); return __builtin_bit_cast(unsigned, b); }
__device__ __forceinline__ unsigned f2bf(float f) { return pk2(f, f) & 0xffffu; }
__device__ __forceinline__ float bf2f(unsigned short b) { return __builtin_bit_cast(float, (unsigned)b << 16); }
__device__ __forceinline__ float bflo(unsigned w) { return __builtin_bit_cast(float, w << 16); }
__device__ __forceinline__ float bfhi(unsigned w) { return __builtin_bit_cast(float, w & 0xffff0000u); }
__device__ __forceinline__ float dpp_f(float v, const int ctrl_sel) {
    const int x = __builtin_bit_cast(int, v); int r;
    if (ctrl_sel == 0) r = __builtin_amdgcn_update_dpp(0, x, 0xB1, 0xF, 0xF, true);
    else if (ctrl_sel == 1) r = __builtin_amdgcn_update_dpp(0, x, 0x4E, 0xF, 0xF, true);
    else if (ctrl_sel == 2) r = __builtin_amdgcn_update_dpp(0, x, 0x141, 0xF, 0xF, true);
    else r = __builtin_amdgcn_update_dpp(0, x, 0x140, 0xF, 0xF, true);
    return __builtin_bit_cast(float, r);
}
__device__ __forceinline__ float row16_sum(float v) { v += dpp_f(v, 0); v += dpp_f(v, 1); v += dpp_f(v, 2); v += dpp_f(v, 3); return v; }
__device__ __forceinline__ float wave_sum(float v) {
    v = row16_sum(v);
    const int x = __builtin_bit_cast(int, v);
    const float r0 = __builtin_bit_cast(float, __builtin_amdgcn_readlane(x, 0)), r1 = __builtin_bit_cast(float, __builtin_amdgcn_readlane(x, 16));
    const float r2 = __builtin_bit_cast(float, __builtin_amdgcn_readlane(x, 32)), r3 = __builtin_bit_cast(float, __builtin_amdgcn_readlane(x, 48));
    return (r0 + r1) + (r2 + r3);
}
__device__ __forceinline__ float wave_total63(float v) {
    v = row16_sum(v);
    v += __builtin_bit_cast(float, __builtin_amdgcn_update_dpp(0, __builtin_bit_cast(int, v), 0x142, 0xA, 0xF, false));
    v += __builtin_bit_cast(float, __builtin_amdgcn_update_dpp(0, __builtin_bit_cast(int, v), 0x143, 0xC, 0xF, false));
    return __builtin_bit_cast(float, __builtin_amdgcn_readlane(__builtin_bit_cast(int, v), 63));
}
__device__ __forceinline__ float sigmoid_f(float x) { return __builtin_amdgcn_rcpf(1.0f + __expf(-x)); }
__device__ __forceinline__ float log_sigmoid_f(float x) { return fminf(x, 0.0f) - log1pf(__expf(-fabsf(x))); }

#define XB_TMO      128
#define XB_XCNT(j)  (256  + 64 * (j))
#define XB_XSUB(j)  (1280 + 64 * (j))
#define XB_XGEN(j)  (2304 + 64 * (j))
#define XB_TOP      3328
#define XB_TOPGEN   3392
#define XCD_BAR_WORDS 3456
#define XB_SPIN_CAP (1u << 18)
#define LAS __attribute__((address_space(3)))

__device__ __forceinline__ unsigned xb_ld(unsigned* p)              { return __hip_atomic_load(p, __ATOMIC_RELAXED, __HIP_MEMORY_SCOPE_AGENT); }
__device__ __forceinline__ unsigned xb_add(unsigned* p, unsigned v) { return __hip_atomic_fetch_add(p, v, __ATOMIC_RELAXED, __HIP_MEMORY_SCOPE_AGENT); }
__device__ __forceinline__ unsigned xb_xcc_id() { return (unsigned)__builtin_amdgcn_s_getreg((3 << 11) | 20) & 0xFu; }
#define XB_SPIN(cond, bar) do { unsigned _sp = 0; while (cond) { __builtin_amdgcn_s_sleep(1); \
    if ((++_sp & 255u) == 0u) { if (xb_ld(&(bar)[XB_TMO])) break; if (_sp > XB_SPIN_CAP) { atomicAdd(&(bar)[XB_TMO], 1u); break; } } } } while (0)

struct XcdBarrier {
    unsigned* bar; unsigned x;
    volatile LAS unsigned* st;
};

__device__ __forceinline__ XcdBarrier xcd_barrier_post(unsigned* bar, volatile LAS unsigned* st) {
    XcdBarrier b; b.bar = bar; b.x = xb_xcc_id(); b.st = st;
    if (threadIdx.x == 0) (void)xb_add(&bar[XB_XCNT(b.x)], 1u);
    return b;
}
__device__ __forceinline__ void xcd_barrier_complete(unsigned* bar, unsigned x, unsigned& nloc, unsigned& nx) {
    const unsigned G = gridDim.x * gridDim.y * gridDim.z;
    unsigned sum, cnt, mine, sp = 0u;
    for (;;) {
        sum = 0u; cnt = 0u; mine = 0u;
#pragma unroll
        for (unsigned j = 0; j < 16; ++j) { const unsigned c = xb_ld(&bar[XB_XCNT(j)]); sum += c; cnt += (c > 0u) ? 1u : 0u; mine = (j == x) ? c : mine; }
        if (sum == G) break;
        __builtin_amdgcn_s_sleep(1);
        if ((++sp & 255u) == 0u) { if (xb_ld(&bar[XB_TMO])) break; if (sp > XB_SPIN_CAP) { atomicAdd(&bar[XB_TMO], 1u); break; } }
    }
    nloc = mine > 0u ? mine : 1u; nx = cnt > 0u ? cnt : 1u;
}

__device__ __forceinline__ void xcd_barrier(const XcdBarrier& b, const int tid) {
    asm volatile("s_waitcnt vmcnt(0)" ::: "memory");
    __syncthreads();
    if (tid == 0) {
        unsigned* bar = b.bar;
        __builtin_amdgcn_s_waitcnt(0);
        unsigned nloc = b.st[0], nx = b.st[1];
        if (nloc == 0u) { xcd_barrier_complete(bar, b.x, nloc, nx); b.st[0] = nloc; b.st[1] = nx; }
        const unsigned old = xb_add(&bar[XB_XSUB(b.x)], 1u);
        const unsigned gen = old / nloc;
        if (old + 1u == (gen + 1u) * nloc) {
            __builtin_amdgcn_fence(__ATOMIC_RELEASE, "agent");
            asm volatile("s_waitcnt vmcnt(0)" ::: "memory");
            const unsigned og = xb_add(&bar[XB_TOP], 1u);
            const unsigned tg = og / nx;
            if (og + 1u == (tg + 1u) * nx) xb_add(&bar[XB_TOPGEN], 1u);
            else XB_SPIN(xb_ld(&bar[XB_TOPGEN]) == tg, bar);
            __builtin_amdgcn_fence(__ATOMIC_ACQUIRE, "agent");
            xb_add(&bar[XB_XGEN(b.x)], 1u);
            asm volatile("s_waitcnt vmcnt(0)" ::: "memory");
        } else {
            XB_SPIN(xb_ld(&bar[XB_XGEN(b.x)]) == gen, bar);
            __builtin_amdgcn_fence(__ATOMIC_ACQUIRE, "agent");
            asm volatile("s_waitcnt vmcnt(0)" ::: "memory");
        }
    }
    __syncthreads();
}
#define LDS_WAIT() asm volatile("s_waitcnt lgkmcnt(0)" ::: "memory")

__device__ __forceinline__ void transpose_item(const float* W, int K, int N, bf16* WT, int dst_row0, int src_col0, int nvalid, int kb, LAS float* scr, int lane) {
    const int k0 = 64 * kb, nl = lane & 31;
#pragma unroll 8
    for (int i = 0; i < 32; ++i) { const int kk = 2 * i + (lane >> 5); scr[kk * 33 + nl] = nl < nvalid ? W[(size_t)(k0 + kk) * N + src_col0 + nl] : 0.f; }
    LDS_WAIT();
    const int c = lane & 7;
#pragma unroll
    for (int j = 0; j < 4; ++j) { const int n = (lane >> 3) + 8 * j; const LAS float* s = scr + (8 * c) * 33 + n;
        v4u o; o.x = pk2(s[0 * 33], s[1 * 33]); o.y = pk2(s[2 * 33], s[3 * 33]); o.z = pk2(s[4 * 33], s[5 * 33]); o.w = pk2(s[6 * 33], s[7 * 33]);
        *(v4u*)(WT + (size_t)(dst_row0 + n) * K + k0 + 8 * c) = o; }
    LDS_WAIT();
}
__device__ __forceinline__ void transpose_item_f8(const float* W, int K, int N, unsigned char* WT, int dst_row0, int src_col0, int kb, float scale, LAS float* scr, int lane) {
    const int k0 = 64 * kb, nl = lane & 31;
#pragma unroll 8
    for (int i = 0; i < 32; ++i) { const int kk = 2 * i + (lane >> 5); scr[kk * 33 + nl] = W[(size_t)(k0 + kk) * N + src_col0 + nl] * scale; }
    LDS_WAIT();
    const int kh = lane >> 5; const LAS float* s = scr + (32 * kh) * 33 + nl; v4u o0, o1;
    o0.x = pg8::pk4_fp8(s[0 * 33], s[1 * 33], s[2 * 33], s[3 * 33]); o0.y = pg8::pk4_fp8(s[4 * 33], s[5 * 33], s[6 * 33], s[7 * 33]); o0.z = pg8::pk4_fp8(s[8 * 33], s[9 * 33], s[10 * 33], s[11 * 33]); o0.w = pg8::pk4_fp8(s[12 * 33], s[13 * 33], s[14 * 33], s[15 * 33]);
    o1.x = pg8::pk4_fp8(s[16 * 33], s[17 * 33], s[18 * 33], s[19 * 33]); o1.y = pg8::pk4_fp8(s[20 * 33], s[21 * 33], s[22 * 33], s[23 * 33]); o1.z = pg8::pk4_fp8(s[24 * 33], s[25 * 33], s[26 * 33], s[27 * 33]); o1.w = pg8::pk4_fp8(s[28 * 33], s[29 * 33], s[30 * 33], s[31 * 33]);
    unsigned char* dst = WT + (size_t)(dst_row0 + nl) * K + k0 + 32 * kh; *(v4u*)dst = o0; *(v4u*)(dst + 16) = o1;
    LDS_WAIT();
}
__device__ __forceinline__ void win_map(int nb, int& src, int& nvalid) { const int v0 = 32 * nb; if (v0 < 2048) { src = v0; nvalid = 32; } else if (v0 < 2816) { src = v0 + 16; nvalid = 32; } else if (v0 == 2816) { src = 2048; nvalid = 16; } else { src = 0; nvalid = 0; } }
__device__ __forceinline__ int gu_map(int nb) { const int v0 = 32 * nb; return ((v0 >> 7) & 1) * FFH + (v0 >> 8) * 128 + (v0 & 127); }

__device__ __forceinline__ void prologue_phase(const float* const* in, unsigned char* ws, LAS unsigned char* lds, int wg, int G, int tid) {
    const int lane = tid & 63, wave = tid >> 6, gw = wg * NWAVES + wave, NGW = G * NWAVES;
    LAS float* scr = (LAS float*)(lds + wave * 16384);
    constexpr int I_WIN = 16 * 96, I_WOUT = 16 * 32, I_GU = 16 * 176, I_DN = 44 * 32;
    constexpr int NITEMS = 2 * I_WIN + 2 * I_WOUT + I_GU + I_DN;
    for (int it = gw; it < NITEMS; it += NGW) {
        int r = it;
        if (r < 2 * I_WIN) { const int L = r / I_WIN; r -= L * I_WIN; const int kb = r / 96, nb = r % 96; int src, nv; win_map(nb, src, nv);
            transpose_item(in[8] + (size_t)L * D * PIN_SRC, D, PIN_SRC, (bf16*)(ws + WS_WIN) + (size_t)L * PLD * D, 32 * nb, src, nv, kb, scr, lane); continue; }
        r -= 2 * I_WIN;
        if (r < 2 * I_WOUT) { const int L = r / I_WOUT; r -= L * I_WOUT; const int kb = r / 32, nb = r % 32;
            transpose_item(in[15] + (size_t)L * D * D, D, D, (bf16*)(ws + WS_WOUT) + (size_t)L * D * D, 32 * nb, 32 * nb, 32, kb, scr, lane); continue; }
        r -= 2 * I_WOUT;
        if (r < I_GU) { const int kb = r / 176, nb = r % 176; transpose_item(in[16], D, 2 * FFH, (bf16*)(ws + WS_WGU), 32 * nb, gu_map(nb), 32, kb, scr, lane); continue; }
        r -= I_GU;
        { const int kb = r / 32, nb = r % 32; transpose_item_f8(in[17], FFH, D, (unsigned char*)(ws + WS_WD), 32 * nb, 32 * nb, kb, pg8::F8_SWD, scr, lane); }
    }
    __syncthreads();
    LAS float* cond_s = (LAS float*)lds;
    LAS float* part = (LAS float*)(lds + 32768);
    for (int i = tid; i < 5 * D; i += NTHR) { const int r = i >> 10, k = i & 1023; const float v = r < 4 ? in[1][r * D + k] : in[3][k]; cond_s[i] = silu_f(v); }
    __syncthreads();
    float* MOD = (float*)(ws + WS_MOD);
    for (int t = wg; t < 192; t += G) {
        const int L = t / 96, nb = t % 96; const float* W = in[6] + (size_t)L * D * 6144 + nb * 64 + lane;
        float a0 = 0.f, a1 = 0.f, a2 = 0.f, a3 = 0.f, a4 = 0.f;
#pragma unroll 8
        for (int kk = 0; kk < 128; ++kk) { const int k = wave * 128 + kk; const float w = W[(size_t)k * 6144];
            a0 += cond_s[k] * w; a1 += cond_s[D + k] * w; a2 += cond_s[2 * D + k] * w; a3 += cond_s[3 * D + k] * w; a4 += cond_s[4 * D + k] * w; }
        part[(wave * 5 + 0) * 64 + lane] = a0; part[(wave * 5 + 1) * 64 + lane] = a1; part[(wave * 5 + 2) * 64 + lane] = a2; part[(wave * 5 + 3) * 64 + lane] = a3; part[(wave * 5 + 4) * 64 + lane] = a4;
        __syncthreads();
        if (tid < 320) { const int r = tid >> 6, l = tid & 63; float s = in[7][L * 6144 + nb * 64 + l];
#pragma unroll
            for (int w = 0; w < 8; ++w) s += part[(w * 5 + r) * 64 + l];
            MOD[(size_t)(L * 5 + r) * 6144 + nb * 64 + l] = s; }
        __syncthreads();
    }
}

__device__ __forceinline__ void moe_convert_items(const float* const* in, unsigned char* ws, LAS unsigned char* lds, int which, int widx, int nw, int tid, int it0 = 0, int it1 = 1 << 30) {
    const int lane = tid & 63, wave = tid >> 6, gw = widx * NWAVES + wave, NGW = nw * NWAVES;
    LAS float* scr = (LAS float*)(lds + wave * 16384);
    constexpr int I_GU = 16 * 176, I_DN = 44 * 32;
    if (which == 0) { for (int it = gw; it < 8 * I_DN; it += NGW) { const int e = it / I_DN, r = it - e * I_DN, kb = r / 32, nb = r % 32;
            transpose_item_f8(in[21] + (size_t)e * FFH * D, FFH, D, (unsigned char*)(ws + WS_MWD) + (size_t)e * D * FFH, 32 * nb, 32 * nb, kb, pg8::F8_SWD, scr, lane); } }
    else { const int hi = it1 < 8 * I_GU ? it1 : 8 * I_GU; for (int it = it0 + gw; it < hi; it += NGW) { const int e = it / I_GU, r = it - e * I_GU, kb = r / 176, nb = r % 176;
            transpose_item_f8(in[20] + (size_t)e * D * 2 * FFH, D, 2 * FFH, (unsigned char*)(ws + WS_MWGU) + (size_t)e * 2 * FFH * D, 32 * nb, gu_map(nb), kb, pg8::F8_SWGU, scr, lane); } }
}

typedef float f32x2w __attribute__((ext_vector_type(2)));
template <bool ROUTER, bool F8OUT = false, bool XB16 = false>
__device__ __forceinline__ void norm_phase(const void* xlat, const void* xctx, bool do_ctx, const float* ng, const float* modL, int chunk_shift, bf16* A,
                                           const float* w_router, const float* b_router, int* tok_e, float* tok_w, int* hist, LAS unsigned char* lds, int wg, int G, int tid) {
    const int lane = tid & 63, wave = tid >> 6;
    LAS int* lh = (LAS int*)(lds + 73728);
    LAS float* RS = (LAS float*)lds + wave * (32 * 65 + 128); LAS float* RT = RS + 32 * 65;
    f32x4 wr0[16], wr1[16];
    if (ROUTER) {
#pragma unroll
        for (int j = 0; j < 4; ++j)
#pragma unroll
            for (int q = 0; q < 4; ++q) { const int c = 4 * lane + 256 * j + q; wr0[4 * j + q] = *(const f32x4*)(w_router + c * 8); wr1[4 * j + q] = *(const f32x4*)(w_router + c * 8 + 4); } }
    for (int blk = wg; blk < 256; blk += G) {
        if (ROUTER) { if (tid < 8) lh[tid] = 0; __syncthreads(); }
        for (int pass = 0; pass < (do_ctx ? 2 : 1); ++pass) {
            const int b = pass == 0 ? (blk >> 6) : 4;
            const float* sh = modL + (size_t)b * 6144 + chunk_shift * D; const float* sc = sh + D;
            f32x4 mul[4], add[4];
#pragma unroll
            for (int j = 0; j < 4; ++j) { const int c = 4 * lane + 256 * j; const f32x4 g = *(const f32x4*)(ng + c), s = *(const f32x4*)(sc + c); mul[j] = g * (s + 1.0f); add[j] = *(const f32x4*)(sh + c); }
            const int nrow = pass == 0 ? 16 : (wave < 4 ? 1 : 0);
            const int lrow0 = pass == 0 ? blk * 128 + wave * 16 : blk * 4 + wave;
            const unsigned char* xbase = (const unsigned char*)(pass == 0 ? xlat : xctx) + ((size_t)lrow0 * D + 4 * lane) * (XB16 ? 2 : 4);
#define NORM_LD(dst_, rowi_) do { _Pragma("unroll") for (int j = 0; j < 4; ++j) { if constexpr (XB16) { const v2u w_ = *(const v2u*)(xbase + ((size_t)(rowi_) * D + 256 * j) * 2); \
                dst_[j] = (f32x4){bflo(w_.x), bfhi(w_.x), bflo(w_.y), bfhi(w_.y)}; } else dst_[j] = *(const f32x4*)(xbase + ((size_t)(rowi_) * D + 256 * j) * 4); } } while (0)
            f32x4 vn[4];
            if (nrow > 0) NORM_LD(vn, 0);
            for (int i = 0; i < nrow; ++i) {
                const int lrow = lrow0 + i; const int arow = pass == 0 ? lrow : NLAT + lrow;
                f32x4 v[4]; float ss = 0.f;
#pragma unroll
                for (int j = 0; j < 4; ++j) { v[j] = vn[j]; ss += (v[j].x * v[j].x + v[j].y * v[j].y) + (v[j].z * v[j].z + v[j].w * v[j].w); }
                if (i + 1 < nrow) NORM_LD(vn, i + 1);
                const float rstd = 1.0f / sqrtf(wave_sum(ss) * (1.0f / D) + EPS);
                unsigned long long* o8 = (unsigned long long*)(A + (size_t)arow * D) + lane;
#pragma unroll
                for (int j = 0; j < 4; ++j) { v[j] = v[j] * rstd * mul[j] + add[j];
                    if constexpr (F8OUT) ((unsigned*)((unsigned char*)A + (size_t)arow * D))[lane + 64 * j] = pg8::pk4_fp8(v[j].x, v[j].y, v[j].z, v[j].w);
                    else o8[64 * j] = (unsigned long long)pk2(v[j].x, v[j].y) | ((unsigned long long)pk2(v[j].z, v[j].w) << 32); }
                if (ROUTER && pass == 0) {
                    typedef float f2r __attribute__((ext_vector_type(2)));
                    f2r l2[4] = {(f2r){0.f, 0.f}, (f2r){0.f, 0.f}, (f2r){0.f, 0.f}, (f2r){0.f, 0.f}};
#pragma unroll
                    for (int j = 0; j < 4; ++j)
#pragma unroll
                        for (int q = 0; q < 4; ++q) { const f32x4 w0 = wr0[4 * j + q], w1 = wr1[4 * j + q]; const float y = v[j][q]; const f2r yy = {y, y};
                            l2[0] += yy * (f2r){w0.x, w0.y}; l2[1] += yy * (f2r){w0.z, w0.w}; l2[2] += yy * (f2r){w1.x, w1.y}; l2[3] += yy * (f2r){w1.z, w1.w}; }
#pragma unroll
                    for (int e = 0; e < 8; ++e) RS[((i & 3) * 8 + e) * 65 + lane] = (e & 1) ? l2[e >> 1].y : l2[e >> 1].x;
                    if ((i & 3) == 3) { LDS_WAIT();
                        const int idx = lane & 31, c0 = (lane >> 5) * 32; float s = 0.f;
#pragma unroll
                        for (int c = 0; c < 32; ++c) s += RS[idx * 65 + c0 + c];
                        s += __shfl_xor(s, 32);
                        if (lane < 32) RT[(i >> 2) * 32 + idx] = s;
                        LDS_WAIT(); }
                }
            }
            if (ROUTER && pass == 0) LDS_WAIT();
            if (ROUTER && pass == 0 && lane < 16) {
                const int lrow = lrow0 + lane; float lg[8];
#pragma unroll
                for (int e = 0; e < 8; ++e) lg[e] = RT[lane * 8 + e] + b_router[e];
                int e1 = 0; float v1 = lg[0];
#pragma unroll
                for (int e = 1; e < 8; ++e) if (lg[e] > v1) { v1 = lg[e]; e1 = e; }
                int e2 = -1; float v2 = -3.0e38f;
#pragma unroll
                for (int e = 0; e < 8; ++e) if (e != e1 && lg[e] > v2) { v2 = lg[e]; e2 = e; }
                const float w2 = 1.0f / (1.0f + __expf(v1 - v2)), w1 = 1.0f - w2;
                *(v2u*)(tok_e + lrow * 2) = (v2u){(unsigned)e1, (unsigned)e2}; *(f32x2w*)(tok_w + lrow * 2) = (f32x2w){w1, w2};
                __hip_atomic_fetch_add(&lh[e1], 1, __ATOMIC_RELAXED, __HIP_MEMORY_SCOPE_WORKGROUP); __hip_atomic_fetch_add(&lh[e2], 1, __ATOMIC_RELAXED, __HIP_MEMORY_SCOPE_WORKGROUP);
            }
        }
        if (ROUTER) { __syncthreads(); if (tid < 8) hist[blk * 8 + tid] = lh[tid]; __syncthreads(); }
    }
}

__device__ __forceinline__ void route_phase(unsigned char* ws, LAS unsigned char* lds, int wg, int G, int tid) {
    const int lane = tid & 63, wave = tid >> 6;
    int* rw = (int*)(ws + WS_ROUTE); const int* hist = rw + RW_HIST;
    const int* tok_e = (const int*)(ws + WS_TOK); const float* tok_w = (const float*)(ws + WS_TOK + 256 * 1024); int* pair_pos = (int*)(ws + WS_TOK + 512 * 1024); float* row_w = (float*)(ws + WS_TOK + 768 * 1024); int* row_tok = (int*)(ws + WS_ROWTOK);
    LAS int* hs = (LAS int*)lds;
    LAS int* tot = hs + 2048;
    LAS int* te = hs + 2048 + 32;
    LAS int* ps = te + 256;
    for (int blk = wg; blk < 256; blk += G) {
        __syncthreads();
        for (int i = tid; i < 2048; i += NTHR) hs[i] = hist[i];
        if (tid < 256) te[tid] = tok_e[blk * 256 + tid];
        __syncthreads();
        { const int e = tid & 7, b0 = (tid >> 3) * 4; int t = 0, mb = 0;
#pragma unroll
            for (int j = 0; j < 4; ++j) { const int h = hs[(b0 + j) * 8 + e]; t += h; mb += (b0 + j < blk) ? h : 0; }
            t += __shfl_xor(t, 8); mb += __shfl_xor(mb, 8); t += __shfl_xor(t, 16); mb += __shfl_xor(mb, 16); t += __shfl_xor(t, 32); mb += __shfl_xor(mb, 32);
            if (lane < 8) { ps[wave * 16 + lane] = t; ps[wave * 16 + 8 + lane] = mb; } }
        __syncthreads();
        if (tid < 8) { int t = 0, mb = 0;
#pragma unroll
            for (int w = 0; w < NWAVES; ++w) { t += ps[w * 16 + tid]; mb += ps[w * 16 + 8 + tid]; } tot[tid] = t; tot[16 + tid] = mb; }
        __syncthreads();
        if (tid == 0) { int s = 0; for (int e = 0; e < 8; ++e) { tot[8 + e] = s; s += (tot[e] + 255) & ~255; } tot[24] = s >> 8; }
        int my_e = 0, my_rank = 0;
        if (tid < 256) { my_e = te[tid];
#pragma unroll
            for (int x = 0; x < 8; ++x) { const unsigned long long m = __ballot(my_e == x); if (my_e == x) my_rank = __popcll(m & ((1ull << lane) - 1ull)); if (lane == x) ps[128 + wave * 8 + x] = __popcll(m); } }
        __syncthreads();
        if (tid < 256) { const int e = my_e; int rank = my_rank; for (int w = 0; w < wave; ++w) rank += ps[128 + w * 8 + e];
            const int pos = tot[8 + e] + tot[16 + e] + rank; pair_pos[blk * 256 + tid] = pos; row_w[pos] = tok_w[blk * 256 + tid]; row_tok[pos] = blk * 128 + (tid >> 1); }
        if (blk == 0) {
            if (tid < 264) { int e = 0; for (int e2 = 1; e2 < 8; ++e2) if (tid * 256 >= tot[8 + e2]) e = e2; rw[RW_TILE_E + tid] = e; }
            if (tid == 0) rw[RW_NTILES] = tot[24];
        }
        if (blk < 8) { const int e = blk, r0 = tot[8 + e] + tot[e], r1 = tot[8 + e] + ((tot[e] + 255) & ~255);
            for (int r = r0 + tid; r < r1; r += NTHR) { row_tok[r] = 0; row_w[r] = 0.f; } }
    }
}

__device__ __forceinline__ void final_phase(const bf16* XB, float* X, const bf16* O, const int* pair_pos, const float* modL, const float* fg, int wg, int G, int tid) {
    const int lane = tid & 63, wave = tid >> 6;
    f32x4 fgv[4];
#pragma unroll
    for (int j = 0; j < 4; ++j) fgv[j] = *(const f32x4*)(fg + 4 * lane + 256 * j);
    const int nw = G * NWAVES, gw = wg * NWAVES + wave, per = (NLAT + nw - 1) / nw, r0 = gw * per, r1 = (r0 + per < NLAT) ? r0 + per : NLAT;
    if (r0 >= r1) return;
    v2u xn[4]; v2u an[4], cn[4]; int p1n = pair_pos[r0 * 2], p2n = pair_pos[r0 * 2 + 1];
#define FIN_ISSUE(row_, p1_, p2_) do { const v2u* xr_ = (const v2u*)(XB + (size_t)(row_) * D) + lane; const v2u* o1_ = (const v2u*)(O + (size_t)(p1_) * D) + lane; const v2u* o2_ = (const v2u*)(O + (size_t)(p2_) * D) + lane; \
        _Pragma("unroll") for (int j = 0; j < 4; ++j) { xn[j] = xr_[64 * j]; an[j] = o1_[64 * j]; cn[j] = o2_[64 * j]; } } while (0)
    FIN_ISSUE(r0, p1n, p2n);
    if (r0 + 1 < r1) { p1n = pair_pos[(r0 + 1) * 2]; p2n = pair_pos[(r0 + 1) * 2 + 1]; }
    for (int row = r0; row < r1; ++row) {
        const int b = row >> 13; const float* g2 = modL + (size_t)b * 6144 + 5 * D;
        f32x4 v[4]; float ss = 0.f;
#pragma unroll
        for (int j = 0; j < 4; ++j) { const f32x4 g = *(const f32x4*)(g2 + 4 * lane + 256 * j); const v2u a = an[j], c = cn[j];
            f32x4 m; m.x = bflo(a.x) + bflo(c.x); m.y = bfhi(a.x) + bfhi(c.x); m.z = bflo(a.y) + bflo(c.y); m.w = bfhi(a.y) + bfhi(c.y);
            v[j] = (f32x4){bflo(xn[j].x), bfhi(xn[j].x), bflo(xn[j].y), bfhi(xn[j].y)} + g * m; ss += (v[j].x * v[j].x + v[j].y * v[j].y) + (v[j].z * v[j].z + v[j].w * v[j].w); }
        if (row + 1 < r1) { FIN_ISSUE(row + 1, p1n, p2n); if (row + 2 < r1) { p1n = pair_pos[(row + 2) * 2]; p2n = pair_pos[(row + 2) * 2 + 1]; } }
        const float rstd = 1.0f / sqrtf(wave_sum(ss) * (1.0f / D) + EPS);
        float* xr = X + (size_t)row * D;
#pragma unroll
        for (int j = 0; j < 4; ++j) *(f32x4*)(xr + 4 * lane + 256 * j) = v[j] * rstd * fgv[j];
    }
#undef FIN_ISSUE
}

typedef float f32x2 __attribute__((ext_vector_type(2)));
__device__ __forceinline__ void fourier_ctx_task(const bf16* P, bf16* Y, LAS unsigned char* lds, int task, int tid) {
    const int lane = tid & 63, wave = tid >> 6;
    LAS f32x2* tab = (LAS f32x2*)lds;
    LAS unsigned short* zb = (LAS unsigned short*)(lds + 65536);
    LAS float* ure_s = (LAS float*)(lds + 98304);
    LAS float* uim_s = ure_s + 1024;
    const int b = task >> 6, g = (task >> 4) & 3, kb = task & 15;
    const int rowbase = NLAT + b * CTXL;
    float ure[2] = {0.f, 0.f}, uim[2] = {0.f, 0.f}; int idx[2] = {0, 0}, stp[2];
#pragma unroll
    for (int j = 0; j < 2; ++j) stp[j] = ((kb * 16 + wave * 2 + j) * 32) & 8191;
    __syncthreads();
#pragma unroll
    for (int i = 0; i < 4; ++i) { const int p = tid + NTHR * i, r = p >> 3, ch = p & 7;
        *(LAS v4u*)(zb + r * 64 + ch * 8) = *(const v4u*)(P + (size_t)(rowbase + r) * PLD + PO_F + g * 64 + ch * 8); }
    __syncthreads();
#pragma unroll 4
    for (int nn = 0; nn < 256; ++nn) { const float z = bf2f(zb[nn * 64 + lane]);
#pragma unroll
        for (int j = 0; j < 2; ++j) { const f32x2 t = tab[idx[j]]; ure[j] += z * t.x; uim[j] -= z * t.y; idx[j] = (idx[j] + stp[j]) & 8191; } }
#pragma unroll
    for (int j = 0; j < 2; ++j) { ure_s[(wave * 2 + j) * 64 + lane] = ure[j]; uim_s[(wave * 2 + j) * 64 + lane] = uim[j]; }
    __syncthreads();
    const float scale = 1.0f / sqrtf(256.0f * 64.0f);
#pragma unroll 1
    for (int j = 0; j < 2; ++j) { const int kl = wave * 2 + j; float acc = 0.f;
#pragma unroll 4
        for (int c = 0; c < 64; ++c) { const f32x2 t = tab[((c * lane) & 63) * 128]; acc += ure_s[kl * 64 + c] * t.x + uim_s[kl * 64 + c] * t.y; }
        Y[(size_t)(rowbase + kb * 16 + kl) * D + 512 + g * 64 + lane] = (bf16)f2bf(acc * scale); }
}

typedef short bf16x8v __attribute__((ext_vector_type(8)));
constexpr size_t WS_GW = WS_R2 + 340 * MiB;
constexpr size_t WS_TKS = WS_R2 + 335 * MiB;
constexpr size_t WS_NS = WS_R2 + 330 * MiB;
constexpr size_t WS_SC = WS_R2 + 333 * MiB;
static_assert(WS_HB + (size_t)16 * 132 * 16384 * 2 <= WS_NS && WS_NS + (size_t)2 * 16 * 132 * 128 * 4 <= WS_SC && WS_SC + (size_t)2 * 16 * 132 * 16 <= WS_END && WS_HF + (size_t)16 * 132 * 16384 * 2 <= WS_R2, "mlstm state map");
constexpr int NCHK = 132;
constexpr float KSC = 0.08838834764831845f;
constexpr float L2E = 1.4426950408889634f;
constexpr float F8_ST = 8.f;
typedef float f32x2s __attribute__((ext_vector_type(2)));
__device__ __forceinline__ int chunk_rowbase(int b, int c) { return c < 128 ? b * SEQ + 64 * c : NLAT + b * CTXL + 64 * (c - 128); }
#define DPP_SHR(x_, id_, n_) __builtin_bit_cast(float, __builtin_amdgcn_update_dpp(__builtin_bit_cast(int, (float)(id_)), __builtin_bit_cast(int, (float)(x_)), 0x110 + (n_), 0xF, 0xF, false))
__device__ __forceinline__ float rl_f(float v, int l) { return __builtin_bit_cast(float, __builtin_amdgcn_readlane(__builtin_bit_cast(int, v), l)); }
__device__ __forceinline__ float scan_add_fwd(float x, int lane) {
    x += DPP_SHR(x, 0.f, 1); x += DPP_SHR(x, 0.f, 2); x += DPP_SHR(x, 0.f, 4); x += DPP_SHR(x, 0.f, 8);
    const float t0 = rl_f(x, 15), t1 = rl_f(x, 31), t2 = rl_f(x, 47); const int row = lane >> 4;
    return x + (row == 0 ? 0.f : row == 1 ? t0 : row == 2 ? t0 + t1 : (t0 + t1) + t2);
}
__device__ __forceinline__ float scan_max_fwd(float x, int lane) {
    const float NI = -3.0e38f;
    x = fmaxf(x, DPP_SHR(x, NI, 1)); x = fmaxf(x, DPP_SHR(x, NI, 2)); x = fmaxf(x, DPP_SHR(x, NI, 4)); x = fmaxf(x, DPP_SHR(x, NI, 8));
    const float t0 = rl_f(x, 15), t1 = rl_f(x, 31), t2 = rl_f(x, 47); const int row = lane >> 4;
    return fmaxf(x, row == 0 ? NI : row == 1 ? t0 : row == 2 ? fmaxf(t0, t1) : fmaxf(fmaxf(t0, t1), t2));
}
#define MFMA16(a, b, c) __builtin_amdgcn_mfma_f32_16x16x32_bf16((a), (b), (c), 0, 0, 0)
__device__ __forceinline__ bf16x8v pack8(const float (&v)[8]) { v4u w; w.x = pk2(v[0], v[1]); w.y = pk2(v[2], v[3]); w.z = pk2(v[4], v[5]); w.w = pk2(v[6], v[7]); return __builtin_bit_cast(bf16x8v, w); }


__device__ __forceinline__ void gate_proj_tasks(const bf16* A, const bf16* WinT, const float* bg, unsigned char* ws, LAS unsigned char* lds, int widx, int nw, int tid) {
    const int lane = tid & 63, wave = tid >> 6, r = lane & 15, g = lane >> 4;
    const bf16* wrow = WinT + (size_t)(2816 + r) * D + 8 * g;
    LAS float* GS = (LAS float*)lds;
    float* TKS = (float*)(ws + WS_TKS); float* GWt = (float*)(ws + WS_GW); float* SC = (float*)(ws + WS_SC);
    for (int t = widx; t < MROWS / 256; t += nw) {
        const int row0 = t * 256 + wave * 32;
        const bf16* a0 = A + (size_t)(row0 + r) * D + 8 * g; const bf16* a1 = a0 + (size_t)16 * D;
        f32x4 c0 = {0.f, 0.f, 0.f, 0.f}, c1 = c0;
#pragma unroll 8
        for (int kk = 0; kk < 32; ++kk) { const bf16x8v b = *(const bf16x8v*)(wrow + 32 * kk), x0 = *(const bf16x8v*)(a0 + 32 * kk), x1 = *(const bf16x8v*)(a1 + 32 * kk);
            c0 = MFMA16(x0, b, c0); c1 = MFMA16(x1, b, c1); }
        __syncthreads();
#pragma unroll
        for (int i = 0; i < 4; ++i) { GS[(wave * 32 + 4 * g + i) * 17 + r] = c0[i]; GS[(wave * 32 + 16 + 4 * g + i) * 17 + r] = c1[i]; }
        __syncthreads();
        const int b = t < 128 ? (t >> 5) : (t - 128), cbase = t < 128 ? 4 * (t & 31) : 128;
        for (int j = wave; j < 32; j += NWAVES) { const int cc = j >> 3, dir = (j >> 2) & 1, h = j & 3, tk = dir ? 63 - lane : lane;
            const LAS float* gr = GS + (64 * cc + tk) * 17 + dir * 8 + h;
            const float a = gr[0] + bg[dir * 8 + h], lf = log_sigmoid_f(gr[4] + bg[dir * 8 + 4 + h]);
            const float cum = scan_add_fwd(lf, lane), gg = a - cum, pm = scan_max_fwd(gg, lane), gmax = rl_f(pm, 63), tot = rl_f(cum, 63);
            const size_t base = (size_t)(dir * 16 + b * 4 + h) * NCHK + cbase + cc;
            TKS[base * 192 + lane] = cum; TKS[base * 192 + 64 + lane] = gg; TKS[base * 192 + 128 + lane] = pm;
            GWt[base * 64 + lane] = __expf(gg - gmax) * (KSC * F8_ST);
            if (lane == 0) { SC[base * 4] = tot; SC[base * 4 + 1] = tot + gmax; } }
    }
}
__device__ __forceinline__ int swz72(int row, int s) { return row * 72 + ((((s >> 3) ^ ((row >> 3) & 7))) << 3) + (s & 7); }
struct M1Regs { v4u k[2], v[2]; float ga, gf; };
__device__ __forceinline__ void m1_issue(M1Regs& R, const bf16* P, const float* Gt, int task, int tid) {
    const int lane = tid & 63, wave = tid >> 6;
    const int bh = task / NCHK, c = task % NCHK, b = bh >> 2, h = bh & 3, rowbase = chunk_rowbase(b, c);
#pragma unroll
    for (int i2 = 0; i2 < 2; ++i2) { const int p = tid + NTHR * i2, s = p >> 4, dg = p & 15;
        R.k[i2] = *(const v4u*)(P + (size_t)(rowbase + s) * PLD + PO_K + h * 128 + dg * 8); R.v[i2] = *(const v4u*)(P + (size_t)(rowbase + s) * PLD + PO_V + h * 128 + dg * 8); }
    R.ga = 0.f; R.gf = 0.f;
    if (wave < 2) R.ga = Gt[((size_t)(wave * 16 + bh) * NCHK + c) * 64 + lane];
}
__device__ __forceinline__ void mlstm_m1_phase(const bf16* P, const float* Gt, const float* bg, unsigned char* ws, LAS unsigned char* lds, int ntask, int wg, int G, int tid) {
    const int lane = tid & 63, wave = tid >> 6, r = lane & 15, g = lane >> 4;
    LAS unsigned short* KT0 = (LAS unsigned short*)lds;
    LAS unsigned short* VT = (LAS unsigned short*)(lds + 36864);
    LAS float* gw = (LAS float*)(lds + 55296);
    float* SC = (float*)(ws + WS_SC); float* NS = (float*)(ws + WS_NS);
    if (wg >= ntask) return;
    M1Regs R; m1_issue(R, P, Gt, wg, tid);
    for (int task = wg; task < ntask; task += G) {
        const int bh = task / NCHK, c = task % NCHK, h = bh & 3;
        __syncthreads();
        if (wave < 2) { const int dir = wave, tk = dir ? 63 - lane : lane; gw[dir * 64 + tk] = R.ga; }
        __syncthreads();
#pragma unroll
        for (int i2 = 0; i2 < 2; ++i2) { const int p = tid + NTHR * i2, s = p >> 4, dg = p & 15;
            const float wf = gw[s], wb = gw[64 + s];
            const unsigned kk[4] = {R.k[i2].x, R.k[i2].y, R.k[i2].z, R.k[i2].w}, vv[4] = {R.v[i2].x, R.v[i2].y, R.v[i2].z, R.v[i2].w};
#pragma unroll
            for (int j = 0; j < 4; ++j) { const float k0 = bflo(kk[j]), k1 = bfhi(kk[j]); const int d = dg * 8 + 2 * j, o0 = swz72(d, s), o1 = swz72(d + 1, s);
                const unsigned pf = pk2(k0 * wf, k1 * wf), pb = pk2(k0 * wb, k1 * wb);
                KT0[o0] = (unsigned short)(pf & 0xffffu); KT0[o1] = (unsigned short)(pf >> 16);
                KT0[9216 + o0] = (unsigned short)(pb & 0xffffu); KT0[9216 + o1] = (unsigned short)(pb >> 16);
                VT[o0] = (unsigned short)(vv[j] & 0xffffu); VT[o1] = (unsigned short)(vv[j] >> 16); } }
        __syncthreads();
        if (task + G < ntask) m1_issue(R, P, Gt, task + G, tid);
        { const int dir = wave >> 2, w4 = wave & 3; LAS unsigned short* KT = KT0 + dir * 9216;
            unsigned char* CS = ws + (dir ? WS_HB : WS_HF) + ((size_t)bh * NCHK + c) * 16384;
            bf16x8v af[2][2];
#pragma unroll
            for (int m = 0; m < 2; ++m)
#pragma unroll
                for (int kk = 0; kk < 2; ++kk) af[m][kk] = *(const LAS bf16x8v*)(KT + swz72(32 * w4 + 8 * (r >> 2) + 4 * m + (r & 3), kk * 32 + 8 * g));
#pragma unroll
            for (int et = 0; et < 8; ++et) {
                const bf16x8v b0 = *(const LAS bf16x8v*)(VT + swz72(et * 16 + r, 8 * g)), b1 = *(const LAS bf16x8v*)(VT + swz72(et * 16 + r, 32 + 8 * g)); v2u o;
#pragma unroll
                for (int m = 0; m < 2; ++m) { f32x4 acc = {0.f, 0.f, 0.f, 0.f}; acc = MFMA16(af[m][0], b0, acc); acc = MFMA16(af[m][1], b1, acc);
                    const unsigned w8 = pg8::pk4_fp8(acc[0], acc[1], acc[2], acc[3]); if (m == 0) o.x = w8; else o.y = w8; }
                *(v2u*)(CS + (size_t)(et * 16 + r) * 128 + 32 * w4 + 8 * g) = o; }
        }
        if (tid < 256) { const int dir = tid >> 7, dd = tid & 127; const LAS unsigned short* kr = KT0 + dir * 9216 + dd * 72; float s = 0.f;
#pragma unroll
            for (int q = 0; q < 8; ++q) { const v4u w = *(const LAS v4u*)(kr + 8 * q); s += (bflo(w.x) + bfhi(w.x)) + (bflo(w.y) + bfhi(w.y)) + (bflo(w.z) + bfhi(w.z)) + (bflo(w.w) + bfhi(w.w)); }
            NS[((size_t)(dir * 16 + bh) * NCHK + c) * 128 + dd] = s * (1.0f / F8_ST); }
    }
}

__device__ __forceinline__ void mlstm_m2_phase(unsigned char* ws, int wg, int G, int tid) {
    for (int u = wg; u < 256; u += G) {
        const int seq = u >> 3, part = u & 7, dir = seq >> 4, bh = seq & 15;
        unsigned char* base = ws + (dir ? WS_HB : WS_HF) + (size_t)bh * NCHK * 16384 + part * 2048 + tid * 4;
        float* SC = (float*)(ws + WS_SC) + (size_t)(dir * 16 + bh) * NCHK * 4;
        float* NSb = (float*)(ws + WS_NS) + (size_t)(dir * 16 + bh) * NCHK * 128 + tid;
        const bool do_n = (part == 0 && tid < 128), do_m = (part == 0 && tid == 0);
        float s0 = 0.f, s1 = 0.f, s2 = 0.f, s3 = 0.f, m = -1e30f, ns = 0.f;
        unsigned dlA[12], dlB[12]; float totA[12], totB[12], mlA[12], mlB[12], dnA[12], dnB[12];
#define M2_CC(j_) (dir ? (NCHK - 1 - (j_)) : (((j_) + 128) % NCHK))
#define M2_LOAD(X_, j0_) { _Pragma("unroll") for (int q = 0; q < 12; ++q) { const int cq = M2_CC((j0_) + q); \
            dl##X_[q] = *(const unsigned*)(base + (size_t)cq * 16384); tot##X_[q] = SC[cq * 4]; ml##X_[q] = SC[cq * 4 + 1]; dn##X_[q] = 0.f; if (do_n) dn##X_[q] = NSb[(size_t)cq * 128]; } }
#define M2_PROC(X_, j0_) { _Pragma("unroll") for (int q = 0; q < 12; ++q) { const int cq = M2_CC((j0_) + q); \
            *(unsigned*)(base + (size_t)cq * 16384) = pg8::pk4_fp8(s0, s1, s2, s3); \
            if (do_n) NSb[(size_t)cq * 128] = ns; \
            if (do_m) SC[cq * 4 + 2] = m; \
            const float me = fmaxf(tot##X_[q] + m, ml##X_[q]), al = __expf(tot##X_[q] + m - me), be = __expf(ml##X_[q] - me); m = me; \
            const f32x2s dlo = __builtin_amdgcn_cvt_pk_f32_fp8((int)dl##X_[q], false), dhi = __builtin_amdgcn_cvt_pk_f32_fp8((int)dl##X_[q], true); \
            s0 = al * s0 + be * dlo.x; s1 = al * s1 + be * dlo.y; s2 = al * s2 + be * dhi.x; s3 = al * s3 + be * dhi.y; ns = ns * al + dn##X_[q] * be; } }
        M2_LOAD(A, 0)
#pragma unroll 1
        for (int j0 = 0; j0 < NCHK; j0 += 24) {
            if (j0 + 12 < NCHK) M2_LOAD(B, j0 + 12)
            M2_PROC(A, j0)
            if (j0 + 12 < NCHK) { if (j0 + 24 < NCHK) M2_LOAD(A, j0 + 24)
                M2_PROC(B, j0 + 12) }
        }
#undef M2_CC
#undef M2_LOAD
#undef M2_PROC
    }
}

struct M3Regs { v4u q[2], k[2], v[2]; float ga, gf, pm, mst; };
__device__ __forceinline__ void m3_issue(M3Regs& R, const bf16* P, const float* TKS, const float* SC, int task, int tid) {
    const int lane = tid & 63, wave = tid >> 6;
    const int bh = task / NCHK, c = task % NCHK, b = bh >> 2, h = bh & 3, rowbase = chunk_rowbase(b, c);
#pragma unroll
    for (int i2 = 0; i2 < 2; ++i2) { const int p = tid + NTHR * i2, s = p >> 4, dg = p & 15; const bf16* pr = P + (size_t)(rowbase + s) * PLD + h * 128 + dg * 8;
        R.q[i2] = *(const v4u*)(pr + PO_Q); R.k[i2] = *(const v4u*)(pr + PO_K); R.v[i2] = *(const v4u*)(pr + PO_V); }
    R.ga = 0.f; R.gf = 0.f; R.pm = 0.f; R.mst = 0.f;
    if (wave < 2) { const float* tk = TKS + ((size_t)(wave * 16 + bh) * NCHK + c) * 192 + lane; R.ga = tk[0]; R.gf = tk[64]; R.pm = tk[128]; R.mst = SC[((size_t)(wave * 16 + bh) * NCHK + c) * 4 + 2]; }
}
__device__ __forceinline__ void mlstm_m3_phase(const bf16* P, const float* Gt, const float* bg, const float* ngl, unsigned char* ws, bf16* Y, LAS unsigned char* lds, int nchunk, int wg, int G, int tid) {
    const int lane = tid & 63, wave = tid >> 6, r = lane & 15, g = lane >> 4;
    LAS unsigned short* Qs = (LAS unsigned short*)lds;
    LAS unsigned short* Ks = (LAS unsigned short*)(lds + 17408);
    LAS unsigned short* VT = (LAS unsigned short*)(lds + 34816);
    LAS unsigned short* CT = (LAS unsigned short*)(lds + 53248);
    LAS float* nsl = (LAS float*)(lds + 122880);
    LAS float* tok = (LAS float*)(lds + 123904);
    LAS float* dens = (LAS float*)(lds + 125952);
    LAS float* HS = (LAS float*)lds;
    const float* SC = (const float*)(ws + WS_SC); const float* NS = (const float*)(ws + WS_NS); const float* TKS = (const float*)(ws + WS_TKS);
    const int ntask = 16 * nchunk;
    if (wg >= ntask) return;
#define M3_TASK(t_) (((t_) / nchunk) * NCHK + ((t_) % nchunk))
    M3Regs R; m3_issue(R, P, TKS, SC, M3_TASK(wg), tid);
    for (int tt = wg; tt < ntask; tt += G) {
        const int task = M3_TASK(tt), bh = task / NCHK, c = task % NCHK, b = bh >> 2, h = bh & 3, rowbase = chunk_rowbase(b, c);
        __syncthreads();
        v4u cr[4]; float nsv0 = 0.f, nsv1 = 0.f;
#pragma unroll
        for (int i2 = 0; i2 < 4; ++i2) { const int p = tid + NTHR * i2, dir = p >> 10, e = (p >> 3) & 127, dg = p & 7;
            const unsigned char* CS = ws + (dir ? WS_HB : WS_HF) + ((size_t)bh * NCHK + c) * 16384; cr[i2] = *(const v4u*)(CS + e * 128 + dg * 16); }
        if (wave >= 2 && wave < 4) { const float* src = NS + ((size_t)((wave - 2) * 16 + bh) * NCHK + c) * 128; nsv0 = src[lane]; nsv1 = src[64 + lane]; }
        if (wave < 2) { const int dir = wave, tk = dir ? 63 - lane : lane;
            tok[dir * 256 + tk] = -fmaxf(R.mst, R.pm) * L2E; tok[dir * 256 + 64 + tk] = R.gf * L2E; tok[dir * 256 + 128 + tk] = R.ga * L2E; tok[dir * 256 + 192 + tk] = R.mst * L2E; }
#pragma unroll
        for (int i2 = 0; i2 < 2; ++i2) { const int p = tid + NTHR * i2, s = p >> 4, dg = p & 15;
            *(LAS v4u*)(Qs + s * 136 + dg * 8) = R.q[i2]; *(LAS v4u*)(Ks + s * 136 + dg * 8) = R.k[i2];
            const unsigned vv[4] = {R.v[i2].x, R.v[i2].y, R.v[i2].z, R.v[i2].w};
#pragma unroll
            for (int j = 0; j < 4; ++j) { const int d = dg * 8 + 2 * j; VT[swz72(d, s)] = (unsigned short)(vv[j] & 0xffffu); VT[swz72(d + 1, s)] = (unsigned short)(vv[j] >> 16); } }
        __syncthreads();
        const int rt = wave & 3, ch = wave >> 2;
        bf16x8v qf[4];
#pragma unroll
        for (int kk = 0; kk < 4; ++kk) qf[kk] = *(const LAS bf16x8v*)(Qs + (16 * rt + r) * 136 + 32 * kk + 8 * g);
        const int t = 16 * rt + r;
        const float uf = tok[t], ub = tok[256 + t], ufk = uf - 3.5f, ubk = ub - 3.5f;
        float dsf = 0.f, dsb = 0.f;
        f32x4 aPf[4], aPb[4];
#pragma unroll
        for (int ct = 0; ct < 4; ++ct) { const f32x4 z = {0.f, 0.f, 0.f, 0.f}; aPf[ct] = z; aPb[ct] = z; }
#pragma unroll 1
        for (int k2 = 0; k2 < 2; ++k2) { float vf[8], vb[8];
#pragma unroll
            for (int hh = 0; hh < 2; ++hh) { const int st = 2 * k2 + hh; f32x4 acc = {0.f, 0.f, 0.f, 0.f};
#pragma unroll
                for (int kk = 0; kk < 4; ++kk) { const bf16x8v a = *(const LAS bf16x8v*)(Ks + (16 * st + r) * 136 + 32 * kk + 8 * g); acc = MFMA16(a, qf[kk], acc); }
#pragma unroll
                for (int i = 0; i < 4; ++i) { const int s = 16 * st + 4 * g + i; const float sv = acc[i];
                    const float wf = (s <= t) ? __builtin_amdgcn_exp2f(ufk + tok[64 + s]) : 0.f, wb = (s >= t) ? __builtin_amdgcn_exp2f(ubk + tok[256 + 64 + s]) : 0.f;
                    vf[4 * hh + i] = sv * wf; vb[4 * hh + i] = sv * wb; dsf += vf[4 * hh + i]; dsb += vb[4 * hh + i]; } }
            const bf16x8v paf = pack8(vf), pab = pack8(vb);
#pragma unroll
            for (int ct = 0; ct < 4; ++ct) { const int e = 64 * ch + 16 * ct + r;
                const v2u lo = *(const LAS v2u*)(VT + swz72(e, 32 * k2 + 4 * g)), hi = *(const LAS v2u*)(VT + swz72(e, 32 * k2 + 16 + 4 * g));
                v4u bw; bw.x = lo.x; bw.y = lo.y; bw.z = hi.x; bw.w = hi.y; const bf16x8v bfr = __builtin_bit_cast(bf16x8v, bw);
                aPf[ct] = MFMA16(paf, bfr, aPf[ct]); aPb[ct] = MFMA16(pab, bfr, aPb[ct]); } }
#pragma unroll
        for (int i2 = 0; i2 < 4; ++i2) { const int p = tid + NTHR * i2, dir = p >> 10, e = (p >> 3) & 127, dg = p & 7;
            const unsigned cw[4] = {cr[i2].x, cr[i2].y, cr[i2].z, cr[i2].w}; unsigned ob[8];
#pragma unroll
            for (int j = 0; j < 4; ++j) { ob[2 * j] = __builtin_bit_cast(unsigned, __builtin_amdgcn_cvt_scalef32_pk_bf16_fp8(cw[j], 1.0f, false)); ob[2 * j + 1] = __builtin_bit_cast(unsigned, __builtin_amdgcn_cvt_scalef32_pk_bf16_fp8(cw[j], 1.0f, true)); }
            v4u o0, o1; o0.x = ob[0]; o0.y = ob[1]; o0.z = ob[2]; o0.w = ob[3]; o1.x = ob[4]; o1.y = ob[5]; o1.z = ob[6]; o1.w = ob[7];
            *(LAS v4u*)(CT + dir * 17408 + e * 136 + dg * 16) = o0; *(LAS v4u*)(CT + dir * 17408 + e * 136 + dg * 16 + 8) = o1; }
        if (wave >= 2 && wave < 4) { nsl[2 * lane + (wave - 2)] = nsv0; nsl[2 * (64 + lane) + (wave - 2)] = nsv1; }
        __syncthreads();
        v4u ocur[2];
#pragma unroll
        for (int i2 = 0; i2 < 2; ++i2) { const int p = tid + NTHR * i2, s = p >> 4, dg = p & 15; ocur[i2] = *(const v4u*)(P + (size_t)(rowbase + s) * PLD + PO_O + h * 128 + dg * 8); }
        if (tt + G < ntask) m3_issue(R, P, TKS, SC, M3_TASK(tt + G), tid);
        f32x2s qn2 = {0.f, 0.f};
#pragma unroll
        for (int kk = 0; kk < 4; ++kk)
#pragma unroll
            for (int i = 0; i < 8; ++i) { const float qv = bf2f((unsigned short)qf[kk][i]); const f32x2s qq = {qv, qv}; qn2 += qq * *(const LAS f32x2s*)(nsl + 2 * (32 * kk + 8 * g + i)); }
        float qnf = qn2.x, qnb = qn2.y;
        dsf += __shfl_xor(dsf, 16); dsf += __shfl_xor(dsf, 32); dsb += __shfl_xor(dsb, 16); dsb += __shfl_xor(dsb, 32);
        qnf += __shfl_xor(qnf, 16); qnf += __shfl_xor(qnf, 32); qnb += __shfl_xor(qnb, 16); qnb += __shfl_xor(qnb, 32);
        if (g == 0) { dens[(wave * 2 + 0) * 16 + r] = dsf + __builtin_amdgcn_exp2f(uf + tok[192 + t]) * qnf; dens[(wave * 2 + 1) * 16 + r] = dsb + __builtin_amdgcn_exp2f(ub + tok[256 + 192 + t]) * qnb; }
        LDS_WAIT();
        f32x4 intf, intb, rdf, rdb;
#pragma unroll
        for (int i = 0; i < 4; ++i) { const int tr = 16 * rt + 4 * g + i, tl = 4 * g + i;
            const float u0 = tok[tr], u1 = tok[256 + tr];
            intf[i] = __builtin_amdgcn_exp2f(u0 + tok[192 + tr]) * (1.0f / F8_ST); intb[i] = __builtin_amdgcn_exp2f(u1 + tok[256 + 192 + tr]) * (1.0f / F8_ST);
            rdf[i] = __builtin_amdgcn_rcpf(fmaxf(fabsf(dens[(wave * 2 + 0) * 16 + tl]), __builtin_amdgcn_exp2f(u0 - tok[128 + tr]))); rdb[i] = __builtin_amdgcn_rcpf(fmaxf(fabsf(dens[(wave * 2 + 1) * 16 + tl]), __builtin_amdgcn_exp2f(u1 - tok[256 + 128 + tr]))); }
#pragma unroll
        for (int ct = 0; ct < 4; ++ct) { const int e0 = 64 * ch + 16 * ct; f32x4 aCf = {0.f, 0.f, 0.f, 0.f}, aCb = aCf;
#pragma unroll
            for (int kk = 0; kk < 4; ++kk) { const bf16x8v cf = *(const LAS bf16x8v*)(CT + (e0 + r) * 136 + 32 * kk + 8 * g), cb = *(const LAS bf16x8v*)(CT + 17408 + (e0 + r) * 136 + 32 * kk + 8 * g);
                aCf = MFMA16(qf[kk], cf, aCf); aCb = MFMA16(qf[kk], cb, aCb); }
            const f32x4 hv = (aPf[ct] + intf * aCf) * rdf + (aPb[ct] + intb * aCb) * rdb;
#pragma unroll
            for (int i = 0; i < 4; ++i) HS[(16 * rt + 4 * g + i) * 132 + e0 + r] = hv[i]; }
        __syncthreads();
#pragma unroll
        for (int i2 = 0; i2 < 2; ++i2) { const int p = tid + NTHR * i2, tk = p >> 4, c8 = p & 15;
            const f32x4 h0 = *(const LAS f32x4*)(HS + tk * 132 + 8 * c8), h1 = *(const LAS f32x4*)(HS + tk * 132 + 8 * c8 + 4);
            const f32x4 sq = h0 * h0 + h1 * h1; float ss = (sq.x + sq.y) + (sq.z + sq.w);
            ss = row16_sum(ss);
            const float rstd = __builtin_amdgcn_rsqf(ss * (1.0f / 128.0f) + EPS);
            const f32x4 g0 = *(const f32x4*)(ngl + h * 128 + 8 * c8), g1 = *(const f32x4*)(ngl + h * 128 + 8 * c8 + 4); const v4u o = ocur[i2];
            const f32x4 s0 = {sigmoid_f(bflo(o.x)), sigmoid_f(bfhi(o.x)), sigmoid_f(bflo(o.y)), sigmoid_f(bfhi(o.y))}, s1 = {sigmoid_f(bflo(o.z)), sigmoid_f(bfhi(o.z)), sigmoid_f(bflo(o.w)), sigmoid_f(bfhi(o.w))};
            const f32x4 y0 = s0 * h0 * (g0 * rstd), y1 = s1 * h1 * (g1 * rstd);
            v4u w; w.x = pk2(y0.x, y0.y); w.y = pk2(y0.z, y0.w); w.z = pk2(y1.x, y1.y); w.w = pk2(y1.z, y1.w);
            *(v4u*)(Y + (size_t)(rowbase + tk) * D + h * 128 + 8 * c8) = w; }
    }
#undef M3_TASK
}

struct ConvRegs { v4u u[6], g[6]; };
__device__ __forceinline__ void conv_issue(ConvRegs& R, const bf16* P, int task_, bool ctx_unused, int tid) {
    (void)ctx_unused; const bool ctx = task_ >= 512; const int task = ctx ? task_ - 512 : task_;
    const int N = ctx ? CTXL : SEQ, ntile = N / 64, b = task / ntile, t0 = (task % ntile) * 64, rowbase = ctx ? NLAT + b * CTXL : b * SEQ;
#pragma unroll
    for (int k = 0; k < 6; ++k) { const int p = tid + NTHR * k, rr = p >> 5, cg = p & 31, t = t0 - 15 + rr; const v4u z = {0u, 0u, 0u, 0u}; R.u[k] = z; R.g[k] = z;
        if (rr < 94 && t >= 0 && t < N) { const bf16* pr = P + (size_t)(rowbase + t) * PLD; R.u[k] = *(const v4u*)(pr + PO_CU + 8 * cg); R.g[k] = *(const v4u*)(pr + PO_CG + 8 * cg); } }
}
__device__ __forceinline__ void conv_phase(const bf16* P, bf16* Y, const float* dw, const float* db, const float* lg, const float* lb, LAS unsigned char* lds, int ntask, bool ctx, int wg, int G, int tid) {
    const int lane = tid & 63, wave = tid >> 6;
    (void)ctx;
    LAS float* a = (LAS float*)lds;
    const int grp = wave & 3, th = wave >> 2, ch = grp * 64 + lane;
    if (wg >= ntask) return;
    typedef float f2c __attribute__((ext_vector_type(2)));
    f2c wp[32];
#pragma unroll
    for (int k = 0; k < 32; ++k) { wp[k].x = k < 31 ? dw[k * 256 + ch] : 0.f; wp[k].y = k > 0 ? dw[(k - 1) * 256 + ch] : 0.f; }
    const float bias = db[ch], gam = lg[ch], bet = lb[ch];
    ConvRegs R; conv_issue(R, P, wg, ctx, tid);
    for (int task = wg; task < ntask; task += G) {
        const bool cx = task >= 512; const int tk = cx ? task - 512 : task, ntile = (cx ? CTXL : SEQ) / 64; const int b = tk / ntile, t0 = (tk % ntile) * 64, rowbase = cx ? NLAT + b * CTXL : b * SEQ;
        __syncthreads();
#pragma unroll
        for (int k = 0; k < 6; ++k) { const int p = tid + NTHR * k, rr = p >> 5, cg = p & 31; const v4u u = R.u[k], gq = R.g[k]; f32x4 o0, o1;
            o0.x = bflo(u.x) * sigmoid_f(bflo(gq.x)); o0.y = bfhi(u.x) * sigmoid_f(bfhi(gq.x)); o0.z = bflo(u.y) * sigmoid_f(bflo(gq.y)); o0.w = bfhi(u.y) * sigmoid_f(bfhi(gq.y));
            o1.x = bflo(u.z) * sigmoid_f(bflo(gq.z)); o1.y = bfhi(u.z) * sigmoid_f(bfhi(gq.z)); o1.z = bflo(u.w) * sigmoid_f(bflo(gq.w)); o1.w = bfhi(u.w) * sigmoid_f(bfhi(gq.w));
            if (rr < 94) { *(LAS f32x4*)(a + rr * 256 + 8 * cg) = o0; *(LAS f32x4*)(a + rr * 256 + 8 * cg + 4) = o1; } }
        __syncthreads();
        if (task + G < ntask) conv_issue(R, P, task + G, ctx, tid);
        f2c acc2[16];
#pragma unroll
        for (int p = 0; p < 16; ++p) acc2[p] = (f2c){bias, bias};
        float vq[4];
#pragma unroll
        for (int j = 0; j < 4; ++j) vq[j] = a[(th * 32 + j) * 256 + ch];
#pragma unroll
        for (int j = 0; j < 62; ++j) { const float v = vq[j & 3]; const f2c vv = {v, v};
            if (j + 4 < 62) vq[j & 3] = a[(th * 32 + j + 4) * 256 + ch];
#pragma unroll
            for (int p = 0; p < 16; ++p) if (j - 2 * p >= 0 && j - 2 * p <= 31) acc2[p] += vv * wp[j - 2 * p];
            asm volatile("" ::: "memory"); }
        __syncthreads();
        LAS float* S = (LAS float*)lds + wave * (32 * 65 + 64); LAS float* St = S + 32 * 65;
#pragma unroll
        for (int p = 0; p < 16; ++p) { S[(2 * p) * 65 + lane] = acc2[p].x; S[(2 * p + 1) * 65 + lane] = acc2[p].y; }
        LDS_WAIT();
        { const int tt = lane & 31, c0 = (lane >> 5) * 32; float s1 = 0.f, s2 = 0.f;
#pragma unroll
            for (int c = 0; c < 32; ++c) { const float x = S[tt * 65 + c0 + c]; s1 += x; s2 += x * x; }
            s1 += __shfl_xor(s1, 32); s2 += __shfl_xor(s2, 32);
            const float mu = s1 * (1.0f / 64.0f), var = fmaxf(s2 * (1.0f / 64.0f) - mu * mu, 0.f);
            if (lane < 32) { St[tt] = mu; St[32 + tt] = __builtin_amdgcn_rsqf(var + EPS); } }
        LDS_WAIT();
#pragma unroll
        for (int t = 0; t < 32; ++t) { const float x = (t & 1) ? acc2[t >> 1].y : acc2[t >> 1].x;
            const float yn = (x - St[t]) * St[32 + t] * gam + bet;
            Y[(size_t)(rowbase + t0 + th * 32 + t) * D + 768 + ch] = (bf16)f2bf(silu_f(yn)); }
    }
}

__device__ __forceinline__ void sincos_rev(float rev, float* s, float* c) { *s = __builtin_amdgcn_sinf(rev); *c = __builtin_amdgcn_cosf(rev); }
constexpr size_t WS_FA = WS_A;
__device__ __forceinline__ void fourier_a_phase(const bf16* P, bf16* FA, LAS unsigned char* lds, int wg, int G, int tid) {
    const int lane = tid & 63, wave = tid >> 6, r = lane & 15, g = lane >> 4;
    LAS unsigned short* ZT = (LAS unsigned short*)lds;
    bf16x8v cfr[4], nsfr[4];
    { const int k1 = 16 * wave + r;
#pragma unroll
        for (int kk = 0; kk < 4; ++kk) { float cv[8], sv[8];
#pragma unroll
            for (int i = 0; i < 8; ++i) { const int n1 = 32 * kk + 8 * g + i; float s, c; sincos_rev((float)((k1 * n1) & 127) * (1.0f / 128.0f), &s, &c); cv[i] = c; sv[i] = -s; }
            cfr[kk] = pack8(cv); nsfr[kk] = pack8(sv); } }
    if (wg >= 16 * 64) return;
    v4u zr[2];
#define FA_ISSUE(task_) do { const int bg_ = (task_) >> 6, n2_ = (task_) & 63, b_ = bg_ >> 2, g4_ = bg_ & 3; _Pragma("unroll") for (int i2 = 0; i2 < 2; ++i2) { const int p = tid + NTHR * i2, n1 = p >> 3, cg = p & 7; \
        zr[i2] = *(const v4u*)(P + (size_t)(b_ * SEQ + 64 * n1 + n2_) * PLD + PO_F + 64 * g4_ + 8 * cg); } } while (0)
    FA_ISSUE(wg);
    for (int task = wg; task < 16 * 64; task += G) {
        const int bg = task >> 6, n2 = task & 63;
        __syncthreads();
#pragma unroll
        for (int i2 = 0; i2 < 2; ++i2) { const int p = tid + NTHR * i2, n1 = p >> 3, cg = p & 7; const unsigned zz[4] = {zr[i2].x, zr[i2].y, zr[i2].z, zr[i2].w};
#pragma unroll
            for (int j = 0; j < 4; ++j) { const int c0 = 8 * cg + 2 * j; const int blk = (((n1 >> 3) ^ cg) << 3) + (n1 & 7);
                ZT[c0 * 136 + blk] = (unsigned short)(zz[j] & 0xffffu); ZT[(c0 + 1) * 136 + blk] = (unsigned short)(zz[j] >> 16); } }
        __syncthreads();
        if (task + G < 16 * 64) FA_ISSUE(task + G);
        const int k1 = 16 * wave + r; float tc, ts; sincos_rev((float)(n2 * k1) * (1.0f / 8192.0f), &ts, &tc);
        bf16* dst = FA + ((size_t)(bg * 128 + k1) * 2) * 4096 + n2 * 64;
        if (wave < 5)
#pragma unroll
        for (int ct = 0; ct < 4; ++ct) { f32x4 aR = {0.f, 0.f, 0.f, 0.f}, aI = aR;
#pragma unroll
            for (int kk = 0; kk < 4; ++kk) { const bf16x8v a = *(const LAS bf16x8v*)(ZT + (16 * ct + r) * 136 + (((4 * kk + g) ^ ((2 * ct + (r >> 3)) & 7)) << 3)); aR = MFMA16(a, cfr[kk], aR); aI = MFMA16(a, nsfr[kk], aI); }
            v2u oR, oI; oR.x = pk2(aR[0] * tc + aI[0] * ts, aR[1] * tc + aI[1] * ts); oR.y = pk2(aR[2] * tc + aI[2] * ts, aR[3] * tc + aI[3] * ts);
            oI.x = pk2(aI[0] * tc - aR[0] * ts, aI[1] * tc - aR[1] * ts); oI.y = pk2(aI[2] * tc - aR[2] * ts, aI[3] * tc - aR[3] * ts);
            if (k1 <= 64) { *(v2u*)(dst + 16 * ct + 4 * g) = oR; *(v2u*)(dst + 4096 + 16 * ct + 4 * g) = oI; } }
    }
}
__device__ __forceinline__ void fourier_b_phase(const bf16* FA, bf16* Y, LAS unsigned char* lds, int wg, int G, int tid) {
    const int lane = tid & 63, wave = tid >> 6, r = lane & 15, g = lane >> 4, kt = wave & 3, kh = wave >> 2;
    LAS unsigned short* Ms = (LAS unsigned short*)lds;
    LAS unsigned short* Ys = (LAS unsigned short*)(lds + 32768);
    bf16x8v Cf[2], Sf[2], NSf[2], C2[2][2], S2[2][2];
    { const int kc = 16 * kt + r;
#pragma unroll
        for (int kk = 0; kk < 2; ++kk) { float cv[8], sv[8], nv[8];
#pragma unroll
            for (int i = 0; i < 8; ++i) { const int c = 32 * kk + 8 * g + i; float s, co; sincos_rev((float)((kc * c) & 63) * (1.0f / 64.0f), &s, &co); cv[i] = co; sv[i] = s; nv[i] = -s; }
            Cf[kk] = pack8(cv); Sf[kk] = pack8(sv); NSf[kk] = pack8(nv); }
#pragma unroll
        for (int m = 0; m < 2; ++m) { const int k2 = 16 * (2 * kh + m) + r;
#pragma unroll
            for (int kk = 0; kk < 2; ++kk) { float cv[8], sv[8];
#pragma unroll
                for (int i = 0; i < 8; ++i) { const int n2 = 32 * kk + 16 * (i >> 2) + 4 * g + (i & 3); float s, co; sincos_rev((float)((k2 * n2) & 63) * (1.0f / 64.0f), &s, &co); cv[i] = co; sv[i] = s; }
                C2[m][kk] = pack8(cv); S2[m][kk] = pack8(sv); } } }
    const float scale = 1.0f / sqrtf(8192.0f * 64.0f);
    if (wg >= 16 * 65) return;
    v4u mr[2];
#define FB_ISSUE(task_) do { const bf16* src_ = FA + (size_t)(((task_) / 65) * 128 + (task_) % 65) * 8192; _Pragma("unroll") for (int i2 = 0; i2 < 2; ++i2) { const int p = tid + NTHR * i2; mr[i2] = *(const v4u*)(src_ + 8 * p); } } while (0)
    FB_ISSUE(wg);
    for (int task = wg; task < 16 * 65; task += G) {
        const int bg = task / 65, k1 = task % 65, b = bg >> 2, g4 = bg & 3;
        __syncthreads();
#pragma unroll
        for (int i2 = 0; i2 < 2; ++i2) { const int p = tid + NTHR * i2, plane = p >> 9, n2 = (p >> 3) & 63, cg = p & 7; *(LAS v4u*)(Ms + plane * 4608 + n2 * 72 + 8 * cg) = mr[i2]; }
        __syncthreads();
        if (task + G < 16 * 65) FB_ISSUE(task + G);
        f32x4 tre[4], tim[4];
#pragma unroll
        for (int nt = 0; nt < 4; ++nt) { f32x4 a = {0.f, 0.f, 0.f, 0.f}, bq = a;
#pragma unroll
            for (int kk = 0; kk < 2; ++kk) { const bf16x8v are = *(const LAS bf16x8v*)(Ms + (16 * nt + r) * 72 + 32 * kk + 8 * g), aim = *(const LAS bf16x8v*)(Ms + 4608 + (16 * nt + r) * 72 + 32 * kk + 8 * g);
                a = MFMA16(are, Cf[kk], a); a = MFMA16(aim, Sf[kk], a); bq = MFMA16(aim, Cf[kk], bq); bq = MFMA16(are, NSf[kk], bq); }
            tre[nt] = a; tim[nt] = bq; }
        bf16x8v bre[2], bim[2];
#pragma unroll
        for (int kk = 0; kk < 2; ++kk) { const float v0[8] = {tre[2 * kk][0], tre[2 * kk][1], tre[2 * kk][2], tre[2 * kk][3], tre[2 * kk + 1][0], tre[2 * kk + 1][1], tre[2 * kk + 1][2], tre[2 * kk + 1][3]};
            const float v1[8] = {tim[2 * kk][0], tim[2 * kk][1], tim[2 * kk][2], tim[2 * kk][3], tim[2 * kk + 1][0], tim[2 * kk + 1][1], tim[2 * kk + 1][2], tim[2 * kk + 1][3]};
            bre[kk] = pack8(v0); bim[kk] = pack8(v1); }
#pragma unroll
        for (int m = 0; m < 2; ++m) { f32x4 y = {0.f, 0.f, 0.f, 0.f};
#pragma unroll
            for (int kk = 0; kk < 2; ++kk) { y = MFMA16(C2[m][kk], bre[kk], y); y = MFMA16(S2[m][kk], bim[kk], y); }
#pragma unroll
            for (int i = 0; i < 4; ++i) { const int k2 = 16 * (2 * kh + m) + 4 * g + i; Ys[k2 * 72 + 16 * kt + r] = (unsigned short)f2bf(y[i] * scale); } }
        __syncthreads();
        { const int row = tid >> 3, ch = tid & 7;
            *(v4u*)(Y + (size_t)(b * SEQ + k1 + 128 * row) * D + 512 + 64 * g4 + 8 * ch) = *(const LAS v4u*)(Ys + row * 72 + 8 * ch);
            if (k1 != 0 && k1 != 64) {
                const LAS unsigned short* sr = Ys + (63 - row) * 72; unsigned short e[8];
#pragma unroll
                for (int j = 0; j < 8; ++j) e[j] = sr[(64 - (8 * ch + j)) & 63];
                v4u w; w.x = (unsigned)e[0] | ((unsigned)e[1] << 16); w.y = (unsigned)e[2] | ((unsigned)e[3] << 16); w.z = (unsigned)e[4] | ((unsigned)e[5] << 16); w.w = (unsigned)e[6] | ((unsigned)e[7] << 16);
                *(v4u*)(Y + (size_t)(b * SEQ + (128 - k1) + 128 * row) * D + 512 + 64 * g4 + 8 * ch) = w; } }
    }
}

__device__ __forceinline__ void mix_a_phase(const float* const* in, unsigned char* ws, int L, bool do_ctx, LAS unsigned char* lds, int wg, int G, int tid) {
    const bf16* P = (const bf16*)(ws + WS_P); bf16* Y = (bf16*)(ws + WS_Y);
#ifndef SUBDUP
#define SUBDUP 0
#endif
    _Pragma("unroll") for (int rep_ = 0; rep_ < ((SUBDUP & 1) ? 2 : 1); ++rep_) mlstm_m1_phase(P, (const float*)(ws + WS_GW), in[9] + L * 16, ws, lds, 16 * NCHK, wg, G, tid);
    _Pragma("unroll") for (int rep_ = 0; rep_ < ((SUBDUP & 2) ? 2 : 1); ++rep_) fourier_a_phase(P, (bf16*)(ws + WS_FA), lds, wg, G, tid);
    if (do_ctx) {
        __syncthreads();
        { LAS f32x2* tab = (LAS f32x2*)lds; for (int i = tid; i < 8192; i += NTHR) { float s, c; sincos_rev((float)i * (1.0f / 8192.0f), &s, &c); tab[i] = (f32x2){c, s}; } }
        __syncthreads();
        for (int t = wg; t < 16 * 4 * 4; t += G) fourier_ctx_task(P, Y, lds, t, tid);
    }
    _Pragma("unroll") for (int rep_ = 0; rep_ < ((SUBDUP & 4) ? 2 : 1); ++rep_) conv_phase(P, Y, in[11] + L * 31 * 256, in[12] + L * 256, in[13] + L * 256, in[14] + L * 256, lds, do_ctx ? 4 * 128 + 4 * 4 : 4 * 128, false, wg, G, tid);
}

constexpr int NPH = 21;
constexpr int GU_SPLIT = 9000;
#ifndef MK_SINGLE
#define MK_SINGLE 1
#endif
struct Params { const float* in[23]; float* out; unsigned char* ws; int ph_lo, ph_hi; };
static_assert(sizeof(Params) == 23 * 8 + 8 + 8 + 8, "Params has no padding");

__global__ void __launch_bounds__(NTHR, 2) fwd_kernel(Params p) {
    extern __shared__ __attribute__((aligned(16))) unsigned char lds_raw[];
    LAS unsigned char* lds = (LAS unsigned char*)lds_raw;
    const int wg = blockIdx.x, G = gridDim.x;
    const int wave_s = __builtin_amdgcn_readfirstlane((int)(threadIdx.x >> 6));
#define FRESH_TID() ([&]() { int w_ = wave_s; asm volatile("" : "+s"(w_)); __builtin_assume(w_ >= 0 && w_ < 8); const int l_ = (int)__builtin_amdgcn_mbcnt_hi(~0u, __builtin_amdgcn_mbcnt_lo(~0u, 0u)); __builtin_assume(l_ >= 0 && l_ < 64); return w_ * 64 + l_; }())
    unsigned char* ws = p.ws;
    const float* const* in = p.in;
    for (int u = (int)threadIdx.x; u < (LDS_BYTES - LDSCTL_OFF) / 4; u += NTHR) ((LAS unsigned*)(lds + LDSCTL_OFF))[u] = 0u;
    __syncthreads();
    if (threadIdx.x == 0) { const unsigned xq = xb_xcc_id() & 7u; ((volatile LAS unsigned*)(lds + LDSCTL_OFF + 128))[0] = xq; ((volatile LAS unsigned*)(lds + LDSCTL_OFF + 128))[1] = xb_add((unsigned*)(ws + WS_CTL) + 64 * xq, 1u); }
    __syncthreads();
    XcdBarrier bar; bar.bar = (unsigned*)(ws + WS_CTL) + CW_BAR; bar.x = 0; bar.st = (volatile LAS unsigned*)(lds + LDSCTL_OFF + 64);
    if (MK_SINGLE) bar = xcd_barrier_post((unsigned*)(ws + WS_CTL) + CW_BAR, (volatile LAS unsigned*)(lds + LDSCTL_OFF + 64));
    const int lo = p.ph_lo, hi = p.ph_hi;
#ifndef PH_MASK
#define PH_MASK 0xFFFFFFFFu
#endif
#define IN(k) (((PH_MASK >> (k)) & 1u) && lo <= (k) && (k) < hi)
#ifndef DUP_MASK
#define DUP_MASK 0u
#endif
#define REP(k) _Pragma("unroll") for (int rep_ = 0; rep_ < ((((DUP_MASK) >> (k)) & 1u) ? 2 : 1); ++rep_)
#define ORDER_ID() ([&]() { const unsigned* cw_ = (const unsigned*)(ws + WS_CTL); bool ok_ = (G % 8) == 0; _Pragma("unroll") for (int j_ = 0; j_ < 8; ++j_) ok_ = ok_ && (xb_ld((unsigned*)cw_ + 64 * j_) == (unsigned)(G / 8)); \
        const unsigned xq_ = ((volatile LAS unsigned*)(lds + LDSCTL_OFF + 128))[0], rk_ = ((volatile LAS unsigned*)(lds + LDSCTL_OFF + 128))[1]; return __builtin_amdgcn_readfirstlane(ok_ ? (int)(xq_ + 8u * rk_) : wg); }())
#define SEAM(k) do { if (MK_SINGLE && IN((k) + 1)) xcd_barrier(bar, FRESH_TID()); } while (0)
#ifndef DEPHASE_Q
#define DEPHASE_Q 0
#endif
#define DEPHASE(K_) do { if (DEPHASE_Q) { const unsigned long long t0_ = __builtin_amdgcn_s_memrealtime(); const unsigned long long d_ = (unsigned long long)((wg >> 3) & 3) * (unsigned long long)(DEPHASE_Q * (K_) / 1024); while (__builtin_amdgcn_s_memrealtime() - t0_ < d_) __builtin_amdgcn_s_sleep(8); } } while (0)
#define MOD ((const float*)(ws + WS_MOD))
#define A ((bf16*)(ws + WS_A))
#define Pb ((bf16*)(ws + WS_P))
#define Yb ((bf16*)(ws + WS_Y))
#define Hb ((bf16*)(ws + WS_H))
#define Gt ((float*)(ws + WS_G))
#define XC ((float*)(ws + WS_XC))
#define XB ((bf16*)(ws + WS_XB))
#define XCB ((bf16*)(ws + WS_XCB))
#define HF ((float*)(ws + WS_HF))
#define HB ((float*)(ws + WS_HB))
#define rw ((int*)(ws + WS_ROUTE))
#define tok_e ((int*)(ws + WS_TOK))
#define tok_w ((float*)(ws + WS_TOK + 256 * 1024))
#define pair_pos ((int*)(ws + WS_TOK + 512 * 1024))
#define row_w ((float*)(ws + WS_TOK + 768 * 1024))
#define MOD1 (MOD + 5 * 6144)

    if (IN(0)) { const int tid = FRESH_TID(); REP(0) { if (rep_) __syncthreads(); prologue_phase(in, ws, lds, wg, G, tid); } SEAM(0); }
#if defined(BARDUP) && BARDUP
    if (MK_SINGLE && IN(1)) { _Pragma("unroll 1") for (int q_ = 0; q_ < BARDUP; ++q_) xcd_barrier(bar, FRESH_TID()); }
#endif
    if (IN(1)) { const int tid = FRESH_TID(); REP(1) { if (rep_) __syncthreads(); norm_phase<false>(in[0], in[2], true, in[4], MOD, 0, A, nullptr, nullptr, nullptr, nullptr, nullptr, lds, wg, G, tid); } SEAM(1); }
    if (IN(2)) { const int tid = FRESH_TID(); REP(2) { if (rep_) __syncthreads(); DEPHASE(D); pg8::Gemm g{A, (const bf16*)(ws + WS_WIN), MROWS, 2816, D}; pg8::StaticOrder S; S.init(MROWS, 2816, G, ORDER_ID()); pg8::EpiP E{Pb, Gt};
        pg8::gemm_phase<pg8::EpiP, pg8::StaticOrder, true, true>(lds, g, S, E, tid);
        { const int nu = (MROWS / 256) * 11, busy = nu % G; if (busy == 0) gate_proj_tasks(A, (const bf16*)(ws + WS_WIN), in[9], ws, lds, ORDER_ID(), G, tid); else if (ORDER_ID() >= busy) gate_proj_tasks(A, (const bf16*)(ws + WS_WIN), in[9], ws, lds, ORDER_ID() - busy, G - busy, tid); }
        } SEAM(2); }
    if (IN(3)) { const int tid = FRESH_TID(); REP(3) { if (rep_) __syncthreads(); mix_a_phase(in, ws, 0, true, lds, wg, G, tid); } SEAM(3); }
    if (IN(4)) { const int tid = FRESH_TID(); REP(4) { if (rep_) __syncthreads(); mlstm_m2_phase(ws, wg, G, tid); REP(21) { if (rep_) __syncthreads(); fourier_b_phase((const bf16*)(ws + WS_FA), Yb, lds, wg, G, tid); } } SEAM(4); }
    if (IN(5)) { const int tid = FRESH_TID(); REP(5) { if (rep_) __syncthreads(); mlstm_m3_phase(Pb, Gt, in[9], in[10], ws, Yb, lds, NCHK, wg, G, tid); } SEAM(5); }
    if (IN(6)) { const int tid = FRESH_TID(); REP(6) { if (rep_) __syncthreads(); DEPHASE(D); pg8::Gemm g{Yb, (const bf16*)(ws + WS_WOUT), MROWS, D, D}; pg8::StaticOrder S; S.init(MROWS, D, G, ORDER_ID()); pg8::EpiResB<true> E{in[0], XB, in[2], XCB, MOD + 2 * D, 1.0f};
        pg8::gemm_phase<pg8::EpiResB<true>, pg8::StaticOrder, true, true>(lds, g, S, E, tid);
        if (G == 256) { if (ORDER_ID() >= 16) moe_convert_items(in, ws, lds, 0, ORDER_ID() - 16, G - 16, tid); } else moe_convert_items(in, ws, lds, 0, wg, G, tid); } SEAM(6); }
    if (IN(7)) { const int tid = FRESH_TID(); REP(7) { if (rep_) __syncthreads(); norm_phase<false, false, true>(XB, XCB, true, in[5], MOD, 3, A, nullptr, nullptr, nullptr, nullptr, nullptr, lds, wg, G, tid); } SEAM(7); }
    if (IN(8)) { const int tid = FRESH_TID(); REP(8) { if (rep_) __syncthreads(); DEPHASE(D); pg8::Gemm g{A, (const bf16*)(ws + WS_WGU), MROWS, 2 * FFH, D}; pg8::StaticOrder S; S.init(MROWS, 2 * FFH, G, ORDER_ID()); pg8::EpiSwigluToF8 E{(unsigned char*)(ws + WS_H)};
        pg8::gemm_phase<pg8::EpiSwigluToF8, pg8::StaticOrder, true, true>(lds, g, S, E, tid);
        if (G == 256 && ORDER_ID() >= 88) moe_convert_items(in, ws, lds, 1, ORDER_ID() - 88, G - 88, tid, 0, GU_SPLIT); } SEAM(8); }
    if (IN(9)) { const int tid = FRESH_TID(); REP(9) { if (rep_) __syncthreads(); DEPHASE(FFH); pg8::Gemm g{Hb, (const bf16*)(ws + WS_WD), MROWS, D, FFH / 2}; pg8::StaticOrder S; S.init(MROWS, D, G, ORDER_ID()); pg8::EpiResB<false> E{XB, XB, XCB, XCB, MOD + 5 * D, 1.0f / (pg8::F8_SH * pg8::F8_SWD)};
        pg8::gemm_phase<pg8::EpiResB<false>, pg8::StaticOrder, true, true, true>(lds, g, S, E, tid);
        if (G == 256) { if (ORDER_ID() >= 16) moe_convert_items(in, ws, lds, 1, ORDER_ID() - 16, G - 16, tid, GU_SPLIT); } else moe_convert_items(in, ws, lds, 1, wg, G, tid); } SEAM(9); }
    if (IN(10)) { const int tid = FRESH_TID(); REP(10) { if (rep_) __syncthreads(); norm_phase<false, false, true>(XB, XCB, true, in[4] + D, MOD1, 0, A, nullptr, nullptr, nullptr, nullptr, nullptr, lds, wg, G, tid); } SEAM(10); }
    if (IN(11)) { const int tid = FRESH_TID(); REP(11) { if (rep_) __syncthreads(); DEPHASE(D); pg8::Gemm g{A, (const bf16*)(ws + WS_WIN) + (size_t)PLD * D, MROWS, 2816, D}; pg8::StaticOrder S; S.init(MROWS, 2816, G, ORDER_ID()); pg8::EpiP E{Pb, Gt};
        pg8::gemm_phase<pg8::EpiP, pg8::StaticOrder, true, true>(lds, g, S, E, tid);
        { const int nu = (MROWS / 256) * 11, busy = nu % G; if (busy == 0) gate_proj_tasks(A, (const bf16*)(ws + WS_WIN) + (size_t)PLD * D, in[9] + 16, ws, lds, ORDER_ID(), G, tid); else if (ORDER_ID() >= busy) gate_proj_tasks(A, (const bf16*)(ws + WS_WIN) + (size_t)PLD * D, in[9] + 16, ws, lds, ORDER_ID() - busy, G - busy, tid); } } SEAM(11); }
    if (IN(12)) { const int tid = FRESH_TID(); REP(12) { if (rep_) __syncthreads(); mix_a_phase(in, ws, 1, false, lds, wg, G, tid); } SEAM(12); }
    if (IN(13)) { const int tid = FRESH_TID(); REP(13) { if (rep_) __syncthreads(); mlstm_m2_phase(ws, wg, G, tid); REP(21) { if (rep_) __syncthreads(); fourier_b_phase((const bf16*)(ws + WS_FA), Yb, lds, wg, G, tid); } } SEAM(13); }
    if (IN(14)) { const int tid = FRESH_TID(); REP(14) { if (rep_) __syncthreads(); mlstm_m3_phase(Pb, Gt, in[9] + 16, in[10] + 512, ws, Yb, lds, 128, wg, G, tid); } SEAM(14); }
    if (IN(15)) { const int tid = FRESH_TID(); REP(15) { if (rep_) __syncthreads(); DEPHASE(D); pg8::Gemm g{Yb, (const bf16*)(ws + WS_WOUT) + (size_t)D * D, NLAT, D, D}; pg8::StaticOrder S; S.init(NLAT, D, G, ORDER_ID()); pg8::EpiResB<false> E{XB, XB, XCB, XCB, MOD1 + 2 * D, 1.0f};
        pg8::gemm_phase<pg8::EpiResB<false>, pg8::StaticOrder, true, true>(lds, g, S, E, tid); } SEAM(15); }
    if (IN(16)) { const int tid = FRESH_TID(); REP(16) { if (rep_) __syncthreads(); norm_phase<true, true, true>(XB, XCB, false, in[5] + D, MOD1, 3, A, in[18], in[19], tok_e, tok_w, rw + RW_HIST, lds, wg, G, tid); } SEAM(16); }
    if (IN(17)) { const int tid = FRESH_TID(); REP(17) { if (rep_) __syncthreads(); route_phase(ws, lds, wg, G, tid); } SEAM(17); }
    if (IN(18)) { const int tid = FRESH_TID(); REP(18) { if (rep_) __syncthreads(); const int nT = __builtin_amdgcn_readfirstlane(rw[RW_NTILES]); DEPHASE(D); pg8::Gemm g{(const bf16*)(ws + WS_A), (const bf16*)(ws + WS_MWGU), nT * 256, NEXP * 2 * FFH, D / 2, (const int*)(ws + WS_ROWTOK)};
        LAS int* te_l = (LAS int*)(lds + LDSCTL_OFF + 1024); for (int i = tid; i < 264; i += NTHR) te_l[i] = rw[RW_TILE_E + i]; __syncthreads();
        pg8::MoeOrder S; S.init_moe(nT, 22, te_l, G, ORDER_ID()); pg8::EpiSwigluF8 E{(unsigned char*)(ws + WS_HSORT)};
        pg8::gemm_phase<pg8::EpiSwigluF8, pg8::MoeOrder, true, true, true, true>(lds, g, S, E, tid); } SEAM(18); }
    if (IN(19)) { const int tid = FRESH_TID(); REP(19) { if (rep_) __syncthreads(); const int nT = __builtin_amdgcn_readfirstlane(rw[RW_NTILES]); DEPHASE(FFH); pg8::Gemm g{(const bf16*)(ws + WS_HSORT), (const bf16*)(ws + WS_MWD), nT * 256, NEXP * D, FFH / 2};
        LAS int* te_l = (LAS int*)(lds + LDSCTL_OFF + 1024); for (int i = tid; i < 264; i += NTHR) te_l[i] = rw[RW_TILE_E + i]; __syncthreads();
        pg8::MoeOrder S; S.init_moe(nT, 4, te_l, G, ORDER_ID()); pg8::EpiMoeDownF8 E{(bf16*)(ws + WS_OPAIR), row_w};
        pg8::gemm_phase<pg8::EpiMoeDownF8, pg8::MoeOrder, true, true, true>(lds, g, S, E, tid); } SEAM(19); }
    if (IN(20)) { const int tid = FRESH_TID(); final_phase(XB, p.out, (const bf16*)(ws + WS_OPAIR), pair_pos, MOD1, in[22], wg, G, tid); }
#undef IN
#undef MOD
#undef A
#undef Pb
#undef Yb
#undef Hb
#undef Gt
#undef XC
#undef XB
#undef XCB
#undef HF
#undef HB
#undef rw
#undef tok_e
#undef tok_w
#undef pair_pos
#undef row_w
#undef MOD1
#undef SEAM
}

extern "C" void kernel_launch(void* const* d_in, const int* in_sizes, int n_in, void* d_out, int out_size, void* d_ws, size_t ws_size, hipStream_t stream) {
    static int grid = 0;
    if (grid == 0) {
        if (n_in != 23 || in_sizes[0] != NLAT * D || out_size != NLAT * D || ws_size < WS_END) { fprintf(stderr, "kernel_launch: unexpected problem shape (n_in %d, out %d, ws %zu); nothing launched\n", n_in, out_size, ws_size); grid = -1; return; }
        int dev = 0, cus = 0;
        if (hipGetDevice(&dev) != hipSuccess || hipDeviceGetAttribute(&cus, hipDeviceAttributeMultiprocessorCount, dev) != hipSuccess) { grid = -1; return; }
        if (hipFuncSetAttribute((const void*)fwd_kernel, hipFuncAttributeMaxDynamicSharedMemorySize, LDS_BYTES) != hipSuccess) { fprintf(stderr, "kernel_launch: hipFuncSetAttribute failed\n"); grid = -1; return; }
        int per_cu = 0;
        if (hipOccupancyMaxActiveBlocksPerMultiprocessor(&per_cu, (const void*)fwd_kernel, NTHR, LDS_BYTES) != hipSuccess || per_cu < 1) { fprintf(stderr, "kernel_launch: occupancy query says %d blocks per CU\n", per_cu); }
        (void)hipGetLastError();
        grid = cus;
    }
    if (grid < 0) return;
    if (hipMemsetAsync((char*)d_ws + WS_CTL, 0, CTL_ZERO_BYTES, stream) != hipSuccess) return;
    Params p{};
    for (int i = 0; i < 23; ++i) p.in[i] = (const float*)d_in[i];
    p.out = (float*)d_out; p.ws = (unsigned char*)d_ws;
#if MK_SINGLE
    p.ph_lo = 0; p.ph_hi = NPH;
    hipLaunchKernelGGL(fwd_kernel, dim3(grid), dim3(NTHR), LDS_BYTES, stream, p);
#else
    for (int k = 0; k < NPH; ++k) { p.ph_lo = k; p.ph_hi = k + 1; hipLaunchKernelGGL(fwd_kernel, dim3(grid), dim3(NTHR), LDS_BYTES, stream, p); }
#endif
}
```
